# Optimizing an MI355X kernel written in HIP

```python
import math
import jax, jax.numpy as jnp
from jax import lax
import numpy as np

D_MODEL = 1024
BATCH = 16
SEQ = 2048
DEPTH = 2

HEAD_DIM = 64
N_MEM_HEADS = 4
MEM_WIDTH = N_MEM_HEADS * HEAD_DIM
SEQ_WIDTH = D_MODEL - MEM_WIDTH
N_MEM = 256
ROPE_THETA = 10000.0
DSA_HEADS = SEQ_WIDTH // HEAD_DIM
IDX_HEADS = 8
IDX_DIM = 64
DSA_MAX_TOPK = 256
SPARSE_Q_BLOCK = 32
GLA_HEADS = 4
GLA_DV = SEQ_WIDTH // GLA_HEADS
GLA_DK = GLA_DV // 2
GLA_GATE_RANK = 16
GLA_TAU = 16.0
GLA_CHUNK = 64
N_GROUPS = 4
EXPERTS_PER_GROUP = 8
EXPERT_TOPK = 2
EXPERT_FF = 256
ALPHA = (2 * DEPTH) ** 0.25
BETA = (8 * DEPTH) ** -0.25
LN_EPS = 1e-5
RMS_EPS = 1e-6
N_DSA_LAYERS = (DEPTH + 1) // 2
N_GLA_LAYERS = DEPTH // 2

DSA_SPLITS = [SEQ_WIDTH, SEQ_WIDTH, SEQ_WIDTH, IDX_HEADS * IDX_DIM, IDX_DIM, IDX_HEADS, MEM_WIDTH]
GLA_SPLITS = [GLA_HEADS * GLA_DK, GLA_HEADS * GLA_DK, SEQ_WIDTH, SEQ_WIDTH, GLA_GATE_RANK, MEM_WIDTH]
DSA_IN_WIDTH = sum(DSA_SPLITS)
GLA_IN_WIDTH = sum(GLA_SPLITS)

kernel_name = "hybrid_dsa_gla_memory_hmoe_deepnorm"


def _split(a, sizes):
    return jnp.split(a, list(np.cumsum(sizes)[:-1]), axis=-1)


def layer_norm(x, g, b):
    xf = x.astype(jnp.float32)
    mu = jnp.mean(xf, -1, keepdims=True)
    var = jnp.mean(jnp.square(xf - mu), -1, keepdims=True)
    return ((xf - mu) * lax.rsqrt(var + LN_EPS) * g + b).astype(x.dtype)


def rope_tables(positions, dim):
    inv = ROPE_THETA ** (-jnp.arange(0, dim, 2, dtype=jnp.float32) / dim)
    ang = positions.astype(jnp.float32)[..., None] * inv
    return jnp.cos(ang), jnp.sin(ang)


def apply_rope(x, cos, sin):
    xf = x.astype(jnp.float32)
    x1, x2 = jnp.split(xf, 2, axis=-1)
    return jnp.concatenate([x1 * cos - x2 * sin, x2 * cos + x1 * sin], -1).astype(x.dtype)


def memory_attention(qm, mem, w_kv):
    B, M, _ = mem.shape
    km, vm = jnp.split(mem @ w_kv, 2, axis=-1)
    km = km.reshape(B, M, N_MEM_HEADS, HEAD_DIM)
    vm = vm.reshape(B, M, N_MEM_HEADS, HEAD_DIM)
    logits = jnp.einsum('bshd,bmhd->bhsm', qm, km).astype(jnp.float32) * HEAD_DIM ** -0.5
    p = jax.nn.softmax(logits, axis=-1).astype(vm.dtype)
    return jnp.einsum('bhsm,bmhd->bshd', p, vm)


def sparse_attention(q, k, v, qi, ki, wi, topk):
    B, S, H, dh = q.shape
    nb = S // SPARSE_Q_BLOCK
    spos = jnp.arange(S)
    gather = jax.vmap(lambda a, i: a[i])

    def to_blocks(a):
        return a.reshape((B, nb, SPARSE_Q_BLOCK) + a.shape[2:]).swapaxes(0, 1)

    def block(args):
        start, qb, qib, wib = args
        tpos = start + jnp.arange(SPARSE_Q_BLOCK)
        rel = jax.nn.relu(jnp.einsum('bqhd,bsd->bqhs', qib, ki))
        score = jnp.einsum('bqhs,bqh->bqs', rel, wib).astype(jnp.float32)
        causal = spos[None, :] <= tpos[:, None]
        score = jnp.where(causal[None], score, -jnp.inf)
        _, sel = lax.top_k(score, topk)
        valid = sel <= tpos[None, :, None]
        kg = gather(k, sel)
        vg = gather(v, sel)
        logits = jnp.einsum('bqhd,bqkhd->bqhk', qb, kg).astype(jnp.float32) * dh ** -0.5
        logits = jnp.where(valid[:, :, None, :], logits, -jnp.inf)
        p = jax.nn.softmax(logits, axis=-1).astype(vg.dtype)
        return jnp.einsum('bqhk,bqkhd->bqhd', p, vg)

    starts = jnp.arange(nb, dtype=jnp.int32) * SPARSE_Q_BLOCK
    out = lax.map(block, (starts, to_blocks(q), to_blocks(qi), to_blocks(wi)))
    return out.swapaxes(0, 1).reshape(B, S, H, dh)


def dsa_mixer(x, cos, sin, w_in, idx_k_g, idx_k_b):
    B, S, _ = x.shape
    q, k, v, qi, ki, wi, qm = _split(x @ w_in, DSA_SPLITS)
    c4, s4 = cos[:, :, None, :], sin[:, :, None, :]
    q = apply_rope(q.reshape(B, S, DSA_HEADS, HEAD_DIM), c4, s4)
    k = apply_rope(k.reshape(B, S, DSA_HEADS, HEAD_DIM), c4, s4)
    v = v.reshape(B, S, DSA_HEADS, HEAD_DIM)
    qi = apply_rope(qi.reshape(B, S, IDX_HEADS, IDX_DIM), c4, s4)
    ki = apply_rope(layer_norm(ki, idx_k_g, idx_k_b), cos, sin)
    wi = wi * (IDX_HEADS ** -0.5 * IDX_DIM ** -0.5)
    topk = min(DSA_MAX_TOPK, S // 4)
    out = sparse_attention(q, k, v, qi, ki, wi, topk)
    return out.reshape(B, S, SEQ_WIDTH), qm


def gla_chunked(q, k, v, g):
    B, S, H, dk = q.shape
    dv = v.shape[-1]
    C = GLA_CHUNK
    nc = S // C

    def chunks(a):
        return a.astype(jnp.float32).reshape(B, nc, C, H, a.shape[-1]).transpose(1, 0, 3, 2, 4)

    tri = jnp.tril(jnp.ones((C, C), bool))[:, :, None]

    def step(state, inp):
        qc, kc, vc, gc = inp
        b = jnp.cumsum(gc, axis=2)
        o_inter = jnp.einsum('bhcd,bhde->bhce', qc * jnp.exp(b), state)
        diff = b[:, :, :, None, :] - b[:, :, None, :, :]
        decay = jnp.where(tri, jnp.exp(jnp.where(tri, diff, 0.0)), 0.0)
        attn = jnp.einsum('bhid,bhjd,bhijd->bhij', qc, kc, decay)
        o_intra = jnp.einsum('bhij,bhje->bhie', attn, vc)
        b_last = b[:, :, -1, :]
        state = state * jnp.exp(b_last)[..., None] + jnp.einsum(
            'bhjd,bhje->bhde', kc * jnp.exp(b_last[:, :, None, :] - b), vc)
        return state, o_inter + o_intra

    state0 = jnp.zeros((B, H, dk, dv), jnp.float32)
    _, o = lax.scan(step, state0, (chunks(q), chunks(k), chunks(v), chunks(g)))
    return o.transpose(1, 0, 3, 2, 4).reshape(B, S, H, dv)


def gla_mixer(x, w_in, w_gate, b_gate, norm_g):
    B, S, _ = x.shape
    q, k, v, r, a1, qm = _split(x @ w_in, GLA_SPLITS)
    q = q.reshape(B, S, GLA_HEADS, GLA_DK) * GLA_DK ** -0.5
    k = k.reshape(B, S, GLA_HEADS, GLA_DK)
    v = v.reshape(B, S, GLA_HEADS, GLA_DV)
    g = jax.nn.log_sigmoid((a1 @ w_gate + b_gate).astype(jnp.float32)) / GLA_TAU
    g = g.reshape(B, S, GLA_HEADS, GLA_DK)
    o = gla_chunked(q, k, v, g)
    o = o * lax.rsqrt(jnp.mean(jnp.square(o), -1, keepdims=True) + RMS_EPS) * norm_g
    o = o.astype(x.dtype) * jax.nn.silu(r.reshape(B, S, GLA_HEADS, GLA_DV))
    return o.reshape(B, S, SEQ_WIDTH), qm


def hier_moe(x, w_group, b_group, w_router, b_router, w13, w2):
    B, S, D = x.shape
    t = x.reshape(-1, D)
    glog = (t @ w_group + b_group).astype(jnp.float32)
    gprob = jax.nn.softmax(glog, axis=-1)
    gsel = jnp.argmax(glog, axis=-1)
    pg = jnp.take_along_axis(gprob, gsel[:, None], axis=1)[:, 0]
    elog = (jnp.einsum('td,gde->tge', t, w_router) + b_router).astype(jnp.float32)
    elog = jnp.take_along_axis(elog, gsel[:, None, None], axis=1)[:, 0]
    top_v, top_i = lax.top_k(elog, EXPERT_TOPK)
    wts = jax.nn.softmax(top_v, axis=-1) * pg[:, None]
    emask = jnp.sum(jax.nn.one_hot(top_i, EXPERTS_PER_GROUP, dtype=jnp.float32) * wts[..., None], axis=1)
    comb = jax.nn.one_hot(gsel, N_GROUPS, dtype=jnp.float32)[:, :, None] * emask[:, None, :]
    y = jnp.zeros(t.shape, jnp.float32)
    for gi in range(N_GROUPS):
        h = jnp.einsum('td,edf->tef', t, w13[gi])
        a, u = jnp.split(h, 2, axis=-1)
        act = jax.nn.silu(a) * u * comb[:, gi, :, None].astype(h.dtype)
        y = y + jnp.einsum('tef,efd->td', act, w2[gi]).astype(jnp.float32)
    return y.astype(x.dtype).reshape(B, S, D)


def setup_inputs(seed: int = 0) -> dict:
    key = jax.random.key(seed)
    ks = jax.random.split(key, 24)
    f32 = jnp.float32

    def nrm(k, shape, fan_in, scale=1.0):
        return jax.random.normal(k, shape, f32) * (scale * fan_in ** -0.5)

    def small(k, shape, s):
        return jax.random.normal(k, shape, f32) * s

    G, E, F = N_GROUPS, EXPERTS_PER_GROUP, EXPERT_FF
    offsets = jax.random.randint(ks[2], (BATCH, 1), 0, 4096, dtype=jnp.int32)
    positions = (offsets + jnp.arange(SEQ, dtype=jnp.int32)[None, :]).astype(jnp.int32)
    return {
        "x": jax.random.normal(ks[0], (BATCH, SEQ, D_MODEL), f32),
        "mem": jax.random.normal(ks[1], (BATCH, N_MEM, D_MODEL), f32),
        "positions": positions,
        "dsa_w_in": nrm(ks[3], (N_DSA_LAYERS, D_MODEL, DSA_IN_WIDTH), D_MODEL),
        "dsa_idx_k_g": 1.0 + small(ks[4], (N_DSA_LAYERS, IDX_DIM), 0.02),
        "dsa_idx_k_b": small(ks[5], (N_DSA_LAYERS, IDX_DIM), 0.02),
        "gla_w_in": nrm(ks[6], (N_GLA_LAYERS, D_MODEL, GLA_IN_WIDTH), D_MODEL),
        "gla_w_gate": nrm(ks[7], (N_GLA_LAYERS, GLA_GATE_RANK, GLA_HEADS * GLA_DK), GLA_GATE_RANK),
        "gla_b_gate": small(ks[8], (N_GLA_LAYERS, GLA_HEADS * GLA_DK), 0.02),
        "gla_norm_g": 1.0 + small(ks[9], (N_GLA_LAYERS, GLA_DV), 0.02),
        "w_mem_kv": nrm(ks[10], (DEPTH, D_MODEL, 2 * MEM_WIDTH), D_MODEL),
        "w_out": nrm(ks[11], (DEPTH, D_MODEL, D_MODEL), D_MODEL, BETA),
        "ln1_g": 1.0 + small(ks[12], (DEPTH, D_MODEL), 0.02),
        "ln1_b": small(ks[13], (DEPTH, D_MODEL), 0.02),
        "ln2_g": 1.0 + small(ks[14], (DEPTH, D_MODEL), 0.02),
        "ln2_b": small(ks[15], (DEPTH, D_MODEL), 0.02),
        "moe_w_group": nrm(ks[16], (DEPTH, D_MODEL, G), D_MODEL),
        "moe_b_group": small(ks[17], (DEPTH, G), 0.01),
        "moe_w_router": nrm(ks[18], (DEPTH, G, D_MODEL, E), D_MODEL),
        "moe_b_router": small(ks[19], (DEPTH, G, E), 0.01),
        "moe_w13": nrm(ks[20], (DEPTH, G, E, D_MODEL, 2 * F), D_MODEL),
        "moe_w2": nrm(ks[21], (DEPTH, G, E, F, D_MODEL), F, BETA),
    }


def reference(x, mem, positions, dsa_w_in, dsa_idx_k_g, dsa_idx_k_b, gla_w_in, gla_w_gate,
              gla_b_gate, gla_norm_g, w_mem_kv, w_out, ln1_g, ln1_b, ln2_g, ln2_b,
              moe_w_group, moe_b_group, moe_w_router, moe_b_router, moe_w13, moe_w2):
    B, S, _ = x.shape
    cos, sin = rope_tables(positions, HEAD_DIM)
    ia = 0
    ib = 0
    for i in range(DEPTH):
        if i % 2 == 0:
            seq_out, qm = dsa_mixer(x, cos, sin, dsa_w_in[ia], dsa_idx_k_g[ia], dsa_idx_k_b[ia])
            ia += 1
        else:
            seq_out, qm = gla_mixer(x, gla_w_in[ib], gla_w_gate[ib], gla_b_gate[ib], gla_norm_g[ib])
            ib += 1
        mem_out = memory_attention(qm.reshape(B, S, N_MEM_HEADS, HEAD_DIM), mem, w_mem_kv[i])
        mixed = jnp.concatenate([seq_out, mem_out.reshape(B, S, MEM_WIDTH)], axis=-1) @ w_out[i]
        x = layer_norm(ALPHA * x + mixed, ln1_g[i], ln1_b[i])
        ffn = hier_moe(x, moe_w_group[i], moe_b_group[i], moe_w_router[i], moe_b_router[i],
                       moe_w13[i], moe_w2[i])
        x = layer_norm(ALPHA * x + ffn, ln2_g[i], ln2_b[i])
    return x
```

```cpp
#include <hip/hip_runtime.h>
#include <cstdio>
#include <cstdint>

#define LAS __attribute__((address_space(3)))
#define GAS __attribute__((address_space(1)))
typedef unsigned short bf16_t;
typedef short bf16x8 __attribute__((ext_vector_type(8)));
typedef short s16x4 __attribute__((ext_vector_type(4)));
typedef float f32x4 __attribute__((ext_vector_type(4)));
typedef float f32x2 __attribute__((ext_vector_type(2)));
typedef float f32x16 __attribute__((ext_vector_type(16)));
typedef unsigned u32x4 __attribute__((ext_vector_type(4)));
typedef unsigned u32x2 __attribute__((ext_vector_type(2)));

#ifndef N_LAUNCH_MODE
#define N_LAUNCH_MODE 0
#endif

constexpr int NB = 16, SEQ = 2048, DM = 1024, NT = NB * SEQ;
constexpr int NMEM = 256;
constexpr int ND = 3328;
constexpr int NG = 2816;
constexpr int DSA_W = 3144, GLA_W = 2576;
constexpr int NEXP = 32;
constexpr int SLOT_ROWS = 73728;
constexpr float ALPHA = 1.4142135623730951f;
constexpr float LN_EPS = 1e-5f, RMS_EPS = 1e-6f;
constexpr float LOG2E = 1.4426950408889634f;
constexpr float C2 = 0.125f * LOG2E;
constexpr int NWAVES = 8;

constexpr size_t MiB = 1u << 20;
constexpr size_t WS_CTL = 0, CTL_ZERO_BYTES = 1 * MiB;
constexpr size_t WS_ROPEC = 1 * MiB, WS_ROPES = 5 * MiB;
constexpr size_t WS_DEC = 9 * MiB;
constexpr size_t WS_WD = 10 * MiB, WS_WG = 17 * MiB, WS_WKV = 23 * MiB, WS_WO = 25 * MiB, WS_W13 = 29 * MiB, WS_W2 = 61 * MiB;
constexpr size_t WS_KVM = 77 * MiB;
constexpr size_t WS_MEMB = 85 * MiB;
constexpr size_t WS_LISTTOK = 85 * MiB, WS_LISTW = 89 * MiB;
constexpr size_t WS_TOKSLOT = 93 * MiB;
constexpr size_t WS_A = 96 * MiB;
constexpr size_t WS_B = 160 * MiB;
constexpr size_t WS_C = 288 * MiB;
constexpr size_t WS_D = 352 * MiB;
constexpr size_t WS_END = 500 * MiB;
constexpr size_t WS_XB = WS_A;
constexpr size_t WS_Q = 160 * MiB, WS_K = 208 * MiB, WS_V = 256 * MiB, WS_QI = 304 * MiB, WS_QM = 336 * MiB, WS_KIW = 352 * MiB, WS_KI = 362 * MiB, WS_WI = 366 * MiB, WS_MASK = 368 * MiB, WS_AO0 = 376 * MiB;
constexpr size_t WS_X1 = WS_B, WS_X1B0 = WS_C, WS_ACT0 = WS_A, WS_Y = WS_D;
constexpr size_t WS_GV = 96 * MiB, WS_GQM = 144 * MiB, WS_GQ = 352 * MiB, WS_GK = 376 * MiB, WS_GR = 400 * MiB, WS_A1 = 448 * MiB, WS_KPT = 450 * MiB, WS_VT = WS_C, WS_AO1 = WS_C;
constexpr size_t WS_X1B1 = WS_A, WS_ACT1 = WS_C;
constexpr int KIW_P = 80;

constexpr int CW_CNT = 64;
constexpr int CW_BAR = 4096;

__device__ __forceinline__ unsigned f2bf(float f) { unsigned u = __builtin_bit_cast(unsigned, f); return (u + 0x7fffu + ((u >> 16) & 1u)) >> 16; }
__device__ __forceinline__ unsigned pk2(float lo, float hi) { return f2bf(lo) | (f2bf(hi) << 16); }
__device__ __forceinline__ float bf2f(unsigned h) { return __builtin_bit_cast(float, h << 16); }
__device__ __forceinline__ float wave_sum(float v) {
#pragma unroll
    for (int o = 1; o < 64; o <<= 1) v += __shfl_xor(v, o);
    return v;
}
__device__ __forceinline__ float fast_exp2(float x) { return __builtin_amdgcn_exp2f(x); }
__device__ __forceinline__ float silu_f(float a) { return a * __builtin_amdgcn_rcpf(1.f + fast_exp2(-a * LOG2E)); }

namespace pg8 {
constexpr int BM = 256, BK = 64, HALF = 128, HTB = HALF * BK * 2, STAGE_BYTES = 8 * HTB, NXCD = 8, WGM = 8;
__host__ __device__ __forceinline__ int lds_byte(int r, int c) { const int st = (r >> 4) * 2 + (c >> 5), rr = r & 15, cc = c & 31, ob = rr * 64 + cc * 2; return st * 1024 + (ob ^ (((ob >> 9) & 1) << 5)); }
__host__ __device__ __forceinline__ void stage_rc(int b, int& R, int& C) { const int st = b / 1024, sb = b % 1024, swz = sb ^ (((sb >> 9) & 1) << 5); R = (st >> 1) * 16 + swz / 64; C = (st & 1) * 32 + (swz % 64) / 2; }
__host__ __device__ __forceinline__ int perm32(int rho) { const int n = rho >> 4, i = rho & 15; return 8 * (i >> 2) + 4 * n + (i & 3); }

struct Unit { int pm, pn, e, r0; };
struct Gemm { const bf16_t* A; const bf16_t* Bt; int M, N, K; };

struct StaticOrder {
    int nM, nN, nwg, G, c;
    __device__ void init(int M, int N, int G_, int c_) { nM = M / BM; nN = N / BM; nwg = nM * nN; G = G_; c = c_; }
    __device__ bool next(int i, Unit& u) const {
        const long L = (long)i * G + c; if (L >= nwg) return false;
        int wgid = (int)L; { const int q = nwg / NXCD, r = nwg % NXCD, xcd = wgid % NXCD, off = wgid / NXCD; wgid = (xcd < r ? xcd * (q + 1) : r * (q + 1) + (xcd - r) * q) + off; }
        const int nig = WGM * nN, gid = wgid / nig, fm = gid * WGM, gsz = (nM - fm) < WGM ? (nM - fm) : WGM;
        u.pm = fm + ((wgid % nig) % gsz); u.pn = (wgid % nig) / gsz; u.e = 0; u.r0 = 0; return true;
    }
    __device__ __forceinline__ int rowidx(const Unit& u, int r) const { return u.pm * BM + r; }
};

typedef __bf16 bf16x2_t __attribute__((ext_vector_type(2)));
__device__ __forceinline__ unsigned cvt_pk_bf16(float lo, float hi) { f32x2 v = {lo, hi}; bf16x2_t b = __builtin_convertvector(v, bf16x2_t); return __builtin_bit_cast(unsigned, b); }

template <class Epi, class Sched, bool ALIGN_EPI, bool SP2>
__device__ __forceinline__ void gemm_phase(LAS unsigned char* lds, const Gemm g, const Sched& S, const Epi& E) {
    const int tid = threadIdx.x, wid = __builtin_amdgcn_readfirstlane(tid >> 6), lane = tid & 63, wr = wid >> 2, wc = wid & 3, fr = lane & 15, fq = lane >> 4;
    const int K = g.K, nt = K / BK;
    int RA[2], CA[2]; unsigned voffB[2];
#pragma unroll
    for (int i = 0; i < 2; ++i) { int R, C; stage_rc(tid * 16 + i * 8192, R, C); const int Rb = (R & ~31) + perm32(R & 31);
        RA[i] = R; CA[i] = C; voffB[i] = (unsigned)(Rb * K + C) * 2u; }
    const size_t kstep = (size_t)(BK * 2);
    const size_t hstep = (size_t)HALF * K * 2;
    const size_t tstep = 2 * hstep;
    const unsigned ldsw = (unsigned)wid * 1024u;
    const int aoff = lds_byte(wr * 64 + fr, fq * 8), boff = lds_byte(wc * 32 + fr, fq * 8);
#define PG8_SA(b, h) (((b) * 2 + (h)) * HTB)
#define PG8_SB(b, h) ((4 + (b) * 2 + (h)) * HTB)
#define PG8_STAGE(bufoff, gbase, voff) do { _Pragma("unroll") for (int _i = 0; _i < 2; ++_i) \
        __builtin_amdgcn_global_load_lds((const unsigned*)((const char*)(gbase) + (voff)[_i]), (LAS unsigned*)(lds + (bufoff) + ldsw + _i * 8192), 16, 0, 0); } while (0)
#define PG8_LDA(dst, b, h) do { _Pragma("unroll") for (int m = 0; m < 4; ++m) _Pragma("unroll") for (int k = 0; k < 2; ++k) dst[m][k] = *(const LAS bf16x8*)(lds + PG8_SA(b, h) + aoff + m * 2048 + k * 1024); } while (0)
#define PG8_LDB(dst, b, h) do { _Pragma("unroll") for (int n = 0; n < 2; ++n) _Pragma("unroll") for (int k = 0; k < 2; ++k) dst[n][k] = *(const LAS bf16x8*)(lds + PG8_SB(b, h) + boff + n * 2048 + k * 1024); } while (0)
#define PG8_MMA(ai, bj, At, Bt) do { __builtin_amdgcn_s_setprio(1); _Pragma("unroll") for (int m = 0; m < 4; ++m) _Pragma("unroll") for (int n = 0; n < 2; ++n) _Pragma("unroll") for (int k = 0; k < 2; ++k) \
        acc[ai][bj][m][n] = __builtin_amdgcn_mfma_f32_16x16x32_bf16(Bt[n][k], At[m][k], acc[ai][bj][m][n], 0, 0, 0); __builtin_amdgcn_s_setprio(0); } while (0)
#define PG8_WAIT_V(n) asm volatile("s_waitcnt vmcnt(" #n ")" ::: "memory")
#define PG8_WAIT_L(n) asm volatile("s_waitcnt lgkmcnt(" #n ")" ::: "memory")
#define PG8_BAR __builtin_amdgcn_s_barrier()
#define PG8_SCHED __builtin_amdgcn_sched_barrier(0)
#define PG8_MKOFF(o0, o1, u) do { _Pragma("unroll") for (int _i = 0; _i < 2; ++_i) { \
        o0[_i] = ((unsigned)S.rowidx(u, RA[_i]) * (unsigned)K + (unsigned)CA[_i]) * 2u; o1[_i] = ((unsigned)S.rowidx(u, HALF + RA[_i]) * (unsigned)K + (unsigned)CA[_i]) * 2u; } } while (0)
    Unit cur, nxt; int ui = 0;
    if (!S.next(0, cur)) return;
    f32x4 acc[2][2][4][2];
#pragma unroll
    for (int a = 0; a < 2; ++a)
#pragma unroll
        for (int b = 0; b < 2; ++b)
#pragma unroll
            for (int m = 0; m < 4; ++m)
#pragma unroll
                for (int n = 0; n < 2; ++n) acc[a][b][m][n] = (f32x4){0.f, 0.f, 0.f, 0.f};
    bf16x8 At[4][2], B0[2][2], B1[2][2];
    const char* const gA = (const char*)g.A;
    unsigned cO0[2], cO1[2], nO0[2], nO1[2];
    PG8_MKOFF(cO0, cO1, cur);
    const char* cB = (const char*)g.Bt + (size_t)cur.pn * tstep;
    if constexpr (SP2) {
        PG8_STAGE(PG8_SB(0, 0), cB, voffB); PG8_STAGE(PG8_SB(0, 1), cB + hstep, voffB); PG8_STAGE(PG8_SA(0, 0), gA, cO0); PG8_STAGE(PG8_SA(0, 1), gA, cO1);
        if (wr == 1) PG8_BAR;
        PG8_WAIT_V(2); PG8_BAR;
        PG8_STAGE(PG8_SB(1, 0), cB + kstep, voffB); PG8_STAGE(PG8_SA(1, 0), gA + kstep, cO0); PG8_STAGE(PG8_SB(1, 1), cB + hstep + kstep, voffB);
        PG8_WAIT_V(6); PG8_BAR;
    } else {
        PG8_STAGE(PG8_SB(0, 0), cB, voffB); PG8_STAGE(PG8_SA(0, 0), gA, cO0); PG8_STAGE(PG8_SB(0, 1), cB + hstep, voffB); PG8_STAGE(PG8_SA(0, 1), gA, cO1);
        if (wr == 1) PG8_BAR;
        PG8_WAIT_V(4); PG8_BAR;
        PG8_STAGE(PG8_SB(1, 0), cB + kstep, voffB); PG8_STAGE(PG8_SA(1, 0), gA + kstep, cO0); PG8_STAGE(PG8_SB(1, 1), cB + hstep + kstep, voffB);
        PG8_WAIT_V(6); PG8_BAR;
    }
    for (;;) {
        const bool has_next = S.next(ui + 1, nxt);
        if (has_next) { PG8_MKOFF(nO0, nO1, nxt); } else {
#pragma unroll
            for (int _i = 0; _i < 2; ++_i) { nO0[_i] = cO0[_i]; nO1[_i] = cO1[_i]; } }
        const char* nB = has_next ? (const char*)g.Bt + (size_t)nxt.pn * tstep : cB;
#pragma unroll 1
        for (int t = 0; t < nt; t += 2) {
            const bool last = (t == nt - 2);
            const char* a1 = gA + (size_t)(t + 1) * kstep;
            const char* a2 = last ? gA : gA + (size_t)(t + 2) * kstep; const char* b2 = last ? nB : cB + (size_t)(t + 2) * kstep;
            const char* a3 = a2 + kstep; const char* b3 = b2 + kstep;
            unsigned x0[2], x1[2];
#pragma unroll
            for (int _i = 0; _i < 2; ++_i) { x0[_i] = last ? nO0[_i] : cO0[_i]; x1[_i] = last ? nO1[_i] : cO1[_i]; }
            if constexpr (SP2) {
            PG8_LDB(B0, 0, 0); PG8_LDB(B1, 0, 1); PG8_SCHED; PG8_LDA(At, 0, 0); PG8_STAGE(PG8_SA(1, 1), a1, cO1);
            PG8_WAIT_V(8); PG8_WAIT_L(0); PG8_BAR; PG8_MMA(0, 0, At, B0); PG8_MMA(0, 1, At, B1); PG8_BAR; PG8_SCHED;
            PG8_LDA(At, 0, 1); PG8_STAGE(PG8_SB(0, 0), b2, voffB); PG8_STAGE(PG8_SB(0, 1), b2 + hstep, voffB); PG8_STAGE(PG8_SA(0, 0), a2, x0);
            PG8_WAIT_V(8); PG8_WAIT_L(0); PG8_BAR; PG8_MMA(1, 0, At, B0); PG8_MMA(1, 1, At, B1); PG8_BAR; PG8_SCHED;
            PG8_LDB(B0, 1, 0); PG8_LDB(B1, 1, 1); PG8_SCHED; PG8_LDA(At, 1, 0); PG8_STAGE(PG8_SA(0, 1), a2, x1);
            PG8_WAIT_V(8); PG8_WAIT_L(0); PG8_BAR; PG8_MMA(0, 0, At, B0); PG8_MMA(0, 1, At, B1); PG8_BAR; PG8_SCHED;
            PG8_LDA(At, 1, 1); PG8_STAGE(PG8_SB(1, 0), b3, voffB); PG8_STAGE(PG8_SB(1, 1), b3 + hstep, voffB); PG8_STAGE(PG8_SA(1, 0), a3, x0);
            PG8_WAIT_V(8); PG8_WAIT_L(0); PG8_BAR; PG8_MMA(1, 0, At, B0); PG8_MMA(1, 1, At, B1); PG8_BAR; PG8_SCHED;
            } else {
            PG8_LDB(B0, 0, 0); PG8_SCHED; PG8_LDA(At, 0, 0); PG8_STAGE(PG8_SA(1, 1), a1, cO1);
            PG8_WAIT_L(8); PG8_BAR; PG8_WAIT_L(0); PG8_MMA(0, 0, At, B0); PG8_BAR; PG8_SCHED;
            PG8_LDB(B1, 0, 1); PG8_STAGE(PG8_SB(0, 0), b2, voffB);
            PG8_BAR; PG8_WAIT_L(0); PG8_MMA(0, 1, At, B1); PG8_BAR;
            PG8_LDA(At, 0, 1); PG8_STAGE(PG8_SA(0, 0), a2, x0);
            PG8_BAR; PG8_WAIT_L(0); PG8_MMA(1, 0, At, B0); PG8_BAR; PG8_SCHED;
            PG8_STAGE(PG8_SB(0, 1), b2 + hstep, voffB);
            PG8_WAIT_V(6); PG8_BAR; PG8_MMA(1, 1, At, B1); PG8_BAR;
            PG8_LDB(B0, 1, 0); PG8_SCHED; PG8_LDA(At, 1, 0); PG8_STAGE(PG8_SA(0, 1), a2, x1);
            PG8_WAIT_L(8); PG8_BAR; PG8_WAIT_L(0); PG8_MMA(0, 0, At, B0); PG8_BAR; PG8_SCHED;
            PG8_LDB(B1, 1, 1); PG8_STAGE(PG8_SB(1, 0), b3, voffB);
            PG8_BAR; PG8_WAIT_L(0); PG8_MMA(0, 1, At, B1); PG8_BAR;
            PG8_LDA(At, 1, 1); PG8_STAGE(PG8_SA(1, 0), a3, x0);
            PG8_BAR; PG8_WAIT_L(0); PG8_MMA(1, 0, At, B0); PG8_BAR; PG8_SCHED;
            PG8_STAGE(PG8_SB(1, 1), b3 + hstep, voffB);
            PG8_WAIT_V(6); PG8_BAR; PG8_MMA(1, 1, At, B1); PG8_BAR;
            }
        }
        if constexpr (ALIGN_EPI) { if (wr == 0) PG8_BAR; }
        E(acc, cur, wr, wc, fr, fq);
        if (!has_next) break;
#pragma unroll
        for (int a = 0; a < 2; ++a)
#pragma unroll
            for (int b = 0; b < 2; ++b)
#pragma unroll
                for (int m = 0; m < 4; ++m)
#pragma unroll
                    for (int n = 0; n < 2; ++n) acc[a][b][m][n] = (f32x4){0.f, 0.f, 0.f, 0.f};
        cur = nxt; cB = nB; ++ui;
#pragma unroll
        for (int _i = 0; _i < 2; ++_i) { cO0[_i] = nO0[_i]; cO1[_i] = nO1[_i]; }
        if constexpr (ALIGN_EPI) { if (wr == 1) PG8_BAR; }
    }
    PG8_WAIT_V(0);
    if constexpr (!ALIGN_EPI) { if (wr == 0) PG8_BAR; }
    PG8_BAR;
#undef PG8_SA
#undef PG8_SB
#undef PG8_STAGE
#undef PG8_LDA
#undef PG8_LDB
#undef PG8_MMA
#undef PG8_WAIT_V
#undef PG8_WAIT_L
#undef PG8_BAR
#undef PG8_SCHED
#undef PG8_MKOFF
}
}

#define XB_TMO      128
#define XB_XCNT(j)  (256  + 64 * (j))
#define XB_XSUB(j)  (1280 + 64 * (j))
#define XB_XGEN(j)  (2304 + 64 * (j))
#define XB_TOP      3328
#define XB_TOPGEN   3392
#define XCD_BAR_WORDS 3456
#define XB_SPIN_CAP (1u << 18)
__device__ __forceinline__ unsigned xb_ld(unsigned* p)              { return __hip_atomic_load(p, __ATOMIC_RELAXED, __HIP_MEMORY_SCOPE_AGENT); }
__device__ __forceinline__ unsigned xb_add(unsigned* p, unsigned v) { return __hip_atomic_fetch_add(p, v, __ATOMIC_RELAXED, __HIP_MEMORY_SCOPE_AGENT); }
__device__ __forceinline__ unsigned xb_xcc_id() { return (unsigned)__builtin_amdgcn_s_getreg((3 << 11) | 20) & 0xFu; }
#define XB_SPIN(cond, bar) do { unsigned _sp = 0; while (cond) { __builtin_amdgcn_s_sleep(1); \
    if ((++_sp & 255u) == 0u) { if (xb_ld(&(bar)[XB_TMO])) break; if (_sp > XB_SPIN_CAP) { atomicAdd(&(bar)[XB_TMO], 1u); break; } } } } while (0)
struct XcdBarrier { unsigned* bar; unsigned x; volatile LAS unsigned* st; };
__device__ __forceinline__ XcdBarrier xcd_barrier_post(unsigned* bar, volatile LAS unsigned* st) {
    XcdBarrier b; b.bar = bar; b.x = xb_xcc_id(); b.st = st;
    if (threadIdx.x == 0) (void)xb_add(&bar[XB_XCNT(b.x)], 1u);
    return b;
}
__device__ __forceinline__ void xcd_barrier_complete(unsigned* bar, unsigned x, unsigned& nloc, unsigned& nx) {
    const unsigned G = gridDim.x * gridDim.y * gridDim.z;
    unsigned sum, cnt, mine, sp = 0u;
    for (;;) {
        sum = 0u; cnt = 0u; mine = 0u;
#pragma unroll
        for (unsigned j = 0; j < 16; ++j) { const unsigned c = xb_ld(&bar[XB_XCNT(j)]); sum += c; cnt += (c > 0u) ? 1u : 0u; mine = (j == x) ? c : mine; }
        if (sum == G) break;
        __builtin_amdgcn_s_sleep(1);
        if ((++sp & 255u) == 0u) { if (xb_ld(&bar[XB_TMO])) break; if (sp > XB_SPIN_CAP) { atomicAdd(&bar[XB_TMO], 1u); break; } }
    }
    nloc = mine > 0u ? mine : 1u; nx = cnt > 0u ? cnt : 1u;
}
__device__ __forceinline__ void xcd_barrier(const XcdBarrier& b) {
    asm volatile("s_waitcnt vmcnt(0)" ::: "memory");
    __syncthreads();
    if (threadIdx.x == 0) {
        unsigned* bar = b.bar;
        __builtin_amdgcn_s_waitcnt(0);
        unsigned nloc = b.st[0], nx = b.st[1];
        if (nloc == 0u) { xcd_barrier_complete(bar, b.x, nloc, nx); b.st[0] = nloc; b.st[1] = nx; }
        const unsigned old = xb_add(&bar[XB_XSUB(b.x)], 1u);
        const unsigned gen = old / nloc;
        if (old + 1u == (gen + 1u) * nloc) {
            __builtin_amdgcn_fence(__ATOMIC_RELEASE, "agent");
            asm volatile("s_waitcnt vmcnt(0)" ::: "memory");
            const unsigned og = xb_add(&bar[XB_TOP], 1u);
            const unsigned tg = og / nx;
            if (og + 1u == (tg + 1u) * nx) xb_add(&bar[XB_TOPGEN], 1u);
            else XB_SPIN(xb_ld(&bar[XB_TOPGEN]) == tg, bar);
            __builtin_amdgcn_fence(__ATOMIC_ACQUIRE, "agent");
            xb_add(&bar[XB_XGEN(b.x)], 1u);
            asm volatile("s_waitcnt vmcnt(0)" ::: "memory");
        } else {
            XB_SPIN(xb_ld(&bar[XB_XGEN(b.x)]) == gen, bar);
            __builtin_amdgcn_fence(__ATOMIC_ACQUIRE, "agent");
            asm volatile("s_waitcnt vmcnt(0)" ::: "memory");
        }
    }
    __syncthreads();
}

constexpr int LDS_BYTES = 147456;
constexpr int MISC_OFF = 135168;
struct Args { const void* in[22]; float* out; unsigned char* ws; int ph_lo, ph_hi; };
struct Frame {
    LAS unsigned char* lds;
    unsigned char* ws; float* out;
    unsigned* ctl;
    int tid, lane, wave, G, gw, NGW;
};
enum { I_X = 0, I_MEM, I_POS, I_DSA_WIN, I_DSA_KG, I_DSA_KB, I_GLA_WIN, I_GLA_WGATE, I_GLA_BGATE, I_GLA_NORMG, I_WMEMKV, I_WOUT, I_LN1G, I_LN1B, I_LN2G, I_LN2B,
       I_MOE_WG, I_MOE_BG, I_MOE_WR, I_MOE_BR, I_MOE_W13, I_MOE_W2 };

__device__ __forceinline__ int dperm(int c) { return ((c >> 2) & 1) * 32 + (c >> 5) * 16 + ((c >> 3) & 3) * 4 + (c & 3); }
__device__ __forceinline__ int dperm_inv(int d) { const int n = d >> 5, i = d & 31; return (i >> 4) * 32 + ((i >> 2) & 3) * 8 + n * 4 + (i & 3); }
__device__ __forceinline__ int dsa_srccol(int n) {
    if (n < 1536) { return (n & ~63) + dperm(n & 63); }
    if (n < 2304) return n;
    if (n < 2816) { return (n & ~63) + dperm(n & 63); }
    if (n < 3072) return 2888 + (n - 2816);
    if (n < 3136) return 2816 + (n - 3072);
    if (n < 3144) return 2880 + (n - 3136);
    return -1;
}
__device__ __forceinline__ int gla_srccol(int n) {
    if (n < 2304) return n;
    if (n < 2560) return 2320 + (n - 2304);
    if (n < 2576) return 2304 + (n - 2560);
    return -1;
}
__device__ __forceinline__ int w13_srccol(int r) { const int pn = r >> 8, bj = (r >> 7) & 1, j = r & 127; return bj * 256 + pn * 128 + j; }
template <int MODE>
__device__ __forceinline__ void transpose_item(const float* W, int K, int ldw, bf16_t* WT, int nrows32, LAS float* scr, int item, int lane) {
    const int kb = item / nrows32, nb = item % nrows32, k0 = 64 * kb, n0 = 32 * nb;
    const int n = n0 + (lane & 31);
    int sc;
    if (MODE == 0) sc = n; else if (MODE == 1) sc = dsa_srccol(n); else if (MODE == 2) sc = gla_srccol(n); else sc = w13_srccol(n);
#pragma unroll 8
    for (int i = 0; i < 32; ++i) { const int kk = 2 * i + (lane >> 5); scr[kk * 33 + (lane & 31)] = (sc >= 0) ? W[(size_t)(k0 + kk) * ldw + sc] : 0.f; }
    asm volatile("s_waitcnt lgkmcnt(0)" ::: "memory");
    const int c = lane & 7;
#pragma unroll
    for (int j = 0; j < 4; ++j) { const int nn = (lane >> 3) + 8 * j; const LAS float* s = scr + (8 * c) * 33 + nn;
        u32x4 o; o.x = pk2(s[0 * 33], s[1 * 33]); o.y = pk2(s[2 * 33], s[3 * 33]); o.z = pk2(s[4 * 33], s[5 * 33]); o.w = pk2(s[6 * 33], s[7 * 33]);
        *(u32x4*)(WT + (size_t)(n0 + nn) * K + k0 + 8 * c) = o; }
    asm volatile("s_waitcnt lgkmcnt(0)" ::: "memory");
}
__device__ __forceinline__ void moe_weight_items(Frame& F, const float* w13, const float* w2, int layer) {
    LAS float* scr = (LAS float*)(F.lds + F.wave * 16384);
    bf16_t* W13 = (bf16_t*)(F.ws + WS_W13); bf16_t* W2 = (bf16_t*)(F.ws + WS_W2);
    constexpr int I13 = (1024 / 64) * (512 / 32), I2 = (256 / 64) * (1024 / 32);
    for (int it = F.gw; it < NEXP * (I13 + I2); it += F.NGW) {
        const int ge = it / (I13 + I2), r = it % (I13 + I2);
        if (r < I13) transpose_item<3>(w13 + ((size_t)layer * NEXP + ge) * 1024 * 512, 1024, 512, W13 + (size_t)ge * 512 * 1024, 16, scr, r, F.lane);
        else transpose_item<0>(w2 + ((size_t)layer * NEXP + ge) * 256 * 1024, 256, 1024, W2 + (size_t)ge * 1024 * 256, 32, scr, r - I13, F.lane);
    }
}
__device__ __forceinline__ void cvt_rows_bf16(Frame& F, const float* src, bf16_t* dst, int rows) {
    for (int m = F.gw; m < rows; m += F.NGW) {
        const f32x4* xr = (const f32x4*)(src + (size_t)m * DM) + F.lane; u32x2* o = (u32x2*)(dst + (size_t)m * DM) + F.lane;
#pragma unroll
        for (int j = 0; j < 4; ++j) { const f32x4 v = xr[64 * j]; u32x2 w; w.x = pk2(v.x, v.y); w.y = pk2(v.z, v.w); o[64 * j] = w; }
    }
}
__device__ __forceinline__ void p_prologue(Frame& F, const Args& a) {
    LAS float* scr = (LAS float*)(F.lds + F.wave * 16384);
    const float* dsa_w = (const float*)a.in[I_DSA_WIN]; const float* gla_w = (const float*)a.in[I_GLA_WIN];
    const float* wkv = (const float*)a.in[I_WMEMKV]; const float* wout = (const float*)a.in[I_WOUT];
    bf16_t* WD = (bf16_t*)(F.ws + WS_WD); bf16_t* WG = (bf16_t*)(F.ws + WS_WG); bf16_t* WKV = (bf16_t*)(F.ws + WS_WKV); bf16_t* WO = (bf16_t*)(F.ws + WS_WO);
    constexpr int ID = 16 * (ND / 32), IG = 16 * (NG / 32), IKV = 16 * (512 / 32), IO = 16 * (1024 / 32);
    constexpr int NIT = ID + IG + 2 * IKV + 2 * IO;
    for (int it = F.gw; it < NIT; it += F.NGW) {
        int r = it;
        if (r < ID) { transpose_item<1>(dsa_w, 1024, DSA_W, WD, ND / 32, scr, r, F.lane); continue; } r -= ID;
        if (r < IG) { transpose_item<2>(gla_w, 1024, GLA_W, WG, NG / 32, scr, r, F.lane); continue; } r -= IG;
        if (r < 2 * IKV) { const int l = r / IKV; transpose_item<0>(wkv + (size_t)l * 1024 * 512, 1024, 512, WKV + (size_t)l * 512 * 1024, 16, scr, r % IKV, F.lane); continue; } r -= 2 * IKV;
        { const int l = r / IO; transpose_item<0>(wout + (size_t)l * 1024 * 1024, 1024, 1024, WO + (size_t)l * 1024 * 1024, 32, scr, r % IO, F.lane); }
    }
    moe_weight_items(F, (const float*)a.in[I_MOE_W13], (const float*)a.in[I_MOE_W2], 0);
    cvt_rows_bf16(F, (const float*)a.in[I_X], (bf16_t*)(F.ws + WS_XB), NT);
    cvt_rows_bf16(F, (const float*)a.in[I_MEM], (bf16_t*)(F.ws + WS_MEMB), NB * NMEM);
    const int* pos = (const int*)a.in[I_POS];
    float* RC = (float*)(F.ws + WS_ROPEC); float* RS = (float*)(F.ws + WS_ROPES);
    for (int idx = blockIdx.x * 512 + F.tid; idx < NT * 32; idx += F.G * 512) {
        const int t = idx >> 5, i = idx & 31;
        const float inv = (float)pow(10000.0, -(double)(2 * i) / 64.0);
        const float ang = (float)pos[t] * inv;
        double s, c; sincos((double)ang, &s, &c);
        RC[idx] = (float)c; RS[idx] = (float)s;
    }
}

typedef const f32x4 (&AccRef)[2][2][4][2];
__device__ __forceinline__ void st_bf16x8(bf16_t* p, f32x4 v0, f32x4 v1) {
    u32x4 w; w.x = pg8::cvt_pk_bf16(v0[0], v0[1]); w.y = pg8::cvt_pk_bf16(v0[2], v0[3]); w.z = pg8::cvt_pk_bf16(v1[0], v1[1]); w.w = pg8::cvt_pk_bf16(v1[2], v1[3]);
    *(u32x4*)p = w;
}
struct EpiDsaProj {
    bf16_t *Q, *K, *V, *QI, *QM; float* KIW; const float *RC, *RS;
    __device__ __forceinline__ void operator()(AccRef acc, const pg8::Unit& u, int wr, int wc, int fr, int fq) const {
        const int pn = u.pn; const int row0 = u.pm * 256 + wr * 64 + fr;
        const int i0 = 16 * (wc & 1) + 4 * fq;
#pragma unroll
        for (int ai = 0; ai < 2; ++ai)
#pragma unroll
            for (int m = 0; m < 4; ++m) {
                const int row = row0 + ai * 128 + m * 16;
                f32x4 c4 = (f32x4){1.f, 1.f, 1.f, 1.f}, s4 = (f32x4){0.f, 0.f, 0.f, 0.f};
                const bool rope = (pn < 6) || (pn == 9) || (pn == 10);
                if (rope) { c4 = *(const f32x4*)(RC + (size_t)row * 32 + i0); s4 = *(const f32x4*)(RS + (size_t)row * 32 + i0); }
#pragma unroll
                for (int bj = 0; bj < 2; ++bj) {
                    const int gcol = pn * 256 + bj * 128 + wc * 32 + 8 * fq;
                    f32x4 v0 = acc[ai][bj][m][0], v1 = acc[ai][bj][m][1];
                    if (rope) { const f32x4 y0 = v0 * c4 - v1 * s4, y1 = v1 * c4 + v0 * s4; v0 = y0; v1 = y1; }
                    if (pn < 3) { v0 = v0 * C2; v1 = v1 * C2; st_bf16x8(Q + (size_t)row * 768 + gcol, v0, v1); }
                    else if (pn < 6) st_bf16x8(K + (size_t)row * 768 + (gcol - 768), v0, v1);
                    else if (pn < 9) st_bf16x8(V + (size_t)row * 768 + (gcol - 1536), v0, v1);
                    else if (pn < 11) st_bf16x8(QI + (size_t)row * 512 + (gcol - 2304), v0, v1);
                    else if (pn == 11) { v0 = v0 * C2; v1 = v1 * C2; st_bf16x8(QM + (size_t)row * 256 + (gcol - 2816), v0, v1); }
                    else { const int lc = gcol - 3072; if (lc < 72) { float* p = KIW + (size_t)row * KIW_P + lc; *(f32x4*)p = v0; *(f32x4*)(p + 4) = v1; } }
                }
            }
    }
};
struct EpiGlaProj {
    bf16_t *GQ, *GK, *GV, *GR, *GQM; float* A1;
    __device__ __forceinline__ void operator()(AccRef acc, const pg8::Unit& u, int wr, int wc, int fr, int fq) const {
        const int pn = u.pn; const int row0 = u.pm * 256 + wr * 64 + fr;
#pragma unroll
        for (int ai = 0; ai < 2; ++ai)
#pragma unroll
            for (int m = 0; m < 4; ++m) {
                const int row = row0 + ai * 128 + m * 16;
#pragma unroll
                for (int bj = 0; bj < 2; ++bj) {
                    const int gcol = pn * 256 + bj * 128 + wc * 32 + 8 * fq;
                    f32x4 v0 = acc[ai][bj][m][0], v1 = acc[ai][bj][m][1];
                    if (pn < 3) {
                        if (gcol < 384) { v0 = v0 * 0.10206207261596577f; v1 = v1 * 0.10206207261596577f; st_bf16x8(GQ + (size_t)row * 384 + gcol, v0, v1); }
                        else st_bf16x8(GK + (size_t)row * 384 + (gcol - 384), v0, v1);
                    }
                    else if (pn < 6) st_bf16x8(GV + (size_t)row * 768 + (gcol - 768), v0, v1);
                    else if (pn < 9) st_bf16x8(GR + (size_t)row * 768 + (gcol - 1536), v0, v1);
                    else if (pn == 9) { v0 = v0 * C2; v1 = v1 * C2; st_bf16x8(GQM + (size_t)row * 256 + (gcol - 2304), v0, v1); }
                    else { const int lc = gcol - 2560; if (lc < 16) { float* p = A1 + (size_t)row * 16 + lc; *(f32x4*)p = v0; *(f32x4*)(p + 4) = v1; } }
                }
            }
    }
};
struct EpiBf16Plain {
    bf16_t* O; int ldc; int ncolmask;
    __device__ __forceinline__ void operator()(AccRef acc, const pg8::Unit& u, int wr, int wc, int fr, int fq) const {
        const int row0 = u.pm * 256 + wr * 64 + fr; const int colt = (u.pn & ncolmask) * 256 + wc * 32 + 8 * fq;
#pragma unroll
        for (int ai = 0; ai < 2; ++ai)
#pragma unroll
            for (int m = 0; m < 4; ++m) { bf16_t* rowp = O + (size_t)(row0 + ai * 128 + m * 16) * ldc + colt;
#pragma unroll
                for (int bj = 0; bj < 2; ++bj) st_bf16x8(rowp + bj * 128, acc[ai][bj][m][0], acc[ai][bj][m][1]); }
    }
};
struct EpiF32Plain {
    float* C; int ldc;
    __device__ __forceinline__ void operator()(AccRef acc, const pg8::Unit& u, int wr, int wc, int fr, int fq) const {
        const int row0 = u.pm * 256 + wr * 64 + fr; const int colt = u.pn * 256 + wc * 32 + 8 * fq;
#pragma unroll
        for (int ai = 0; ai < 2; ++ai)
#pragma unroll
            for (int m = 0; m < 4; ++m) { float* rowp = C + (size_t)(row0 + ai * 128 + m * 16) * ldc + colt;
#pragma unroll
                for (int bj = 0; bj < 2; ++bj) { *(f32x4*)(rowp + bj * 128) = acc[ai][bj][m][0]; *(f32x4*)(rowp + bj * 128 + 4) = acc[ai][bj][m][1]; } }
    }
};
struct EpiMoe1 {
    bf16_t* ACT; const float* LISTW; const unsigned* cnt;
    __device__ __forceinline__ void operator()(AccRef acc, const pg8::Unit& u, int wr, int wc, int fr, int fq) const {
        const int j2 = u.pn & 1; const int rl0 = wr * 64 + fr; const int ce = (int)cnt[u.e];
#pragma unroll
        for (int ai = 0; ai < 2; ++ai)
#pragma unroll
            for (int m = 0; m < 4; ++m) {
                const int rl = rl0 + ai * 128 + m * 16; const int pos = u.r0 + rl;
                const float wt = (pos < ce) ? LISTW[(size_t)u.e * NT + pos] : 0.f;
                f32x4 a0 = acc[ai][0][m][0], a1 = acc[ai][0][m][1], u0 = acc[ai][1][m][0], u1 = acc[ai][1][m][1], o0, o1;
#pragma unroll
                for (int j = 0; j < 4; ++j) { o0[j] = silu_f(a0[j]) * u0[j] * wt; o1[j] = silu_f(a1[j]) * u1[j] * wt; }
                st_bf16x8(ACT + (size_t)(u.pm * 256 + rl) * 256 + j2 * 128 + wc * 32 + 8 * fq, o0, o1);
            }
    }
};
struct MoeOrder {
    const LAS int* tp; const unsigned* cnt; const int* LISTTOK; int ncol, G, c; bool gather;
    __device__ bool next(int i, pg8::Unit& u) const {
        const long L = (long)i * G + c; const int ntile = tp[NEXP];
        if (L >= (long)ntile * ncol) return false;
        const int tile = (int)(L / ncol), col = (int)(L % ncol);
        int e = 0;
#pragma unroll 1
        while (tp[e + 1] <= tile) ++e;
        u.pm = tile; u.pn = e * ncol + col; u.e = e; u.r0 = (tile - tp[e]) * 256; return true;
    }
    __device__ __forceinline__ int rowidx(const pg8::Unit& u, int r) const {
        if (!gather) return u.pm * 256 + r;
        const int pos = u.r0 + r;
        return (pos < (int)cnt[u.e]) ? LISTTOK[(size_t)u.e * NT + pos] : 0;
    }
};
__device__ __forceinline__ void moe_tile_table(Frame& F, const unsigned* cnt, LAS int* tp) {
    if (F.tid == 0) { int s = 0; for (int e = 0; e < NEXP; ++e) { tp[e] = s; s += ((int)cnt[e] + 255) >> 8; } tp[NEXP] = s; }
    __syncthreads();
}

__device__ __forceinline__ void p_ki(Frame& F, const Args& a) {
    const float* KIW = (const float*)(F.ws + WS_KIW); bf16_t* KI = (bf16_t*)(F.ws + WS_KI); float* WI = (float*)(F.ws + WS_WI);
    const float* RC = (const float*)(F.ws + WS_ROPEC); const float* RS = (const float*)(F.ws + WS_ROPES);
    const float* g = (const float*)a.in[I_DSA_KG]; const float* bb = (const float*)a.in[I_DSA_KB];
    const int d = F.lane; const float gd = g[d], bd = bb[d]; const int dst = dperm_inv(d);
    for (int t = F.gw; t < NT; t += F.NGW) {
        const float v = KIW[(size_t)t * KIW_P + d];
        const float mu = wave_sum(v) * (1.f / 64.f); const float dv = v - mu;
        const float var = wave_sum(dv * dv) * (1.f / 64.f);
        const float n = dv * (1.f / sqrtf(var + LN_EPS)) * gd + bd;
        const float pr = __shfl_xor(n, 32);
        const float c = RC[(size_t)t * 32 + (d & 31)], s = RS[(size_t)t * 32 + (d & 31)];
        const float o = (d < 32) ? (n * c - pr * s) : (n * c + pr * s);
        KI[(size_t)t * 64 + dst] = (bf16_t)f2bf(o);
        if (d < 8) WI[(size_t)t * 8 + d] = KIW[(size_t)t * KIW_P + 64 + d] * 0.04419417382415922f;
    }
}

__device__ __forceinline__ unsigned ordkey(float f) { const unsigned u = __builtin_bit_cast(unsigned, f); return (u & 0x80000000u) ? ~u : (u | 0x80000000u); }
__device__ __forceinline__ void p_indexer(Frame& F) {
    const bf16_t* QI = (const bf16_t*)(F.ws + WS_QI); const bf16_t* KI = (const bf16_t*)(F.ws + WS_KI); const float* WI = (const float*)(F.ws + WS_WI);
    unsigned long long* MASK = (unsigned long long*)(F.ws + WS_MASK);
    LAS float* sc = (LAS float*)F.lds;
    LAS float* wis = (LAS float*)(F.lds + 131072);
    const int lane = F.lane, r32 = lane & 31, hi = lane >> 5, wave = F.wave;
    for (int i = 0;; ++i) {
        const int U = i * F.G + (int)blockIdx.x; if (U >= NB * 128) break;
        const int b = U >> 7, tl = U & 127, tile = (i & 1) ? 127 - tl : tl;
        const int t0 = tile * 16; const size_t rowbase = (size_t)b * SEQ;
        if (t0 < 256) {
#pragma unroll
            for (int u = 0; u < 2; ++u) { const int t = t0 + 2 * wave + u;
                if (lane < 32) { const int nb = t + 1 - 64 * lane; const unsigned long long m = nb >= 64 ? ~0ull : (nb <= 0 ? 0ull : ((1ull << nb) - 1ull)); MASK[(rowbase + t) * 32 + lane] = m; } }
            continue;
        }
        if (F.tid < 128) wis[F.tid] = WI[(rowbase + t0) * 8 + F.tid];
        bf16x8 af[4][4];
        { const int m = r32, j = m & 3, hp = (m >> 2) & 1, ii = m >> 3, tokl = 2 * hp + (ii >> 1), head = 4 * (ii & 1) + j;
#pragma unroll
          for (int mt = 0; mt < 4; ++mt)
#pragma unroll
            for (int ks = 0; ks < 4; ++ks) af[mt][ks] = *(const bf16x8*)(QI + (rowbase + t0 + 4 * mt + tokl) * 512 + head * 64 + ks * 16 + hi * 8); }
        __syncthreads();
        const int n32 = (t0 + 16 + 31) >> 5;
        for (int kt = wave; kt < n32; kt += NWAVES) {
            const int key = kt * 32 + r32;
            bf16x8 bfr[4];
#pragma unroll
            for (int ks = 0; ks < 4; ++ks) bfr[ks] = *(const bf16x8*)(KI + (rowbase + key) * 64 + ks * 16 + hi * 8);
#pragma unroll
            for (int mt = 0; mt < 4; ++mt) {
                f32x16 acc = {};
#pragma unroll
                for (int ks = 0; ks < 4; ++ks) acc = __builtin_amdgcn_mfma_f32_32x32x16_bf16(af[mt][ks], bfr[ks], acc, 0, 0, 0);
#pragma unroll
                for (int u = 0; u < 2; ++u) { const int tk = 4 * mt + 2 * hi + u;
                    const f32x4 w0 = *(const LAS f32x4*)(wis + tk * 8), w1 = *(const LAS f32x4*)(wis + tk * 8 + 4);
                    float s = 0.f;
#pragma unroll
                    for (int h = 0; h < 4; ++h) { s += w0[h] * fmaxf(acc[8 * u + h], 0.f); }
#pragma unroll
                    for (int h = 0; h < 4; ++h) { s += w1[h] * fmaxf(acc[8 * u + 4 + h], 0.f); }
                    sc[tk * 2048 + key] = s + 0.f; }
            }
        }
        __syncthreads();
#pragma unroll 1
        for (int u = 0; u < 2; ++u) {
            const int tk = 2 * wave + u, t = t0 + tk;
            unsigned key[32];
#pragma unroll
            for (int q = 0; q < 32; ++q) { const int s = lane + 64 * q; key[q] = (s <= t) ? ordkey(sc[tk * 2048 + s]) : 0u; }
            unsigned T = 0u; bool exact = false;
#pragma unroll 1
            for (int bit = 31; bit >= 0; --bit) {
                const unsigned cand = T | (1u << bit); int c = 0;
#pragma unroll
                for (int q = 0; q < 32; ++q) c += __builtin_popcountll(__ballot(key[q] >= cand));
                if (c >= 256) { T = cand; if (c == 256) { exact = true; break; } }
            }
            int need = 0, ceq = 0;
            if (!exact) { int cgt = 0;
#pragma unroll
                for (int q = 0; q < 32; ++q) { cgt += __builtin_popcountll(__ballot(key[q] > T)); ceq += __builtin_popcountll(__ballot(key[q] == T)); }
                need = 256 - cgt; }
            unsigned long long mymask = 0ull;
            if (exact || need == ceq) {
#pragma unroll
                for (int q = 0; q < 32; ++q) { const unsigned long long bal = __ballot(key[q] >= T); if (lane == q) mymask = bal; }
            } else {
#pragma unroll
                for (int q = 0; q < 32; ++q) {
                    unsigned long long eq = __ballot(key[q] == T); const unsigned long long gt = __ballot(key[q] > T);
                    int pc = __builtin_popcountll(eq); const int take = pc < need ? pc : need;
                    while (pc > take) { eq &= ~(1ull << (63 - __builtin_clzll(eq))); --pc; }
                    need -= take;
                    if (lane == q) mymask = gt | eq;
                }
            }
            if (lane < 32) MASK[(rowbase + t) * 32 + lane] = mymask;
        }
        __syncthreads();
    }
}

typedef short v4i16_t __attribute__((ext_vector_type(4)));
__device__ __forceinline__ s16x4 vtr(const LAS unsigned char* p) { return __builtin_bit_cast(s16x4, __builtin_amdgcn_ds_read_tr16_b64_v4i16((LAS v4i16_t*)p)); }
template <bool MASKED>
__device__ __forceinline__ void attn_unit(Frame& F, const bf16_t* Qp, int qpitch, const bf16_t* Kp, const bf16_t* Vp, int kvpitch, int ntiles,
                                          const unsigned long long* maskp, bf16_t* Op, int opitch) {
    const int tid = F.tid, lane = F.lane, r32 = lane & 31, hi = lane >> 5, wave = F.wave;
    LAS unsigned char* lds = F.lds;
    bf16x8 qf[4];
#pragma unroll
    for (int ks = 0; ks < 4; ++ks) qf[ks] = *(const bf16x8*)(Qp + (size_t)(wave * 32 + r32) * qpitch + ks * 16 + hi * 8);
    const unsigned long long* mrow = maskp + (size_t)(wave * 32 + r32) * 32;
    const int kkey = tid & 63, kch = tid >> 6, vkey = tid >> 3, vpc = tid & 7;
    const bf16_t* ksrc = Kp + (size_t)kkey * kvpitch + kch * 8; const bf16_t* vsrc = Vp + (size_t)vkey * kvpitch + vpc * 8;
    const int kdst = kch * 1024 + kkey * 16, vdst = 8192 + (vpc >> 2) * 4096 + vkey * 64 + (vpc & 3) * 16;
    u32x4 kreg = *(const u32x4*)ksrc, vreg = *(const u32x4*)vsrc;
    *(LAS u32x4*)(lds + kdst) = kreg; *(LAS u32x4*)(lds + vdst) = vreg;
    __syncthreads();
    float m_run = -1e30f, l_run = 0.f; f32x16 o0 = {}, o1 = {};
    const int vlane = ((lane >> 4) & 1) * 32 + (lane & 3) * 8 + (4 * hi + ((lane & 15) >> 2)) * 64;
    for (int t = 0; t < ntiles; ++t) {
        const int cb = (t & 1) * 16384, nb = 16384 - cb;
        if (t + 1 < ntiles) { kreg = *(const u32x4*)(ksrc + (size_t)(t + 1) * 64 * kvpitch); vreg = *(const u32x4*)(vsrc + (size_t)(t + 1) * 64 * kvpitch); }
        unsigned long long mw = ~0ull; if (MASKED) mw = mrow[t];
        f32x16 p0 = {}, p1 = {};
#pragma unroll
        for (int ks = 0; ks < 4; ++ks) {
            const bf16x8 a0 = *(const LAS bf16x8*)(lds + cb + (2 * ks + hi) * 1024 + r32 * 16);
            const bf16x8 a1 = *(const LAS bf16x8*)(lds + cb + (2 * ks + hi) * 1024 + (32 + r32) * 16);
            p0 = __builtin_amdgcn_mfma_f32_32x32x16_bf16(a0, qf[ks], p0, 0, 0, 0);
            p1 = __builtin_amdgcn_mfma_f32_32x32x16_bf16(a1, qf[ks], p1, 0, 0, 0);
        }
        if (MASKED) { const unsigned lo = (unsigned)mw >> (4 * hi), hw = (unsigned)(mw >> 32) >> (4 * hi);
#pragma unroll
            for (int r = 0; r < 16; ++r) { const unsigned bit = 1u << ((r & 3) + 8 * (r >> 2)); p0[r] = (lo & bit) ? p0[r] : -1e30f; p1[r] = (hw & bit) ? p1[r] : -1e30f; } }
        float rm = fmaxf(p0[0], p1[0]);
#pragma unroll
        for (int r = 1; r < 16; ++r) rm = fmaxf(rm, fmaxf(p0[r], p1[r]));
        { auto rr = __builtin_amdgcn_permlane32_swap(__float_as_uint(rm), __float_as_uint(rm), false, false); rm = fmaxf(__uint_as_float(rr[0]), __uint_as_float(rr[1])); }
        const float m_new = fmaxf(m_run, rm); const float alpha = fast_exp2(m_run - m_new); m_run = m_new;
        l_run *= alpha;
#pragma unroll
        for (int r = 0; r < 16; ++r) { o0[r] *= alpha; o1[r] *= alpha; }
        float ls = 0.f;
#pragma unroll
        for (int r = 0; r < 16; ++r) { p0[r] = fast_exp2(p0[r] - m_new); p1[r] = fast_exp2(p1[r] - m_new); ls += p0[r] + p1[r]; }
        l_run += ls;
        bf16x8 pw[2][2];
#pragma unroll
        for (int s = 0; s < 2; ++s) {
            u32x4 w; w.x = pg8::cvt_pk_bf16(p0[8 * s + 0], p0[8 * s + 1]); w.y = pg8::cvt_pk_bf16(p0[8 * s + 2], p0[8 * s + 3]); w.z = pg8::cvt_pk_bf16(p0[8 * s + 4], p0[8 * s + 5]); w.w = pg8::cvt_pk_bf16(p0[8 * s + 6], p0[8 * s + 7]);
            pw[0][s] = __builtin_bit_cast(bf16x8, w);
            u32x4 x; x.x = pg8::cvt_pk_bf16(p1[8 * s + 0], p1[8 * s + 1]); x.y = pg8::cvt_pk_bf16(p1[8 * s + 2], p1[8 * s + 3]); x.z = pg8::cvt_pk_bf16(p1[8 * s + 4], p1[8 * s + 5]); x.w = pg8::cvt_pk_bf16(p1[8 * s + 6], p1[8 * s + 7]);
            pw[1][s] = __builtin_bit_cast(bf16x8, x);
        }
        const LAS unsigned char* vb = lds + cb + 8192 + vlane;
#pragma unroll
        for (int kh = 0; kh < 2; ++kh)
#pragma unroll
            for (int s = 0; s < 2; ++s) {
                const int ko = (32 * kh + 16 * s) * 64;
                const s16x4 a_lo0 = vtr(vb + ko), a_hi0 = vtr(vb + ko + 512), a_lo1 = vtr(vb + 4096 + ko), a_hi1 = vtr(vb + 4096 + ko + 512);
                const bf16x8 A0 = (bf16x8){a_lo0[0], a_lo0[1], a_lo0[2], a_lo0[3], a_hi0[0], a_hi0[1], a_hi0[2], a_hi0[3]};
                const bf16x8 A1 = (bf16x8){a_lo1[0], a_lo1[1], a_lo1[2], a_lo1[3], a_hi1[0], a_hi1[1], a_hi1[2], a_hi1[3]};
                o0 = __builtin_amdgcn_mfma_f32_32x32x16_bf16(A0, pw[kh][s], o0, 0, 0, 0);
                o1 = __builtin_amdgcn_mfma_f32_32x32x16_bf16(A1, pw[kh][s], o1, 0, 0, 0);
            }
        if (t + 1 < ntiles) { *(LAS u32x4*)(lds + nb + kdst) = kreg; *(LAS u32x4*)(lds + nb + vdst) = vreg; }
        __syncthreads();
    }
    { auto rr = __builtin_amdgcn_permlane32_swap(__float_as_uint(l_run), __float_as_uint(l_run), false, false); l_run = __uint_as_float(rr[0]) + __uint_as_float(rr[1]); }
    const float inv = 1.f / l_run;
    bf16_t* orow = Op + (size_t)(wave * 32 + r32) * opitch;
#pragma unroll
    for (int rg = 0; rg < 4; ++rg) {
        u32x2 w0, w1;
        w0.x = pg8::cvt_pk_bf16(o0[4 * rg] * inv, o0[4 * rg + 1] * inv); w0.y = pg8::cvt_pk_bf16(o0[4 * rg + 2] * inv, o0[4 * rg + 3] * inv);
        w1.x = pg8::cvt_pk_bf16(o1[4 * rg] * inv, o1[4 * rg + 1] * inv); w1.y = pg8::cvt_pk_bf16(o1[4 * rg + 2] * inv, o1[4 * rg + 3] * inv);
        *(u32x2*)(orow + 8 * rg + 4 * hi) = w0; *(u32x2*)(orow + 32 + 8 * rg + 4 * hi) = w1;
    }
}
__device__ __forceinline__ void mem_attn_units(Frame& F, const bf16_t* QM, int layer, bf16_t* AO) {
    const bf16_t* KVM = (const bf16_t*)(F.ws + WS_KVM);
    for (int mu = blockIdx.x; mu < NB * 32; mu += F.G) {
        const int b = mu >> 5, hm = (mu >> 3) & 3, qb = mu & 7;
        const size_t row0 = (size_t)b * SEQ + qb * 256;
        attn_unit<false>(F, QM + row0 * 256 + hm * 64, 256, KVM + (size_t)b * NMEM * 1024 + layer * 512 + hm * 64, KVM + (size_t)b * NMEM * 1024 + layer * 512 + 256 + hm * 64, 1024, 4,
                         nullptr, AO + row0 * 1024 + 768 + hm * 64, 1024);
    }
}
__device__ __forceinline__ void p_attn_dsa(Frame& F) {
    const bf16_t* Q = (const bf16_t*)(F.ws + WS_Q); const bf16_t* K = (const bf16_t*)(F.ws + WS_K); const bf16_t* V = (const bf16_t*)(F.ws + WS_V);
    const unsigned long long* MASK = (const unsigned long long*)(F.ws + WS_MASK); bf16_t* AO = (bf16_t*)(F.ws + WS_AO0);
    for (int pu = blockIdx.x; pu < NB * 12 * 4; pu += F.G) {
        const int bh = pu >> 2, pr = pu & 3, b = bh / 12, h = bh % 12;
#pragma unroll 1
        for (int z = 0; z < 2; ++z) {
            const int qb = z ? 7 - pr : pr; const size_t rb = (size_t)b * SEQ, row0 = rb + qb * 256;
            attn_unit<true>(F, Q + row0 * 768 + h * 64, 768, K + rb * 768 + h * 64, V + rb * 768 + h * 64, 768, 4 * (qb + 1), MASK + row0 * 32, AO + row0 * 1024 + h * 64, 1024);
        }
    }
    mem_attn_units(F, (const bf16_t*)(F.ws + WS_QM), 0, AO);
}

__device__ __forceinline__ void p_ln1_router(Frame& F, const Args& a, int layer, const float* resid, bf16_t* X1b) {
    const float* MIX = F.out; float* X1 = (float*)(F.ws + WS_X1);
    const float* g1 = (const float*)a.in[I_LN1G] + layer * 1024; const float* b1 = (const float*)a.in[I_LN1B] + layer * 1024;
    const float* wg = (const float*)a.in[I_MOE_WG] + (size_t)layer * 1024 * 4; const float* bg = (const float*)a.in[I_MOE_BG] + layer * 4;
    const float* wr = (const float*)a.in[I_MOE_WR] + (size_t)layer * 4 * 1024 * 8; const float* br = (const float*)a.in[I_MOE_BR] + layer * 32;
    unsigned* cnt = F.ctl + CW_CNT + layer * 32;
    int* LISTTOK = (int*)(F.ws + WS_LISTTOK); float* LISTW = (float*)(F.ws + WS_LISTW); int* TOKSLOT = (int*)(F.ws + WS_TOKSLOT);
    const int lane = F.lane;
    f32x4 gv[4], bv[4];
#pragma unroll
    for (int j = 0; j < 4; ++j) { gv[j] = *((const f32x4*)g1 + lane + 64 * j); bv[j] = *((const f32x4*)b1 + lane + 64 * j); }
    for (int t = F.gw; t < NT; t += F.NGW) {
        const f32x4* xr = (const f32x4*)(resid + (size_t)t * DM) + lane; const f32x4* mr = (const f32x4*)(MIX + (size_t)t * DM) + lane;
        f32x4 v[4]; float s = 0.f;
#pragma unroll
        for (int j = 0; j < 4; ++j) { v[j] = xr[64 * j] * ALPHA + mr[64 * j]; s += (v[j].x + v[j].y) + (v[j].z + v[j].w); }
        const float mean = wave_sum(s) * (1.f / DM); float s2 = 0.f;
#pragma unroll
        for (int j = 0; j < 4; ++j) { v[j] = v[j] - mean; s2 += (v[j].x * v[j].x + v[j].y * v[j].y) + (v[j].z * v[j].z + v[j].w * v[j].w); }
        const float rstd = 1.f / sqrtf(wave_sum(s2) * (1.f / DM) + LN_EPS);
        f32x4* o4 = (f32x4*)(X1 + (size_t)t * DM) + lane; u32x2* ob = (u32x2*)(X1b + (size_t)t * DM) + lane;
#pragma unroll
        for (int j = 0; j < 4; ++j) { v[j] = v[j] * rstd * gv[j] + bv[j]; o4[64 * j] = v[j]; u32x2 w; w.x = pk2(v[j].x, v[j].y); w.y = pk2(v[j].z, v[j].w); ob[64 * j] = w; }
        float gl[4] = {0.f, 0.f, 0.f, 0.f};
#pragma unroll
        for (int j = 0; j < 4; ++j)
#pragma unroll
            for (int c = 0; c < 4; ++c) { const f32x4 w4 = *(const f32x4*)(wg + (size_t)(256 * j + 4 * lane + c) * 4);
#pragma unroll
                for (int k = 0; k < 4; ++k) gl[k] += v[j][c] * w4[k]; }
#pragma unroll
        for (int k = 0; k < 4; ++k) gl[k] = wave_sum(gl[k]) + bg[k];
        int gsel = 0; float gmax = gl[0];
#pragma unroll
        for (int k = 1; k < 4; ++k) if (gl[k] > gmax) { gmax = gl[k]; gsel = k; }
        float gs = 0.f;
#pragma unroll
        for (int k = 0; k < 4; ++k) gs += __expf(gl[k] - gmax);
        const float pg = 1.f / gs;
        gsel = __builtin_amdgcn_readfirstlane(gsel);
        const float* wrg = wr + (size_t)gsel * 1024 * 8;
        float el[8] = {0.f, 0.f, 0.f, 0.f, 0.f, 0.f, 0.f, 0.f};
#pragma unroll
        for (int j = 0; j < 4; ++j)
#pragma unroll
            for (int c = 0; c < 4; ++c) { const float* wp = wrg + (size_t)(256 * j + 4 * lane + c) * 8; const f32x4 w0 = *(const f32x4*)wp, w1 = *(const f32x4*)(wp + 4);
#pragma unroll
                for (int k = 0; k < 4; ++k) { el[k] += v[j][c] * w0[k]; el[4 + k] += v[j][c] * w1[k]; } }
#pragma unroll
        for (int k = 0; k < 8; ++k) el[k] = wave_sum(el[k]) + br[gsel * 8 + k];
        int i1 = 0; float v1 = el[0];
#pragma unroll
        for (int k = 1; k < 8; ++k) if (el[k] > v1) { v1 = el[k]; i1 = k; }
        int i2 = -1; float v2 = -INFINITY;
#pragma unroll
        for (int k = 0; k < 8; ++k) if (k != i1 && (i2 < 0 || el[k] > v2)) { v2 = el[k]; i2 = k; }
        const float e2 = __expf(v2 - v1); const float wt1 = pg / (1.f + e2), wt2 = pg * e2 / (1.f + e2);
        if (lane == 0) {
            const int ge1 = gsel * 8 + i1, ge2 = gsel * 8 + i2;
            const unsigned p1 = atomicAdd(&cnt[ge1], 1u), p2 = atomicAdd(&cnt[ge2], 1u);
            LISTTOK[(size_t)ge1 * NT + p1] = t; LISTW[(size_t)ge1 * NT + p1] = wt1;
            LISTTOK[(size_t)ge2 * NT + p2] = t; LISTW[(size_t)ge2 * NT + p2] = wt2;
            *(int4*)(TOKSLOT + (size_t)t * 4) = make_int4(ge1, (int)p1, ge2, (int)p2);
        }
    }
}
__device__ __forceinline__ void p_ln2(Frame& F, const Args& a, int layer, float* dst, bf16_t* dstb) {
    const float* X1 = (const float*)(F.ws + WS_X1); const bf16_t* Y = (const bf16_t*)(F.ws + WS_Y); const int* TOKSLOT = (const int*)(F.ws + WS_TOKSLOT);
    const float* g2 = (const float*)a.in[I_LN2G] + layer * 1024; const float* b2 = (const float*)a.in[I_LN2B] + layer * 1024;
    LAS int* tp = (LAS int*)(F.lds + MISC_OFF + 256);
    moe_tile_table(F, F.ctl + CW_CNT + layer * 32, tp);
    const int lane = F.lane;
    f32x4 gv[4], bv[4];
#pragma unroll
    for (int j = 0; j < 4; ++j) { gv[j] = *((const f32x4*)g2 + lane + 64 * j); bv[j] = *((const f32x4*)b2 + lane + 64 * j); }
    for (int t = F.gw; t < NT; t += F.NGW) {
        const int4 ts = *(const int4*)(TOKSLOT + (size_t)t * 4);
        const size_t s0 = (size_t)tp[ts.x] * 256 + ts.y, s1 = (size_t)tp[ts.z] * 256 + ts.w;
        const f32x4* xr = (const f32x4*)(X1 + (size_t)t * DM) + lane;
        const u32x2* y0 = (const u32x2*)(Y + s0 * DM) + lane; const u32x2* y1 = (const u32x2*)(Y + s1 * DM) + lane;
        f32x4 v[4]; float s = 0.f;
#pragma unroll
        for (int j = 0; j < 4; ++j) { const u32x2 p = y0[64 * j], q = y1[64 * j];
            f32x4 yy; yy.x = bf2f(p.x & 0xffffu) + bf2f(q.x & 0xffffu); yy.y = bf2f(p.x >> 16) + bf2f(q.x >> 16); yy.z = bf2f(p.y & 0xffffu) + bf2f(q.y & 0xffffu); yy.w = bf2f(p.y >> 16) + bf2f(q.y >> 16);
            v[j] = xr[64 * j] * ALPHA + yy; s += (v[j].x + v[j].y) + (v[j].z + v[j].w); }
        const float mean = wave_sum(s) * (1.f / DM); float s2 = 0.f;
#pragma unroll
        for (int j = 0; j < 4; ++j) { v[j] = v[j] - mean; s2 += (v[j].x * v[j].x + v[j].y * v[j].y) + (v[j].z * v[j].z + v[j].w * v[j].w); }
        const float rstd = 1.f / sqrtf(wave_sum(s2) * (1.f / DM) + LN_EPS);
        f32x4* o4 = (f32x4*)(dst + (size_t)t * DM) + lane;
#pragma unroll
        for (int j = 0; j < 4; ++j) { v[j] = v[j] * rstd * gv[j] + bv[j]; o4[64 * j] = v[j]; }
        if (dstb) { u32x2* ob = (u32x2*)(dstb + (size_t)t * DM) + lane;
#pragma unroll
            for (int j = 0; j < 4; ++j) { u32x2 w; w.x = pk2(v[j].x, v[j].y); w.y = pk2(v[j].z, v[j].w); ob[64 * j] = w; } }
    }
}

constexpr int KS_P = 97, VS_P = 194;
__device__ __forceinline__ void p_gla_prep(Frame& F, const Args& a) {
    bf16_t* GQ = (bf16_t*)(F.ws + WS_GQ); bf16_t* GK = (bf16_t*)(F.ws + WS_GK); const bf16_t* GV = (const bf16_t*)(F.ws + WS_GV); const float* A1 = (const float*)(F.ws + WS_A1);
    bf16_t* KPT = (bf16_t*)(F.ws + WS_KPT); bf16_t* VT = (bf16_t*)(F.ws + WS_VT); float* DEC = (float*)(F.ws + WS_DEC);
    const float* wgate = (const float*)a.in[I_GLA_WGATE]; const float* bgate = (const float*)a.in[I_GLA_BGATE];
    LAS float* a1s = (LAS float*)F.lds;
    LAS float* wgs = a1s + 1024;
    LAS float* bgs = wgs + 1536;
    LAS float* Gs = bgs + 96;
    LAS float* ks = Gs + 6144;
    LAS bf16_t* vs = (LAS bf16_t*)(ks + 64 * KS_P);
    const int tid = F.tid;
    for (int U = blockIdx.x; U < NB * 4 * 32; U += F.G) {
        const int c = U & 31, h = (U >> 5) & 3, b = U >> 7; const size_t row0 = (size_t)b * SEQ + c * 64;
        if (tid < 256) *(LAS f32x4*)(a1s + tid * 4) = *(const f32x4*)(A1 + (row0 + (tid >> 2)) * 16 + (tid & 3) * 4);
        if (tid < 384) { const int r = tid / 24, d4 = (tid % 24) * 4; *(LAS f32x4*)(wgs + r * 96 + d4) = *(const f32x4*)(wgate + r * 384 + h * 96 + d4); }
        if (tid < 96) bgs[tid] = bgate[h * 96 + tid];
        for (int idx = tid; idx < 64 * 192; idx += 512) { const int pos = idx / 192, e = idx % 192; vs[pos * VS_P + e] = GV[(row0 + pos) * 768 + h * 192 + e]; }
        __syncthreads();
        for (int idx = tid; idx < 64 * 96; idx += 512) { const int pos = idx / 96, d = idx % 96;
            float z = bgs[d];
#pragma unroll
            for (int r = 0; r < 16; ++r) z += a1s[pos * 16 + r] * wgs[r * 96 + d];
            const float ls = fminf(z, 0.f) - log1pf(__expf(-fabsf(z)));
            Gs[pos * 96 + d] = ls * (1.f / 16.f); }
        __syncthreads();
        if (tid < 96) { float run = 0.f; for (int pos = 0; pos < 64; ++pos) { run += Gs[pos * 96 + tid]; Gs[pos * 96 + tid] = run; } DEC[(size_t)U * 96 + tid] = __expf(run); }
        __syncthreads();
        for (int idx = tid; idx < 64 * 96; idx += 512) { const int pos = idx / 96, d = idx % 96;
            const float bb = Gs[pos * 96 + d], bl = Gs[63 * 96 + d];
            const size_t gi = (row0 + pos) * 384 + h * 96 + d;
            const float q = bf2f(GQ[gi]), k = bf2f(GK[gi]);
            GQ[gi] = (bf16_t)f2bf(q * __expf(bb)); GK[gi] = (bf16_t)f2bf(k * __expf(-bb));
            ks[pos * KS_P + d] = k * __expf(bl - bb); }
        __syncthreads();
        for (int idx = tid; idx < 96 * 64; idx += 512) { const int pos = idx & 63, d = idx >> 6; KPT[((size_t)(b * 4 + h) * 96 + d) * SEQ + c * 64 + pos] = (bf16_t)f2bf(ks[pos * KS_P + d]); }
        for (int idx = tid; idx < 192 * 64; idx += 512) { const int pos = idx & 63, e = idx >> 6; VT[((size_t)(b * 4 + h) * 192 + e) * SEQ + c * 64 + pos] = vs[pos * VS_P + e]; }
        __syncthreads();
    }
}
__device__ __forceinline__ bf16x8 ld2x8(const bf16_t* p0, const bf16_t* p1) { const u32x2 a = *(const u32x2*)p0, b = *(const u32x2*)p1; u32x4 w; w.x = a.x; w.y = a.y; w.z = b.x; w.w = b.y; return __builtin_bit_cast(bf16x8, w); }
__device__ __forceinline__ bf16x8 pack8(f32x4 lo, f32x4 hi) { u32x4 w; w.x = pg8::cvt_pk_bf16(lo[0], lo[1]); w.y = pg8::cvt_pk_bf16(lo[2], lo[3]); w.z = pg8::cvt_pk_bf16(hi[0], hi[1]); w.w = pg8::cvt_pk_bf16(hi[2], hi[3]); return __builtin_bit_cast(bf16x8, w); }
__device__ __forceinline__ void p_gla_scan(Frame& F) {
    const bf16_t* GQ = (const bf16_t*)(F.ws + WS_GQ); const bf16_t* GK = (const bf16_t*)(F.ws + WS_GK);
    const bf16_t* KPT = (const bf16_t*)(F.ws + WS_KPT); const bf16_t* VT = (const bf16_t*)(F.ws + WS_VT); const float* DEC = (const float*)(F.ws + WS_DEC);
    float* OG = F.out;
    const int lane = F.lane, li = lane & 15, fq = lane >> 4;
    for (int U = F.wave * F.G + (int)blockIdx.x; U < NB * 4 * 12; U += NWAVES * F.G) {
        const int et = U % 12, bh = U / 12, h = bh & 3, b = bh >> 2;
        f32x4 S[6];
#pragma unroll
        for (int dt = 0; dt < 6; ++dt) S[dt] = (f32x4){0.f, 0.f, 0.f, 0.f};
        const bf16_t* vtp = VT + ((size_t)bh * 192 + 16 * et + li) * SEQ + 4 * fq;
        const bf16_t* kpp = KPT + ((size_t)bh * 96 + li) * SEQ + 4 * fq;
#pragma unroll 1
        for (int c = 0; c < 32; ++c) {
            const size_t pos0 = (size_t)b * SEQ + c * 64;
            bf16x8 qf[4][3], kf[4][3];
#pragma unroll
            for (int it = 0; it < 4; ++it)
#pragma unroll
                for (int s = 0; s < 3; ++s) { const size_t off = (pos0 + 16 * it + li) * 384 + h * 96 + 32 * s + 4 * fq;
                    qf[it][s] = ld2x8(GQ + off, GQ + off + 16); kf[it][s] = ld2x8(GK + off, GK + off + 16); }
            bf16x8 vf[2];
#pragma unroll
            for (int s2 = 0; s2 < 2; ++s2) vf[s2] = ld2x8(vtp + c * 64 + 32 * s2, vtp + c * 64 + 32 * s2 + 16);
            bf16x8 am[4][2];
#pragma unroll
            for (int it = 0; it < 4; ++it) {
                f32x4 tl[4];
#pragma unroll
                for (int jt = 0; jt < 4; ++jt) {
                    tl[jt] = (f32x4){0.f, 0.f, 0.f, 0.f};
                    if (jt <= it) {
#pragma unroll
                        for (int s = 0; s < 3; ++s) tl[jt] = __builtin_amdgcn_mfma_f32_16x16x32_bf16(kf[jt][s], qf[it][s], tl[jt], 0, 0, 0);
                        if (jt == it) {
#pragma unroll
                            for (int r = 0; r < 4; ++r) if (4 * fq + r > li) tl[jt][r] = 0.f; }
                    }
                }
                am[it][0] = pack8(tl[0], tl[1]); am[it][1] = pack8(tl[2], tl[3]);
            }
            bf16x8 Sb[3];
#pragma unroll
            for (int s = 0; s < 3; ++s) Sb[s] = pack8(S[2 * s], S[2 * s + 1]);
#pragma unroll
            for (int it = 0; it < 4; ++it) {
                f32x4 o = (f32x4){0.f, 0.f, 0.f, 0.f};
#pragma unroll
                for (int s2 = 0; s2 < 2; ++s2) if (2 * s2 <= it) o = __builtin_amdgcn_mfma_f32_16x16x32_bf16(am[it][s2], vf[s2], o, 0, 0, 0);
#pragma unroll
                for (int s = 0; s < 3; ++s) o = __builtin_amdgcn_mfma_f32_16x16x32_bf16(qf[it][s], Sb[s], o, 0, 0, 0);
#pragma unroll
                for (int r = 0; r < 4; ++r) OG[(pos0 + 16 * it + 4 * fq + r) * 768 + h * 192 + 16 * et + li] = o[r];
            }
            const float* dp = DEC + ((size_t)bh * 32 + c) * 96 + 4 * fq;
#pragma unroll
            for (int dt = 0; dt < 6; ++dt) {
                const f32x4 dc = *(const f32x4*)(dp + 16 * dt);
                f32x4 acc = S[dt] * dc;
#pragma unroll
                for (int s2 = 0; s2 < 2; ++s2) { const bf16_t* kp = kpp + (size_t)(16 * dt) * SEQ + c * 64 + 32 * s2;
                    acc = __builtin_amdgcn_mfma_f32_16x16x32_bf16(ld2x8(kp, kp + 16), vf[s2], acc, 0, 0, 0); }
                S[dt] = acc;
            }
        }
    }
}
__device__ __forceinline__ void p_gla_norm(Frame& F, const Args& a) {
    const float* OG = F.out; const bf16_t* GR = (const bf16_t*)(F.ws + WS_GR); bf16_t* AO = (bf16_t*)(F.ws + WS_AO1);
    const float* ng = (const float*)a.in[I_GLA_NORMG];
    const int lane = F.lane;
    float ngv[3];
#pragma unroll
    for (int j = 0; j < 3; ++j) ngv[j] = ng[lane + 64 * j];
    for (int idx = F.gw; idx < NT * 4; idx += F.NGW) {
        const int t = idx >> 2, h = idx & 3;
        float o[3]; float ss = 0.f;
#pragma unroll
        for (int j = 0; j < 3; ++j) { o[j] = OG[(size_t)t * 768 + h * 192 + lane + 64 * j]; ss += o[j] * o[j]; }
        const float r = 1.f / sqrtf(wave_sum(ss) * (1.f / 192.f) + RMS_EPS);
#pragma unroll
        for (int j = 0; j < 3; ++j) { const float rr = bf2f(GR[(size_t)t * 768 + h * 192 + lane + 64 * j]);
            AO[(size_t)t * 1024 + h * 192 + lane + 64 * j] = (bf16_t)f2bf(o[j] * r * ngv[j] * silu_f(rr)); }
    }
}

constexpr int NPHASE = 19;
#define GEMM_CALL(EpiT, SchedT, g, S, E) pg8::gemm_phase<EpiT, SchedT, true, true>(F.lds, g, S, E)
__device__ __forceinline__ void moe_gemms_up(Frame& F, int layer, const bf16_t* X1b, bf16_t* ACT) {
    LAS int* tp = (LAS int*)(F.lds + MISC_OFF + 256);
    const unsigned* cnt = F.ctl + CW_CNT + layer * 32;
    moe_tile_table(F, cnt, tp);
    pg8::Gemm g{X1b, (const bf16_t*)(F.ws + WS_W13), SLOT_ROWS, 512, 1024};
    MoeOrder S{tp, cnt, (const int*)(F.ws + WS_LISTTOK), 2, F.G, (int)blockIdx.x, true};
    EpiMoe1 E{ACT, (const float*)(F.ws + WS_LISTW), cnt};
    GEMM_CALL(EpiMoe1, MoeOrder, g, S, E);
}
__device__ __forceinline__ void moe_gemms_down(Frame& F, int layer, const bf16_t* ACT) {
    LAS int* tp = (LAS int*)(F.lds + MISC_OFF + 256);
    const unsigned* cnt = F.ctl + CW_CNT + layer * 32;
    moe_tile_table(F, cnt, tp);
    pg8::Gemm g{ACT, (const bf16_t*)(F.ws + WS_W2), SLOT_ROWS, 1024, 256};
    MoeOrder S{tp, cnt, nullptr, 4, F.G, (int)blockIdx.x, false};
    EpiBf16Plain E{(bf16_t*)(F.ws + WS_Y), 1024, 3};
    GEMM_CALL(EpiBf16Plain, MoeOrder, g, S, E);
}
__device__ __forceinline__ void out_proj(Frame& F, int layer, const bf16_t* AO) {
    pg8::Gemm g{AO, (const bf16_t*)(F.ws + WS_WO) + (size_t)layer * 1024 * 1024, NT, 1024, 1024};
    pg8::StaticOrder S; S.init(NT, 1024, F.G, (int)blockIdx.x);
    EpiF32Plain E{F.out, 1024};
    GEMM_CALL(EpiF32Plain, pg8::StaticOrder, g, S, E);
}

__global__ void __launch_bounds__(NWAVES * 64, 2) mk_fwd(Args args) {
    extern __shared__ __attribute__((aligned(16))) unsigned char lds_raw[];
    Frame F;
    F.lds = (LAS unsigned char*)lds_raw; F.ws = args.ws; F.out = args.out; F.ctl = (unsigned*)(args.ws + WS_CTL);
    F.tid = threadIdx.x; F.lane = F.tid & 63; F.wave = __builtin_amdgcn_readfirstlane(F.tid >> 6); F.G = gridDim.x;
    F.gw = blockIdx.x * NWAVES + F.wave; F.NGW = F.G * NWAVES;
    volatile LAS unsigned* MISC = (volatile LAS unsigned*)(F.lds + MISC_OFF);
    if (F.tid < 64) MISC[F.tid] = 0u;
    __syncthreads();
#if N_LAUNCH_MODE == 1
    XcdBarrier bar = xcd_barrier_post(F.ctl + CW_BAR, MISC + 8);
#define SEAM() xcd_barrier(bar)
#else
#define SEAM() do {} while (0)
#endif
    const int lo = args.ph_lo, hi = args.ph_hi;
#ifndef PH_ENABLE
#define PH_ENABLE 0xFFFFFFFFu
#endif
#define IN(k) (((PH_ENABLE >> (k)) & 1u) && lo <= (k) && (k) < hi)
#define ENDPH(k) do { if (IN((k) + 1)) SEAM(); } while (0)

    if (IN(0)) { p_prologue(F, args); ENDPH(0); }
    if (IN(1)) {
        { pg8::Gemm g{(const bf16_t*)(F.ws + WS_XB), (const bf16_t*)(F.ws + WS_WD), NT, ND, 1024};
          pg8::StaticOrder S; S.init(NT, ND, F.G, (int)blockIdx.x);
          EpiDsaProj E{(bf16_t*)(F.ws + WS_Q), (bf16_t*)(F.ws + WS_K), (bf16_t*)(F.ws + WS_V), (bf16_t*)(F.ws + WS_QI), (bf16_t*)(F.ws + WS_QM), (float*)(F.ws + WS_KIW),
                       (const float*)(F.ws + WS_ROPEC), (const float*)(F.ws + WS_ROPES)};
          GEMM_CALL(EpiDsaProj, pg8::StaticOrder, g, S, E); }
        { pg8::Gemm g{(const bf16_t*)(F.ws + WS_MEMB), (const bf16_t*)(F.ws + WS_WKV), NB * NMEM, 1024, 1024};
          pg8::StaticOrder S; S.init(NB * NMEM, 1024, F.G, (int)blockIdx.x);
          EpiBf16Plain E{(bf16_t*)(F.ws + WS_KVM), 1024, 0x7fffffff};
          GEMM_CALL(EpiBf16Plain, pg8::StaticOrder, g, S, E); }
        ENDPH(1);
    }
    if (IN(2)) { p_ki(F, args); ENDPH(2); }
    if (IN(3)) { p_indexer(F); ENDPH(3); }
    if (IN(4)) { p_attn_dsa(F); ENDPH(4); }
    if (IN(5)) { out_proj(F, 0, (const bf16_t*)(F.ws + WS_AO0)); ENDPH(5); }
    if (IN(6)) { p_ln1_router(F, args, 0, (const float*)args.in[I_X], (bf16_t*)(F.ws + WS_X1B0)); ENDPH(6); }
    if (IN(7)) { moe_gemms_up(F, 0, (const bf16_t*)(F.ws + WS_X1B0), (bf16_t*)(F.ws + WS_ACT0)); ENDPH(7); }
    if (IN(8)) { moe_gemms_down(F, 0, (const bf16_t*)(F.ws + WS_ACT0)); ENDPH(8); }
    if (IN(9)) { p_ln2(F, args, 0, (float*)(F.ws + WS_X1), (bf16_t*)(F.ws + WS_C));
                 moe_weight_items(F, (const float*)args.in[I_MOE_W13], (const float*)args.in[I_MOE_W2], 1); ENDPH(9); }
    if (IN(10)) {
        pg8::Gemm g{(const bf16_t*)(F.ws + WS_C), (const bf16_t*)(F.ws + WS_WG), NT, NG, 1024};
        pg8::StaticOrder S; S.init(NT, NG, F.G, (int)blockIdx.x);
        EpiGlaProj E{(bf16_t*)(F.ws + WS_GQ), (bf16_t*)(F.ws + WS_GK), (bf16_t*)(F.ws + WS_GV), (bf16_t*)(F.ws + WS_GR), (bf16_t*)(F.ws + WS_GQM), (float*)(F.ws + WS_A1)};
        GEMM_CALL(EpiGlaProj, pg8::StaticOrder, g, S, E);
        ENDPH(10);
    }
    if (IN(11)) { p_gla_prep(F, args); ENDPH(11); }
    if (IN(12)) { p_gla_scan(F); ENDPH(12); }
    if (IN(13)) { p_gla_norm(F, args); mem_attn_units(F, (const bf16_t*)(F.ws + WS_GQM), 1, (bf16_t*)(F.ws + WS_AO1)); ENDPH(13); }
    if (IN(14)) { out_proj(F, 1, (const bf16_t*)(F.ws + WS_AO1)); ENDPH(14); }
    if (IN(15)) { p_ln1_router(F, args, 1, (const float*)(F.ws + WS_X1), (bf16_t*)(F.ws + WS_X1B1)); ENDPH(15); }
    if (IN(16)) { moe_gemms_up(F, 1, (const bf16_t*)(F.ws + WS_X1B1), (bf16_t*)(F.ws + WS_ACT1)); ENDPH(16); }
    if (IN(17)) { moe_gemms_down(F, 1, (const bf16_t*)(F.ws + WS_ACT1)); ENDPH(17); }
    if (IN(18)) { p_ln2(F, args, 1, F.out, nullptr); }
#undef IN
#undef ENDPH
}

extern "C" void kernel_launch(void* const* d_in, const int* in_sizes, int n_in, void* d_out, int out_size, void* d_ws, size_t ws_size, hipStream_t stream) {
    static int grid = 0;
    if (grid == 0) {
        if (n_in != 22 || out_size != NT * DM || ws_size < WS_END) { fprintf(stderr, "kernel_launch: unexpected shapes: n_in %d out %d ws %zu (need %zu)\n", n_in, out_size, ws_size, (size_t)WS_END); grid = -1; return; }
        int dev = 0, cus = 0, per_cu = 0;
        if (hipGetDevice(&dev) != hipSuccess || hipDeviceGetAttribute(&cus, hipDeviceAttributeMultiprocessorCount, dev) != hipSuccess) { grid = -1; return; }
        if (hipFuncSetAttribute((const void*)mk_fwd, hipFuncAttributeMaxDynamicSharedMemorySize, LDS_BYTES) != hipSuccess) { fprintf(stderr, "kernel_launch: hipFuncSetAttribute failed\n"); grid = -1; return; }
        if (hipOccupancyMaxActiveBlocksPerMultiprocessor(&per_cu, (const void*)mk_fwd, NWAVES * 64, LDS_BYTES) != hipSuccess || per_cu < 1) fprintf(stderr, "kernel_launch: occupancy query reports %d\n", per_cu);
        (void)hipGetLastError();
        grid = cus;
    }
    if (grid < 0) return;
    (void)hipMemsetAsync((char*)d_ws + WS_CTL, 0, CTL_ZERO_BYTES, stream);
    Args a{};
    for (int i = 0; i < 22; ++i) a.in[i] = d_in[i];
    a.out = (float*)d_out; a.ws = (unsigned char*)d_ws;
#if N_LAUNCH_MODE == 1
    a.ph_lo = 0; a.ph_hi = NPHASE;
    hipLaunchKernelGGL(mk_fwd, dim3(grid), dim3(NWAVES * 64), LDS_BYTES, stream, a);
#else
    for (int k = 0; k < NPHASE; ++k) { a.ph_lo = k; a.ph_hi = k + 1; hipLaunchKernelGGL(mk_fwd, dim3(grid), dim3(NWAVES * 64), LDS_BYTES, stream, a); }
#endif
}
```

```cpp
#include <hip/hip_runtime.h>
#include <cstdio>
#include <cstdint>

#define LAS __attribute__((address_space(3)))
#define GAS __attribute__((address_space(1)))
typedef unsigned short bf16_t;
typedef short bf16x8 __attribute__((ext_vector_type(8)));
typedef short s16x4 __attribute__((ext_vector_type(4)));
typedef float f32x4 __attribute__((ext_vector_type(4)));
typedef float f32x2 __attribute__((ext_vector_type(2)));
typedef float f32x16 __attribute__((ext_vector_type(16)));
typedef unsigned u32x4 __attribute__((ext_vector_type(4)));
typedef unsigned u32x2 __attribute__((ext_vector_type(2)));

#ifndef N_LAUNCH_MODE
#define N_LAUNCH_MODE 1
#endif

constexpr int NB = 16, SEQ = 2048, DM = 1024, NT = NB * SEQ;
constexpr int NMEM = 256;
constexpr int ND = 3328;
constexpr int NG = 2816;
constexpr int DSA_W = 3144, GLA_W = 2576;
constexpr int NEXP = 32;
constexpr int SLOT_ROWS = 73728;
constexpr float ALPHA = 1.4142135623730951f;
constexpr float LN_EPS = 1e-5f, RMS_EPS = 1e-6f;
constexpr float LOG2E = 1.4426950408889634f;
constexpr float C2 = 0.125f * LOG2E;
constexpr int NWAVES = 8;

constexpr size_t MiB = 1u << 20;
constexpr size_t WS_CTL = 0, CTL_ZERO_BYTES = 1 * MiB;
constexpr size_t WS_ROPEC = 1 * MiB, WS_ROPES = 5 * MiB;
constexpr size_t WS_DEC = 9 * MiB;
constexpr size_t WS_WD = 10 * MiB, WS_WG = 17 * MiB, WS_WKV = 23 * MiB, WS_WO = 25 * MiB, WS_W13 = 29 * MiB, WS_W2 = 61 * MiB;
constexpr size_t WS_KVM = 77 * MiB;
constexpr size_t WS_MEMB = 85 * MiB;
constexpr size_t WS_LISTTOK = 85 * MiB, WS_LISTW = 89 * MiB;
constexpr size_t WS_TOKSLOT = 93 * MiB;
constexpr size_t WS_A = 96 * MiB;
constexpr size_t WS_B = 160 * MiB;
constexpr size_t WS_C = 288 * MiB;
constexpr size_t WS_D = 352 * MiB;
constexpr size_t WS_END = 500 * MiB;
constexpr size_t WS_XB = WS_A;
constexpr size_t WS_Q = 160 * MiB, WS_K = 208 * MiB, WS_V = 256 * MiB, WS_QI = 304 * MiB, WS_QM = 336 * MiB, WS_KIW = 352 * MiB, WS_KI = 362 * MiB, WS_WI = 366 * MiB, WS_MASK = 368 * MiB, WS_AO0 = 376 * MiB;
constexpr size_t WS_X1 = WS_B, WS_X1B0 = WS_C, WS_ACT0 = WS_A, WS_Y = WS_D;
constexpr size_t WS_GV = 96 * MiB, WS_GQM = 144 * MiB, WS_GQ = 352 * MiB, WS_GK = 376 * MiB, WS_GR = 400 * MiB, WS_A1 = 448 * MiB, WS_KPT = 450 * MiB, WS_VT = WS_C, WS_AO1 = WS_C;
constexpr size_t WS_X1B1 = WS_A, WS_ACT1 = WS_C;
constexpr int KIW_P = 80;

constexpr int CW_CNT = 64;
constexpr int CW_BAR = 4096;

__device__ __forceinline__ unsigned f2bf(float f) { unsigned u = __builtin_bit_cast(unsigned, f); return (u + 0x7fffu + ((u >> 16) & 1u)) >> 16; }
__device__ __forceinline__ unsigned pk2(float lo, float hi) { return f2bf(lo) | (f2bf(hi) << 16); }
__device__ __forceinline__ float bf2f(unsigned h) { return __builtin_bit_cast(float, h << 16); }
__device__ __forceinline__ float wave_sum(float v) {
#pragma unroll
    for (int o = 1; o < 64; o <<= 1) v += __shfl_xor(v, o);
    return v;
}
__device__ __forceinline__ float fast_exp2(float x) { return __builtin_amdgcn_exp2f(x); }
__device__ __forceinline__ float silu_f(float a) { return a * __builtin_amdgcn_rcpf(1.f + fast_exp2(-a * LOG2E)); }

namespace pg8 {
constexpr int BM = 256, BK = 64, HALF = 128, HTB = HALF * BK * 2, STAGE_BYTES = 8 * HTB, NXCD = 8, WGM = 8;
__host__ __device__ __forceinline__ int lds_byte(int r, int c) { const int st = (r >> 4) * 2 + (c >> 5), rr = r & 15, cc = c & 31, ob = rr * 64 + cc * 2; return st * 1024 + (ob ^ (((ob >> 9) & 1) << 5)); }
__host__ __device__ __forceinline__ void stage_rc(int b, int& R, int& C) { const int st = b / 1024, sb = b % 1024, swz = sb ^ (((sb >> 9) & 1) << 5); R = (st >> 1) * 16 + swz / 64; C = (st & 1) * 32 + (swz % 64) / 2; }
__host__ __device__ __forceinline__ int perm32(int rho) { const int n = rho >> 4, i = rho & 15; return 8 * (i >> 2) + 4 * n + (i & 3); }

struct Unit { int pm, pn, e, r0; };
struct Gemm { const bf16_t* A; const bf16_t* Bt; int M, N, K; };

struct StaticOrder {
    int nM, nN, nwg, G, c;
    __device__ void init(int M, int N, int G_, int c_) { nM = M / BM; nN = N / BM; nwg = nM * nN; G = G_; c = c_; }
    __device__ bool next(int i, Unit& u) const {
        const long L = (long)i * G + c; if (L >= nwg) return false;
        int wgid = (int)L; { const int q = nwg / NXCD, r = nwg % NXCD, xcd = wgid % NXCD, off = wgid / NXCD; wgid = (xcd < r ? xcd * (q + 1) : r * (q + 1) + (xcd - r) * q) + off; }
        const int nig = WGM * nN, gid = wgid / nig, fm = gid * WGM, gsz = (nM - fm) < WGM ? (nM - fm) : WGM;
        u.pm = fm + ((wgid % nig) % gsz); u.pn = (wgid % nig) / gsz; u.e = 0; u.r0 = 0; return true;
    }
    __device__ __forceinline__ int rowidx(const Unit& u, int r) const { return u.pm * BM + r; }
};

typedef __bf16 bf16x2_t __attribute__((ext_vector_type(2)));
__device__ __forceinline__ unsigned cvt_pk_bf16(float lo, float hi) { f32x2 v = {lo, hi}; bf16x2_t b = __builtin_convertvector(v, bf16x2_t); return __builtin_bit_cast(unsigned, b); }

template <class Epi, class Sched, bool ALIGN_EPI, bool SP2>
__device__ __forceinline__ void gemm_phase(LAS unsigned char* lds, const Gemm g, const Sched& S, const Epi& E) {
    const int tid = threadIdx.x, wid = __builtin_amdgcn_readfirstlane(tid >> 6), lane = tid & 63, wr = wid >> 2, wc = wid & 3, fr = lane & 15, fq = lane >> 4;
    const int K = g.K, nt = K / BK;
    int RA[2], CA[2]; unsigned voffB[2];
#pragma unroll
    for (int i = 0; i < 2; ++i) { int R, C; stage_rc(tid * 16 + i * 8192, R, C); const int Rb = (R & ~31) + perm32(R & 31);
        RA[i] = R; CA[i] = C; voffB[i] = (unsigned)(Rb * K + C) * 2u; }
    const size_t kstep = (size_t)(BK * 2);
    const size_t hstep = (size_t)HALF * K * 2;
    const size_t tstep = 2 * hstep;
    const unsigned ldsw = (unsigned)wid * 1024u;
    const int aoff = lds_byte(wr * 64 + fr, fq * 8), boff = lds_byte(wc * 32 + fr, fq * 8);
#define PG8_SA(b, h) (((b) * 2 + (h)) * HTB)
#define PG8_SB(b, h) ((4 + (b) * 2 + (h)) * HTB)
#define PG8_STAGE(bufoff, gbase, voff) do { _Pragma("unroll") for (int _i = 0; _i < 2; ++_i) \
        __builtin_amdgcn_global_load_lds((const unsigned*)((const char*)(gbase) + (voff)[_i]), (LAS unsigned*)(lds + (bufoff) + ldsw + _i * 8192), 16, 0, 0); } while (0)
#define PG8_LDA(dst, b, h) do { _Pragma("unroll") for (int m = 0; m < 4; ++m) _Pragma("unroll") for (int k = 0; k < 2; ++k) dst[m][k] = *(const LAS bf16x8*)(lds + PG8_SA(b, h) + aoff + m * 2048 + k * 1024); } while (0)
#define PG8_LDB(dst, b, h) do { _Pragma("unroll") for (int n = 0; n < 2; ++n) _Pragma("unroll") for (int k = 0; k < 2; ++k) dst[n][k] = *(const LAS bf16x8*)(lds + PG8_SB(b, h) + boff + n * 2048 + k * 1024); } while (0)
#define PG8_MMA(ai, bj, At, Bt) do { __builtin_amdgcn_s_setprio(1); _Pragma("unroll") for (int m = 0; m < 4; ++m) _Pragma("unroll") for (int n = 0; n < 2; ++n) _Pragma("unroll") for (int k = 0; k < 2; ++k) \
        acc[ai][bj][m][n] = __builtin_amdgcn_mfma_f32_16x16x32_bf16(Bt[n][k], At[m][k], acc[ai][bj][m][n], 0, 0, 0); __builtin_amdgcn_s_setprio(0); } while (0)
#define PG8_WAIT_V(n) asm volatile("s_waitcnt vmcnt(" #n ")" ::: "memory")
#define PG8_WAIT_L(n) asm volatile("s_waitcnt lgkmcnt(" #n ")" ::: "memory")
#define PG8_BAR __builtin_amdgcn_s_barrier()
#define PG8_SCHED __builtin_amdgcn_sched_barrier(0)
#define PG8_MKOFF(o0, o1, u) do { _Pragma("unroll") for (int _i = 0; _i < 2; ++_i) { \
        o0[_i] = ((unsigned)S.rowidx(u, RA[_i]) * (unsigned)K + (unsigned)CA[_i]) * 2u; o1[_i] = ((unsigned)S.rowidx(u, HALF + RA[_i]) * (unsigned)K + (unsigned)CA[_i]) * 2u; } } while (0)
    Unit cur, nxt; int ui = 0;
    if (!S.next(0, cur)) return;
    f32x4 acc[2][2][4][2];
#pragma unroll
    for (int a = 0; a < 2; ++a)
#pragma unroll
        for (int b = 0; b < 2; ++b)
#pragma unroll
            for (int m = 0; m < 4; ++m)
#pragma unroll
                for (int n = 0; n < 2; ++n) acc[a][b][m][n] = (f32x4){0.f, 0.f, 0.f, 0.f};
    bf16x8 At[4][2], B0[2][2], B1[2][2];
    const char* const gA = (const char*)g.A;
    unsigned cO0[2], cO1[2], nO0[2], nO1[2];
    PG8_MKOFF(cO0, cO1, cur);
    const char* cB = (const char*)g.Bt + (size_t)cur.pn * tstep;
    if constexpr (SP2) {
        PG8_STAGE(PG8_SB(0, 0), cB, voffB); PG8_STAGE(PG8_SB(0, 1), cB + hstep, voffB); PG8_STAGE(PG8_SA(0, 0), gA, cO0); PG8_STAGE(PG8_SA(0, 1), gA, cO1);
        if (wr == 1) PG8_BAR;
        PG8_WAIT_V(2); PG8_BAR;
        PG8_STAGE(PG8_SB(1, 0), cB + kstep, voffB); PG8_STAGE(PG8_SA(1, 0), gA + kstep, cO0); PG8_STAGE(PG8_SB(1, 1), cB + hstep + kstep, voffB);
        PG8_WAIT_V(6); PG8_BAR;
    } else {
        PG8_STAGE(PG8_SB(0, 0), cB, voffB); PG8_STAGE(PG8_SA(0, 0), gA, cO0); PG8_STAGE(PG8_SB(0, 1), cB + hstep, voffB); PG8_STAGE(PG8_SA(0, 1), gA, cO1);
        if (wr == 1) PG8_BAR;
        PG8_WAIT_V(4); PG8_BAR;
        PG8_STAGE(PG8_SB(1, 0), cB + kstep, voffB); PG8_STAGE(PG8_SA(1, 0), gA + kstep, cO0); PG8_STAGE(PG8_SB(1, 1), cB + hstep + kstep, voffB);
        PG8_WAIT_V(6); PG8_BAR;
    }
    for (;;) {
        const bool has_next = S.next(ui + 1, nxt);
        if (has_next) { PG8_MKOFF(nO0, nO1, nxt); } else {
#pragma unroll
            for (int _i = 0; _i < 2; ++_i) { nO0[_i] = cO0[_i]; nO1[_i] = cO1[_i]; } }
        const char* nB = has_next ? (const char*)g.Bt + (size_t)nxt.pn * tstep : cB;
#pragma unroll 1
        for (int t = 0; t < nt; t += 2) {
            const bool last = (t == nt - 2);
            const char* a1 = gA + (size_t)(t + 1) * kstep;
            const char* a2 = last ? gA : gA + (size_t)(t + 2) * kstep; const char* b2 = last ? nB : cB + (size_t)(t + 2) * kstep;
            const char* a3 = a2 + kstep; const char* b3 = b2 + kstep;
            unsigned x0[2], x1[2];
#pragma unroll
            for (int _i = 0; _i < 2; ++_i) { x0[_i] = last ? nO0[_i] : cO0[_i]; x1[_i] = last ? nO1[_i] : cO1[_i]; }
            if constexpr (SP2) {
            PG8_LDB(B0, 0, 0); PG8_LDB(B1, 0, 1); PG8_SCHED; PG8_LDA(At, 0, 0); PG8_STAGE(PG8_SA(1, 1), a1, cO1);
            PG8_WAIT_V(8); PG8_WAIT_L(0); PG8_BAR; PG8_MMA(0, 0, At, B0); PG8_MMA(0, 1, At, B1); PG8_BAR; PG8_SCHED;
            PG8_LDA(At, 0, 1); PG8_STAGE(PG8_SB(0, 0), b2, voffB); PG8_STAGE(PG8_SB(0, 1), b2 + hstep, voffB); PG8_STAGE(PG8_SA(0, 0), a2, x0);
            PG8_WAIT_V(8); PG8_WAIT_L(0); PG8_BAR; PG8_MMA(1, 0, At, B0); PG8_MMA(1, 1, At, B1); PG8_BAR; PG8_SCHED;
            PG8_LDB(B0, 1, 0); PG8_LDB(B1, 1, 1); PG8_SCHED; PG8_LDA(At, 1, 0); PG8_STAGE(PG8_SA(0, 1), a2, x1);
            PG8_WAIT_V(8); PG8_WAIT_L(0); PG8_BAR; PG8_MMA(0, 0, At, B0); PG8_MMA(0, 1, At, B1); PG8_BAR; PG8_SCHED;
            PG8_LDA(At, 1, 1); PG8_STAGE(PG8_SB(1, 0), b3, voffB); PG8_STAGE(PG8_SB(1, 1), b3 + hstep, voffB); PG8_STAGE(PG8_SA(1, 0), a3, x0);
            PG8_WAIT_V(8); PG8_WAIT_L(0); PG8_BAR; PG8_MMA(1, 0, At, B0); PG8_MMA(1, 1, At, B1); PG8_BAR; PG8_SCHED;
            } else {
            PG8_LDB(B0, 0, 0); PG8_SCHED; PG8_LDA(At, 0, 0); PG8_STAGE(PG8_SA(1, 1), a1, cO1);
            PG8_WAIT_L(8); PG8_BAR; PG8_WAIT_L(0); PG8_MMA(0, 0, At, B0); PG8_BAR; PG8_SCHED;
            PG8_LDB(B1, 0, 1); PG8_STAGE(PG8_SB(0, 0), b2, voffB);
            PG8_BAR; PG8_WAIT_L(0); PG8_MMA(0, 1, At, B1); PG8_BAR;
            PG8_LDA(At, 0, 1); PG8_STAGE(PG8_SA(0, 0), a2, x0);
            PG8_BAR; PG8_WAIT_L(0); PG8_MMA(1, 0, At, B0); PG8_BAR; PG8_SCHED;
            PG8_STAGE(PG8_SB(0, 1), b2 + hstep, voffB);
            PG8_WAIT_V(6); PG8_BAR; PG8_MMA(1, 1, At, B1); PG8_BAR;
            PG8_LDB(B0, 1, 0); PG8_SCHED; PG8_LDA(At, 1, 0); PG8_STAGE(PG8_SA(0, 1), a2, x1);
            PG8_WAIT_L(8); PG8_BAR; PG8_WAIT_L(0); PG8_MMA(0, 0, At, B0); PG8_BAR; PG8_SCHED;
            PG8_LDB(B1, 1, 1); PG8_STAGE(PG8_SB(1, 0), b3, voffB);
            PG8_BAR; PG8_WAIT_L(0); PG8_MMA(0, 1, At, B1); PG8_BAR;
            PG8_LDA(At, 1, 1); PG8_STAGE(PG8_SA(1, 0), a3, x0);
            PG8_BAR; PG8_WAIT_L(0); PG8_MMA(1, 0, At, B0); PG8_BAR; PG8_SCHED;
            PG8_STAGE(PG8_SB(1, 1), b3 + hstep, voffB);
            PG8_WAIT_V(6); PG8_BAR; PG8_MMA(1, 1, At, B1); PG8_BAR;
            }
        }
        if constexpr (ALIGN_EPI) { if (wr == 0) PG8_BAR; }
        E(acc, cur, wr, wc, fr, fq);
        if (!has_next) break;
#pragma unroll
        for (int a = 0; a < 2; ++a)
#pragma unroll
            for (int b = 0; b < 2; ++b)
#pragma unroll
                for (int m = 0; m < 4; ++m)
#pragma unroll
                    for (int n = 0; n < 2; ++n) acc[a][b][m][n] = (f32x4){0.f, 0.f, 0.f, 0.f};
        cur = nxt; cB = nB; ++ui;
#pragma unroll
        for (int _i = 0; _i < 2; ++_i) { cO0[_i] = nO0[_i]; cO1[_i] = nO1[_i]; }
        if constexpr (ALIGN_EPI) { if (wr == 1) PG8_BAR; }
    }
    PG8_WAIT_V(0);
    if constexpr (!ALIGN_EPI) { if (wr == 0) PG8_BAR; }
    PG8_BAR;
#undef PG8_SA
#undef PG8_SB
#undef PG8_STAGE
#undef PG8_LDA
#undef PG8_LDB
#undef PG8_MMA
#undef PG8_WAIT_V
#undef PG8_WAIT_L
#undef PG8_BAR
#undef PG8_SCHED
#undef PG8_MKOFF
}
}

#define XB_TMO      128
#define XB_XCNT(j)  (256  + 64 * (j))
#define XB_XSUB(j)  (1280 + 64 * (j))
#define XB_XGEN(j)  (2304 + 64 * (j))
#define XB_TOP      3328
#define XB_TOPGEN   3392
#define XCD_BAR_WORDS 3456
#define XB_SPIN_CAP (1u << 18)
__device__ __forceinline__ unsigned xb_ld(unsigned* p)              { return __hip_atomic_load(p, __ATOMIC_RELAXED, __HIP_MEMORY_SCOPE_AGENT); }
__device__ __forceinline__ unsigned xb_add(unsigned* p, unsigned v) { return __hip_atomic_fetch_add(p, v, __ATOMIC_RELAXED, __HIP_MEMORY_SCOPE_AGENT); }
__device__ __forceinline__ unsigned xb_xcc_id() { return (unsigned)__builtin_amdgcn_s_getreg((3 << 11) | 20) & 0xFu; }
#define XB_SPIN(cond, bar) do { unsigned _sp = 0; while (cond) { __builtin_amdgcn_s_sleep(1); \
    if ((++_sp & 255u) == 0u) { if (xb_ld(&(bar)[XB_TMO])) break; if (_sp > XB_SPIN_CAP) { atomicAdd(&(bar)[XB_TMO], 1u); break; } } } } while (0)
struct XcdBarrier { unsigned* bar; unsigned x; volatile LAS unsigned* st; };
__device__ __forceinline__ XcdBarrier xcd_barrier_post(unsigned* bar, volatile LAS unsigned* st) {
    XcdBarrier b; b.bar = bar; b.x = xb_xcc_id(); b.st = st;
    if (threadIdx.x == 0) (void)xb_add(&bar[XB_XCNT(b.x)], 1u);
    return b;
}
__device__ __forceinline__ void xcd_barrier_complete(unsigned* bar, unsigned x, unsigned& nloc, unsigned& nx) {
    const unsigned G = gridDim.x * gridDim.y * gridDim.z;
    unsigned sum, cnt, mine, sp = 0u;
    for (;;) {
        sum = 0u; cnt = 0u; mine = 0u;
#pragma unroll
        for (unsigned j = 0; j < 16; ++j) { const unsigned c = xb_ld(&bar[XB_XCNT(j)]); sum += c; cnt += (c > 0u) ? 1u : 0u; mine = (j == x) ? c : mine; }
        if (sum == G) break;
        __builtin_amdgcn_s_sleep(1);
        if ((++sp & 255u) == 0u) { if (xb_ld(&bar[XB_TMO])) break; if (sp > XB_SPIN_CAP) { atomicAdd(&bar[XB_TMO], 1u); break; } }
    }
    nloc = mine > 0u ? mine : 1u; nx = cnt > 0u ? cnt : 1u;
}
__device__ __forceinline__ void xcd_barrier(const XcdBarrier& b) {
    asm volatile("s_waitcnt vmcnt(0)" ::: "memory");
    __syncthreads();
    if (threadIdx.x == 0) {
        unsigned* bar = b.bar;
        __builtin_amdgcn_s_waitcnt(0);
        unsigned nloc = b.st[0], nx = b.st[1];
        if (nloc == 0u) { xcd_barrier_complete(bar, b.x, nloc, nx); b.st[0] = nloc; b.st[1] = nx; }
        const unsigned old = xb_add(&bar[XB_XSUB(b.x)], 1u);
        const unsigned gen = old / nloc;
        if (old + 1u == (gen + 1u) * nloc) {
            __builtin_amdgcn_fence(__ATOMIC_RELEASE, "agent");
            asm volatile("s_waitcnt vmcnt(0)" ::: "memory");
            const unsigned og = xb_add(&bar[XB_TOP], 1u);
            const unsigned tg = og / nx;
            if (og + 1u == (tg + 1u) * nx) xb_add(&bar[XB_TOPGEN], 1u);
            else XB_SPIN(xb_ld(&bar[XB_TOPGEN]) == tg, bar);
            __builtin_amdgcn_fence(__ATOMIC_ACQUIRE, "agent");
            xb_add(&bar[XB_XGEN(b.x)], 1u);
            asm volatile("s_waitcnt vmcnt(0)" ::: "memory");
        } else {
            XB_SPIN(xb_ld(&bar[XB_XGEN(b.x)]) == gen, bar);
            __builtin_amdgcn_fence(__ATOMIC_ACQUIRE, "agent");
            asm volatile("s_waitcnt vmcnt(0)" ::: "memory");
        }
    }
    __syncthreads();
}

constexpr int LDS_BYTES = 147456;
constexpr int MISC_OFF = 135168;
struct Args { const void* in[22]; float* out; unsigned char* ws; int ph_lo, ph_hi; };
struct Frame {
    LAS unsigned char* lds;
    unsigned char* ws; float* out;
    unsigned* ctl;
    int tid, lane, wave, G, gw, NGW;
};
enum { I_X = 0, I_MEM, I_POS, I_DSA_WIN, I_DSA_KG, I_DSA_KB, I_GLA_WIN, I_GLA_WGATE, I_GLA_BGATE, I_GLA_NORMG, I_WMEMKV, I_WOUT, I_LN1G, I_LN1B, I_LN2G, I_LN2B,
       I_MOE_WG, I_MOE_BG, I_MOE_WR, I_MOE_BR, I_MOE_W13, I_MOE_W2 };

__device__ __forceinline__ int dperm(int c) { return ((c >> 2) & 1) * 32 + (c >> 5) * 16 + ((c >> 3) & 3) * 4 + (c & 3); }
__device__ __forceinline__ int dperm_inv(int d) { const int n = d >> 5, i = d & 31; return (i >> 4) * 32 + ((i >> 2) & 3) * 8 + n * 4 + (i & 3); }
__device__ __forceinline__ int dsa_srccol(int n) {
    if (n < 1536) { return (n & ~63) + dperm(n & 63); }
    if (n < 2304) return n;
    if (n < 2816) { return (n & ~63) + dperm(n & 63); }
    if (n < 3072) return 2888 + (n - 2816);
    if (n < 3136) return 2816 + (n - 3072);
    if (n < 3144) return 2880 + (n - 3136);
    return -1;
}
__device__ __forceinline__ int gla_srccol(int n) {
    if (n < 2304) return n;
    if (n < 2560) return 2320 + (n - 2304);
    if (n < 2576) return 2304 + (n - 2560);
    return -1;
}
__device__ __forceinline__ int w13_srccol(int r) { const int pn = r >> 8, bj = (r >> 7) & 1, j = r & 127; return bj * 256 + pn * 128 + j; }
template <int MODE>
__device__ __forceinline__ void transpose_item(const float* W, int K, int ldw, bf16_t* WT, int nrows32, LAS float* scr, int item, int lane) {
    const int kb = item / nrows32, nb = item % nrows32, k0 = 64 * kb, n0 = 32 * nb;
    const int n = n0 + (lane & 31);
    int sc;
    if (MODE == 0) sc = n; else if (MODE == 1) sc = dsa_srccol(n); else if (MODE == 2) sc = gla_srccol(n); else sc = w13_srccol(n);
#pragma unroll 8
    for (int i = 0; i < 32; ++i) { const int kk = 2 * i + (lane >> 5); scr[kk * 33 + (lane & 31)] = (sc >= 0) ? W[(size_t)(k0 + kk) * ldw + sc] : 0.f; }
    asm volatile("s_waitcnt lgkmcnt(0)" ::: "memory");
    const int c = lane & 7;
#pragma unroll
    for (int j = 0; j < 4; ++j) { const int nn = (lane >> 3) + 8 * j; const LAS float* s = scr + (8 * c) * 33 + nn;
        u32x4 o; o.x = pk2(s[0 * 33], s[1 * 33]); o.y = pk2(s[2 * 33], s[3 * 33]); o.z = pk2(s[4 * 33], s[5 * 33]); o.w = pk2(s[6 * 33], s[7 * 33]);
        *(u32x4*)(WT + (size_t)(n0 + nn) * K + k0 + 8 * c) = o; }
    asm volatile("s_waitcnt lgkmcnt(0)" ::: "memory");
}
__device__ __forceinline__ void moe_weight_items(Frame& F, const float* w13, const float* w2, int layer) {
    LAS float* scr = (LAS float*)(F.lds + F.wave * 16384);
    bf16_t* W13 = (bf16_t*)(F.ws + WS_W13); bf16_t* W2 = (bf16_t*)(F.ws + WS_W2);
    constexpr int I13 = (1024 / 64) * (512 / 32), I2 = (256 / 64) * (1024 / 32);
    for (int it = F.gw; it < NEXP * (I13 + I2); it += F.NGW) {
        const int ge = it / (I13 + I2), r = it % (I13 + I2);
        if (r < I13) transpose_item<3>(w13 + ((size_t)layer * NEXP + ge) * 1024 * 512, 1024, 512, W13 + (size_t)ge * 512 * 1024, 16, scr, r, F.lane);
        else transpose_item<0>(w2 + ((size_t)layer * NEXP + ge) * 256 * 1024, 256, 1024, W2 + (size_t)ge * 1024 * 256, 32, scr, r - I13, F.lane);
    }
}
__device__ __forceinline__ void cvt_rows_bf16(Frame& F, const float* src, bf16_t* dst, int rows) {
    for (int m = F.gw; m < rows; m += F.NGW) {
        const f32x4* xr = (const f32x4*)(src + (size_t)m * DM) + F.lane; u32x2* o = (u32x2*)(dst + (size_t)m * DM) + F.lane;
#pragma unroll
        for (int j = 0; j < 4; ++j) { const f32x4 v = xr[64 * j]; u32x2 w; w.x = pk2(v.x, v.y); w.y = pk2(v.z, v.w); o[64 * j] = w; }
    }
}
__device__ __forceinline__ void p_prologue(Frame& F, const Args& a) {
    LAS float* scr = (LAS float*)(F.lds + F.wave * 16384);
    const float* dsa_w = (const float*)a.in[I_DSA_WIN]; const float* gla_w = (const float*)a.in[I_GLA_WIN];
    const float* wkv = (const float*)a.in[I_WMEMKV]; const float* wout = (const float*)a.in[I_WOUT];
    bf16_t* WD = (bf16_t*)(F.ws + WS_WD); bf16_t* WG = (bf16_t*)(F.ws + WS_WG); bf16_t* WKV = (bf16_t*)(F.ws + WS_WKV); bf16_t* WO = (bf16_t*)(F.ws + WS_WO);
    constexpr int ID = 16 * (ND / 32), IG = 16 * (NG / 32), IKV = 16 * (512 / 32), IO = 16 * (1024 / 32);
    constexpr int NIT = ID + IG + 2 * IKV + 2 * IO;
    for (int it = F.gw; it < NIT; it += F.NGW) {
        int r = it;
        if (r < ID) { transpose_item<1>(dsa_w, 1024, DSA_W, WD, ND / 32, scr, r, F.lane); continue; } r -= ID;
        if (r < IG) { transpose_item<2>(gla_w, 1024, GLA_W, WG, NG / 32, scr, r, F.lane); continue; } r -= IG;
        if (r < 2 * IKV) { const int l = r / IKV; transpose_item<0>(wkv + (size_t)l * 1024 * 512, 1024, 512, WKV + (size_t)l * 512 * 1024, 16, scr, r % IKV, F.lane); continue; } r -= 2 * IKV;
        { const int l = r / IO; transpose_item<0>(wout + (size_t)l * 1024 * 1024, 1024, 1024, WO + (size_t)l * 1024 * 1024, 32, scr, r % IO, F.lane); }
    }
    moe_weight_items(F, (const float*)a.in[I_MOE_W13], (const float*)a.in[I_MOE_W2], 0);
    cvt_rows_bf16(F, (const float*)a.in[I_X], (bf16_t*)(F.ws + WS_XB), NT);
    cvt_rows_bf16(F, (const float*)a.in[I_MEM], (bf16_t*)(F.ws + WS_MEMB), NB * NMEM);
    const int* pos = (const int*)a.in[I_POS];
    float* RC = (float*)(F.ws + WS_ROPEC); float* RS = (float*)(F.ws + WS_ROPES);
    for (int idx = blockIdx.x * 512 + F.tid; idx < NT * 32; idx += F.G * 512) {
        const int t = idx >> 5, i = idx & 31;
        const float inv = (float)pow(10000.0, -(double)(2 * i) / 64.0);
        const float ang = (float)pos[t] * inv;
        double s, c; sincos((double)ang, &s, &c);
        RC[idx] = (float)c; RS[idx] = (float)s;
    }
}

typedef const f32x4 (&AccRef)[2][2][4][2];
__device__ __forceinline__ void st_bf16x8(bf16_t* p, f32x4 v0, f32x4 v1) {
    u32x4 w; w.x = pg8::cvt_pk_bf16(v0[0], v0[1]); w.y = pg8::cvt_pk_bf16(v0[2], v0[3]); w.z = pg8::cvt_pk_bf16(v1[0], v1[1]); w.w = pg8::cvt_pk_bf16(v1[2], v1[3]);
    *(u32x4*)p = w;
}
struct EpiDsaProj {
    bf16_t *Q, *K, *V, *QI, *QM; float* KIW; const float *RC, *RS;
    __device__ __forceinline__ void operator()(AccRef acc, const pg8::Unit& u, int wr, int wc, int fr, int fq) const {
        const int pn = u.pn; const int row0 = u.pm * 256 + wr * 64 + fr;
        const int i0 = 16 * (wc & 1) + 4 * fq;
#pragma unroll
        for (int ai = 0; ai < 2; ++ai)
#pragma unroll
            for (int m = 0; m < 4; ++m) {
                const int row = row0 + ai * 128 + m * 16;
                f32x4 c4 = (f32x4){1.f, 1.f, 1.f, 1.f}, s4 = (f32x4){0.f, 0.f, 0.f, 0.f};
                const bool rope = (pn < 6) || (pn == 9) || (pn == 10);
                if (rope) { c4 = *(const f32x4*)(RC + (size_t)row * 32 + i0); s4 = *(const f32x4*)(RS + (size_t)row * 32 + i0); }
#pragma unroll
                for (int bj = 0; bj < 2; ++bj) {
                    const int gcol = pn * 256 + bj * 128 + wc * 32 + 8 * fq;
                    f32x4 v0 = acc[ai][bj][m][0], v1 = acc[ai][bj][m][1];
                    if (rope) { const f32x4 y0 = v0 * c4 - v1 * s4, y1 = v1 * c4 + v0 * s4; v0 = y0; v1 = y1; }
                    if (pn < 3) { v0 = v0 * C2; v1 = v1 * C2; st_bf16x8(Q + (size_t)row * 768 + gcol, v0, v1); }
                    else if (pn < 6) st_bf16x8(K + (size_t)row * 768 + (gcol - 768), v0, v1);
                    else if (pn < 9) st_bf16x8(V + (size_t)row * 768 + (gcol - 1536), v0, v1);
                    else if (pn < 11) st_bf16x8(QI + (size_t)row * 512 + (gcol - 2304), v0, v1);
                    else if (pn == 11) { v0 = v0 * C2; v1 = v1 * C2; st_bf16x8(QM + (size_t)row * 256 + (gcol - 2816), v0, v1); }
                    else { const int lc = gcol - 3072; if (lc < 72) { float* p = KIW + (size_t)row * KIW_P + lc; *(f32x4*)p = v0; *(f32x4*)(p + 4) = v1; } }
                }
            }
    }
};
struct EpiGlaProj {
    bf16_t *GQ, *GK, *GV, *GR, *GQM; float* A1;
    __device__ __forceinline__ void operator()(AccRef acc, const pg8::Unit& u, int wr, int wc, int fr, int fq) const {
        const int pn = u.pn; const int row0 = u.pm * 256 + wr * 64 + fr;
#pragma unroll
        for (int ai = 0; ai < 2; ++ai)
#pragma unroll
            for (int m = 0; m < 4; ++m) {
                const int row = row0 + ai * 128 + m * 16;
#pragma unroll
                for (int bj = 0; bj < 2; ++bj) {
                    const int gcol = pn * 256 + bj * 128 + wc * 32 + 8 * fq;
                    f32x4 v0 = acc[ai][bj][m][0], v1 = acc[ai][bj][m][1];
                    if (pn < 3) {
                        if (gcol < 384) { v0 = v0 * 0.10206207261596577f; v1 = v1 * 0.10206207261596577f; st_bf16x8(GQ + (size_t)row * 384 + gcol, v0, v1); }
                        else st_bf16x8(GK + (size_t)row * 384 + (gcol - 384), v0, v1);
                    }
                    else if (pn < 6) st_bf16x8(GV + (size_t)row * 768 + (gcol - 768), v0, v1);
                    else if (pn < 9) st_bf16x8(GR + (size_t)row * 768 + (gcol - 1536), v0, v1);
                    else if (pn == 9) { v0 = v0 * C2; v1 = v1 * C2; st_bf16x8(GQM + (size_t)row * 256 + (gcol - 2304), v0, v1); }
                    else { const int lc = gcol - 2560; if (lc < 16) { float* p = A1 + (size_t)row * 16 + lc; *(f32x4*)p = v0; *(f32x4*)(p + 4) = v1; } }
                }
            }
    }
};
struct EpiBf16Plain {
    bf16_t* O; int ldc; int ncolmask;
    __device__ __forceinline__ void operator()(AccRef acc, const pg8::Unit& u, int wr, int wc, int fr, int fq) const {
        const int row0 = u.pm * 256 + wr * 64 + fr; const int colt = (u.pn & ncolmask) * 256 + wc * 32 + 8 * fq;
#pragma unroll
        for (int ai = 0; ai < 2; ++ai)
#pragma unroll
            for (int m = 0; m < 4; ++m) { bf16_t* rowp = O + (size_t)(row0 + ai * 128 + m * 16) * ldc + colt;
#pragma unroll
                for (int bj = 0; bj < 2; ++bj) st_bf16x8(rowp + bj * 128, acc[ai][bj][m][0], acc[ai][bj][m][1]); }
    }
};
struct EpiF32Plain {
    float* C; int ldc;
    __device__ __forceinline__ void operator()(AccRef acc, const pg8::Unit& u, int wr, int wc, int fr, int fq) const {
        const int row0 = u.pm * 256 + wr * 64 + fr; const int colt = u.pn * 256 + wc * 32 + 8 * fq;
#pragma unroll
        for (int ai = 0; ai < 2; ++ai)
#pragma unroll
            for (int m = 0; m < 4; ++m) { float* rowp = C + (size_t)(row0 + ai * 128 + m * 16) * ldc + colt;
#pragma unroll
                for (int bj = 0; bj < 2; ++bj) { *(f32x4*)(rowp + bj * 128) = acc[ai][bj][m][0]; *(f32x4*)(rowp + bj * 128 + 4) = acc[ai][bj][m][1]; } }
    }
};
struct EpiMoe1 {
    bf16_t* ACT; const float* LISTW; const unsigned* cnt;
    __device__ __forceinline__ void operator()(AccRef acc, const pg8::Unit& u, int wr, int wc, int fr, int fq) const {
        const int j2 = u.pn & 1; const int rl0 = wr * 64 + fr; const int ce = (int)cnt[u.e];
#pragma unroll
        for (int ai = 0; ai < 2; ++ai)
#pragma unroll
            for (int m = 0; m < 4; ++m) {
                const int rl = rl0 + ai * 128 + m * 16; const int pos = u.r0 + rl;
                const float wt = (pos < ce) ? LISTW[(size_t)u.e * NT + pos] : 0.f;
                f32x4 a0 = acc[ai][0][m][0], a1 = acc[ai][0][m][1], u0 = acc[ai][1][m][0], u1 = acc[ai][1][m][1], o0, o1;
#pragma unroll
                for (int j = 0; j < 4; ++j) { o0[j] = silu_f(a0[j]) * u0[j] * wt; o1[j] = silu_f(a1[j]) * u1[j] * wt; }
                st_bf16x8(ACT + (size_t)(u.pm * 256 + rl) * 256 + j2 * 128 + wc * 32 + 8 * fq, o0, o1);
            }
    }
};
struct MoeOrder {
    const LAS int* tp; const unsigned* cnt; const int* LISTTOK; int ncol, G, c; bool gather;
    __device__ bool next(int i, pg8::Unit& u) const {
        const long L = (long)i * G + c; const int ntile = tp[NEXP];
        if (L >= (long)ntile * ncol) return false;
        const int tile = (int)(L / ncol), col = (int)(L % ncol);
        int e = 0;
#pragma unroll 1
        while (tp[e + 1] <= tile) ++e;
        u.pm = tile; u.pn = e * ncol + col; u.e = e; u.r0 = (tile - tp[e]) * 256; return true;
    }
    __device__ __forceinline__ int rowidx(const pg8::Unit& u, int r) const {
        if (!gather) return u.pm * 256 + r;
        const int pos = u.r0 + r;
        return (pos < (int)cnt[u.e]) ? LISTTOK[(size_t)u.e * NT + pos] : 0;
    }
};
__device__ __forceinline__ void moe_tile_table(Frame& F, const unsigned* cnt, LAS int* tp) {
    if (F.tid == 0) { int s = 0; for (int e = 0; e < NEXP; ++e) { tp[e] = s; s += ((int)cnt[e] + 255) >> 8; } tp[NEXP] = s; }
    __syncthreads();
}

__device__ __forceinline__ void p_ki(Frame& F, const Args& a) {
    const float* KIW = (const float*)(F.ws + WS_KIW); bf16_t* KI = (bf16_t*)(F.ws + WS_KI); float* WI = (float*)(F.ws + WS_WI);
    const float* RC = (const float*)(F.ws + WS_ROPEC); const float* RS = (const float*)(F.ws + WS_ROPES);
    const float* g = (const float*)a.in[I_DSA_KG]; const float* bb = (const float*)a.in[I_DSA_KB];
    const int d = F.lane; const float gd = g[d], bd = bb[d]; const int dst = dperm_inv(d);
    for (int t = F.gw; t < NT; t += F.NGW) {
        const float v = KIW[(size_t)t * KIW_P + d];
        const float mu = wave_sum(v) * (1.f / 64.f); const float dv = v - mu;
        const float var = wave_sum(dv * dv) * (1.f / 64.f);
        const float n = dv * (1.f / sqrtf(var + LN_EPS)) * gd + bd;
        const float pr = __shfl_xor(n, 32);
        const float c = RC[(size_t)t * 32 + (d & 31)], s = RS[(size_t)t * 32 + (d & 31)];
        const float o = (d < 32) ? (n * c - pr * s) : (n * c + pr * s);
        KI[(size_t)t * 64 + dst] = (bf16_t)f2bf(o);
        if (d < 8) WI[(size_t)t * 8 + d] = KIW[(size_t)t * KIW_P + 64 + d] * 0.04419417382415922f;
    }
}

__device__ __forceinline__ unsigned ordkey(float f) { const unsigned u = __builtin_bit_cast(unsigned, f); return (u & 0x80000000u) ? ~u : (u | 0x80000000u); }
__device__ __forceinline__ void p_indexer(Frame& F) {
    const bf16_t* QI = (const bf16_t*)(F.ws + WS_QI); const bf16_t* KI = (const bf16_t*)(F.ws + WS_KI); const float* WI = (const float*)(F.ws + WS_WI);
    unsigned long long* MASK = (unsigned long long*)(F.ws + WS_MASK);
    LAS float* sc = (LAS float*)F.lds;
    LAS float* wis = (LAS float*)(F.lds + 131072);
    const int lane = F.lane, r32 = lane & 31, hi = lane >> 5, wave = F.wave;
    for (int i = 0;; ++i) {
        const int U = i * F.G + (int)blockIdx.x; if (U >= NB * 128) break;
        const int b = U >> 7, tl = U & 127, tile = (i & 1) ? 127 - tl : tl;
        const int t0 = tile * 16; const size_t rowbase = (size_t)b * SEQ;
        if (t0 < 256) {
#pragma unroll
            for (int u = 0; u < 2; ++u) { const int t = t0 + 2 * wave + u;
                if (lane < 32) { const int nb = t + 1 - 64 * lane; const unsigned long long m = nb >= 64 ? ~0ull : (nb <= 0 ? 0ull : ((1ull << nb) - 1ull)); MASK[(rowbase + t) * 32 + lane] = m; } }
            continue;
        }
        if (F.tid < 128) wis[F.tid] = WI[(rowbase + t0) * 8 + F.tid];
        bf16x8 af[4][4];
        { const int m = r32, j = m & 3, hp = (m >> 2) & 1, ii = m >> 3, tokl = 2 * hp + (ii >> 1), head = 4 * (ii & 1) + j;
#pragma unroll
          for (int mt = 0; mt < 4; ++mt)
#pragma unroll
            for (int ks = 0; ks < 4; ++ks) af[mt][ks] = *(const bf16x8*)(QI + (rowbase + t0 + 4 * mt + tokl) * 512 + head * 64 + ks * 16 + hi * 8); }
        __syncthreads();
        const int n32 = (t0 + 16 + 31) >> 5;
        for (int kt = wave; kt < n32; kt += NWAVES) {
            const int key = kt * 32 + r32;
            bf16x8 bfr[4];
#pragma unroll
            for (int ks = 0; ks < 4; ++ks) bfr[ks] = *(const bf16x8*)(KI + (rowbase + key) * 64 + ks * 16 + hi * 8);
#pragma unroll
            for (int mt = 0; mt < 4; ++mt) {
                f32x16 acc = {};
#pragma unroll
                for (int ks = 0; ks < 4; ++ks) acc = __builtin_amdgcn_mfma_f32_32x32x16_bf16(af[mt][ks], bfr[ks], acc, 0, 0, 0);
#pragma unroll
                for (int u = 0; u < 2; ++u) { const int tk = 4 * mt + 2 * hi + u;
                    const f32x4 w0 = *(const LAS f32x4*)(wis + tk * 8), w1 = *(const LAS f32x4*)(wis + tk * 8 + 4);
                    float s = 0.f;
#pragma unroll
                    for (int h = 0; h < 4; ++h) { s += w0[h] * fmaxf(acc[8 * u + h], 0.f); }
#pragma unroll
                    for (int h = 0; h < 4; ++h) { s += w1[h] * fmaxf(acc[8 * u + 4 + h], 0.f); }
                    sc[tk * 2048 + key] = s + 0.f; }
            }
        }
        __syncthreads();
#pragma unroll 1
        for (int u = 0; u < 2; ++u) {
            const int tk = 2 * wave + u, t = t0 + tk;
            unsigned key[32];
#pragma unroll
            for (int q = 0; q < 32; ++q) { const int s = lane + 64 * q; key[q] = (s <= t) ? ordkey(sc[tk * 2048 + s]) : 0u; }
            unsigned T = 0u; bool exact = false;
#pragma unroll 1
            for (int bit = 31; bit >= 0; --bit) {
                const unsigned cand = T | (1u << bit); int c = 0;
#pragma unroll
                for (int q = 0; q < 32; ++q) c += __builtin_popcountll(__ballot(key[q] >= cand));
                if (c >= 256) { T = cand; if (c == 256) { exact = true; break; } }
            }
            int need = 0, ceq = 0;
            if (!exact) { int cgt = 0;
#pragma unroll
                for (int q = 0; q < 32; ++q) { cgt += __builtin_popcountll(__ballot(key[q] > T)); ceq += __builtin_popcountll(__ballot(key[q] == T)); }
                need = 256 - cgt; }
            unsigned long long mymask = 0ull;
            if (exact || need == ceq) {
#pragma unroll
                for (int q = 0; q < 32; ++q) { const unsigned long long bal = __ballot(key[q] >= T); if (lane == q) mymask = bal; }
            } else {
#pragma unroll
                for (int q = 0; q < 32; ++q) {
                    unsigned long long eq = __ballot(key[q] == T); const unsigned long long gt = __ballot(key[q] > T);
                    int pc = __builtin_popcountll(eq); const int take = pc < need ? pc : need;
                    while (pc > take) { eq &= ~(1ull << (63 - __builtin_clzll(eq))); --pc; }
                    need -= take;
                    if (lane == q) mymask = gt | eq;
                }
            }
            if (lane < 32) MASK[(rowbase + t) * 32 + lane] = mymask;
        }
        __syncthreads();
    }
}

typedef short v4i16_t __attribute__((ext_vector_type(4)));
__device__ __forceinline__ s16x4 vtr(const LAS unsigned char* p) { return __builtin_bit_cast(s16x4, __builtin_amdgcn_ds_read_tr16_b64_v4i16((LAS v4i16_t*)p)); }
template <bool MASKED>
__device__ __forceinline__ void attn_unit(Frame& F, const bf16_t* Qp, int qpitch, const bf16_t* Kp, const bf16_t* Vp, int kvpitch, int ntiles,
                                          const unsigned long long* maskp, bf16_t* Op, int opitch) {
    const int tid = F.tid, lane = F.lane, r32 = lane & 31, hi = lane >> 5, wave = F.wave;
    LAS unsigned char* lds = F.lds;
    bf16x8 qf[4];
#pragma unroll
    for (int ks = 0; ks < 4; ++ks) qf[ks] = *(const bf16x8*)(Qp + (size_t)(wave * 32 + r32) * qpitch + ks * 16 + hi * 8);
    const unsigned long long* mrow = maskp + (size_t)(wave * 32 + r32) * 32;
    const int kkey = tid & 63, kch = tid >> 6, vkey = tid >> 3, vpc = tid & 7;
    const bf16_t* ksrc = Kp + (size_t)kkey * kvpitch + kch * 8; const bf16_t* vsrc = Vp + (size_t)vkey * kvpitch + vpc * 8;
    const int kdst = kch * 1024 + kkey * 16, vdst = 8192 + (vpc >> 2) * 4096 + vkey * 64 + (vpc & 3) * 16;
    u32x4 kreg = *(const u32x4*)ksrc, vreg = *(const u32x4*)vsrc;
    *(LAS u32x4*)(lds + kdst) = kreg; *(LAS u32x4*)(lds + vdst) = vreg;
    __syncthreads();
    float m_run = -1e30f, l_run = 0.f; f32x16 o0 = {}, o1 = {};
    const int vlane = ((lane >> 4) & 1) * 32 + (lane & 3) * 8 + (4 * hi + ((lane & 15) >> 2)) * 64;
    for (int t = 0; t < ntiles; ++t) {
        const int cb = (t & 1) * 16384, nb = 16384 - cb;
        if (t + 1 < ntiles) { kreg = *(const u32x4*)(ksrc + (size_t)(t + 1) * 64 * kvpitch); vreg = *(const u32x4*)(vsrc + (size_t)(t + 1) * 64 * kvpitch); }
        unsigned long long mw = ~0ull; if (MASKED) mw = mrow[t];
        f32x16 p0 = {}, p1 = {};
#pragma unroll
        for (int ks = 0; ks < 4; ++ks) {
            const bf16x8 a0 = *(const LAS bf16x8*)(lds + cb + (2 * ks + hi) * 1024 + r32 * 16);
            const bf16x8 a1 = *(const LAS bf16x8*)(lds + cb + (2 * ks + hi) * 1024 + (32 + r32) * 16);
            p0 = __builtin_amdgcn_mfma_f32_32x32x16_bf16(a0, qf[ks], p0, 0, 0, 0);
            p1 = __builtin_amdgcn_mfma_f32_32x32x16_bf16(a1, qf[ks], p1, 0, 0, 0);
        }
        if (MASKED) { const unsigned lo = (unsigned)mw >> (4 * hi), hw = (unsigned)(mw >> 32) >> (4 * hi);
#pragma unroll
            for (int r = 0; r < 16; ++r) { const unsigned bit = 1u << ((r & 3) + 8 * (r >> 2)); p0[r] = (lo & bit) ? p0[r] : -1e30f; p1[r] = (hw & bit) ? p1[r] : -1e30f; } }
        float rm = fmaxf(p0[0], p1[0]);
#pragma unroll
        for (int r = 1; r < 16; ++r) rm = fmaxf(rm, fmaxf(p0[r], p1[r]));
        { auto rr = __builtin_amdgcn_permlane32_swap(__float_as_uint(rm), __float_as_uint(rm), false, false); rm = fmaxf(__uint_as_float(rr[0]), __uint_as_float(rr[1])); }
        const float m_new = fmaxf(m_run, rm); const float alpha = fast_exp2(m_run - m_new); m_run = m_new;
        l_run *= alpha;
#pragma unroll
        for (int r = 0; r < 16; ++r) { o0[r] *= alpha; o1[r] *= alpha; }
        float ls = 0.f;
#pragma unroll
        for (int r = 0; r < 16; ++r) { p0[r] = fast_exp2(p0[r] - m_new); p1[r] = fast_exp2(p1[r] - m_new); ls += p0[r] + p1[r]; }
        l_run += ls;
        bf16x8 pw[2][2];
#pragma unroll
        for (int s = 0; s < 2; ++s) {
            u32x4 w; w.x = pg8::cvt_pk_bf16(p0[8 * s + 0], p0[8 * s + 1]); w.y = pg8::cvt_pk_bf16(p0[8 * s + 2], p0[8 * s + 3]); w.z = pg8::cvt_pk_bf16(p0[8 * s + 4], p0[8 * s + 5]); w.w = pg8::cvt_pk_bf16(p0[8 * s + 6], p0[8 * s + 7]);
            pw[0][s] = __builtin_bit_cast(bf16x8, w);
            u32x4 x; x.x = pg8::cvt_pk_bf16(p1[8 * s + 0], p1[8 * s + 1]); x.y = pg8::cvt_pk_bf16(p1[8 * s + 2], p1[8 * s + 3]); x.z = pg8::cvt_pk_bf16(p1[8 * s + 4], p1[8 * s + 5]); x.w = pg8::cvt_pk_bf16(p1[8 * s + 6], p1[8 * s + 7]);
            pw[1][s] = __builtin_bit_cast(bf16x8, x);
        }
        const LAS unsigned char* vb = lds + cb + 8192 + vlane;
#pragma unroll
        for (int kh = 0; kh < 2; ++kh)
#pragma unroll
            for (int s = 0; s < 2; ++s) {
                const int ko = (32 * kh + 16 * s) * 64;
                const s16x4 a_lo0 = vtr(vb + ko), a_hi0 = vtr(vb + ko + 512), a_lo1 = vtr(vb + 4096 + ko), a_hi1 = vtr(vb + 4096 + ko + 512);
                const bf16x8 A0 = (bf16x8){a_lo0[0], a_lo0[1], a_lo0[2], a_lo0[3], a_hi0[0], a_hi0[1], a_hi0[2], a_hi0[3]};
                const bf16x8 A1 = (bf16x8){a_lo1[0], a_lo1[1], a_lo1[2], a_lo1[3], a_hi1[0], a_hi1[1], a_hi1[2], a_hi1[3]};
                o0 = __builtin_amdgcn_mfma_f32_32x32x16_bf16(A0, pw[kh][s], o0, 0, 0, 0);
                o1 = __builtin_amdgcn_mfma_f32_32x32x16_bf16(A1, pw[kh][s], o1, 0, 0, 0);
            }
        if (t + 1 < ntiles) { *(LAS u32x4*)(lds + nb + kdst) = kreg; *(LAS u32x4*)(lds + nb + vdst) = vreg; }
        __syncthreads();
    }
    { auto rr = __builtin_amdgcn_permlane32_swap(__float_as_uint(l_run), __float_as_uint(l_run), false, false); l_run = __uint_as_float(rr[0]) + __uint_as_float(rr[1]); }
    const float inv = 1.f / l_run;
    bf16_t* orow = Op + (size_t)(wave * 32 + r32) * opitch;
#pragma unroll
    for (int rg = 0; rg < 4; ++rg) {
        u32x2 w0, w1;
        w0.x = pg8::cvt_pk_bf16(o0[4 * rg] * inv, o0[4 * rg + 1] * inv); w0.y = pg8::cvt_pk_bf16(o0[4 * rg + 2] * inv, o0[4 * rg + 3] * inv);
        w1.x = pg8::cvt_pk_bf16(o1[4 * rg] * inv, o1[4 * rg + 1] * inv); w1.y = pg8::cvt_pk_bf16(o1[4 * rg + 2] * inv, o1[4 * rg + 3] * inv);
        *(u32x2*)(orow + 8 * rg + 4 * hi) = w0; *(u32x2*)(orow + 32 + 8 * rg + 4 * hi) = w1;
    }
}
__device__ __forceinline__ void mem_attn_units(Frame& F, const bf16_t* QM, int layer, bf16_t* AO) {
    const bf16_t* KVM = (const bf16_t*)(F.ws + WS_KVM);
    for (int mu = blockIdx.x; mu < NB * 32; mu += F.G) {
        const int b = mu >> 5, hm = (mu >> 3) & 3, qb = mu & 7;
        const size_t row0 = (size_t)b * SEQ + qb * 256;
        attn_unit<false>(F, QM + row0 * 256 + hm * 64, 256, KVM + (size_t)b * NMEM * 1024 + layer * 512 + hm * 64, KVM + (size_t)b * NMEM * 1024 + layer * 512 + 256 + hm * 64, 1024, 4,
                         nullptr, AO + row0 * 1024 + 768 + hm * 64, 1024);
    }
}
__device__ __forceinline__ void p_attn_dsa(Frame& F) {
    const bf16_t* Q = (const bf16_t*)(F.ws + WS_Q); const bf16_t* K = (const bf16_t*)(F.ws + WS_K); const bf16_t* V = (const bf16_t*)(F.ws + WS_V);
    const unsigned long long* MASK = (const unsigned long long*)(F.ws + WS_MASK); bf16_t* AO = (bf16_t*)(F.ws + WS_AO0);
    for (int pu = blockIdx.x; pu < NB * 12 * 4; pu += F.G) {
        const int bh = pu >> 2, pr = pu & 3, b = bh / 12, h = bh % 12;
#pragma unroll 1
        for (int z = 0; z < 2; ++z) {
            const int qb = z ? 7 - pr : pr; const size_t rb = (size_t)b * SEQ, row0 = rb + qb * 256;
            attn_unit<true>(F, Q + row0 * 768 + h * 64, 768, K + rb * 768 + h * 64, V + rb * 768 + h * 64, 768, 4 * (qb + 1), MASK + row0 * 32, AO + row0 * 1024 + h * 64, 1024);
        }
    }
    mem_attn_units(F, (const bf16_t*)(F.ws + WS_QM), 0, AO);
}

__device__ __forceinline__ void p_ln1_router(Frame& F, const Args& a, int layer, const float* resid, bf16_t* X1b) {
    const float* MIX = F.out; float* X1 = (float*)(F.ws + WS_X1);
    const float* g1 = (const float*)a.in[I_LN1G] + layer * 1024; const float* b1 = (const float*)a.in[I_LN1B] + layer * 1024;
    const float* wg = (const float*)a.in[I_MOE_WG] + (size_t)layer * 1024 * 4; const float* bg = (const float*)a.in[I_MOE_BG] + layer * 4;
    const float* wr = (const float*)a.in[I_MOE_WR] + (size_t)layer * 4 * 1024 * 8; const float* br = (const float*)a.in[I_MOE_BR] + layer * 32;
    unsigned* cnt = F.ctl + CW_CNT + layer * 32;
    int* LISTTOK = (int*)(F.ws + WS_LISTTOK); float* LISTW = (float*)(F.ws + WS_LISTW); int* TOKSLOT = (int*)(F.ws + WS_TOKSLOT);
    const int lane = F.lane;
    f32x4 gv[4], bv[4];
#pragma unroll
    for (int j = 0; j < 4; ++j) { gv[j] = *((const f32x4*)g1 + lane + 64 * j); bv[j] = *((const f32x4*)b1 + lane + 64 * j); }
    for (int t = F.gw; t < NT; t += F.NGW) {
        const f32x4* xr = (const f32x4*)(resid + (size_t)t * DM) + lane; const f32x4* mr = (const f32x4*)(MIX + (size_t)t * DM) + lane;
        f32x4 v[4]; float s = 0.f;
#pragma unroll
        for (int j = 0; j < 4; ++j) { v[j] = xr[64 * j] * ALPHA + mr[64 * j]; s += (v[j].x + v[j].y) + (v[j].z + v[j].w); }
        const float mean = wave_sum(s) * (1.f / DM); float s2 = 0.f;
#pragma unroll
        for (int j = 0; j < 4; ++j) { v[j] = v[j] - mean; s2 += (v[j].x * v[j].x + v[j].y * v[j].y) + (v[j].z * v[j].z + v[j].w * v[j].w); }
        const float rstd = 1.f / sqrtf(wave_sum(s2) * (1.f / DM) + LN_EPS);
        f32x4* o4 = (f32x4*)(X1 + (size_t)t * DM) + lane; u32x2* ob = (u32x2*)(X1b + (size_t)t * DM) + lane;
#pragma unroll
        for (int j = 0; j < 4; ++j) { v[j] = v[j] * rstd * gv[j] + bv[j]; o4[64 * j] = v[j]; u32x2 w; w.x = pk2(v[j].x, v[j].y); w.y = pk2(v[j].z, v[j].w); ob[64 * j] = w; }
        float gl[4] = {0.f, 0.f, 0.f, 0.f};
#pragma unroll
        for (int j = 0; j < 4; ++j)
#pragma unroll
            for (int c = 0; c < 4; ++c) { const f32x4 w4 = *(const f32x4*)(wg + (size_t)(256 * j + 4 * lane + c) * 4);
#pragma unroll
                for (int k = 0; k < 4; ++k) gl[k] += v[j][c] * w4[k]; }
#pragma unroll
        for (int k = 0; k < 4; ++k) gl[k] = wave_sum(gl[k]) + bg[k];
        int gsel = 0; float gmax = gl[0];
#pragma unroll
        for (int k = 1; k < 4; ++k) if (gl[k] > gmax) { gmax = gl[k]; gsel = k; }
        float gs = 0.f;
#pragma unroll
        for (int k = 0; k < 4; ++k) gs += __expf(gl[k] - gmax);
        const float pg = 1.f / gs;
        gsel = __builtin_amdgcn_readfirstlane(gsel);
        const float* wrg = wr + (size_t)gsel * 1024 * 8;
        float el[8] = {0.f, 0.f, 0.f, 0.f, 0.f, 0.f, 0.f, 0.f};
#pragma unroll
        for (int j = 0; j < 4; ++j)
#pragma unroll
            for (int c = 0; c < 4; ++c) { const float* wp = wrg + (size_t)(256 * j + 4 * lane + c) * 8; const f32x4 w0 = *(const f32x4*)wp, w1 = *(const f32x4*)(wp + 4);
#pragma unroll
                for (int k = 0; k < 4; ++k) { el[k] += v[j][c] * w0[k]; el[4 + k] += v[j][c] * w1[k]; } }
#pragma unroll
        for (int k = 0; k < 8; ++k) el[k] = wave_sum(el[k]) + br[gsel * 8 + k];
        int i1 = 0; float v1 = el[0];
#pragma unroll
        for (int k = 1; k < 8; ++k) if (el[k] > v1) { v1 = el[k]; i1 = k; }
        int i2 = -1; float v2 = -INFINITY;
#pragma unroll
        for (int k = 0; k < 8; ++k) if (k != i1 && (i2 < 0 || el[k] > v2)) { v2 = el[k]; i2 = k; }
        const float e2 = __expf(v2 - v1); const float wt1 = pg / (1.f + e2), wt2 = pg * e2 / (1.f + e2);
        if (lane == 0) {
            const int ge1 = gsel * 8 + i1, ge2 = gsel * 8 + i2;
            const unsigned p1 = atomicAdd(&cnt[ge1], 1u), p2 = atomicAdd(&cnt[ge2], 1u);
            LISTTOK[(size_t)ge1 * NT + p1] = t; LISTW[(size_t)ge1 * NT + p1] = wt1;
            LISTTOK[(size_t)ge2 * NT + p2] = t; LISTW[(size_t)ge2 * NT + p2] = wt2;
            *(int4*)(TOKSLOT + (size_t)t * 4) = make_int4(ge1, (int)p1, ge2, (int)p2);
        }
    }
}
__device__ __forceinline__ void p_ln2(Frame& F, const Args& a, int layer, float* dst, bf16_t* dstb) {
    const float* X1 = (const float*)(F.ws + WS_X1); const bf16_t* Y = (const bf16_t*)(F.ws + WS_Y); const int* TOKSLOT = (const int*)(F.ws + WS_TOKSLOT);
    const float* g2 = (const float*)a.in[I_LN2G] + layer * 1024; const float* b2 = (const float*)a.in[I_LN2B] + layer * 1024;
    LAS int* tp = (LAS int*)(F.lds + MISC_OFF + 256);
    moe_tile_table(F, F.ctl + CW_CNT + layer * 32, tp);
    const int lane = F.lane;
    f32x4 gv[4], bv[4];
#pragma unroll
    for (int j = 0; j < 4; ++j) { gv[j] = *((const f32x4*)g2 + lane + 64 * j); bv[j] = *((const f32x4*)b2 + lane + 64 * j); }
    for (int t = F.gw; t < NT; t += F.NGW) {
        const int4 ts = *(const int4*)(TOKSLOT + (size_t)t * 4);
        const size_t s0 = (size_t)tp[ts.x] * 256 + ts.y, s1 = (size_t)tp[ts.z] * 256 + ts.w;
        const f32x4* xr = (const f32x4*)(X1 + (size_t)t * DM) + lane;
        const u32x2* y0 = (const u32x2*)(Y + s0 * DM) + lane; const u32x2* y1 = (const u32x2*)(Y + s1 * DM) + lane;
        f32x4 v[4]; float s = 0.f;
#pragma unroll
        for (int j = 0; j < 4; ++j) { const u32x2 p = y0[64 * j], q = y1[64 * j];
            f32x4 yy; yy.x = bf2f(p.x & 0xffffu) + bf2f(q.x & 0xffffu); yy.y = bf2f(p.x >> 16) + bf2f(q.x >> 16); yy.z = bf2f(p.y & 0xffffu) + bf2f(q.y & 0xffffu); yy.w = bf2f(p.y >> 16) + bf2f(q.y >> 16);
            v[j] = xr[64 * j] * ALPHA + yy; s += (v[j].x + v[j].y) + (v[j].z + v[j].w); }
        const float mean = wave_sum(s) * (1.f / DM); float s2 = 0.f;
#pragma unroll
        for (int j = 0; j < 4; ++j) { v[j] = v[j] - mean; s2 += (v[j].x * v[j].x + v[j].y * v[j].y) + (v[j].z * v[j].z + v[j].w * v[j].w); }
        const float rstd = 1.f / sqrtf(wave_sum(s2) * (1.f / DM) + LN_EPS);
        f32x4* o4 = (f32x4*)(dst + (size_t)t * DM) + lane;
#pragma unroll
        for (int j = 0; j < 4; ++j) { v[j] = v[j] * rstd * gv[j] + bv[j]; o4[64 * j] = v[j]; }
        if (dstb) { u32x2* ob = (u32x2*)(dstb + (size_t)t * DM) + lane;
#pragma unroll
            for (int j = 0; j < 4; ++j) { u32x2 w; w.x = pk2(v[j].x, v[j].y); w.y = pk2(v[j].z, v[j].w); ob[64 * j] = w; } }
    }
}

constexpr int KS_P = 97, VS_P = 194;
__device__ __forceinline__ void p_gla_prep(Frame& F, const Args& a) {
    bf16_t* GQ = (bf16_t*)(F.ws + WS_GQ); bf16_t* GK = (bf16_t*)(F.ws + WS_GK); const bf16_t* GV = (const bf16_t*)(F.ws + WS_GV); const float* A1 = (const float*)(F.ws + WS_A1);
    bf16_t* KPT = (bf16_t*)(F.ws + WS_KPT); bf16_t* VT = (bf16_t*)(F.ws + WS_VT); float* DEC = (float*)(F.ws + WS_DEC);
    const float* wgate = (const float*)a.in[I_GLA_WGATE]; const float* bgate = (const float*)a.in[I_GLA_BGATE];
    LAS float* a1s = (LAS float*)F.lds;
    LAS float* wgs = a1s + 1024;
    LAS float* bgs = wgs + 1536;
    LAS float* Gs = bgs + 96;
    LAS float* ks = Gs + 6144;
    LAS bf16_t* vs = (LAS bf16_t*)(ks + 64 * KS_P);
    const int tid = F.tid;
    for (int U = blockIdx.x; U < NB * 4 * 32; U += F.G) {
        const int c = U & 31, h = (U >> 5) & 3, b = U >> 7; const size_t row0 = (size_t)b * SEQ + c * 64;
        if (tid < 256) *(LAS f32x4*)(a1s + tid * 4) = *(const f32x4*)(A1 + (row0 + (tid >> 2)) * 16 + (tid & 3) * 4);
        if (tid < 384) { const int r = tid / 24, d4 = (tid % 24) * 4; *(LAS f32x4*)(wgs + r * 96 + d4) = *(const f32x4*)(wgate + r * 384 + h * 96 + d4); }
        if (tid < 96) bgs[tid] = bgate[h * 96 + tid];
        for (int idx = tid; idx < 64 * 192; idx += 512) { const int pos = idx / 192, e = idx % 192; vs[pos * VS_P + e] = GV[(row0 + pos) * 768 + h * 192 + e]; }
        __syncthreads();
        for (int idx = tid; idx < 64 * 96; idx += 512) { const int pos = idx / 96, d = idx % 96;
            float z = bgs[d];
#pragma unroll
            for (int r = 0; r < 16; ++r) z += a1s[pos * 16 + r] * wgs[r * 96 + d];
            const float ls = fminf(z, 0.f) - log1pf(__expf(-fabsf(z)));
            Gs[pos * 96 + d] = ls * (1.f / 16.f); }
        __syncthreads();
        if (tid < 96) { float run = 0.f; for (int pos = 0; pos < 64; ++pos) { run += Gs[pos * 96 + tid]; Gs[pos * 96 + tid] = run; } DEC[(size_t)U * 96 + tid] = __expf(run); }
        __syncthreads();
        for (int idx = tid; idx < 64 * 96; idx += 512) { const int pos = idx / 96, d = idx % 96;
            const float bb = Gs[pos * 96 + d], bl = Gs[63 * 96 + d];
            const size_t gi = (row0 + pos) * 384 + h * 96 + d;
            const float q = bf2f(GQ[gi]), k = bf2f(GK[gi]);
            GQ[gi] = (bf16_t)f2bf(q * __expf(bb)); GK[gi] = (bf16_t)f2bf(k * __expf(-bb));
            ks[pos * KS_P + d] = k * __expf(bl - bb); }
        __syncthreads();
        for (int idx = tid; idx < 96 * 64; idx += 512) { const int pos = idx & 63, d = idx >> 6; KPT[((size_t)(b * 4 + h) * 96 + d) * SEQ + c * 64 + pos] = (bf16_t)f2bf(ks[pos * KS_P + d]); }
        for (int idx = tid; idx < 192 * 64; idx += 512) { const int pos = idx & 63, e = idx >> 6; VT[((size_t)(b * 4 + h) * 192 + e) * SEQ + c * 64 + pos] = vs[pos * VS_P + e]; }
        __syncthreads();
    }
}
__device__ __forceinline__ bf16x8 ld2x8(const bf16_t* p0, const bf16_t* p1) { const u32x2 a = *(const u32x2*)p0, b = *(const u32x2*)p1; u32x4 w; w.x = a.x; w.y = a.y; w.z = b.x; w.w = b.y; return __builtin_bit_cast(bf16x8, w); }
__device__ __forceinline__ bf16x8 pack8(f32x4 lo, f32x4 hi) { u32x4 w; w.x = pg8::cvt_pk_bf16(lo[0], lo[1]); w.y = pg8::cvt_pk_bf16(lo[2], lo[3]); w.z = pg8::cvt_pk_bf16(hi[0], hi[1]); w.w = pg8::cvt_pk_bf16(hi[2], hi[3]); return __builtin_bit_cast(bf16x8, w); }
__device__ __forceinline__ void p_gla_scan(Frame& F) {
    const bf16_t* GQ = (const bf16_t*)(F.ws + WS_GQ); const bf16_t* GK = (const bf16_t*)(F.ws + WS_GK);
    const bf16_t* KPT = (const bf16_t*)(F.ws + WS_KPT); const bf16_t* VT = (const bf16_t*)(F.ws + WS_VT); const float* DEC = (const float*)(F.ws + WS_DEC);
    float* OG = F.out;
    const int lane = F.lane, li = lane & 15, fq = lane >> 4;
    for (int U = F.wave * F.G + (int)blockIdx.x; U < NB * 4 * 12; U += NWAVES * F.G) {
        const int et = U % 12, bh = U / 12, h = bh & 3, b = bh >> 2;
        f32x4 S[6];
#pragma unroll
        for (int dt = 0; dt < 6; ++dt) S[dt] = (f32x4){0.f, 0.f, 0.f, 0.f};
        const bf16_t* vtp = VT + ((size_t)bh * 192 + 16 * et + li) * SEQ + 4 * fq;
        const bf16_t* kpp = KPT + ((size_t)bh * 96 + li) * SEQ + 4 * fq;
#pragma unroll 1
        for (int c = 0; c < 32; ++c) {
            const size_t pos0 = (size_t)b * SEQ + c * 64;
            bf16x8 qf[4][3], kf[4][3];
#pragma unroll
            for (int it = 0; it < 4; ++it)
#pragma unroll
                for (int s = 0; s < 3; ++s) { const size_t off = (pos0 + 16 * it + li) * 384 + h * 96 + 32 * s + 4 * fq;
                    qf[it][s] = ld2x8(GQ + off, GQ + off + 16); kf[it][s] = ld2x8(GK + off, GK + off + 16); }
            bf16x8 vf[2];
#pragma unroll
            for (int s2 = 0; s2 < 2; ++s2) vf[s2] = ld2x8(vtp + c * 64 + 32 * s2, vtp + c * 64 + 32 * s2 + 16);
            bf16x8 am[4][2];
#pragma unroll
            for (int it = 0; it < 4; ++it) {
                f32x4 tl[4];
#pragma unroll
                for (int jt = 0; jt < 4; ++jt) {
                    tl[jt] = (f32x4){0.f, 0.f, 0.f, 0.f};
                    if (jt <= it) {
#pragma unroll
                        for (int s = 0; s < 3; ++s) tl[jt] = __builtin_amdgcn_mfma_f32_16x16x32_bf16(kf[jt][s], qf[it][s], tl[jt], 0, 0, 0);
                        if (jt == it) {
#pragma unroll
                            for (int r = 0; r < 4; ++r) if (4 * fq + r > li) tl[jt][r] = 0.f; }
                    }
                }
                am[it][0] = pack8(tl[0], tl[1]); am[it][1] = pack8(tl[2], tl[3]);
            }
            bf16x8 Sb[3];
#pragma unroll
            for (int s = 0; s < 3; ++s) Sb[s] = pack8(S[2 * s], S[2 * s + 1]);
#pragma unroll
            for (int it = 0; it < 4; ++it) {
                f32x4 o = (f32x4){0.f, 0.f, 0.f, 0.f};
#pragma unroll
                for (int s2 = 0; s2 < 2; ++s2) if (2 * s2 <= it) o = __builtin_amdgcn_mfma_f32_16x16x32_bf16(am[it][s2], vf[s2], o, 0, 0, 0);
#pragma unroll
                for (int s = 0; s < 3; ++s) o = __builtin_amdgcn_mfma_f32_16x16x32_bf16(qf[it][s], Sb[s], o, 0, 0, 0);
#pragma unroll
                for (int r = 0; r < 4; ++r) OG[(pos0 + 16 * it + 4 * fq + r) * 768 + h * 192 + 16 * et + li] = o[r];
            }
            const float* dp = DEC + ((size_t)bh * 32 + c) * 96 + 4 * fq;
#pragma unroll
            for (int dt = 0; dt < 6; ++dt) {
                const f32x4 dc = *(const f32x4*)(dp + 16 * dt);
                f32x4 acc = S[dt] * dc;
#pragma unroll
                for (int s2 = 0; s2 < 2; ++s2) { const bf16_t* kp = kpp + (size_t)(16 * dt) * SEQ + c * 64 + 32 * s2;
                    acc = __builtin_amdgcn_mfma_f32_16x16x32_bf16(ld2x8(kp, kp + 16), vf[s2], acc, 0, 0, 0); }
                S[dt] = acc;
            }
        }
    }
}
__device__ __forceinline__ void p_gla_norm(Frame& F, const Args& a) {
    const float* OG = F.out; const bf16_t* GR = (const bf16_t*)(F.ws + WS_GR); bf16_t* AO = (bf16_t*)(F.ws + WS_AO1);
    const float* ng = (const float*)a.in[I_GLA_NORMG];
    const int lane = F.lane;
    float ngv[3];
#pragma unroll
    for (int j = 0; j < 3; ++j) ngv[j] = ng[lane + 64 * j];
    for (int idx = F.gw; idx < NT * 4; idx += F.NGW) {
        const int t = idx >> 2, h = idx & 3;
        float o[3]; float ss = 0.f;
#pragma unroll
        for (int j = 0; j < 3; ++j) { o[j] = OG[(size_t)t * 768 + h * 192 + lane + 64 * j]; ss += o[j] * o[j]; }
        const float r = 1.f / sqrtf(wave_sum(ss) * (1.f / 192.f) + RMS_EPS);
#pragma unroll
        for (int j = 0; j < 3; ++j) { const float rr = bf2f(GR[(size_t)t * 768 + h * 192 + lane + 64 * j]);
            AO[(size_t)t * 1024 + h * 192 + lane + 64 * j] = (bf16_t)f2bf(o[j] * r * ngv[j] * silu_f(rr)); }
    }
}

constexpr int NPHASE = 19;
#define GEMM_CALL(EpiT, SchedT, g, S, E) pg8::gemm_phase<EpiT, SchedT, true, true>(F.lds, g, S, E)
__device__ __forceinline__ void moe_gemms_up(Frame& F, int layer, const bf16_t* X1b, bf16_t* ACT) {
    LAS int* tp = (LAS int*)(F.lds + MISC_OFF + 256);
    const unsigned* cnt = F.ctl + CW_CNT + layer * 32;
    moe_tile_table(F, cnt, tp);
    pg8::Gemm g{X1b, (const bf16_t*)(F.ws + WS_W13), SLOT_ROWS, 512, 1024};
    MoeOrder S{tp, cnt, (const int*)(F.ws + WS_LISTTOK), 2, F.G, (int)blockIdx.x, true};
    EpiMoe1 E{ACT, (const float*)(F.ws + WS_LISTW), cnt};
    GEMM_CALL(EpiMoe1, MoeOrder, g, S, E);
}
__device__ __forceinline__ void moe_gemms_down(Frame& F, int layer, const bf16_t* ACT) {
    LAS int* tp = (LAS int*)(F.lds + MISC_OFF + 256);
    const unsigned* cnt = F.ctl + CW_CNT + layer * 32;
    moe_tile_table(F, cnt, tp);
    pg8::Gemm g{ACT, (const bf16_t*)(F.ws + WS_W2), SLOT_ROWS, 1024, 256};
    MoeOrder S{tp, cnt, nullptr, 4, F.G, (int)blockIdx.x, false};
    EpiBf16Plain E{(bf16_t*)(F.ws + WS_Y), 1024, 3};
    GEMM_CALL(EpiBf16Plain, MoeOrder, g, S, E);
}
__device__ __forceinline__ void out_proj(Frame& F, int layer, const bf16_t* AO) {
    pg8::Gemm g{AO, (const bf16_t*)(F.ws + WS_WO) + (size_t)layer * 1024 * 1024, NT, 1024, 1024};
    pg8::StaticOrder S; S.init(NT, 1024, F.G, (int)blockIdx.x);
    EpiF32Plain E{F.out, 1024};
    GEMM_CALL(EpiF32Plain, pg8::StaticOrder, g, S, E);
}

__global__ void __launch_bounds__(NWAVES * 64, 2) mk_fwd(Args args) {
    extern __shared__ __attribute__((aligned(16))) unsigned char lds_raw[];
    Frame F;
    F.lds = (LAS unsigned char*)lds_raw; F.ws = args.ws; F.out = args.out; F.ctl = (unsigned*)(args.ws + WS_CTL);
    F.tid = threadIdx.x; F.lane = F.tid & 63; F.wave = __builtin_amdgcn_readfirstlane(F.tid >> 6); F.G = gridDim.x;
    F.gw = blockIdx.x * NWAVES + F.wave; F.NGW = F.G * NWAVES;
    volatile LAS unsigned* MISC = (volatile LAS unsigned*)(F.lds + MISC_OFF);
    if (F.tid < 64) MISC[F.tid] = 0u;
    __syncthreads();
#if N_LAUNCH_MODE == 1
    XcdBarrier bar = xcd_barrier_post(F.ctl + CW_BAR, MISC + 8);
#define SEAM() xcd_barrier(bar)
#else
#define SEAM() do {} while (0)
#endif
    const int lo = args.ph_lo, hi = args.ph_hi;
#ifndef PH_ENABLE
#define PH_ENABLE 0xFFFFFFFFu
#endif
#define IN(k) (((PH_ENABLE >> (k)) & 1u) && lo <= (k) && (k) < hi)
#define ENDPH(k) do { if (IN((k) + 1)) SEAM(); } while (0)

    if (IN(0)) { p_prologue(F, args); ENDPH(0); }
    if (IN(1)) {
        { pg8::Gemm g{(const bf16_t*)(F.ws + WS_XB), (const bf16_t*)(F.ws + WS_WD), NT, ND, 1024};
          pg8::StaticOrder S; S.init(NT, ND, F.G, (int)blockIdx.x);
          EpiDsaProj E{(bf16_t*)(F.ws + WS_Q), (bf16_t*)(F.ws + WS_K), (bf16_t*)(F.ws + WS_V), (bf16_t*)(F.ws + WS_QI), (bf16_t*)(F.ws + WS_QM), (float*)(F.ws + WS_KIW),
                       (const float*)(F.ws + WS_ROPEC), (const float*)(F.ws + WS_ROPES)};
          GEMM_CALL(EpiDsaProj, pg8::StaticOrder, g, S, E); }
        { pg8::Gemm g{(const bf16_t*)(F.ws + WS_MEMB), (const bf16_t*)(F.ws + WS_WKV), NB * NMEM, 1024, 1024};
          pg8::StaticOrder S; S.init(NB * NMEM, 1024, F.G, (int)blockIdx.x);
          EpiBf16Plain E{(bf16_t*)(F.ws + WS_KVM), 1024, 0x7fffffff};
          GEMM_CALL(EpiBf16Plain, pg8::StaticOrder, g, S, E); }
        ENDPH(1);
    }
    if (IN(2)) { p_ki(F, args); ENDPH(2); }
    if (IN(3)) { p_indexer(F); ENDPH(3); }
    if (IN(4)) { p_attn_dsa(F); ENDPH(4); }
    if (IN(5)) { out_proj(F, 0, (const bf16_t*)(F.ws + WS_AO0)); ENDPH(5); }
    if (IN(6)) { p_ln1_router(F, args, 0, (const float*)args.in[I_X], (bf16_t*)(F.ws + WS_X1B0)); ENDPH(6); }
    if (IN(7)) { moe_gemms_up(F, 0, (const bf16_t*)(F.ws + WS_X1B0), (bf16_t*)(F.ws + WS_ACT0)); ENDPH(7); }
    if (IN(8)) { moe_gemms_down(F, 0, (const bf16_t*)(F.ws + WS_ACT0)); ENDPH(8); }
    if (IN(9)) { p_ln2(F, args, 0, (float*)(F.ws + WS_X1), (bf16_t*)(F.ws + WS_C));
                 moe_weight_items(F, (const float*)args.in[I_MOE_W13], (const float*)args.in[I_MOE_W2], 1); ENDPH(9); }
    if (IN(10)) {
        pg8::Gemm g{(const bf16_t*)(F.ws + WS_C), (const bf16_t*)(F.ws + WS_WG), NT, NG, 1024};
        pg8::StaticOrder S; S.init(NT, NG, F.G, (int)blockIdx.x);
        EpiGlaProj E{(bf16_t*)(F.ws + WS_GQ), (bf16_t*)(F.ws + WS_GK), (bf16_t*)(F.ws + WS_GV), (bf16_t*)(F.ws + WS_GR), (bf16_t*)(F.ws + WS_GQM), (float*)(F.ws + WS_A1)};
        GEMM_CALL(EpiGlaProj, pg8::StaticOrder, g, S, E);
        ENDPH(10);
    }
    if (IN(11)) { p_gla_prep(F, args); ENDPH(11); }
    if (IN(12)) { p_gla_scan(F); ENDPH(12); }
    if (IN(13)) { p_gla_norm(F, args); mem_attn_units(F, (const bf16_t*)(F.ws + WS_GQM), 1, (bf16_t*)(F.ws + WS_AO1)); ENDPH(13); }
    if (IN(14)) { out_proj(F, 1, (const bf16_t*)(F.ws + WS_AO1)); ENDPH(14); }
    if (IN(15)) { p_ln1_router(F, args, 1, (const float*)(F.ws + WS_X1), (bf16_t*)(F.ws + WS_X1B1)); ENDPH(15); }
    if (IN(16)) { moe_gemms_up(F, 1, (const bf16_t*)(F.ws + WS_X1B1), (bf16_t*)(F.ws + WS_ACT1)); ENDPH(16); }
    if (IN(17)) { moe_gemms_down(F, 1, (const bf16_t*)(F.ws + WS_ACT1)); ENDPH(17); }
    if (IN(18)) { p_ln2(F, args, 1, F.out, nullptr); }
#undef IN
#undef ENDPH
}

extern "C" void kernel_launch(void* const* d_in, const int* in_sizes, int n_in, void* d_out, int out_size, void* d_ws, size_t ws_size, hipStream_t stream) {
    static int grid = 0;
    if (grid == 0) {
        if (n_in != 22 || out_size != NT * DM || ws_size < WS_END) { fprintf(stderr, "kernel_launch: unexpected shapes: n_in %d out %d ws %zu (need %zu)\n", n_in, out_size, ws_size, (size_t)WS_END); grid = -1; return; }
        int dev = 0, cus = 0, per_cu = 0;
        if (hipGetDevice(&dev) != hipSuccess || hipDeviceGetAttribute(&cus, hipDeviceAttributeMultiprocessorCount, dev) != hipSuccess) { grid = -1; return; }
        if (hipFuncSetAttribute((const void*)mk_fwd, hipFuncAttributeMaxDynamicSharedMemorySize, LDS_BYTES) != hipSuccess) { fprintf(stderr, "kernel_launch: hipFuncSetAttribute failed\n"); grid = -1; return; }
        if (hipOccupancyMaxActiveBlocksPerMultiprocessor(&per_cu, (const void*)mk_fwd, NWAVES * 64, LDS_BYTES) != hipSuccess || per_cu < 1) fprintf(stderr, "kernel_launch: occupancy query reports %d\n", per_cu);
        (void)hipGetLastError();
        grid = cus;
    }
    if (grid < 0) return;
    (void)hipMemsetAsync((char*)d_ws + WS_CTL, 0, CTL_ZERO_BYTES, stream);
    Args a{};
    for (int i = 0; i < 22; ++i) a.in[i] = d_in[i];
    a.out = (float*)d_out; a.ws = (unsigned char*)d_ws;
#if N_LAUNCH_MODE == 1
    a.ph_lo = 0; a.ph_hi = NPHASE;
    hipLaunchKernelGGL(mk_fwd, dim3(grid), dim3(NWAVES * 64), LDS_BYTES, stream, a);
#else
    for (int k = 0; k < NPHASE; ++k) { a.ph_lo = k; a.ph_hi = k + 1; hipLaunchKernelGGL(mk_fwd, dim3(grid), dim3(NWAVES * 64), LDS_BYTES, stream, a); }
#endif
}
```

```cpp
#include <hip/hip_runtime.h>
#include <cstdio>
#include <cstdint>

#define LAS __attribute__((address_space(3)))
#define GAS __attribute__((address_space(1)))
typedef unsigned short bf16_t;
typedef short bf16x8 __attribute__((ext_vector_type(8)));
typedef short s16x4 __attribute__((ext_vector_type(4)));
typedef float f32x4 __attribute__((ext_vector_type(4)));
typedef float f32x2 __attribute__((ext_vector_type(2)));
typedef float f32x16 __attribute__((ext_vector_type(16)));
typedef unsigned u32x4 __attribute__((ext_vector_type(4)));
typedef unsigned u32x2 __attribute__((ext_vector_type(2)));

#ifndef N_LAUNCH_MODE
#define N_LAUNCH_MODE 1
#endif

constexpr int NB = 16, SEQ = 2048, DM = 1024, NT = NB * SEQ;
constexpr int NMEM = 256;
constexpr int ND = 3328;
constexpr int NG = 2816;
constexpr int DSA_W = 3144, GLA_W = 2576;
constexpr int NEXP = 32;
constexpr int SLOT_ROWS = 73728;
constexpr float ALPHA = 1.4142135623730951f;
constexpr float LN_EPS = 1e-5f, RMS_EPS = 1e-6f;
constexpr float LOG2E = 1.4426950408889634f;
constexpr float C2 = 0.125f * LOG2E;
constexpr int NWAVES = 8;

constexpr size_t MiB = 1u << 20;
constexpr size_t WS_CTL = 0, CTL_ZERO_BYTES = 1 * MiB;
constexpr size_t WS_ROPEC = 1 * MiB, WS_ROPES = 5 * MiB;
constexpr size_t WS_DEC = 9 * MiB;
constexpr size_t WS_WD = 10 * MiB, WS_WG = 17 * MiB, WS_WKV = 23 * MiB, WS_WO = 25 * MiB, WS_W13 = 29 * MiB, WS_W2 = 61 * MiB;
constexpr size_t WS_KVM = 77 * MiB;
constexpr size_t WS_MEMB = 85 * MiB;
constexpr size_t WS_LISTTOK = 85 * MiB, WS_LISTW = 89 * MiB;
constexpr size_t WS_TOKSLOT = 93 * MiB;
constexpr size_t WS_A = 96 * MiB;
constexpr size_t WS_B = 160 * MiB;
constexpr size_t WS_C = 288 * MiB;
constexpr size_t WS_D = 352 * MiB;
constexpr size_t WS_END = 500 * MiB;
constexpr size_t WS_XB = WS_A;
constexpr size_t WS_Q = 160 * MiB, WS_K = 208 * MiB, WS_V = 256 * MiB, WS_QI = 304 * MiB, WS_QM = 336 * MiB, WS_KIW = 352 * MiB, WS_KI = 362 * MiB, WS_WI = 366 * MiB, WS_MASK = 368 * MiB, WS_AO0 = 376 * MiB;
constexpr size_t WS_X1 = WS_B, WS_X1B0 = WS_C, WS_ACT0 = WS_A, WS_Y = WS_D;
constexpr size_t WS_GV = 96 * MiB, WS_GQM = 144 * MiB, WS_GQ = 352 * MiB, WS_GK = 376 * MiB, WS_GR = 400 * MiB, WS_A1 = 448 * MiB, WS_KPT = 450 * MiB, WS_VT = WS_C, WS_AO1 = WS_C;
constexpr size_t WS_X1B1 = WS_A, WS_ACT1 = WS_C;
constexpr int KIW_P = 80;

constexpr int CW_CNT = 64;
constexpr int CW_BAR = 4096;

__device__ __forceinline__ unsigned f2bf(float f) { unsigned u = __builtin_bit_cast(unsigned, f); return (u + 0x7fffu + ((u >> 16) & 1u)) >> 16; }
__device__ __forceinline__ unsigned pk2(float lo, float hi) { return f2bf(lo) | (f2bf(hi) << 16); }
__device__ __forceinline__ float bf2f(unsigned h) { return __builtin_bit_cast(float, h << 16); }
__device__ __forceinline__ float wave_sum(float v) {
#pragma unroll
    for (int o = 1; o < 64; o <<= 1) v += __shfl_xor(v, o);
    return v;
}
__device__ __forceinline__ float fast_exp2(float x) { return __builtin_amdgcn_exp2f(x); }
__device__ __forceinline__ float silu_f(float a) { return a * __builtin_amdgcn_rcpf(1.f + fast_exp2(-a * LOG2E)); }

namespace pg8 {
constexpr int BM = 256, BK = 64, HALF = 128, HTB = HALF * BK * 2, STAGE_BYTES = 8 * HTB, NXCD = 8, WGM = 8;
__host__ __device__ __forceinline__ int lds_byte(int r, int c) { const int st = (r >> 4) * 2 + (c >> 5), rr = r & 15, cc = c & 31, ob = rr * 64 + cc * 2; return st * 1024 + (ob ^ (((ob >> 9) & 1) << 5)); }
__host__ __device__ __forceinline__ void stage_rc(int b, int& R, int& C) { const int st = b / 1024, sb = b % 1024, swz = sb ^ (((sb >> 9) & 1) << 5); R = (st >> 1) * 16 + swz / 64; C = (st & 1) * 32 + (swz % 64) / 2; }
__host__ __device__ __forceinline__ int perm32(int rho) { const int n = rho >> 4, i = rho & 15; return 8 * (i >> 2) + 4 * n + (i & 3); }

struct Unit { int pm, pn, e, r0; };
struct Gemm { const bf16_t* A; const bf16_t* Bt; int M, N, K; };

struct StaticOrder {
    int nM, nN, nwg, G, c;
    __device__ void init(int M, int N, int G_, int c_) { nM = M / BM; nN = N / BM; nwg = nM * nN; G = G_; c = c_; }
    __device__ bool next(int i, Unit& u) const {
        const long L = (long)i * G + c; if (L >= nwg) return false;
        int wgid = (int)L; { const int q = nwg / NXCD, r = nwg % NXCD, xcd = wgid % NXCD, off = wgid / NXCD; wgid = (xcd < r ? xcd * (q + 1) : r * (q + 1) + (xcd - r) * q) + off; }
        const int nig = WGM * nN, gid = wgid / nig, fm = gid * WGM, gsz = (nM - fm) < WGM ? (nM - fm) : WGM;
        u.pm = fm + ((wgid % nig) % gsz); u.pn = (wgid % nig) / gsz; u.e = 0; u.r0 = 0; return true;
    }
    __device__ __forceinline__ int rowidx(const Unit& u, int r) const { return u.pm * BM + r; }
};

typedef __bf16 bf16x2_t __attribute__((ext_vector_type(2)));
__device__ __forceinline__ unsigned cvt_pk_bf16(float lo, float hi) { f32x2 v = {lo, hi}; bf16x2_t b = __builtin_convertvector(v, bf16x2_t); return __builtin_bit_cast(unsigned, b); }

template <class Epi, class Sched, bool ALIGN_EPI, bool SP2>
__device__ __forceinline__ void gemm_phase(LAS unsigned char* lds, const Gemm g, const Sched& S, const Epi& E) {
    const int tid = threadIdx.x, wid = __builtin_amdgcn_readfirstlane(tid >> 6), lane = tid & 63, wr = wid >> 2, wc = wid & 3, fr = lane & 15, fq = lane >> 4;
    const int K = g.K, nt = K / BK;
    int RA[2], CA[2]; unsigned voffB[2];
#pragma unroll
    for (int i = 0; i < 2; ++i) { int R, C; stage_rc(tid * 16 + i * 8192, R, C); const int Rb = (R & ~31) + perm32(R & 31);
        RA[i] = R; CA[i] = C; voffB[i] = (unsigned)(Rb * K + C) * 2u; }
    const size_t kstep = (size_t)(BK * 2);
    const size_t hstep = (size_t)HALF * K * 2;
    const size_t tstep = 2 * hstep;
    const unsigned ldsw = (unsigned)wid * 1024u;
    const int aoff = lds_byte(wr * 64 + fr, fq * 8), boff = lds_byte(wc * 32 + fr, fq * 8);
#define PG8_SA(b, h) (((b) * 2 + (h)) * HTB)
#define PG8_SB(b, h) ((4 + (b) * 2 + (h)) * HTB)
#define PG8_STAGE(bufoff, gbase, voff) do { _Pragma("unroll") for (int _i = 0; _i < 2; ++_i) \
        __builtin_amdgcn_global_load_lds((const unsigned*)((const char*)(gbase) + (voff)[_i]), (LAS unsigned*)(lds + (bufoff) + ldsw + _i * 8192), 16, 0, 0); } while (0)
#define PG8_LDA(dst, b, h) do { _Pragma("unroll") for (int m = 0; m < 4; ++m) _Pragma("unroll") for (int k = 0; k < 2; ++k) dst[m][k] = *(const LAS bf16x8*)(lds + PG8_SA(b, h) + aoff + m * 2048 + k * 1024); } while (0)
#define PG8_LDB(dst, b, h) do { _Pragma("unroll") for (int n = 0; n < 2; ++n) _Pragma("unroll") for (int k = 0; k < 2; ++k) dst[n][k] = *(const LAS bf16x8*)(lds + PG8_SB(b, h) + boff + n * 2048 + k * 1024); } while (0)
#define PG8_MMA(ai, bj, At, Bt) do { __builtin_amdgcn_s_setprio(1); _Pragma("unroll") for (int m = 0; m < 4; ++m) _Pragma("unroll") for (int n = 0; n < 2; ++n) _Pragma("unroll") for (int k = 0; k < 2; ++k) \
        acc[ai][bj][m][n] = __builtin_amdgcn_mfma_f32_16x16x32_bf16(Bt[n][k], At[m][k], acc[ai][bj][m][n], 0, 0, 0); __builtin_amdgcn_s_setprio(0); } while (0)
#define PG8_WAIT_V(n) asm volatile("s_waitcnt vmcnt(" #n ")" ::: "memory")
#define PG8_WAIT_L(n) asm volatile("s_waitcnt lgkmcnt(" #n ")" ::: "memory")
#define PG8_BAR __builtin_amdgcn_s_barrier()
#define PG8_SCHED __builtin_amdgcn_sched_barrier(0)
#define PG8_MKOFF(o0, o1, u) do { _Pragma("unroll") for (int _i = 0; _i < 2; ++_i) { \
        o0[_i] = ((unsigned)S.rowidx(u, RA[_i]) * (unsigned)K + (unsigned)CA[_i]) * 2u; o1[_i] = ((unsigned)S.rowidx(u, HALF + RA[_i]) * (unsigned)K + (unsigned)CA[_i]) * 2u; } } while (0)
    Unit cur, nxt; int ui = 0;
    if (!S.next(0, cur)) return;
    f32x4 acc[2][2][4][2];
#pragma unroll
    for (int a = 0; a < 2; ++a)
#pragma unroll
        for (int b = 0; b < 2; ++b)
#pragma unroll
            for (int m = 0; m < 4; ++m)
#pragma unroll
                for (int n = 0; n < 2; ++n) acc[a][b][m][n] = (f32x4){0.f, 0.f, 0.f, 0.f};
    bf16x8 At[4][2], B0[2][2], B1[2][2];
    const char* const gA = (const char*)g.A;
    unsigned cO0[2], cO1[2], nO0[2], nO1[2];
    PG8_MKOFF(cO0, cO1, cur);
    const char* cB = (const char*)g.Bt + (size_t)cur.pn * tstep;
    if constexpr (SP2) {
        PG8_STAGE(PG8_SB(0, 0), cB, voffB); PG8_STAGE(PG8_SB(0, 1), cB + hstep, voffB); PG8_STAGE(PG8_SA(0, 0), gA, cO0); PG8_STAGE(PG8_SA(0, 1), gA, cO1);
        if (wr == 1) PG8_BAR;
        PG8_WAIT_V(2); PG8_BAR;
        PG8_STAGE(PG8_SB(1, 0), cB + kstep, voffB); PG8_STAGE(PG8_SA(1, 0), gA + kstep, cO0); PG8_STAGE(PG8_SB(1, 1), cB + hstep + kstep, voffB);
        PG8_WAIT_V(6); PG8_BAR;
    } else {
        PG8_STAGE(PG8_SB(0, 0), cB, voffB); PG8_STAGE(PG8_SA(0, 0), gA, cO0); PG8_STAGE(PG8_SB(0, 1), cB + hstep, voffB); PG8_STAGE(PG8_SA(0, 1), gA, cO1);
        if (wr == 1) PG8_BAR;
        PG8_WAIT_V(4); PG8_BAR;
        PG8_STAGE(PG8_SB(1, 0), cB + kstep, voffB); PG8_STAGE(PG8_SA(1, 0), gA + kstep, cO0); PG8_STAGE(PG8_SB(1, 1), cB + hstep + kstep, voffB);
        PG8_WAIT_V(6); PG8_BAR;
    }
    for (;;) {
        const bool has_next = S.next(ui + 1, nxt);
        if (has_next) { PG8_MKOFF(nO0, nO1, nxt); } else {
#pragma unroll
            for (int _i = 0; _i < 2; ++_i) { nO0[_i] = cO0[_i]; nO1[_i] = cO1[_i]; } }
        const char* nB = has_next ? (const char*)g.Bt + (size_t)nxt.pn * tstep : cB;
#pragma unroll 1
        for (int t = 0; t < nt; t += 2) {
            const bool last = (t == nt - 2);
            const char* a1 = gA + (size_t)(t + 1) * kstep;
            const char* a2 = last ? gA : gA + (size_t)(t + 2) * kstep; const char* b2 = last ? nB : cB + (size_t)(t + 2) * kstep;
            const char* a3 = a2 + kstep; const char* b3 = b2 + kstep;
            unsigned x0[2], x1[2];
#pragma unroll
            for (int _i = 0; _i < 2; ++_i) { x0[_i] = last ? nO0[_i] : cO0[_i]; x1[_i] = last ? nO1[_i] : cO1[_i]; }
            if constexpr (SP2) {
            PG8_LDB(B0, 0, 0); PG8_LDB(B1, 0, 1); PG8_SCHED; PG8_LDA(At, 0, 0); PG8_STAGE(PG8_SA(1, 1), a1, cO1);
            PG8_WAIT_V(8); PG8_WAIT_L(0); PG8_BAR; PG8_MMA(0, 0, At, B0); PG8_MMA(0, 1, At, B1); PG8_BAR; PG8_SCHED;
            PG8_LDA(At, 0, 1); PG8_STAGE(PG8_SB(0, 0), b2, voffB); PG8_STAGE(PG8_SB(0, 1), b2 + hstep, voffB); PG8_STAGE(PG8_SA(0, 0), a2, x0);
            PG8_WAIT_V(8); PG8_WAIT_L(0); PG8_BAR; PG8_MMA(1, 0, At, B0); PG8_MMA(1, 1, At, B1); PG8_BAR; PG8_SCHED;
            PG8_LDB(B0, 1, 0); PG8_LDB(B1, 1, 1); PG8_SCHED; PG8_LDA(At, 1, 0); PG8_STAGE(PG8_SA(0, 1), a2, x1);
            PG8_WAIT_V(8); PG8_WAIT_L(0); PG8_BAR; PG8_MMA(0, 0, At, B0); PG8_MMA(0, 1, At, B1); PG8_BAR; PG8_SCHED;
            PG8_LDA(At, 1, 1); PG8_STAGE(PG8_SB(1, 0), b3, voffB); PG8_STAGE(PG8_SB(1, 1), b3 + hstep, voffB); PG8_STAGE(PG8_SA(1, 0), a3, x0);
            PG8_WAIT_V(8); PG8_WAIT_L(0); PG8_BAR; PG8_MMA(1, 0, At, B0); PG8_MMA(1, 1, At, B1); PG8_BAR; PG8_SCHED;
            } else {
            PG8_LDB(B0, 0, 0); PG8_SCHED; PG8_LDA(At, 0, 0); PG8_STAGE(PG8_SA(1, 1), a1, cO1);
            PG8_WAIT_L(8); PG8_BAR; PG8_WAIT_L(0); PG8_MMA(0, 0, At, B0); PG8_BAR; PG8_SCHED;
            PG8_LDB(B1, 0, 1); PG8_STAGE(PG8_SB(0, 0), b2, voffB);
            PG8_BAR; PG8_WAIT_L(0); PG8_MMA(0, 1, At, B1); PG8_BAR;
            PG8_LDA(At, 0, 1); PG8_STAGE(PG8_SA(0, 0), a2, x0);
            PG8_BAR; PG8_WAIT_L(0); PG8_MMA(1, 0, At, B0); PG8_BAR; PG8_SCHED;
            PG8_STAGE(PG8_SB(0, 1), b2 + hstep, voffB);
            PG8_WAIT_V(6); PG8_BAR; PG8_MMA(1, 1, At, B1); PG8_BAR;
            PG8_LDB(B0, 1, 0); PG8_SCHED; PG8_LDA(At, 1, 0); PG8_STAGE(PG8_SA(0, 1), a2, x1);
            PG8_WAIT_L(8); PG8_BAR; PG8_WAIT_L(0); PG8_MMA(0, 0, At, B0); PG8_BAR; PG8_SCHED;
            PG8_LDB(B1, 1, 1); PG8_STAGE(PG8_SB(1, 0), b3, voffB);
            PG8_BAR; PG8_WAIT_L(0); PG8_MMA(0, 1, At, B1); PG8_BAR;
            PG8_LDA(At, 1, 1); PG8_STAGE(PG8_SA(1, 0), a3, x0);
            PG8_BAR; PG8_WAIT_L(0); PG8_MMA(1, 0, At, B0); PG8_BAR; PG8_SCHED;
            PG8_STAGE(PG8_SB(1, 1), b3 + hstep, voffB);
            PG8_WAIT_V(6); PG8_BAR; PG8_MMA(1, 1, At, B1); PG8_BAR;
            }
        }
        if constexpr (ALIGN_EPI) { if (wr == 0) PG8_BAR; }
        E(acc, cur, wr, wc, fr, fq);
        if (!has_next) break;
#pragma unroll
        for (int a = 0; a < 2; ++a)
#pragma unroll
            for (int b = 0; b < 2; ++b)
#pragma unroll
                for (int m = 0; m < 4; ++m)
#pragma unroll
                    for (int n = 0; n < 2; ++n) acc[a][b][m][n] = (f32x4){0.f, 0.f, 0.f, 0.f};
        cur = nxt; cB = nB; ++ui;
#pragma unroll
        for (int _i = 0; _i < 2; ++_i) { cO0[_i] = nO0[_i]; cO1[_i] = nO1[_i]; }
        if constexpr (ALIGN_EPI) { if (wr == 1) PG8_BAR; }
    }
    PG8_WAIT_V(0);
    if constexpr (!ALIGN_EPI) { if (wr == 0) PG8_BAR; }
    PG8_BAR;
#undef PG8_SA
#undef PG8_SB
#undef PG8_STAGE
#undef PG8_LDA
#undef PG8_LDB
#undef PG8_MMA
#undef PG8_WAIT_V
#undef PG8_WAIT_L
#undef PG8_BAR
#undef PG8_SCHED
#undef PG8_MKOFF
}
}

#define XB_TMO      128
#define XB_XCNT(j)  (256  + 64 * (j))
#define XB_XSUB(j)  (1280 + 64 * (j))
#define XB_XGEN(j)  (2304 + 64 * (j))
#define XB_TOP      3328
#define XB_TOPGEN   3392
#define XCD_BAR_WORDS 3456
#define XB_SPIN_CAP (1u << 18)
__device__ __forceinline__ unsigned xb_ld(unsigned* p)              { return __hip_atomic_load(p, __ATOMIC_RELAXED, __HIP_MEMORY_SCOPE_AGENT); }
__device__ __forceinline__ unsigned xb_add(unsigned* p, unsigned v) { return __hip_atomic_fetch_add(p, v, __ATOMIC_RELAXED, __HIP_MEMORY_SCOPE_AGENT); }
__device__ __forceinline__ unsigned xb_xcc_id() { return (unsigned)__builtin_amdgcn_s_getreg((3 << 11) | 20) & 0xFu; }
#define XB_SPIN(cond, bar) do { unsigned _sp = 0; while (cond) { __builtin_amdgcn_s_sleep(1); \
    if ((++_sp & 255u) == 0u) { if (xb_ld(&(bar)[XB_TMO])) break; if (_sp > XB_SPIN_CAP) { atomicAdd(&(bar)[XB_TMO], 1u); break; } } } } while (0)
struct XcdBarrier { unsigned* bar; unsigned x; volatile LAS unsigned* st; };
__device__ __forceinline__ XcdBarrier xcd_barrier_post(unsigned* bar, volatile LAS unsigned* st) {
    XcdBarrier b; b.bar = bar; b.x = xb_xcc_id(); b.st = st;
    if (threadIdx.x == 0) (void)xb_add(&bar[XB_XCNT(b.x)], 1u);
    return b;
}
__device__ __forceinline__ void xcd_barrier_complete(unsigned* bar, unsigned x, unsigned& nloc, unsigned& nx) {
    const unsigned G = gridDim.x * gridDim.y * gridDim.z;
    unsigned sum, cnt, mine, sp = 0u;
    for (;;) {
        sum = 0u; cnt = 0u; mine = 0u;
#pragma unroll
        for (unsigned j = 0; j < 16; ++j) { const unsigned c = xb_ld(&bar[XB_XCNT(j)]); sum += c; cnt += (c > 0u) ? 1u : 0u; mine = (j == x) ? c : mine; }
        if (sum == G) break;
        __builtin_amdgcn_s_sleep(1);
        if ((++sp & 255u) == 0u) { if (xb_ld(&bar[XB_TMO])) break; if (sp > XB_SPIN_CAP) { atomicAdd(&bar[XB_TMO], 1u); break; } }
    }
    nloc = mine > 0u ? mine : 1u; nx = cnt > 0u ? cnt : 1u;
}
__device__ __forceinline__ void xcd_barrier(const XcdBarrier& b) {
    asm volatile("s_waitcnt vmcnt(0)" ::: "memory");
    __syncthreads();
    if (threadIdx.x == 0) {
        unsigned* bar = b.bar;
        __builtin_amdgcn_s_waitcnt(0);
        unsigned nloc = b.st[0], nx = b.st[1];
        if (nloc == 0u) { xcd_barrier_complete(bar, b.x, nloc, nx); b.st[0] = nloc; b.st[1] = nx; }
        const unsigned old = xb_add(&bar[XB_XSUB(b.x)], 1u);
        const unsigned gen = old / nloc;
        if (old + 1u == (gen + 1u) * nloc) {
            __builtin_amdgcn_fence(__ATOMIC_RELEASE, "agent");
            asm volatile("s_waitcnt vmcnt(0)" ::: "memory");
            const unsigned og = xb_add(&bar[XB_TOP], 1u);
            const unsigned tg = og / nx;
            if (og + 1u == (tg + 1u) * nx) xb_add(&bar[XB_TOPGEN], 1u);
            else XB_SPIN(xb_ld(&bar[XB_TOPGEN]) == tg, bar);
            __builtin_amdgcn_fence(__ATOMIC_ACQUIRE, "agent");
            xb_add(&bar[XB_XGEN(b.x)], 1u);
            asm volatile("s_waitcnt vmcnt(0)" ::: "memory");
        } else {
            XB_SPIN(xb_ld(&bar[XB_XGEN(b.x)]) == gen, bar);
            __builtin_amdgcn_fence(__ATOMIC_ACQUIRE, "agent");
            asm volatile("s_waitcnt vmcnt(0)" ::: "memory");
        }
    }
    __syncthreads();
}

constexpr int LDS_BYTES = 147456;
constexpr int MISC_OFF = 135168;
struct Args { const void* in[22]; float* out; unsigned char* ws; int ph_lo, ph_hi; };
struct Frame {
    LAS unsigned char* lds;
    unsigned char* ws; float* out;
    unsigned* ctl;
    int tid, lane, wave, G, gw, NGW;
};
enum { I_X = 0, I_MEM, I_POS, I_DSA_WIN, I_DSA_KG, I_DSA_KB, I_GLA_WIN, I_GLA_WGATE, I_GLA_BGATE, I_GLA_NORMG, I_WMEMKV, I_WOUT, I_LN1G, I_LN1B, I_LN2G, I_LN2B,
       I_MOE_WG, I_MOE_BG, I_MOE_WR, I_MOE_BR, I_MOE_W13, I_MOE_W2 };

__device__ __forceinline__ int dperm(int c) { return ((c >> 2) & 1) * 32 + (c >> 5) * 16 + ((c >> 3) & 3) * 4 + (c & 3); }
__device__ __forceinline__ int dperm_inv(int d) { const int n = d >> 5, i = d & 31; return (i >> 4) * 32 + ((i >> 2) & 3) * 8 + n * 4 + (i & 3); }
__device__ __forceinline__ int dsa_srccol(int n) {
    if (n < 1536) { return (n & ~63) + dperm(n & 63); }
    if (n < 2304) return n;
    if (n < 2816) { return (n & ~63) + dperm(n & 63); }
    if (n < 3072) return 2888 + (n - 2816);
    if (n < 3136) return 2816 + (n - 3072);
    if (n < 3144) return 2880 + (n - 3136);
    return -1;
}
__device__ __forceinline__ int gla_srccol(int n) {
    if (n < 2304) return n;
    if (n < 2560) return 2320 + (n - 2304);
    if (n < 2576) return 2304 + (n - 2560);
    return -1;
}
__device__ __forceinline__ int w13_srccol(int r) { const int pn = r >> 8, bj = (r >> 7) & 1, j = r & 127; return bj * 256 + pn * 128 + j; }
template <int MODE>
__device__ __forceinline__ void transpose_item(const float* W, int K, int ldw, bf16_t* WT, int nrows32, LAS float* scr, int item, int lane) {
    const int kb = item / nrows32, nb = item % nrows32, k0 = 64 * kb, n0 = 32 * nb;
    const int n = n0 + (lane & 31);
    int sc;
    if (MODE == 0) sc = n; else if (MODE == 1) sc = dsa_srccol(n); else if (MODE == 2) sc = gla_srccol(n); else sc = w13_srccol(n);
#pragma unroll 8
    for (int i = 0; i < 32; ++i) { const int kk = 2 * i + (lane >> 5); scr[kk * 33 + (lane & 31)] = (sc >= 0) ? W[(size_t)(k0 + kk) * ldw + sc] : 0.f; }
    asm volatile("s_waitcnt lgkmcnt(0)" ::: "memory");
    const int c = lane & 7;
#pragma unroll
    for (int j = 0; j < 4; ++j) { const int nn = (lane >> 3) + 8 * j; const LAS float* s = scr + (8 * c) * 33 + nn;
        u32x4 o; o.x = pk2(s[0 * 33], s[1 * 33]); o.y = pk2(s[2 * 33], s[3 * 33]); o.z = pk2(s[4 * 33], s[5 * 33]); o.w = pk2(s[6 * 33], s[7 * 33]);
        *(u32x4*)(WT + (size_t)(n0 + nn) * K + k0 + 8 * c) = o; }
    asm volatile("s_waitcnt lgkmcnt(0)" ::: "memory");
}
__device__ __forceinline__ void moe_weight_items(Frame& F, const float* w13, const float* w2, int layer) {
    LAS float* scr = (LAS float*)(F.lds + F.wave * 16384);
    bf16_t* W13 = (bf16_t*)(F.ws + WS_W13); bf16_t* W2 = (bf16_t*)(F.ws + WS_W2);
    constexpr int I13 = (1024 / 64) * (512 / 32), I2 = (256 / 64) * (1024 / 32);
    for (int it = F.gw; it < NEXP * (I13 + I2); it += F.NGW) {
        const int ge = it / (I13 + I2), r = it % (I13 + I2);
        if (r < I13) transpose_item<3>(w13 + ((size_t)layer * NEXP + ge) * 1024 * 512, 1024, 512, W13 + (size_t)ge * 512 * 1024, 16, scr, r, F.lane);
        else transpose_item<0>(w2 + ((size_t)layer * NEXP + ge) * 256 * 1024, 256, 1024, W2 + (size_t)ge * 1024 * 256, 32, scr, r - I13, F.lane);
    }
}
__device__ __forceinline__ void cvt_rows_bf16(Frame& F, const float* src, bf16_t* dst, int rows) {
    for (int m = F.gw; m < rows; m += F.NGW) {
        const f32x4* xr = (const f32x4*)(src + (size_t)m * DM) + F.lane; u32x2* o = (u32x2*)(dst + (size_t)m * DM) + F.lane;
#pragma unroll
        for (int j = 0; j < 4; ++j) { const f32x4 v = xr[64 * j]; u32x2 w; w.x = pk2(v.x, v.y); w.y = pk2(v.z, v.w); o[64 * j] = w; }
    }
}
__device__ __forceinline__ void p_prologue(Frame& F, const Args& a) {
    LAS float* scr = (LAS float*)(F.lds + F.wave * 16384);
    const float* dsa_w = (const float*)a.in[I_DSA_WIN]; const float* gla_w = (const float*)a.in[I_GLA_WIN];
    const float* wkv = (const float*)a.in[I_WMEMKV]; const float* wout = (const float*)a.in[I_WOUT];
    bf16_t* WD = (bf16_t*)(F.ws + WS_WD); bf16_t* WG = (bf16_t*)(F.ws + WS_WG); bf16_t* WKV = (bf16_t*)(F.ws + WS_WKV); bf16_t* WO = (bf16_t*)(F.ws + WS_WO);
    constexpr int ID = 16 * (ND / 32), IG = 16 * (NG / 32), IKV = 16 * (512 / 32), IO = 16 * (1024 / 32);
    constexpr int NIT = ID + IG + 2 * IKV + 2 * IO;
    for (int it = F.gw; it < NIT; it += F.NGW) {
        int r = it;
        if (r < ID) { transpose_item<1>(dsa_w, 1024, DSA_W, WD, ND / 32, scr, r, F.lane); continue; } r -= ID;
        if (r < IG) { transpose_item<2>(gla_w, 1024, GLA_W, WG, NG / 32, scr, r, F.lane); continue; } r -= IG;
        if (r < 2 * IKV) { const int l = r / IKV; transpose_item<0>(wkv + (size_t)l * 1024 * 512, 1024, 512, WKV + (size_t)l * 512 * 1024, 16, scr, r % IKV, F.lane); continue; } r -= 2 * IKV;
        { const int l = r / IO; transpose_item<0>(wout + (size_t)l * 1024 * 1024, 1024, 1024, WO + (size_t)l * 1024 * 1024, 32, scr, r % IO, F.lane); }
    }
    moe_weight_items(F, (const float*)a.in[I_MOE_W13], (const float*)a.in[I_MOE_W2], 0);
    cvt_rows_bf16(F, (const float*)a.in[I_X], (bf16_t*)(F.ws + WS_XB), NT);
    cvt_rows_bf16(F, (const float*)a.in[I_MEM], (bf16_t*)(F.ws + WS_MEMB), NB * NMEM);
    const int* pos = (const int*)a.in[I_POS];
    float* RC = (float*)(F.ws + WS_ROPEC); float* RS = (float*)(F.ws + WS_ROPES);
    for (int idx = blockIdx.x * 512 + F.tid; idx < NT * 32; idx += F.G * 512) {
        const int t = idx >> 5, i = idx & 31;
        const float inv = (float)pow(10000.0, -(double)(2 * i) / 64.0);
        const float ang = (float)pos[t] * inv;
        double s, c; sincos((double)ang, &s, &c);
        RC[idx] = (float)c; RS[idx] = (float)s;
    }
}

typedef const f32x4 (&AccRef)[2][2][4][2];
__device__ __forceinline__ void st_bf16x8(bf16_t* p, f32x4 v0, f32x4 v1) {
    u32x4 w; w.x = pg8::cvt_pk_bf16(v0[0], v0[1]); w.y = pg8::cvt_pk_bf16(v0[2], v0[3]); w.z = pg8::cvt_pk_bf16(v1[0], v1[1]); w.w = pg8::cvt_pk_bf16(v1[2], v1[3]);
    *(u32x4*)p = w;
}
struct EpiDsaProj {
    bf16_t *Q, *K, *V, *QI, *QM; float* KIW; const float *RC, *RS;
    __device__ __forceinline__ void operator()(AccRef acc, const pg8::Unit& u, int wr, int wc, int fr, int fq) const {
        const int pn = u.pn; const int row0 = u.pm * 256 + wr * 64 + fr;
        const int i0 = 16 * (wc & 1) + 4 * fq;
#pragma unroll
        for (int ai = 0; ai < 2; ++ai)
#pragma unroll
            for (int m = 0; m < 4; ++m) {
                const int row = row0 + ai * 128 + m * 16;
                f32x4 c4 = (f32x4){1.f, 1.f, 1.f, 1.f}, s4 = (f32x4){0.f, 0.f, 0.f, 0.f};
                const bool rope = (pn < 6) || (pn == 9) || (pn == 10);
                if (rope) { c4 = *(const f32x4*)(RC + (size_t)row * 32 + i0); s4 = *(const f32x4*)(RS + (size_t)row * 32 + i0); }
#pragma unroll
                for (int bj = 0; bj < 2; ++bj) {
                    const int gcol = pn * 256 + bj * 128 + wc * 32 + 8 * fq;
                    f32x4 v0 = acc[ai][bj][m][0], v1 = acc[ai][bj][m][1];
                    if (rope) { const f32x4 y0 = v0 * c4 - v1 * s4, y1 = v1 * c4 + v0 * s4; v0 = y0; v1 = y1; }
                    if (pn < 3) { v0 = v0 * C2; v1 = v1 * C2; st_bf16x8(Q + (size_t)row * 768 + gcol, v0, v1); }
                    else if (pn < 6) st_bf16x8(K + (size_t)row * 768 + (gcol - 768), v0, v1);
                    else if (pn < 9) st_bf16x8(V + (size_t)row * 768 + (gcol - 1536), v0, v1);
                    else if (pn < 11) st_bf16x8(QI + (size_t)row * 512 + (gcol - 2304), v0, v1);
                    else if (pn == 11) { v0 = v0 * C2; v1 = v1 * C2; st_bf16x8(QM + (size_t)row * 256 + (gcol - 2816), v0, v1); }
                    else { const int lc = gcol - 3072; if (lc < 72) { float* p = KIW + (size_t)row * KIW_P + lc; *(f32x4*)p = v0; *(f32x4*)(p + 4) = v1; } }
                }
            }
    }
};
struct EpiGlaProj {
    bf16_t *GQ, *GK, *GV, *GR, *GQM; float* A1;
    __device__ __forceinline__ void operator()(AccRef acc, const pg8::Unit& u, int wr, int wc, int fr, int fq) const {
        const int pn = u.pn; const int row0 = u.pm * 256 + wr * 64 + fr;
#pragma unroll
        for (int ai = 0; ai < 2; ++ai)
#pragma unroll
            for (int m = 0; m < 4; ++m) {
                const int row = row0 + ai * 128 + m * 16;
#pragma unroll
                for (int bj = 0; bj < 2; ++bj) {
                    const int gcol = pn * 256 + bj * 128 + wc * 32 + 8 * fq;
                    f32x4 v0 = acc[ai][bj][m][0], v1 = acc[ai][bj][m][1];
                    if (pn < 3) {
                        if (gcol < 384) { v0 = v0 * 0.10206207261596577f; v1 = v1 * 0.10206207261596577f; st_bf16x8(GQ + (size_t)row * 384 + gcol, v0, v1); }
                        else st_bf16x8(GK + (size_t)row * 384 + (gcol - 384), v0, v1);
                    }
                    else if (pn < 6) st_bf16x8(GV + (size_t)row * 768 + (gcol - 768), v0, v1);
                    else if (pn < 9) st_bf16x8(GR + (size_t)row * 768 + (gcol - 1536), v0, v1);
                    else if (pn == 9) { v0 = v0 * C2; v1 = v1 * C2; st_bf16x8(GQM + (size_t)row * 256 + (gcol - 2304), v0, v1); }
                    else { const int lc = gcol - 2560; if (lc < 16) { float* p = A1 + (size_t)row * 16 + lc; *(f32x4*)p = v0; *(f32x4*)(p + 4) = v1; } }
                }
            }
    }
};
struct EpiBf16Plain {
    bf16_t* O; int ldc; int ncolmask;
    __device__ __forceinline__ void operator()(AccRef acc, const pg8::Unit& u, int wr, int wc, int fr, int fq) const {
        const int row0 = u.pm * 256 + wr * 64 + fr; const int colt = (u.pn & ncolmask) * 256 + wc * 32 + 8 * fq;
#pragma unroll
        for (int ai = 0; ai < 2; ++ai)
#pragma unroll
            for (int m = 0; m < 4; ++m) { bf16_t* rowp = O + (size_t)(row0 + ai * 128 + m * 16) * ldc + colt;
#pragma unroll
                for (int bj = 0; bj < 2; ++bj) st_bf16x8(rowp + bj * 128, acc[ai][bj][m][0], acc[ai][bj][m][1]); }
    }
};
struct EpiF32Plain {
    float* C; int ldc;
    __device__ __forceinline__ void operator()(AccRef acc, const pg8::Unit& u, int wr, int wc, int fr, int fq) const {
        const int row0 = u.pm * 256 + wr * 64 + fr; const int colt = u.pn * 256 + wc * 32 + 8 * fq;
#pragma unroll
        for (int ai = 0; ai < 2; ++ai)
#pragma unroll
            for (int m = 0; m < 4; ++m) { float* rowp = C + (size_t)(row0 + ai * 128 + m * 16) * ldc + colt;
#pragma unroll
                for (int bj = 0; bj < 2; ++bj) { *(f32x4*)(rowp + bj * 128) = acc[ai][bj][m][0]; *(f32x4*)(rowp + bj * 128 + 4) = acc[ai][bj][m][1]; } }
    }
};
struct EpiMoe1 {
    bf16_t* ACT; const float* LISTW; const unsigned* cnt;
    __device__ __forceinline__ void operator()(AccRef acc, const pg8::Unit& u, int wr, int wc, int fr, int fq) const {
        const int j2 = u.pn & 1; const int rl0 = wr * 64 + fr; const int ce = (int)cnt[u.e];
#pragma unroll
        for (int ai = 0; ai < 2; ++ai)
#pragma unroll
            for (int m = 0; m < 4; ++m) {
                const int rl = rl0 + ai * 128 + m * 16; const int pos = u.r0 + rl;
                const float wt = (pos < ce) ? LISTW[(size_t)u.e * NT + pos] : 0.f;
                f32x4 a0 = acc[ai][0][m][0], a1 = acc[ai][0][m][1], u0 = acc[ai][1][m][0], u1 = acc[ai][1][m][1], o0, o1;
#pragma unroll
                for (int j = 0; j < 4; ++j) { o0[j] = silu_f(a0[j]) * u0[j] * wt; o1[j] = silu_f(a1[j]) * u1[j] * wt; }
                st_bf16x8(ACT + (size_t)(u.pm * 256 + rl) * 256 + j2 * 128 + wc * 32 + 8 * fq, o0, o1);
            }
    }
};
struct MoeOrder {
    const LAS int* tp; const unsigned* cnt; const int* LISTTOK; int ncol, G, c; bool gather;
    __device__ bool next(int i, pg8::Unit& u) const {
        const long L = (long)i * G + c; const int ntile = tp[NEXP];
        if (L >= (long)ntile * ncol) return false;
        const int tile = (int)(L / ncol), col = (int)(L % ncol);
        int e = 0;
#pragma unroll 1
        while (tp[e + 1] <= tile) ++e;
        u.pm = tile; u.pn = e * ncol + col; u.e = e; u.r0 = (tile - tp[e]) * 256; return true;
    }
    __device__ __forceinline__ int rowidx(const pg8::Unit& u, int r) const {
        if (!gather) return u.pm * 256 + r;
        const int pos = u.r0 + r;
        return (pos < (int)cnt[u.e]) ? LISTTOK[(size_t)u.e * NT + pos] : 0;
    }
};
__device__ __forceinline__ void moe_tile_table(Frame& F, const unsigned* cnt, LAS int* tp) {
    if (F.tid == 0) { int s = 0; for (int e = 0; e < NEXP; ++e) { tp[e] = s; s += ((int)cnt[e] + 255) >> 8; } tp[NEXP] = s; }
    __syncthreads();
}

__device__ __forceinline__ void p_ki(Frame& F, const Args& a) {
    const float* KIW = (const float*)(F.ws + WS_KIW); bf16_t* KI = (bf16_t*)(F.ws + WS_KI); float* WI = (float*)(F.ws + WS_WI);
    const float* RC = (const float*)(F.ws + WS_ROPEC); const float* RS = (const float*)(F.ws + WS_ROPES);
    const float* g = (const float*)a.in[I_DSA_KG]; const float* bb = (const float*)a.in[I_DSA_KB];
    const int d = F.lane; const float gd = g[d], bd = bb[d]; const int dst = dperm_inv(d);
    for (int t = F.gw; t < NT; t += F.NGW) {
        const float v = KIW[(size_t)t * KIW_P + d];
        const float mu = wave_sum(v) * (1.f / 64.f); const float dv = v - mu;
        const float var = wave_sum(dv * dv) * (1.f / 64.f);
        const float n = dv * (1.f / sqrtf(var + LN_EPS)) * gd + bd;
        const float pr = __shfl_xor(n, 32);
        const float c = RC[(size_t)t * 32 + (d & 31)], s = RS[(size_t)t * 32 + (d & 31)];
        const float o = (d < 32) ? (n * c - pr * s) : (n * c + pr * s);
        KI[(size_t)t * 64 + dst] = (bf16_t)f2bf(o);
        if (d < 8) WI[(size_t)t * 8 + d] = KIW[(size_t)t * KIW_P + 64 + d] * 0.04419417382415922f;
    }
}

__device__ __forceinline__ unsigned ordkey(float f) { const unsigned u = __builtin_bit_cast(unsigned, f); return (u & 0x80000000u) ? ~u : (u | 0x80000000u); }
__device__ __forceinline__ void p_indexer(Frame& F) {
    const bf16_t* QI = (const bf16_t*)(F.ws + WS_QI); const bf16_t* KI = (const bf16_t*)(F.ws + WS_KI); const float* WI = (const float*)(F.ws + WS_WI);
    unsigned long long* MASK = (unsigned long long*)(F.ws + WS_MASK);
    LAS float* sc = (LAS float*)F.lds;
    LAS float* wis = (LAS float*)(F.lds + 131072);
    const int lane = F.lane, r32 = lane & 31, hi = lane >> 5, wave = F.wave;
    for (int i = 0;; ++i) {
        const int U = i * F.G + (int)blockIdx.x; if (U >= NB * 128) break;
        const int b = U >> 7, tl = U & 127, tile = (i & 1) ? 127 - tl : tl;
        const int t0 = tile * 16; const size_t rowbase = (size_t)b * SEQ;
        if (t0 < 256) {
#pragma unroll
            for (int u = 0; u < 2; ++u) { const int t = t0 + 2 * wave + u;
                if (lane < 32) { const int nb = t + 1 - 64 * lane; const unsigned long long m = nb >= 64 ? ~0ull : (nb <= 0 ? 0ull : ((1ull << nb) - 1ull)); MASK[(rowbase + t) * 32 + lane] = m; } }
            continue;
        }
        if (F.tid < 128) wis[F.tid] = WI[(rowbase + t0) * 8 + F.tid];
        bf16x8 af[4][4];
        { const int m = r32, j = m & 3, hp = (m >> 2) & 1, ii = m >> 3, tokl = 2 * hp + (ii >> 1), head = 4 * (ii & 1) + j;
#pragma unroll
          for (int mt = 0; mt < 4; ++mt)
#pragma unroll
            for (int ks = 0; ks < 4; ++ks) af[mt][ks] = *(const bf16x8*)(QI + (rowbase + t0 + 4 * mt + tokl) * 512 + head * 64 + ks * 16 + hi * 8); }
        __syncthreads();
        const int n32 = (t0 + 16 + 31) >> 5;
        for (int kt = wave; kt < n32; kt += NWAVES) {
            const int key = kt * 32 + r32;
            bf16x8 bfr[4];
#pragma unroll
            for (int ks = 0; ks < 4; ++ks) bfr[ks] = *(const bf16x8*)(KI + (rowbase + key) * 64 + ks * 16 + hi * 8);
#pragma unroll
            for (int mt = 0; mt < 4; ++mt) {
                f32x16 acc = {};
#pragma unroll
                for (int ks = 0; ks < 4; ++ks) acc = __builtin_amdgcn_mfma_f32_32x32x16_bf16(af[mt][ks], bfr[ks], acc, 0, 0, 0);
#pragma unroll
                for (int u = 0; u < 2; ++u) { const int tk = 4 * mt + 2 * hi + u;
                    const f32x4 w0 = *(const LAS f32x4*)(wis + tk * 8), w1 = *(const LAS f32x4*)(wis + tk * 8 + 4);
                    float s = 0.f;
#pragma unroll
                    for (int h = 0; h < 4; ++h) { s += w0[h] * fmaxf(acc[8 * u + h], 0.f); }
#pragma unroll
                    for (int h = 0; h < 4; ++h) { s += w1[h] * fmaxf(acc[8 * u + 4 + h], 0.f); }
                    sc[tk * 2048 + key] = s + 0.f; }
            }
        }
        __syncthreads();
#pragma unroll 1
        for (int u = 0; u < 2; ++u) {
            const int tk = 2 * wave + u, t = t0 + tk;
            unsigned key[32];
#pragma unroll
            for (int q = 0; q < 32; ++q) { const int s = lane + 64 * q; key[q] = (s <= t) ? ordkey(sc[tk * 2048 + s]) : 0u; }
            unsigned T = 0u; bool exact = false;
#pragma unroll 1
            for (int bit = 31; bit >= 0; --bit) {
                const unsigned cand = T | (1u << bit); int c = 0;
#pragma unroll
                for (int q = 0; q < 32; ++q) c += __builtin_popcountll(__ballot(key[q] >= cand));
                if (c >= 256) { T = cand; if (c == 256) { exact = true; break; } }
            }
            int need = 0, ceq = 0;
            if (!exact) { int cgt = 0;
#pragma unroll
                for (int q = 0; q < 32; ++q) { cgt += __builtin_popcountll(__ballot(key[q] > T)); ceq += __builtin_popcountll(__ballot(key[q] == T)); }
                need = 256 - cgt; }
            unsigned long long mymask = 0ull;
            if (exact || need == ceq) {
#pragma unroll
                for (int q = 0; q < 32; ++q) { const unsigned long long bal = __ballot(key[q] >= T); if (lane == q) mymask = bal; }
            } else {
#pragma unroll
                for (int q = 0; q < 32; ++q) {
                    unsigned long long eq = __ballot(key[q] == T); const unsigned long long gt = __ballot(key[q] > T);
                    int pc = __builtin_popcountll(eq); const int take = pc < need ? pc : need;
                    while (pc > take) { eq &= ~(1ull << (63 - __builtin_clzll(eq))); --pc; }
                    need -= take;
                    if (lane == q) mymask = gt | eq;
                }
            }
            if (lane < 32) MASK[(rowbase + t) * 32 + lane] = mymask;
        }
        __syncthreads();
    }
}

typedef short v4i16_t __attribute__((ext_vector_type(4)));
__device__ __forceinline__ s16x4 vtr(const LAS unsigned char* p) { return __builtin_bit_cast(s16x4, __builtin_amdgcn_ds_read_tr16_b64_v4i16((LAS v4i16_t*)p)); }
template <bool MASKED>
__device__ __forceinline__ void attn_unit(Frame& F, const bf16_t* Qp, int qpitch, const bf16_t* Kp, const bf16_t* Vp, int kvpitch, int ntiles,
                                          const unsigned long long* maskp, bf16_t* Op, int opitch) {
    const int tid = F.tid, lane = F.lane, r32 = lane & 31, hi = lane >> 5, wave = F.wave;
    LAS unsigned char* lds = F.lds;
    bf16x8 qf[4];
#pragma unroll
    for (int ks = 0; ks < 4; ++ks) qf[ks] = *(const bf16x8*)(Qp + (size_t)(wave * 32 + r32) * qpitch + ks * 16 + hi * 8);
    const unsigned long long* mrow = maskp + (size_t)(wave * 32 + r32) * 32;
    const int kkey = tid & 63, kch = tid >> 6, vkey = tid >> 3, vpc = tid & 7;
    const bf16_t* ksrc = Kp + (size_t)kkey * kvpitch + kch * 8; const bf16_t* vsrc = Vp + (size_t)vkey * kvpitch + vpc * 8;
    const int kdst = kch * 1024 + kkey * 16, vdst = 8192 + (vpc >> 2) * 4096 + vkey * 64 + (vpc & 3) * 16;
    u32x4 kreg = *(const u32x4*)ksrc, vreg = *(const u32x4*)vsrc;
    *(LAS u32x4*)(lds + kdst) = kreg; *(LAS u32x4*)(lds + vdst) = vreg;
    __syncthreads();
    float m_run = -1e30f, l_run = 0.f; f32x16 o0 = {}, o1 = {};
    const int vlane = ((lane >> 4) & 1) * 32 + (lane & 3) * 8 + (4 * hi + ((lane & 15) >> 2)) * 64;
    for (int t = 0; t < ntiles; ++t) {
        const int cb = (t & 1) * 16384, nb = 16384 - cb;
        if (t + 1 < ntiles) { kreg = *(const u32x4*)(ksrc + (size_t)(t + 1) * 64 * kvpitch); vreg = *(const u32x4*)(vsrc + (size_t)(t + 1) * 64 * kvpitch); }
        unsigned long long mw = ~0ull; if (MASKED) mw = mrow[t];
        f32x16 p0 = {}, p1 = {};
#pragma unroll
        for (int ks = 0; ks < 4; ++ks) {
            const bf16x8 a0 = *(const LAS bf16x8*)(lds + cb + (2 * ks + hi) * 1024 + r32 * 16);
            const bf16x8 a1 = *(const LAS bf16x8*)(lds + cb + (2 * ks + hi) * 1024 + (32 + r32) * 16);
            p0 = __builtin_amdgcn_mfma_f32_32x32x16_bf16(a0, qf[ks], p0, 0, 0, 0);
            p1 = __builtin_amdgcn_mfma_f32_32x32x16_bf16(a1, qf[ks], p1, 0, 0, 0);
        }
        if (MASKED) { const unsigned lo = (unsigned)mw >> (4 * hi), hw = (unsigned)(mw >> 32) >> (4 * hi);
#pragma unroll
            for (int r = 0; r < 16; ++r) { const unsigned bit = 1u << ((r & 3) + 8 * (r >> 2)); p0[r] = (lo & bit) ? p0[r] : -1e30f; p1[r] = (hw & bit) ? p1[r] : -1e30f; } }
        float rm = fmaxf(p0[0], p1[0]);
#pragma unroll
        for (int r = 1; r < 16; ++r) rm = fmaxf(rm, fmaxf(p0[r], p1[r]));
        { auto rr = __builtin_amdgcn_permlane32_swap(__float_as_uint(rm), __float_as_uint(rm), false, false); rm = fmaxf(__uint_as_float(rr[0]), __uint_as_float(rr[1])); }
        const float m_new = fmaxf(m_run, rm); const float alpha = fast_exp2(m_run - m_new); m_run = m_new;
        l_run *= alpha;
#pragma unroll
        for (int r = 0; r < 16; ++r) { o0[r] *= alpha; o1[r] *= alpha; }
        float ls = 0.f;
#pragma unroll
        for (int r = 0; r < 16; ++r) { p0[r] = fast_exp2(p0[r] - m_new); p1[r] = fast_exp2(p1[r] - m_new); ls += p0[r] + p1[r]; }
        l_run += ls;
        bf16x8 pw[2][2];
#pragma unroll
        for (int s = 0; s < 2; ++s) {
            u32x4 w; w.x = pg8::cvt_pk_bf16(p0[8 * s + 0], p0[8 * s + 1]); w.y = pg8::cvt_pk_bf16(p0[8 * s + 2], p0[8 * s + 3]); w.z = pg8::cvt_pk_bf16(p0[8 * s + 4], p0[8 * s + 5]); w.w = pg8::cvt_pk_bf16(p0[8 * s + 6], p0[8 * s + 7]);
            pw[0][s] = __builtin_bit_cast(bf16x8, w);
            u32x4 x; x.x = pg8::cvt_pk_bf16(p1[8 * s + 0], p1[8 * s + 1]); x.y = pg8::cvt_pk_bf16(p1[8 * s + 2], p1[8 * s + 3]); x.z = pg8::cvt_pk_bf16(p1[8 * s + 4], p1[8 * s + 5]); x.w = pg8::cvt_pk_bf16(p1[8 * s + 6], p1[8 * s + 7]);
            pw[1][s] = __builtin_bit_cast(bf16x8, x);
        }
        const LAS unsigned char* vb = lds + cb + 8192 + vlane;
#pragma unroll
        for (int kh = 0; kh < 2; ++kh)
#pragma unroll
            for (int s = 0; s < 2; ++s) {
                const int ko = (32 * kh + 16 * s) * 64;
                const s16x4 a_lo0 = vtr(vb + ko), a_hi0 = vtr(vb + ko + 512), a_lo1 = vtr(vb + 4096 + ko), a_hi1 = vtr(vb + 4096 + ko + 512);
                const bf16x8 A0 = (bf16x8){a_lo0[0], a_lo0[1], a_lo0[2], a_lo0[3], a_hi0[0], a_hi0[1], a_hi0[2], a_hi0[3]};
                const bf16x8 A1 = (bf16x8){a_lo1[0], a_lo1[1], a_lo1[2], a_lo1[3], a_hi1[0], a_hi1[1], a_hi1[2], a_hi1[3]};
                o0 = __builtin_amdgcn_mfma_f32_32x32x16_bf16(A0, pw[kh][s], o0, 0, 0, 0);
                o1 = __builtin_amdgcn_mfma_f32_32x32x16_bf16(A1, pw[kh][s], o1, 0, 0, 0);
            }
        if (t + 1 < ntiles) { *(LAS u32x4*)(lds + nb + kdst) = kreg; *(LAS u32x4*)(lds + nb + vdst) = vreg; }
        __syncthreads();
    }
    { auto rr = __builtin_amdgcn_permlane32_swap(__float_as_uint(l_run), __float_as_uint(l_run), false, false); l_run = __uint_as_float(rr[0]) + __uint_as_float(rr[1]); }
    const float inv = 1.f / l_run;
    bf16_t* orow = Op + (size_t)(wave * 32 + r32) * opitch;
#pragma unroll
    for (int rg = 0; rg < 4; ++rg) {
        u32x2 w0, w1;
        w0.x = pg8::cvt_pk_bf16(o0[4 * rg] * inv, o0[4 * rg + 1] * inv); w0.y = pg8::cvt_pk_bf16(o0[4 * rg + 2] * inv, o0[4 * rg + 3] * inv);
        w1.x = pg8::cvt_pk_bf16(o1[4 * rg] * inv, o1[4 * rg + 1] * inv); w1.y = pg8::cvt_pk_bf16(o1[4 * rg + 2] * inv, o1[4 * rg + 3] * inv);
        *(u32x2*)(orow + 8 * rg + 4 * hi) = w0; *(u32x2*)(orow + 32 + 8 * rg + 4 * hi) = w1;
    }
}
__device__ __forceinline__ void mem_attn_units(Frame& F, const bf16_t* QM, int layer, bf16_t* AO) {
    const bf16_t* KVM = (const bf16_t*)(F.ws + WS_KVM);
    for (int mu = blockIdx.x; mu < NB * 32; mu += F.G) {
        const int b = mu >> 5, hm = (mu >> 3) & 3, qb = mu & 7;
        const size_t row0 = (size_t)b * SEQ + qb * 256;
        attn_unit<false>(F, QM + row0 * 256 + hm * 64, 256, KVM + (size_t)b * NMEM * 1024 + layer * 512 + hm * 64, KVM + (size_t)b * NMEM * 1024 + layer * 512 + 256 + hm * 64, 1024, 4,
                         nullptr, AO + row0 * 1024 + 768 + hm * 64, 1024);
    }
}
__device__ __forceinline__ void p_attn_dsa(Frame& F) {
    const bf16_t* Q = (const bf16_t*)(F.ws + WS_Q); const bf16_t* K = (const bf16_t*)(F.ws + WS_K); const bf16_t* V = (const bf16_t*)(F.ws + WS_V);
    const unsigned long long* MASK = (const unsigned long long*)(F.ws + WS_MASK); bf16_t* AO = (bf16_t*)(F.ws + WS_AO0);
    for (int pu = blockIdx.x; pu < NB * 12 * 4; pu += F.G) {
        const int bh = pu >> 2, pr = pu & 3, b = bh / 12, h = bh % 12;
#pragma unroll 1
        for (int z = 0; z < 2; ++z) {
            const int qb = z ? 7 - pr : pr; const size_t rb = (size_t)b * SEQ, row0 = rb + qb * 256;
            attn_unit<true>(F, Q + row0 * 768 + h * 64, 768, K + rb * 768 + h * 64, V + rb * 768 + h * 64, 768, 4 * (qb + 1), MASK + row0 * 32, AO + row0 * 1024 + h * 64, 1024);
        }
    }
    mem_attn_units(F, (const bf16_t*)(F.ws + WS_QM), 0, AO);
}

__device__ __forceinline__ void p_ln1_router(Frame& F, const Args& a, int layer, const float* resid, bf16_t* X1b, bool dry = false) {
    const float* MIX = F.out; float* X1 = (float*)(F.ws + WS_X1);
    const float* g1 = (const float*)a.in[I_LN1G] + layer * 1024; const float* b1 = (const float*)a.in[I_LN1B] + layer * 1024;
    const float* wg = (const float*)a.in[I_MOE_WG] + (size_t)layer * 1024 * 4; const float* bg = (const float*)a.in[I_MOE_BG] + layer * 4;
    const float* wr = (const float*)a.in[I_MOE_WR] + (size_t)layer * 4 * 1024 * 8; const float* br = (const float*)a.in[I_MOE_BR] + layer * 32;
    unsigned* cnt = F.ctl + CW_CNT + layer * 32;
    int* LISTTOK = (int*)(F.ws + WS_LISTTOK); float* LISTW = (float*)(F.ws + WS_LISTW); int* TOKSLOT = (int*)(F.ws + WS_TOKSLOT);
    const int lane = F.lane;
    f32x4 gv[4], bv[4];
#pragma unroll
    for (int j = 0; j < 4; ++j) { gv[j] = *((const f32x4*)g1 + lane + 64 * j); bv[j] = *((const f32x4*)b1 + lane + 64 * j); }
    for (int t = F.gw; t < NT; t += F.NGW) {
        const f32x4* xr = (const f32x4*)(resid + (size_t)t * DM) + lane; const f32x4* mr = (const f32x4*)(MIX + (size_t)t * DM) + lane;
        f32x4 v[4]; float s = 0.f;
#pragma unroll
        for (int j = 0; j < 4; ++j) { v[j] = xr[64 * j] * ALPHA + mr[64 * j]; s += (v[j].x + v[j].y) + (v[j].z + v[j].w); }
        const float mean = wave_sum(s) * (1.f / DM); float s2 = 0.f;
#pragma unroll
        for (int j = 0; j < 4; ++j) { v[j] = v[j] - mean; s2 += (v[j].x * v[j].x + v[j].y * v[j].y) + (v[j].z * v[j].z + v[j].w * v[j].w); }
        const float rstd = 1.f / sqrtf(wave_sum(s2) * (1.f / DM) + LN_EPS);
        f32x4* o4 = (f32x4*)(X1 + (size_t)t * DM) + lane; u32x2* ob = (u32x2*)(X1b + (size_t)t * DM) + lane;
#pragma unroll
        for (int j = 0; j < 4; ++j) { v[j] = v[j] * rstd * gv[j] + bv[j]; o4[64 * j] = v[j]; u32x2 w; w.x = pk2(v[j].x, v[j].y); w.y = pk2(v[j].z, v[j].w); ob[64 * j] = w; }
        float gl[4] = {0.f, 0.f, 0.f, 0.f};
#pragma unroll
        for (int j = 0; j < 4; ++j)
#pragma unroll
            for (int c = 0; c < 4; ++c) { const f32x4 w4 = *(const f32x4*)(wg + (size_t)(256 * j + 4 * lane + c) * 4);
#pragma unroll
                for (int k = 0; k < 4; ++k) gl[k] += v[j][c] * w4[k]; }
#pragma unroll
        for (int k = 0; k < 4; ++k) gl[k] = wave_sum(gl[k]) + bg[k];
        int gsel = 0; float gmax = gl[0];
#pragma unroll
        for (int k = 1; k < 4; ++k) if (gl[k] > gmax) { gmax = gl[k]; gsel = k; }
        float gs = 0.f;
#pragma unroll
        for (int k = 0; k < 4; ++k) gs += __expf(gl[k] - gmax);
        const float pg = 1.f / gs;
        gsel = __builtin_amdgcn_readfirstlane(gsel);
        const float* wrg = wr + (size_t)gsel * 1024 * 8;
        float el[8] = {0.f, 0.f, 0.f, 0.f, 0.f, 0.f, 0.f, 0.f};
#pragma unroll
        for (int j = 0; j < 4; ++j)
#pragma unroll
            for (int c = 0; c < 4; ++c) { const float* wp = wrg + (size_t)(256 * j + 4 * lane + c) * 8; const f32x4 w0 = *(const f32x4*)wp, w1 = *(const f32x4*)(wp + 4);
#pragma unroll
                for (int k = 0; k < 4; ++k) { el[k] += v[j][c] * w0[k]; el[4 + k] += v[j][c] * w1[k]; } }
#pragma unroll
        for (int k = 0; k < 8; ++k) el[k] = wave_sum(el[k]) + br[gsel * 8 + k];
        int i1 = 0; float v1 = el[0];
#pragma unroll
        for (int k = 1; k < 8; ++k) if (el[k] > v1) { v1 = el[k]; i1 = k; }
        int i2 = -1; float v2 = -INFINITY;
#pragma unroll
        for (int k = 0; k < 8; ++k) if (k != i1 && (i2 < 0 || el[k] > v2)) { v2 = el[k]; i2 = k; }
        const float e2 = __expf(v2 - v1); const float wt1 = pg / (1.f + e2), wt2 = pg * e2 / (1.f + e2);
        if (lane == 0 && !dry) {
            const int ge1 = gsel * 8 + i1, ge2 = gsel * 8 + i2;
            const unsigned p1 = atomicAdd(&cnt[ge1], 1u), p2 = atomicAdd(&cnt[ge2], 1u);
            LISTTOK[(size_t)ge1 * NT + p1] = t; LISTW[(size_t)ge1 * NT + p1] = wt1;
            LISTTOK[(size_t)ge2 * NT + p2] = t; LISTW[(size_t)ge2 * NT + p2] = wt2;
            *(int4*)(TOKSLOT + (size_t)t * 4) = make_int4(ge1, (int)p1, ge2, (int)p2);
        }
    }
}
__device__ __forceinline__ void p_ln2(Frame& F, const Args& a, int layer, float* dst, bf16_t* dstb) {
    const float* X1 = (const float*)(F.ws + WS_X1); const bf16_t* Y = (const bf16_t*)(F.ws + WS_Y); const int* TOKSLOT = (const int*)(F.ws + WS_TOKSLOT);
    const float* g2 = (const float*)a.in[I_LN2G] + layer * 1024; const float* b2 = (const float*)a.in[I_LN2B] + layer * 1024;
    LAS int* tp = (LAS int*)(F.lds + MISC_OFF + 256);
    moe_tile_table(F, F.ctl + CW_CNT + layer * 32, tp);
    const int lane = F.lane;
    f32x4 gv[4], bv[4];
#pragma unroll
    for (int j = 0; j < 4; ++j) { gv[j] = *((const f32x4*)g2 + lane + 64 * j); bv[j] = *((const f32x4*)b2 + lane + 64 * j); }
    for (int t = F.gw; t < NT; t += F.NGW) {
        const int4 ts = *(const int4*)(TOKSLOT + (size_t)t * 4);
        const size_t s0 = (size_t)tp[ts.x] * 256 + ts.y, s1 = (size_t)tp[ts.z] * 256 + ts.w;
        const f32x4* xr = (const f32x4*)(X1 + (size_t)t * DM) + lane;
        const u32x2* y0 = (const u32x2*)(Y + s0 * DM) + lane; const u32x2* y1 = (const u32x2*)(Y + s1 * DM) + lane;
        f32x4 v[4]; float s = 0.f;
#pragma unroll
        for (int j = 0; j < 4; ++j) { const u32x2 p = y0[64 * j], q = y1[64 * j];
            f32x4 yy; yy.x = bf2f(p.x & 0xffffu) + bf2f(q.x & 0xffffu); yy.y = bf2f(p.x >> 16) + bf2f(q.x >> 16); yy.z = bf2f(p.y & 0xffffu) + bf2f(q.y & 0xffffu); yy.w = bf2f(p.y >> 16) + bf2f(q.y >> 16);
            v[j] = xr[64 * j] * ALPHA + yy; s += (v[j].x + v[j].y) + (v[j].z + v[j].w); }
        const float mean = wave_sum(s) * (1.f / DM); float s2 = 0.f;
#pragma unroll
        for (int j = 0; j < 4; ++j) { v[j] = v[j] - mean; s2 += (v[j].x * v[j].x + v[j].y * v[j].y) + (v[j].z * v[j].z + v[j].w * v[j].w); }
        const float rstd = 1.f / sqrtf(wave_sum(s2) * (1.f / DM) + LN_EPS);
        f32x4* o4 = (f32x4*)(dst + (size_t)t * DM) + lane;
#pragma unroll
        for (int j = 0; j < 4; ++j) { v[j] = v[j] * rstd * gv[j] + bv[j]; o4[64 * j] = v[j]; }
        if (dstb) { u32x2* ob = (u32x2*)(dstb + (size_t)t * DM) + lane;
#pragma unroll
            for (int j = 0; j < 4; ++j) { u32x2 w; w.x = pk2(v[j].x, v[j].y); w.y = pk2(v[j].z, v[j].w); ob[64 * j] = w; } }
    }
}

__device__ __forceinline__ bf16x8 pack8(f32x4 lo, f32x4 hi) { u32x4 w; w.x = pg8::cvt_pk_bf16(lo[0], lo[1]); w.y = pg8::cvt_pk_bf16(lo[2], lo[3]); w.z = pg8::cvt_pk_bf16(hi[0], hi[1]); w.w = pg8::cvt_pk_bf16(hi[2], hi[3]); return __builtin_bit_cast(bf16x8, w); }
constexpr int GLA_QP = 208, GLA_VP = 400;
constexpr int GL_WGS = 0, GL_BGS = 6144, GL_Q = 8192, GL_K = 8192 + 13312, GL_V = 8192 + 2 * 13312, GL_ST = GL_V + 25600;
__device__ __forceinline__ void gla_gates(const float* a1row, const LAS float* wgs, const LAS float* bgs, int w, int lane, float (&bq)[12], float (&bl)[12]) {
    f32x4 av[4];
#pragma unroll
    for (int r = 0; r < 4; ++r) av[r] = *(const f32x4*)(a1row + 4 * r);
#pragma unroll
    for (int k = 0; k < 12; ++k) {
        const int d = 12 * w + k; float z = bgs[d];
#pragma unroll
        for (int r = 0; r < 16; ++r) z += av[r >> 2][r & 3] * wgs[r * 96 + d];
        float g = (fminf(z, 0.f) - __logf(1.f + __expf(-fabsf(z)))) * (1.f / 16.f);
#pragma unroll
        for (int o = 1; o < 64; o <<= 1) { const float t = __shfl_up(g, o); if (lane >= o) g += t; }
        bq[k] = g; bl[k] = __shfl(g, 63);
    }
}
__device__ __forceinline__ void gla_stage_common(Frame& F, const Args& a, int h, size_t row0) {
    const float* wgate = (const float*)a.in[I_GLA_WGATE]; const float* bgate = (const float*)a.in[I_GLA_BGATE];
    const bf16_t* GV = (const bf16_t*)(F.ws + WS_GV);
    LAS float* wgs = (LAS float*)(F.lds + GL_WGS); LAS float* bgs = (LAS float*)(F.lds + GL_BGS);
    const int tid = F.tid;
    if (tid < 384) { const int r = tid / 24, d4 = (tid % 24) * 4; *(LAS f32x4*)(wgs + r * 96 + d4) = *(const f32x4*)(wgate + r * 384 + h * 96 + d4); }
    if (tid < 96) bgs[tid] = bgate[h * 96 + tid];
#pragma unroll
    for (int i = 0; i < 3; ++i) { const int p = tid + 512 * i, row = p / 24, pc = p % 24;
        *(LAS u32x4*)(F.lds + GL_V + row * GLA_VP + pc * 16) = *(const u32x4*)(GV + (row0 + row) * 768 + h * 192 + pc * 8); }
}
__device__ __forceinline__ bf16x8 tr2(const LAS unsigned char* p0, const LAS unsigned char* p1) { const s16x4 a = vtr(p0), b = vtr(p1); return (bf16x8){a[0], a[1], a[2], a[3], b[0], b[1], b[2], b[3]}; }
__device__ __forceinline__ u32x2 pack4(f32x4 v) { u32x2 w; w.x = pg8::cvt_pk_bf16(v[0], v[1]); w.y = pg8::cvt_pk_bf16(v[2], v[3]); return w; }
__device__ __forceinline__ void p_gla_u(Frame& F, const Args& a) {
    const bf16_t* GK = (const bf16_t*)(F.ws + WS_GK); const float* A1 = (const float*)(F.ws + WS_A1);
    u32x2* UF = (u32x2*)F.out; float* DEC = (float*)(F.ws + WS_DEC);
    const int lane = F.lane, w = F.wave, fq = lane >> 4, qq = (lane & 15) >> 2, pp = lane & 3;
    for (int U = blockIdx.x; U < NB * 4 * 32; U += F.G) {
        const int c = U & 31, h = (U >> 5) & 3, b = U >> 7; const size_t row0 = (size_t)b * SEQ + c * 64;
        gla_stage_common(F, a, h, row0);
        __syncthreads();
        float bq[12], bl[12];
        gla_gates(A1 + (row0 + lane) * 16, (const LAS float*)(F.lds + GL_WGS), (const LAS float*)(F.lds + GL_BGS), w, lane, bq, bl);
        { const u32x2* kp = (const u32x2*)(GK + (row0 + lane) * 384 + h * 96 + 12 * w);
#pragma unroll
          for (int i = 0; i < 3; ++i) { const u32x2 kv = kp[i]; f32x4 o;
              o[0] = bf2f(kv.x & 0xffffu) * __expf(bl[4 * i] - bq[4 * i]); o[1] = bf2f(kv.x >> 16) * __expf(bl[4 * i + 1] - bq[4 * i + 1]);
              o[2] = bf2f(kv.y & 0xffffu) * __expf(bl[4 * i + 2] - bq[4 * i + 2]); o[3] = bf2f(kv.y >> 16) * __expf(bl[4 * i + 3] - bq[4 * i + 3]);
              *(LAS u32x2*)(F.lds + GL_K + lane * GLA_QP + (12 * w + 4 * i) * 2) = pack4(o); } }
        if (lane == 0) {
#pragma unroll
            for (int i = 0; i < 3; ++i) *(f32x4*)(DEC + (size_t)U * 96 + 12 * w + 4 * i) = (f32x4){__expf(bl[4 * i]), __expf(bl[4 * i + 1]), __expf(bl[4 * i + 2]), __expf(bl[4 * i + 3])}; }
        __syncthreads();
        const int dt0 = 3 * (w >> 2), et0 = 3 * (w & 3);
        bf16x8 af[3][2], bfv[3][2];
#pragma unroll
        for (int ks = 0; ks < 2; ++ks) { const int prow = 32 * ks + 8 * fq + qq;
#pragma unroll
            for (int i = 0; i < 3; ++i) {
                const LAS unsigned char* ka = F.lds + GL_K + prow * GLA_QP + (16 * (dt0 + i) + 4 * pp) * 2; af[i][ks] = tr2(ka, ka + 4 * GLA_QP);
                const LAS unsigned char* va = F.lds + GL_V + prow * GLA_VP + (16 * (et0 + i) + 4 * pp) * 2; bfv[i][ks] = tr2(va, va + 4 * GLA_VP); } }
#pragma unroll
        for (int i = 0; i < 3; ++i)
#pragma unroll
            for (int j = 0; j < 3; ++j) { f32x4 acc = (f32x4){0.f, 0.f, 0.f, 0.f};
#pragma unroll
                for (int ks = 0; ks < 2; ++ks) acc = __builtin_amdgcn_mfma_f32_16x16x32_bf16(af[i][ks], bfv[j][ks], acc, 0, 0, 0);
                UF[((size_t)U * 72 + (dt0 + i) * 12 + (et0 + j)) * 64 + lane] = pack4(acc); }
        __syncthreads();
    }
}
__device__ __forceinline__ void p_gla_scan(Frame& F) {
    u32x2* UF = (u32x2*)F.out; const float* DEC = (const float*)(F.ws + WS_DEC);
    for (int idx = blockIdx.x * 512 + F.tid; idx < 64 * 72 * 64; idx += F.G * 512) {
        const int bh = idx / 4608, rem = idx % 4608, tile = rem >> 6, ln = rem & 63, dt = tile / 12, fq = ln >> 4;
        f32x4 S = (f32x4){0.f, 0.f, 0.f, 0.f};
        u32x2* p = UF + ((size_t)bh * 32 * 72 + tile) * 64 + ln; const float* dp = DEC + (size_t)bh * 32 * 96 + 16 * dt + 4 * fq;
#pragma unroll 4
        for (int c = 0; c < 32; ++c) {
            const u32x2 u = *p; const f32x4 dc = *(const f32x4*)dp;
            *p = pack4(S);
            S[0] = S[0] * dc[0] + bf2f(u.x & 0xffffu); S[1] = S[1] * dc[1] + bf2f(u.x >> 16); S[2] = S[2] * dc[2] + bf2f(u.y & 0xffffu); S[3] = S[3] * dc[3] + bf2f(u.y >> 16);
            p += 72 * 64; dp += 96; }
    }
}
__device__ __forceinline__ void p_gla_out(Frame& F, const Args& a) {
    const bf16_t* GQ = (const bf16_t*)(F.ws + WS_GQ); const bf16_t* GK = (const bf16_t*)(F.ws + WS_GK); const bf16_t* GR = (const bf16_t*)(F.ws + WS_GR); const float* A1 = (const float*)(F.ws + WS_A1);
    const u32x2* SF = (const u32x2*)F.out; bf16_t* AO = (bf16_t*)(F.ws + WS_AO1); const float* ng = (const float*)a.in[I_GLA_NORMG];
    const int lane = F.lane, w = F.wave, li = lane & 15, fq = lane >> 4, qq = li >> 2, pp = lane & 3;
    LAS float* stats = (LAS float*)(F.lds + GL_ST);
    for (int U = blockIdx.x; U < NB * 4 * 32; U += F.G) {
        const int c = U & 31, h = (U >> 5) & 3, b = U >> 7; const size_t row0 = (size_t)b * SEQ + c * 64;
        gla_stage_common(F, a, h, row0);
        __syncthreads();
        { float bq[12], bl[12];
          gla_gates(A1 + (row0 + lane) * 16, (const LAS float*)(F.lds + GL_WGS), (const LAS float*)(F.lds + GL_BGS), w, lane, bq, bl);
          const u32x2* qp = (const u32x2*)(GQ + (row0 + lane) * 384 + h * 96 + 12 * w); const u32x2* kp = (const u32x2*)(GK + (row0 + lane) * 384 + h * 96 + 12 * w);
#pragma unroll
          for (int i = 0; i < 3; ++i) { const u32x2 qv = qp[i], kv = kp[i]; f32x4 oq, ok;
              const float e0 = __expf(bq[4 * i]), e1 = __expf(bq[4 * i + 1]), e2 = __expf(bq[4 * i + 2]), e3 = __expf(bq[4 * i + 3]);
              oq[0] = bf2f(qv.x & 0xffffu) * e0; oq[1] = bf2f(qv.x >> 16) * e1; oq[2] = bf2f(qv.y & 0xffffu) * e2; oq[3] = bf2f(qv.y >> 16) * e3;
              ok[0] = bf2f(kv.x & 0xffffu) * __builtin_amdgcn_rcpf(e0); ok[1] = bf2f(kv.x >> 16) * __builtin_amdgcn_rcpf(e1); ok[2] = bf2f(kv.y & 0xffffu) * __builtin_amdgcn_rcpf(e2); ok[3] = bf2f(kv.y >> 16) * __builtin_amdgcn_rcpf(e3);
              *(LAS u32x2*)(F.lds + GL_Q + lane * GLA_QP + (12 * w + 4 * i) * 2) = pack4(oq);
              *(LAS u32x2*)(F.lds + GL_K + lane * GLA_QP + (12 * w + 4 * i) * 2) = pack4(ok); } }
        __syncthreads();
        const int ip = w >> 2, et0 = 3 * (w & 3);
        f32x4 o[2][3]; float ssq[2][4];
#pragma unroll
        for (int iti = 0; iti < 2; ++iti) {
            const int it = 2 * ip + iti;
            const LAS unsigned char* qrow = F.lds + GL_Q + (16 * it + li) * GLA_QP;
            bf16x8 qB[3], qA[3];
#pragma unroll
            for (int ks = 0; ks < 3; ++ks) { qB[ks] = *(const LAS bf16x8*)(qrow + (32 * ks + 8 * fq) * 2);
                const u32x2 x0 = *(const LAS u32x2*)(qrow + (32 * ks + 4 * fq) * 2), x1 = *(const LAS u32x2*)(qrow + (32 * ks + 16 + 4 * fq) * 2);
                u32x4 x; x.x = x0.x; x.y = x0.y; x.z = x1.x; x.w = x1.y; qA[ks] = __builtin_bit_cast(bf16x8, x); }
            f32x4 tl[4];
#pragma unroll
            for (int jt = 0; jt < 4; ++jt) {
                tl[jt] = (f32x4){0.f, 0.f, 0.f, 0.f};
                if (jt <= it) {
                    const LAS unsigned char* krow = F.lds + GL_K + (16 * jt + li) * GLA_QP;
#pragma unroll
                    for (int ks = 0; ks < 3; ++ks) tl[jt] = __builtin_amdgcn_mfma_f32_16x16x32_bf16(*(const LAS bf16x8*)(krow + (32 * ks + 8 * fq) * 2), qB[ks], tl[jt], 0, 0, 0);
                    if (jt == it) {
#pragma unroll
                        for (int r = 0; r < 4; ++r) if (4 * fq + r > li) tl[jt][r] = 0.f; }
                }
            }
            bf16x8 am[2]; am[0] = pack8(tl[0], tl[1]); am[1] = pack8(tl[2], tl[3]);
#pragma unroll
            for (int eti = 0; eti < 3; ++eti) {
                const int et = et0 + eti;
                f32x4 acc = (f32x4){0.f, 0.f, 0.f, 0.f};
#pragma unroll
                for (int s2 = 0; s2 < 2; ++s2) if (2 * s2 <= it) {
                    const LAS unsigned char* va = F.lds + GL_V + (32 * s2 + 4 * fq + qq) * GLA_VP + (16 * et + 4 * pp) * 2;
                    acc = __builtin_amdgcn_mfma_f32_16x16x32_bf16(am[s2], tr2(va, va + 16 * GLA_VP), acc, 0, 0, 0); }
#pragma unroll
                for (int s = 0; s < 3; ++s) {
                    const u32x2 s0 = SF[((size_t)U * 72 + (2 * s) * 12 + et) * 64 + lane], s1 = SF[((size_t)U * 72 + (2 * s + 1) * 12 + et) * 64 + lane];
                    u32x4 x; x.x = s0.x; x.y = s0.y; x.z = s1.x; x.w = s1.y;
                    acc = __builtin_amdgcn_mfma_f32_16x16x32_bf16(qA[s], __builtin_bit_cast(bf16x8, x), acc, 0, 0, 0); }
                o[iti][eti] = acc;
            }
#pragma unroll
            for (int r = 0; r < 4; ++r) { float q2 = o[iti][0][r] * o[iti][0][r] + o[iti][1][r] * o[iti][1][r] + o[iti][2][r] * o[iti][2][r];
                q2 += __shfl_xor(q2, 1); q2 += __shfl_xor(q2, 2); q2 += __shfl_xor(q2, 4); q2 += __shfl_xor(q2, 8); ssq[iti][r] = q2; }
            if (li == 0) {
#pragma unroll
                for (int r = 0; r < 4; ++r) stats[(16 * it + 4 * fq + r) * 4 + (w & 3)] = ssq[iti][r]; }
        }
        __syncthreads();
#pragma unroll
        for (int iti = 0; iti < 2; ++iti) { const int it = 2 * ip + iti;
#pragma unroll
            for (int r = 0; r < 4; ++r) { const int rl = 16 * it + 4 * fq + r; const f32x4 st = *(const LAS f32x4*)(stats + rl * 4);
                const float rs = 1.f / sqrtf(((st[0] + st[1]) + (st[2] + st[3])) * (1.f / 192.f) + RMS_EPS);
#pragma unroll
                for (int eti = 0; eti < 3; ++eti) { const int e = 16 * (et0 + eti) + li;
                    const float rr = bf2f(GR[(row0 + rl) * 768 + h * 192 + e]);
                    AO[(row0 + rl) * 1024 + h * 192 + e] = (bf16_t)f2bf(o[iti][eti][r] * rs * ng[e] * silu_f(rr)); } } }
        __syncthreads();
    }
}
constexpr int NPHASE = 19;
#define GEMM_CALL(EpiT, SchedT, g, S, E) pg8::gemm_phase<EpiT, SchedT, true, true>(F.lds, g, S, E)
__device__ __forceinline__ void moe_gemms_up(Frame& F, int layer, const bf16_t* X1b, bf16_t* ACT) {
    LAS int* tp = (LAS int*)(F.lds + MISC_OFF + 256);
    const unsigned* cnt = F.ctl + CW_CNT + layer * 32;
    moe_tile_table(F, cnt, tp);
    pg8::Gemm g{X1b, (const bf16_t*)(F.ws + WS_W13), SLOT_ROWS, 512, 1024};
    MoeOrder S{tp, cnt, (const int*)(F.ws + WS_LISTTOK), 2, F.G, (int)blockIdx.x, true};
    EpiMoe1 E{ACT, (const float*)(F.ws + WS_LISTW), cnt};
    GEMM_CALL(EpiMoe1, MoeOrder, g, S, E);
}
__device__ __forceinline__ void moe_gemms_down(Frame& F, int layer, const bf16_t* ACT) {
    LAS int* tp = (LAS int*)(F.lds + MISC_OFF + 256);
    const unsigned* cnt = F.ctl + CW_CNT + layer * 32;
    moe_tile_table(F, cnt, tp);
    pg8::Gemm g{ACT, (const bf16_t*)(F.ws + WS_W2), SLOT_ROWS, 1024, 256};
    MoeOrder S{tp, cnt, nullptr, 4, F.G, (int)blockIdx.x, false};
    EpiBf16Plain E{(bf16_t*)(F.ws + WS_Y), 1024, 3};
    GEMM_CALL(EpiBf16Plain, MoeOrder, g, S, E);
}
__device__ __forceinline__ void out_proj(Frame& F, int layer, const bf16_t* AO) {
    pg8::Gemm g{AO, (const bf16_t*)(F.ws + WS_WO) + (size_t)layer * 1024 * 1024, NT, 1024, 1024};
    pg8::StaticOrder S; S.init(NT, 1024, F.G, (int)blockIdx.x);
    EpiF32Plain E{F.out, 1024};
    GEMM_CALL(EpiF32Plain, pg8::StaticOrder, g, S, E);
}

__global__ void __launch_bounds__(NWAVES * 64, 2) mk_fwd(Args args) {
    extern __shared__ __attribute__((aligned(16))) unsigned char lds_raw[];
    Frame F;
    F.lds = (LAS unsigned char*)lds_raw; F.ws = args.ws; F.out = args.out; F.ctl = (unsigned*)(args.ws + WS_CTL);
    F.tid = threadIdx.x; F.lane = F.tid & 63; F.wave = __builtin_amdgcn_readfirstlane(F.tid >> 6); F.G = gridDim.x;
    F.gw = blockIdx.x * NWAVES + F.wave; F.NGW = F.G * NWAVES;
    volatile LAS unsigned* MISC = (volatile LAS unsigned*)(F.lds + MISC_OFF);
    if (F.tid < 64) MISC[F.tid] = 0u;
    __syncthreads();
#if N_LAUNCH_MODE == 1
    XcdBarrier bar = xcd_barrier_post(F.ctl + CW_BAR, MISC + 8);
#define SEAM() xcd_barrier(bar)
#else
#define SEAM() do {} while (0)
#endif
    const int lo = args.ph_lo, hi = args.ph_hi;
#ifndef PH_ENABLE
#define PH_ENABLE 0xFFFFFFFFu
#endif
#define IN(k) (((PH_ENABLE >> (k)) & 1u) && lo <= (k) && (k) < hi)
#define ENDPH(k) do { if (IN((k) + 1)) SEAM(); } while (0)
#ifndef REP_MASK
#define REP_MASK 0u
#endif
#define REPS(k) for (int rep_ = 0; rep_ < 1 + (int)((REP_MASK >> (k)) & 1u); ++rep_)
#define REPSEAM(k) do { if ((REP_MASK >> (k)) & 1u) { if (rep_ == 0) SEAM(); } } while (0)

    if (IN(0)) REPS(0) { p_prologue(F, args); ENDPH(0); }
    if (IN(1)) REPS(1) {
        { pg8::Gemm g{(const bf16_t*)(F.ws + WS_XB), (const bf16_t*)(F.ws + WS_WD), NT, ND, 1024};
          pg8::StaticOrder S; S.init(NT, ND, F.G, (int)blockIdx.x);
          EpiDsaProj E{(bf16_t*)(F.ws + WS_Q), (bf16_t*)(F.ws + WS_K), (bf16_t*)(F.ws + WS_V), (bf16_t*)(F.ws + WS_QI), (bf16_t*)(F.ws + WS_QM), (float*)(F.ws + WS_KIW),
                       (const float*)(F.ws + WS_ROPEC), (const float*)(F.ws + WS_ROPES)};
          GEMM_CALL(EpiDsaProj, pg8::StaticOrder, g, S, E); }
        { pg8::Gemm g{(const bf16_t*)(F.ws + WS_MEMB), (const bf16_t*)(F.ws + WS_WKV), NB * NMEM, 1024, 1024};
          pg8::StaticOrder S; S.init(NB * NMEM, 1024, F.G, (int)blockIdx.x);
          EpiBf16Plain E{(bf16_t*)(F.ws + WS_KVM), 1024, 0x7fffffff};
          GEMM_CALL(EpiBf16Plain, pg8::StaticOrder, g, S, E); }
        ENDPH(1);
    }
    if (IN(2)) REPS(2) { p_ki(F, args); ENDPH(2); }
    if (IN(3)) REPS(3) { p_indexer(F); ENDPH(3); }
    if (IN(4)) REPS(4) { p_attn_dsa(F); ENDPH(4); }
    if (IN(5)) REPS(5) { out_proj(F, 0, (const bf16_t*)(F.ws + WS_AO0)); ENDPH(5); }
    if (IN(6)) REPS(6) { p_ln1_router(F, args, 0, (const float*)args.in[I_X], (bf16_t*)(F.ws + WS_X1B0), rep_ > 0); ENDPH(6); }
    if (IN(7)) REPS(7) { moe_gemms_up(F, 0, (const bf16_t*)(F.ws + WS_X1B0), (bf16_t*)(F.ws + WS_ACT0)); ENDPH(7); }
    if (IN(8)) REPS(8) { moe_gemms_down(F, 0, (const bf16_t*)(F.ws + WS_ACT0)); ENDPH(8); }
    if (IN(9)) { p_ln2(F, args, 0, (float*)(F.ws + WS_X1), (bf16_t*)(F.ws + WS_C));
                 moe_weight_items(F, (const float*)args.in[I_MOE_W13], (const float*)args.in[I_MOE_W2], 1); ENDPH(9); }
    if (IN(10)) REPS(10) {
        pg8::Gemm g{(const bf16_t*)(F.ws + WS_C), (const bf16_t*)(F.ws + WS_WG), NT, NG, 1024};
        pg8::StaticOrder S; S.init(NT, NG, F.G, (int)blockIdx.x);
        EpiGlaProj E{(bf16_t*)(F.ws + WS_GQ), (bf16_t*)(F.ws + WS_GK), (bf16_t*)(F.ws + WS_GV), (bf16_t*)(F.ws + WS_GR), (bf16_t*)(F.ws + WS_GQM), (float*)(F.ws + WS_A1)};
        GEMM_CALL(EpiGlaProj, pg8::StaticOrder, g, S, E);
        ENDPH(10);
    }
    if (IN(11)) REPS(11) { p_gla_u(F, args); ENDPH(11); }
    if (IN(12)) { p_gla_scan(F); ENDPH(12); }
    if (IN(13)) REPS(13) { p_gla_out(F, args); mem_attn_units(F, (const bf16_t*)(F.ws + WS_GQM), 1, (bf16_t*)(F.ws + WS_AO1)); ENDPH(13); }
    if (IN(14)) REPS(14) { out_proj(F, 1, (const bf16_t*)(F.ws + WS_AO1)); ENDPH(14); }
    if (IN(15)) { p_ln1_router(F, args, 1, (const float*)(F.ws + WS_X1), (bf16_t*)(F.ws + WS_X1B1)); ENDPH(15); }
    if (IN(16)) REPS(16) { moe_gemms_up(F, 1, (const bf16_t*)(F.ws + WS_X1B1), (bf16_t*)(F.ws + WS_ACT1)); ENDPH(16); }
    if (IN(17)) REPS(17) { moe_gemms_down(F, 1, (const bf16_t*)(F.ws + WS_ACT1)); ENDPH(17); }
    if (IN(18)) REPS(18) { p_ln2(F, args, 1, F.out, nullptr); }
#undef IN
#undef ENDPH
}

extern "C" void kernel_launch(void* const* d_in, const int* in_sizes, int n_in, void* d_out, int out_size, void* d_ws, size_t ws_size, hipStream_t stream) {
    static int grid = 0;
    if (grid == 0) {
        if (n_in != 22 || out_size != NT * DM || ws_size < WS_END) { fprintf(stderr, "kernel_launch: unexpected shapes: n_in %d out %d ws %zu (need %zu)\n", n_in, out_size, ws_size, (size_t)WS_END); grid = -1; return; }
        int dev = 0, cus = 0, per_cu = 0;
        if (hipGetDevice(&dev) != hipSuccess || hipDeviceGetAttribute(&cus, hipDeviceAttributeMultiprocessorCount, dev) != hipSuccess) { grid = -1; return; }
        if (hipFuncSetAttribute((const void*)mk_fwd, hipFuncAttributeMaxDynamicSharedMemorySize, LDS_BYTES) != hipSuccess) { fprintf(stderr, "kernel_launch: hipFuncSetAttribute failed\n"); grid = -1; return; }
        if (hipOccupancyMaxActiveBlocksPerMultiprocessor(&per_cu, (const void*)mk_fwd, NWAVES * 64, LDS_BYTES) != hipSuccess || per_cu < 1) fprintf(stderr, "kernel_launch: occupancy query reports %d\n", per_cu);
        (void)hipGetLastError();
        grid = cus;
    }
    if (grid < 0) return;
    (void)hipMemsetAsync((char*)d_ws + WS_CTL, 0, CTL_ZERO_BYTES, stream);
    Args a{};
    for (int i = 0; i < 22; ++i) a.in[i] = d_in[i];
    a.out = (float*)d_out; a.ws = (unsigned char*)d_ws;
#if N_LAUNCH_MODE == 1
    a.ph_lo = 0; a.ph_hi = NPHASE;
    hipLaunchKernelGGL(mk_fwd, dim3(grid), dim3(NWAVES * 64), LDS_BYTES, stream, a);
#else
    for (int k = 0; k < NPHASE; ++k) { a.ph_lo = k; a.ph_hi = k + 1; hipLaunchKernelGGL(mk_fwd, dim3(grid), dim3(NWAVES * 64), LDS_BYTES, stream, a); }
#endif
}
```

```cpp
#include <hip/hip_runtime.h>
#include <cstdio>
#include <cstdint>

#define LAS __attribute__((address_space(3)))
#define GAS __attribute__((address_space(1)))
typedef unsigned short bf16_t;
typedef short bf16x8 __attribute__((ext_vector_type(8)));
typedef short s16x4 __attribute__((ext_vector_type(4)));
typedef float f32x4 __attribute__((ext_vector_type(4)));
typedef float f32x2 __attribute__((ext_vector_type(2)));
typedef float f32x16 __attribute__((ext_vector_type(16)));
typedef unsigned u32x4 __attribute__((ext_vector_type(4)));
typedef unsigned u32x2 __attribute__((ext_vector_type(2)));

#ifndef N_LAUNCH_MODE
#define N_LAUNCH_MODE 1
#endif

constexpr int NB = 16, SEQ = 2048, DM = 1024, NT = NB * SEQ;
constexpr int NMEM = 256;
constexpr int ND = 3328;
constexpr int NG = 2816;
constexpr int DSA_W = 3144, GLA_W = 2576;
constexpr int NEXP = 32;
constexpr int SLOT_ROWS = 73728;
constexpr float ALPHA = 1.4142135623730951f;
constexpr float LN_EPS = 1e-5f, RMS_EPS = 1e-6f;
constexpr float LOG2E = 1.4426950408889634f;
constexpr float C2 = 0.125f * LOG2E;
constexpr int NWAVES = 8;

constexpr size_t MiB = 1u << 20;
constexpr size_t WS_CTL = 0, CTL_ZERO_BYTES = 1 * MiB;
constexpr size_t WS_ROPEC = 1 * MiB, WS_ROPES = 5 * MiB;
constexpr size_t WS_DEC = 9 * MiB;
constexpr size_t WS_WD = 10 * MiB, WS_WG = 17 * MiB, WS_WKV = 23 * MiB, WS_WO = 25 * MiB, WS_W13 = 29 * MiB, WS_W2 = 61 * MiB;
constexpr size_t WS_KVM = 77 * MiB;
constexpr size_t WS_MEMB = 85 * MiB;
constexpr size_t WS_LISTTOK = 85 * MiB, WS_LISTW = 89 * MiB;
constexpr size_t WS_TOKSLOT = 93 * MiB;
constexpr size_t WS_A = 96 * MiB;
constexpr size_t WS_B = 160 * MiB;
constexpr size_t WS_C = 288 * MiB;
constexpr size_t WS_D = 352 * MiB;
constexpr size_t WS_END = 500 * MiB;
constexpr size_t WS_XB = WS_A;
constexpr size_t WS_Q = 160 * MiB, WS_K = 208 * MiB, WS_V = 256 * MiB, WS_QI = 304 * MiB, WS_QM = 336 * MiB, WS_KIW = 352 * MiB, WS_KI = 362 * MiB, WS_WI = 366 * MiB, WS_MASK = 368 * MiB, WS_AO0 = 376 * MiB;
constexpr size_t WS_X1 = WS_B, WS_X1B0 = WS_C, WS_ACT0 = WS_A, WS_Y = WS_D;
constexpr size_t WS_GV = 96 * MiB, WS_GQM = 144 * MiB, WS_GQ = 352 * MiB, WS_GK = 376 * MiB, WS_GR = 400 * MiB, WS_A1 = 448 * MiB, WS_KPT = 450 * MiB, WS_VT = WS_C, WS_AO1 = WS_B;
constexpr size_t WS_X1B1 = WS_A, WS_ACT1 = WS_C;
constexpr int KIW_P = 80;

constexpr int CW_CNT = 8192;
constexpr int CW_BAR = 4096;

__device__ __forceinline__ unsigned f2bf(float f) { unsigned u = __builtin_bit_cast(unsigned, f); return (u + 0x7fffu + ((u >> 16) & 1u)) >> 16; }
__device__ __forceinline__ unsigned pk2(float lo, float hi) { return f2bf(lo) | (f2bf(hi) << 16); }
__device__ __forceinline__ float bf2f(unsigned h) { return __builtin_bit_cast(float, h << 16); }
__device__ __forceinline__ float wave_sum(float v) {
#pragma unroll
    for (int o = 1; o < 64; o <<= 1) v += __shfl_xor(v, o);
    return v;
}
__device__ __forceinline__ float fast_exp2(float x) { return __builtin_amdgcn_exp2f(x); }
__device__ __forceinline__ float silu_f(float a) { return a * __builtin_amdgcn_rcpf(1.f + fast_exp2(-a * LOG2E)); }

namespace pg8 {
constexpr int BM = 256, BK = 64, HALF = 128, HTB = HALF * BK * 2, STAGE_BYTES = 8 * HTB, NXCD = 8, WGM = 8;
__host__ __device__ __forceinline__ int lds_byte(int r, int c) { const int st = (r >> 4) * 2 + (c >> 5), rr = r & 15, cc = c & 31, ob = rr * 64 + cc * 2; return st * 1024 + (ob ^ (((ob >> 9) & 1) << 5)); }
__host__ __device__ __forceinline__ void stage_rc(int b, int& R, int& C) { const int st = b / 1024, sb = b % 1024, swz = sb ^ (((sb >> 9) & 1) << 5); R = (st >> 1) * 16 + swz / 64; C = (st & 1) * 32 + (swz % 64) / 2; }
__host__ __device__ __forceinline__ int perm32(int rho) { const int n = rho >> 4, i = rho & 15; return 8 * (i >> 2) + 4 * n + (i & 3); }

struct Unit { int pm, pn, e, r0; };
struct Gemm { const bf16_t* A; const bf16_t* Bt; int M, N, K; };

struct StaticOrder {
    int nM, nN, nwg, G, c;
    __device__ void init(int M, int N, int G_, int c_) { nM = M / BM; nN = N / BM; nwg = nM * nN; G = G_; c = c_; }
    __device__ bool next(int i, Unit& u) const {
        const long L = (long)i * G + c; if (L >= nwg) return false;
        int wgid = (int)L; { const int q = nwg / NXCD, r = nwg % NXCD, xcd = wgid % NXCD, off = wgid / NXCD; wgid = (xcd < r ? xcd * (q + 1) : r * (q + 1) + (xcd - r) * q) + off; }
        const int nig = WGM * nN, gid = wgid / nig, fm = gid * WGM, gsz = (nM - fm) < WGM ? (nM - fm) : WGM;
        u.pm = fm + ((wgid % nig) % gsz); u.pn = (wgid % nig) / gsz; u.e = 0; u.r0 = 0; return true;
    }
    __device__ __forceinline__ int rowidx(const Unit& u, int r) const { return u.pm * BM + r; }
};

typedef __bf16 bf16x2_t __attribute__((ext_vector_type(2)));
__device__ __forceinline__ unsigned cvt_pk_bf16(float lo, float hi) { f32x2 v = {lo, hi}; bf16x2_t b = __builtin_convertvector(v, bf16x2_t); return __builtin_bit_cast(unsigned, b); }

template <class Epi, class Sched, bool ALIGN_EPI, bool SP2>
__device__ __forceinline__ void gemm_phase(LAS unsigned char* lds, const Gemm g, const Sched& S, const Epi& E) {
    const int tid = threadIdx.x, wid = __builtin_amdgcn_readfirstlane(tid >> 6), lane = tid & 63, wr = wid >> 2, wc = wid & 3, fr = lane & 15, fq = lane >> 4;
    const int K = g.K, nt = K / BK;
    int RA[2], CA[2]; unsigned voffB[2];
#pragma unroll
    for (int i = 0; i < 2; ++i) { int R, C; stage_rc(tid * 16 + i * 8192, R, C); const int Rb = (R & ~31) + perm32(R & 31);
        RA[i] = R; CA[i] = C; voffB[i] = (unsigned)(Rb * K + C) * 2u; }
    const size_t kstep = (size_t)(BK * 2);
    const size_t hstep = (size_t)HALF * K * 2;
    const size_t tstep = 2 * hstep;
    const unsigned ldsw = (unsigned)wid * 1024u;
    const int aoff = lds_byte(wr * 64 + fr, fq * 8), boff = lds_byte(wc * 32 + fr, fq * 8);
#define PG8_SA(b, h) (((b) * 2 + (h)) * HTB)
#define PG8_SB(b, h) ((4 + (b) * 2 + (h)) * HTB)
#define PG8_STAGE(bufoff, gbase, voff) do { _Pragma("unroll") for (int _i = 0; _i < 2; ++_i) \
        __builtin_amdgcn_global_load_lds((const unsigned*)((const char*)(gbase) + (voff)[_i]), (LAS unsigned*)(lds + (bufoff) + ldsw + _i * 8192), 16, 0, 0); } while (0)
#define PG8_LDA(dst, b, h) do { _Pragma("unroll") for (int m = 0; m < 4; ++m) _Pragma("unroll") for (int k = 0; k < 2; ++k) dst[m][k] = *(const LAS bf16x8*)(lds + PG8_SA(b, h) + aoff + m * 2048 + k * 1024); } while (0)
#define PG8_LDB(dst, b, h) do { _Pragma("unroll") for (int n = 0; n < 2; ++n) _Pragma("unroll") for (int k = 0; k < 2; ++k) dst[n][k] = *(const LAS bf16x8*)(lds + PG8_SB(b, h) + boff + n * 2048 + k * 1024); } while (0)
#define PG8_MMA(ai, bj, At, Bt) do { __builtin_amdgcn_s_setprio(1); _Pragma("unroll") for (int m = 0; m < 4; ++m) _Pragma("unroll") for (int n = 0; n < 2; ++n) _Pragma("unroll") for (int k = 0; k < 2; ++k) \
        acc[ai][bj][m][n] = __builtin_amdgcn_mfma_f32_16x16x32_bf16(Bt[n][k], At[m][k], acc[ai][bj][m][n], 0, 0, 0); __builtin_amdgcn_s_setprio(0); } while (0)
#define PG8_WAIT_V(n) asm volatile("s_waitcnt vmcnt(" #n ")" ::: "memory")
#define PG8_WAIT_L(n) asm volatile("s_waitcnt lgkmcnt(" #n ")" ::: "memory")
#define PG8_BAR __builtin_amdgcn_s_barrier()
#define PG8_SCHED __builtin_amdgcn_sched_barrier(0)
#define PG8_MKOFF(o0, o1, u) do { _Pragma("unroll") for (int _i = 0; _i < 2; ++_i) { \
        o0[_i] = ((unsigned)S.rowidx(u, RA[_i]) * (unsigned)K + (unsigned)CA[_i]) * 2u; o1[_i] = ((unsigned)S.rowidx(u, HALF + RA[_i]) * (unsigned)K + (unsigned)CA[_i]) * 2u; } } while (0)
    Unit cur, nxt; int ui = 0;
    if (!S.next(0, cur)) return;
    f32x4 acc[2][2][4][2];
#pragma unroll
    for (int a = 0; a < 2; ++a)
#pragma unroll
        for (int b = 0; b < 2; ++b)
#pragma unroll
            for (int m = 0; m < 4; ++m)
#pragma unroll
                for (int n = 0; n < 2; ++n) acc[a][b][m][n] = (f32x4){0.f, 0.f, 0.f, 0.f};
    bf16x8 At[4][2], B0[2][2], B1[2][2];
    const char* const gA = (const char*)g.A;
    unsigned cO0[2], cO1[2], nO0[2], nO1[2];
    PG8_MKOFF(cO0, cO1, cur);
    const char* cB = (const char*)g.Bt + (size_t)cur.pn * tstep;
    if constexpr (SP2) {
        PG8_STAGE(PG8_SB(0, 0), cB, voffB); PG8_STAGE(PG8_SB(0, 1), cB + hstep, voffB); PG8_STAGE(PG8_SA(0, 0), gA, cO0); PG8_STAGE(PG8_SA(0, 1), gA, cO1);
        if (wr == 1) PG8_BAR;
        PG8_WAIT_V(2); PG8_BAR;
        PG8_STAGE(PG8_SB(1, 0), cB + kstep, voffB); PG8_STAGE(PG8_SA(1, 0), gA + kstep, cO0); PG8_STAGE(PG8_SB(1, 1), cB + hstep + kstep, voffB);
        PG8_WAIT_V(6); PG8_BAR;
    } else {
        PG8_STAGE(PG8_SB(0, 0), cB, voffB); PG8_STAGE(PG8_SA(0, 0), gA, cO0); PG8_STAGE(PG8_SB(0, 1), cB + hstep, voffB); PG8_STAGE(PG8_SA(0, 1), gA, cO1);
        if (wr == 1) PG8_BAR;
        PG8_WAIT_V(4); PG8_BAR;
        PG8_STAGE(PG8_SB(1, 0), cB + kstep, voffB); PG8_STAGE(PG8_SA(1, 0), gA + kstep, cO0); PG8_STAGE(PG8_SB(1, 1), cB + hstep + kstep, voffB);
        PG8_WAIT_V(6); PG8_BAR;
    }
    for (;;) {
        const bool has_next = S.next(ui + 1, nxt);
        if (has_next) { PG8_MKOFF(nO0, nO1, nxt); } else {
#pragma unroll
            for (int _i = 0; _i < 2; ++_i) { nO0[_i] = cO0[_i]; nO1[_i] = cO1[_i]; } }
        const char* nB = has_next ? (const char*)g.Bt + (size_t)nxt.pn * tstep : cB;
#pragma unroll 1
        for (int t = 0; t < nt; t += 2) {
            const bool last = (t == nt - 2);
            const char* a1 = gA + (size_t)(t + 1) * kstep;
            const char* a2 = last ? gA : gA + (size_t)(t + 2) * kstep; const char* b2 = last ? nB : cB + (size_t)(t + 2) * kstep;
            const char* a3 = a2 + kstep; const char* b3 = b2 + kstep;
            unsigned x0[2], x1[2];
#pragma unroll
            for (int _i = 0; _i < 2; ++_i) { x0[_i] = last ? nO0[_i] : cO0[_i]; x1[_i] = last ? nO1[_i] : cO1[_i]; }
            if constexpr (SP2) {
            PG8_LDB(B0, 0, 0); PG8_LDB(B1, 0, 1); PG8_SCHED; PG8_LDA(At, 0, 0); PG8_STAGE(PG8_SA(1, 1), a1, cO1);
            PG8_WAIT_V(8); PG8_WAIT_L(0); PG8_BAR; PG8_MMA(0, 0, At, B0); PG8_MMA(0, 1, At, B1); PG8_BAR; PG8_SCHED;
            PG8_LDA(At, 0, 1); PG8_STAGE(PG8_SB(0, 0), b2, voffB); PG8_STAGE(PG8_SB(0, 1), b2 + hstep, voffB); PG8_STAGE(PG8_SA(0, 0), a2, x0);
            PG8_WAIT_V(8); PG8_WAIT_L(0); PG8_BAR; PG8_MMA(1, 0, At, B0); PG8_MMA(1, 1, At, B1); PG8_BAR; PG8_SCHED;
            PG8_LDB(B0, 1, 0); PG8_LDB(B1, 1, 1); PG8_SCHED; PG8_LDA(At, 1, 0); PG8_STAGE(PG8_SA(0, 1), a2, x1);
            PG8_WAIT_V(8); PG8_WAIT_L(0); PG8_BAR; PG8_MMA(0, 0, At, B0); PG8_MMA(0, 1, At, B1); PG8_BAR; PG8_SCHED;
            PG8_LDA(At, 1, 1); PG8_STAGE(PG8_SB(1, 0), b3, voffB); PG8_STAGE(PG8_SB(1, 1), b3 + hstep, voffB); PG8_STAGE(PG8_SA(1, 0), a3, x0);
            PG8_WAIT_V(8); PG8_WAIT_L(0); PG8_BAR; PG8_MMA(1, 0, At, B0); PG8_MMA(1, 1, At, B1); PG8_BAR; PG8_SCHED;
            } else {
            PG8_LDB(B0, 0, 0); PG8_SCHED; PG8_LDA(At, 0, 0); PG8_STAGE(PG8_SA(1, 1), a1, cO1);
            PG8_WAIT_L(8); PG8_BAR; PG8_WAIT_L(0); PG8_MMA(0, 0, At, B0); PG8_BAR; PG8_SCHED;
            PG8_LDB(B1, 0, 1); PG8_STAGE(PG8_SB(0, 0), b2, voffB);
            PG8_BAR; PG8_WAIT_L(0); PG8_MMA(0, 1, At, B1); PG8_BAR;
            PG8_LDA(At, 0, 1); PG8_STAGE(PG8_SA(0, 0), a2, x0);
            PG8_BAR; PG8_WAIT_L(0); PG8_MMA(1, 0, At, B0); PG8_BAR; PG8_SCHED;
            PG8_STAGE(PG8_SB(0, 1), b2 + hstep, voffB);
            PG8_WAIT_V(6); PG8_BAR; PG8_MMA(1, 1, At, B1); PG8_BAR;
            PG8_LDB(B0, 1, 0); PG8_SCHED; PG8_LDA(At, 1, 0); PG8_STAGE(PG8_SA(0, 1), a2, x1);
            PG8_WAIT_L(8); PG8_BAR; PG8_WAIT_L(0); PG8_MMA(0, 0, At, B0); PG8_BAR; PG8_SCHED;
            PG8_LDB(B1, 1, 1); PG8_STAGE(PG8_SB(1, 0), b3, voffB);
            PG8_BAR; PG8_WAIT_L(0); PG8_MMA(0, 1, At, B1); PG8_BAR;
            PG8_LDA(At, 1, 1); PG8_STAGE(PG8_SA(1, 0), a3, x0);
            PG8_BAR; PG8_WAIT_L(0); PG8_MMA(1, 0, At, B0); PG8_BAR; PG8_SCHED;
            PG8_STAGE(PG8_SB(1, 1), b3 + hstep, voffB);
            PG8_WAIT_V(6); PG8_BAR; PG8_MMA(1, 1, At, B1); PG8_BAR;
            }
        }
        if constexpr (ALIGN_EPI) { if (wr == 0) PG8_BAR; }
        E(acc, cur, wr, wc, fr, fq);
        if (!has_next) break;
#pragma unroll
        for (int a = 0; a < 2; ++a)
#pragma unroll
            for (int b = 0; b < 2; ++b)
#pragma unroll
                for (int m = 0; m < 4; ++m)
#pragma unroll
                    for (int n = 0; n < 2; ++n) acc[a][b][m][n] = (f32x4){0.f, 0.f, 0.f, 0.f};
        cur = nxt; cB = nB; ++ui;
#pragma unroll
        for (int _i = 0; _i < 2; ++_i) { cO0[_i] = nO0[_i]; cO1[_i] = nO1[_i]; }
        if constexpr (ALIGN_EPI) { if (wr == 1) PG8_BAR; }
    }
    PG8_WAIT_V(0);
    if constexpr (!ALIGN_EPI) { if (wr == 0) PG8_BAR; }
    PG8_BAR;
#undef PG8_SA
#undef PG8_SB
#undef PG8_STAGE
#undef PG8_LDA
#undef PG8_LDB
#undef PG8_MMA
#undef PG8_WAIT_V
#undef PG8_WAIT_L
#undef PG8_BAR
#undef PG8_SCHED
#undef PG8_MKOFF
}
}

#define XB_TMO      128
#define XB_XCNT(j)  (256  + 64 * (j))
#define XB_XSUB(j)  (1280 + 64 * (j))
#define XB_XGEN(j)  (2304 + 64 * (j))
#define XB_TOP      3328
#define XB_TOPGEN   3392
#define XCD_BAR_WORDS 3456
#define XB_SPIN_CAP (1u << 18)
__device__ __forceinline__ unsigned xb_ld(unsigned* p)              { return __hip_atomic_load(p, __ATOMIC_RELAXED, __HIP_MEMORY_SCOPE_AGENT); }
__device__ __forceinline__ unsigned xb_add(unsigned* p, unsigned v) { return __hip_atomic_fetch_add(p, v, __ATOMIC_RELAXED, __HIP_MEMORY_SCOPE_AGENT); }
__device__ __forceinline__ unsigned xb_xcc_id() { return (unsigned)__builtin_amdgcn_s_getreg((3 << 11) | 20) & 0xFu; }
#define XB_SPIN(cond, bar) do { unsigned _sp = 0; while (cond) { __builtin_amdgcn_s_sleep(1); \
    if ((++_sp & 255u) == 0u) { if (xb_ld(&(bar)[XB_TMO])) break; if (_sp > XB_SPIN_CAP) { atomicAdd(&(bar)[XB_TMO], 1u); break; } } } } while (0)
struct XcdBarrier { unsigned* bar; unsigned x; volatile LAS unsigned* st; };
__device__ __forceinline__ XcdBarrier xcd_barrier_post(unsigned* bar, volatile LAS unsigned* st) {
    XcdBarrier b; b.bar = bar; b.x = xb_xcc_id(); b.st = st;
    if (threadIdx.x == 0) (void)xb_add(&bar[XB_XCNT(b.x)], 1u);
    return b;
}
__device__ __forceinline__ void xcd_barrier_complete(unsigned* bar, unsigned x, unsigned& nloc, unsigned& nx) {
    const unsigned G = gridDim.x * gridDim.y * gridDim.z;
    unsigned sum, cnt, mine, sp = 0u;
    for (;;) {
        sum = 0u; cnt = 0u; mine = 0u;
#pragma unroll
        for (unsigned j = 0; j < 16; ++j) { const unsigned c = xb_ld(&bar[XB_XCNT(j)]); sum += c; cnt += (c > 0u) ? 1u : 0u; mine = (j == x) ? c : mine; }
        if (sum == G) break;
        __builtin_amdgcn_s_sleep(1);
        if ((++sp & 255u) == 0u) { if (xb_ld(&bar[XB_TMO])) break; if (sp > XB_SPIN_CAP) { atomicAdd(&bar[XB_TMO], 1u); break; } }
    }
    nloc = mine > 0u ? mine : 1u; nx = cnt > 0u ? cnt : 1u;
}
__device__ __forceinline__ void xcd_barrier(const XcdBarrier& b) {
    asm volatile("s_waitcnt vmcnt(0)" ::: "memory");
    __syncthreads();
    if (threadIdx.x == 0) {
        unsigned* bar = b.bar;
        __builtin_amdgcn_s_waitcnt(0);
        unsigned nloc = b.st[0], nx = b.st[1];
        if (nloc == 0u) { xcd_barrier_complete(bar, b.x, nloc, nx); b.st[0] = nloc; b.st[1] = nx; }
        const unsigned old = xb_add(&bar[XB_XSUB(b.x)], 1u);
        const unsigned gen = old / nloc;
        if (old + 1u == (gen + 1u) * nloc) {
            __builtin_amdgcn_fence(__ATOMIC_RELEASE, "agent");
            asm volatile("s_waitcnt vmcnt(0)" ::: "memory");
            const unsigned og = xb_add(&bar[XB_TOP], 1u);
            const unsigned tg = og / nx;
            if (og + 1u == (tg + 1u) * nx) xb_add(&bar[XB_TOPGEN], 1u);
            else XB_SPIN(xb_ld(&bar[XB_TOPGEN]) == tg, bar);
            __builtin_amdgcn_fence(__ATOMIC_ACQUIRE, "agent");
            xb_add(&bar[XB_XGEN(b.x)], 1u);
            asm volatile("s_waitcnt vmcnt(0)" ::: "memory");
        } else {
            XB_SPIN(xb_ld(&bar[XB_XGEN(b.x)]) == gen, bar);
            __builtin_amdgcn_fence(__ATOMIC_ACQUIRE, "agent");
            asm volatile("s_waitcnt vmcnt(0)" ::: "memory");
        }
    }
    __syncthreads();
}

constexpr int LDS_BYTES = 147456;
constexpr int MISC_OFF = 135168;
struct Args { const void* in[22]; float* out; unsigned char* ws; int ph_lo, ph_hi; };
struct Frame {
    LAS unsigned char* lds;
    unsigned char* ws; float* out;
    unsigned* ctl;
    int tid, lane, wave, G, gw, NGW;
};
enum { I_X = 0, I_MEM, I_POS, I_DSA_WIN, I_DSA_KG, I_DSA_KB, I_GLA_WIN, I_GLA_WGATE, I_GLA_BGATE, I_GLA_NORMG, I_WMEMKV, I_WOUT, I_LN1G, I_LN1B, I_LN2G, I_LN2B,
       I_MOE_WG, I_MOE_BG, I_MOE_WR, I_MOE_BR, I_MOE_W13, I_MOE_W2 };

__device__ __forceinline__ int dperm(int c) { return ((c >> 2) & 1) * 32 + (c >> 5) * 16 + ((c >> 3) & 3) * 4 + (c & 3); }
__device__ __forceinline__ int dperm_inv(int d) { const int n = d >> 5, i = d & 31; return (i >> 4) * 32 + ((i >> 2) & 3) * 8 + n * 4 + (i & 3); }
__device__ __forceinline__ int dsa_srccol(int n) {
    if (n < 1536) { return (n & ~63) + dperm(n & 63); }
    if (n < 2304) return n;
    if (n < 2816) { return (n & ~63) + dperm(n & 63); }
    if (n < 3072) return 2888 + (n - 2816);
    if (n < 3136) return 2816 + (n - 3072);
    if (n < 3144) return 2880 + (n - 3136);
    return -1;
}
__device__ __forceinline__ int gla_srccol(int n) {
    if (n < 2304) return n;
    if (n < 2560) return 2320 + (n - 2304);
    if (n < 2576) return 2304 + (n - 2560);
    return -1;
}
__device__ __forceinline__ int w13_srccol(int r) { const int pn = r >> 8, bj = (r >> 7) & 1, j = r & 127; return bj * 256 + pn * 128 + j; }
template <int MODE>
__device__ __forceinline__ void transpose_item(const float* W, int K, int ldw, bf16_t* WT, int nrows32, LAS float* scr, int item, int lane) {
    const int kb = item / nrows32, nb = item % nrows32, k0 = 64 * kb, n0 = 32 * nb;
    const int n = n0 + (lane & 31);
    int sc;
    if (MODE == 0) sc = n; else if (MODE == 1) sc = dsa_srccol(n); else if (MODE == 2) sc = gla_srccol(n); else sc = w13_srccol(n);
#pragma unroll 8
    for (int i = 0; i < 32; ++i) { const int kk = 2 * i + (lane >> 5); scr[kk * 33 + (lane & 31)] = (sc >= 0) ? W[(size_t)(k0 + kk) * ldw + sc] : 0.f; }
    asm volatile("s_waitcnt lgkmcnt(0)" ::: "memory");
    const int c = lane & 7;
#pragma unroll
    for (int j = 0; j < 4; ++j) { const int nn = (lane >> 3) + 8 * j; const LAS float* s = scr + (8 * c) * 33 + nn;
        u32x4 o; o.x = pk2(s[0 * 33], s[1 * 33]); o.y = pk2(s[2 * 33], s[3 * 33]); o.z = pk2(s[4 * 33], s[5 * 33]); o.w = pk2(s[6 * 33], s[7 * 33]);
        *(u32x4*)(WT + (size_t)(n0 + nn) * K + k0 + 8 * c) = o; }
    asm volatile("s_waitcnt lgkmcnt(0)" ::: "memory");
}
__device__ __forceinline__ void moe_weight_items(Frame& F, const float* w13, const float* w2, int layer) {
    LAS float* scr = (LAS float*)(F.lds + F.wave * 16384);
    bf16_t* W13 = (bf16_t*)(F.ws + WS_W13); bf16_t* W2 = (bf16_t*)(F.ws + WS_W2);
    constexpr int I13 = (1024 / 64) * (512 / 32), I2 = (256 / 64) * (1024 / 32);
    for (int it = F.gw; it < NEXP * (I13 + I2); it += F.NGW) {
        const int ge = it / (I13 + I2), r = it % (I13 + I2);
        if (r < I13) transpose_item<3>(w13 + ((size_t)layer * NEXP + ge) * 1024 * 512, 1024, 512, W13 + (size_t)ge * 512 * 1024, 16, scr, r, F.lane);
        else transpose_item<0>(w2 + ((size_t)layer * NEXP + ge) * 256 * 1024, 256, 1024, W2 + (size_t)ge * 1024 * 256, 32, scr, r - I13, F.lane);
    }
}
__device__ __forceinline__ void cvt_rows_bf16(Frame& F, const float* src, bf16_t* dst, int rows) {
    for (int m = F.gw; m < rows; m += F.NGW) {
        const f32x4* xr = (const f32x4*)(src + (size_t)m * DM) + F.lane; u32x2* o = (u32x2*)(dst + (size_t)m * DM) + F.lane;
#pragma unroll
        for (int j = 0; j < 4; ++j) { const f32x4 v = xr[64 * j]; u32x2 w; w.x = pk2(v.x, v.y); w.y = pk2(v.z, v.w); o[64 * j] = w; }
    }
}
__device__ __forceinline__ void p_prologue(Frame& F, const Args& a) {
    LAS float* scr = (LAS float*)(F.lds + F.wave * 16384);
    const float* dsa_w = (const float*)a.in[I_DSA_WIN]; const float* gla_w = (const float*)a.in[I_GLA_WIN];
    const float* wkv = (const float*)a.in[I_WMEMKV]; const float* wout = (const float*)a.in[I_WOUT];
    bf16_t* WD = (bf16_t*)(F.ws + WS_WD); bf16_t* WG = (bf16_t*)(F.ws + WS_WG); bf16_t* WKV = (bf16_t*)(F.ws + WS_WKV); bf16_t* WO = (bf16_t*)(F.ws + WS_WO);
    constexpr int ID = 16 * (ND / 32), IG = 16 * (NG / 32), IKV = 16 * (512 / 32), IO = 16 * (1024 / 32);
    constexpr int NIT = ID + IG + 2 * IKV + 2 * IO;
    for (int it = F.gw; it < NIT; it += F.NGW) {
        int r = it;
        if (r < ID) { transpose_item<1>(dsa_w, 1024, DSA_W, WD, ND / 32, scr, r, F.lane); continue; } r -= ID;
        if (r < IG) { transpose_item<2>(gla_w, 1024, GLA_W, WG, NG / 32, scr, r, F.lane); continue; } r -= IG;
        if (r < 2 * IKV) { const int l = r / IKV; transpose_item<0>(wkv + (size_t)l * 1024 * 512, 1024, 512, WKV + (size_t)l * 512 * 1024, 16, scr, r % IKV, F.lane); continue; } r -= 2 * IKV;
        { const int l = r / IO; transpose_item<0>(wout + (size_t)l * 1024 * 1024, 1024, 1024, WO + (size_t)l * 1024 * 1024, 32, scr, r % IO, F.lane); }
    }
    moe_weight_items(F, (const float*)a.in[I_MOE_W13], (const float*)a.in[I_MOE_W2], 0);
    cvt_rows_bf16(F, (const float*)a.in[I_X], (bf16_t*)(F.ws + WS_XB), NT);
    cvt_rows_bf16(F, (const float*)a.in[I_MEM], (bf16_t*)(F.ws + WS_MEMB), NB * NMEM);
    const int* pos = (const int*)a.in[I_POS];
    float* RC = (float*)(F.ws + WS_ROPEC); float* RS = (float*)(F.ws + WS_ROPES);
    for (int idx = blockIdx.x * 512 + F.tid; idx < NT * 32; idx += F.G * 512) {
        const int t = idx >> 5, i = idx & 31;
        const float inv = (float)pow(10000.0, -(double)(2 * i) / 64.0);
        const float ang = (float)pos[t] * inv;
        double s, c; sincos((double)ang, &s, &c);
        RC[idx] = (float)c; RS[idx] = (float)s;
    }
}

typedef const f32x4 (&AccRef)[2][2][4][2];
__device__ __forceinline__ void st_bf16x8(bf16_t* p, f32x4 v0, f32x4 v1) {
    u32x4 w; w.x = pg8::cvt_pk_bf16(v0[0], v0[1]); w.y = pg8::cvt_pk_bf16(v0[2], v0[3]); w.z = pg8::cvt_pk_bf16(v1[0], v1[1]); w.w = pg8::cvt_pk_bf16(v1[2], v1[3]);
    *(u32x4*)p = w;
}
struct EpiDsaProj {
    bf16_t *Q, *K, *V, *QI, *QM; float* KIW; const float *RC, *RS;
    __device__ __forceinline__ void operator()(AccRef acc, const pg8::Unit& u, int wr, int wc, int fr, int fq) const {
        const int pn = u.pn; const int row0 = u.pm * 256 + wr * 64 + fr;
        const int i0 = 16 * (wc & 1) + 4 * fq;
#pragma unroll
        for (int ai = 0; ai < 2; ++ai)
#pragma unroll
            for (int m = 0; m < 4; ++m) {
                const int row = row0 + ai * 128 + m * 16;
                f32x4 c4 = (f32x4){1.f, 1.f, 1.f, 1.f}, s4 = (f32x4){0.f, 0.f, 0.f, 0.f};
                const bool rope = (pn < 6) || (pn == 9) || (pn == 10);
                if (rope) { c4 = *(const f32x4*)(RC + (size_t)row * 32 + i0); s4 = *(const f32x4*)(RS + (size_t)row * 32 + i0); }
#pragma unroll
                for (int bj = 0; bj < 2; ++bj) {
                    const int gcol = pn * 256 + bj * 128 + wc * 32 + 8 * fq;
                    f32x4 v0 = acc[ai][bj][m][0], v1 = acc[ai][bj][m][1];
                    if (rope) { const f32x4 y0 = v0 * c4 - v1 * s4, y1 = v1 * c4 + v0 * s4; v0 = y0; v1 = y1; }
                    if (pn < 3) { v0 = v0 * C2; v1 = v1 * C2; st_bf16x8(Q + (size_t)row * 768 + gcol, v0, v1); }
                    else if (pn < 6) st_bf16x8(K + (size_t)row * 768 + (gcol - 768), v0, v1);
                    else if (pn < 9) st_bf16x8(V + (size_t)row * 768 + (gcol - 1536), v0, v1);
                    else if (pn < 11) st_bf16x8(QI + (size_t)row * 512 + (gcol - 2304), v0, v1);
                    else if (pn == 11) { v0 = v0 * C2; v1 = v1 * C2; st_bf16x8(QM + (size_t)row * 256 + (gcol - 2816), v0, v1); }
                    else { const int lc = gcol - 3072; if (lc < 72) { float* p = KIW + (size_t)row * KIW_P + lc; *(f32x4*)p = v0; *(f32x4*)(p + 4) = v1; } }
                }
            }
    }
};
struct EpiGlaProj {
    bf16_t *GQ, *GK, *GV, *GR, *GQM; float* A1;
    __device__ __forceinline__ void operator()(AccRef acc, const pg8::Unit& u, int wr, int wc, int fr, int fq) const {
        const int pn = u.pn; const int row0 = u.pm * 256 + wr * 64 + fr;
#pragma unroll
        for (int ai = 0; ai < 2; ++ai)
#pragma unroll
            for (int m = 0; m < 4; ++m) {
                const int row = row0 + ai * 128 + m * 16;
#pragma unroll
                for (int bj = 0; bj < 2; ++bj) {
                    const int gcol = pn * 256 + bj * 128 + wc * 32 + 8 * fq;
                    f32x4 v0 = acc[ai][bj][m][0], v1 = acc[ai][bj][m][1];
                    if (pn < 3) {
                        if (gcol < 384) { v0 = v0 * 0.10206207261596577f; v1 = v1 * 0.10206207261596577f; st_bf16x8(GQ + (size_t)row * 384 + gcol, v0, v1); }
                        else st_bf16x8(GK + (size_t)row * 384 + (gcol - 384), v0, v1);
                    }
                    else if (pn < 6) st_bf16x8(GV + (size_t)row * 768 + (gcol - 768), v0, v1);
                    else if (pn < 9) st_bf16x8(GR + (size_t)row * 768 + (gcol - 1536), v0, v1);
                    else if (pn == 9) { v0 = v0 * C2; v1 = v1 * C2; st_bf16x8(GQM + (size_t)row * 256 + (gcol - 2304), v0, v1); }
                    else { const int lc = gcol - 2560; if (lc < 16) { float* p = A1 + (size_t)row * 16 + lc; *(f32x4*)p = v0; *(f32x4*)(p + 4) = v1; } }
                }
            }
    }
};
struct EpiBf16Plain {
    bf16_t* O; int ldc; int ncolmask;
    __device__ __forceinline__ void operator()(AccRef acc, const pg8::Unit& u, int wr, int wc, int fr, int fq) const {
        const int row0 = u.pm * 256 + wr * 64 + fr; const int colt = (u.pn & ncolmask) * 256 + wc * 32 + 8 * fq;
#pragma unroll
        for (int ai = 0; ai < 2; ++ai)
#pragma unroll
            for (int m = 0; m < 4; ++m) { bf16_t* rowp = O + (size_t)(row0 + ai * 128 + m * 16) * ldc + colt;
#pragma unroll
                for (int bj = 0; bj < 2; ++bj) st_bf16x8(rowp + bj * 128, acc[ai][bj][m][0], acc[ai][bj][m][1]); }
    }
};
struct EpiF32Plain {
    float* C; int ldc;
    __device__ __forceinline__ void operator()(AccRef acc, const pg8::Unit& u, int wr, int wc, int fr, int fq) const {
        const int row0 = u.pm * 256 + wr * 64 + fr; const int colt = u.pn * 256 + wc * 32 + 8 * fq;
#pragma unroll
        for (int ai = 0; ai < 2; ++ai)
#pragma unroll
            for (int m = 0; m < 4; ++m) { float* rowp = C + (size_t)(row0 + ai * 128 + m * 16) * ldc + colt;
#pragma unroll
                for (int bj = 0; bj < 2; ++bj) { *(f32x4*)(rowp + bj * 128) = acc[ai][bj][m][0]; *(f32x4*)(rowp + bj * 128 + 4) = acc[ai][bj][m][1]; } }
    }
};
struct EpiMoe1 {
    bf16_t* ACT; const float* LISTW; const unsigned* cnt;
    __device__ __forceinline__ void operator()(AccRef acc, const pg8::Unit& u, int wr, int wc, int fr, int fq) const {
        const int j2 = u.pn & 1; const int rl0 = wr * 64 + fr; const int ce = (int)cnt[u.e * 64];
#pragma unroll
        for (int ai = 0; ai < 2; ++ai)
#pragma unroll
            for (int m = 0; m < 4; ++m) {
                const int rl = rl0 + ai * 128 + m * 16; const int pos = u.r0 + rl;
                const float wt = (pos < ce) ? LISTW[(size_t)u.e * NT + pos] : 0.f;
                f32x4 a0 = acc[ai][0][m][0], a1 = acc[ai][0][m][1], u0 = acc[ai][1][m][0], u1 = acc[ai][1][m][1], o0, o1;
#pragma unroll
                for (int j = 0; j < 4; ++j) { o0[j] = silu_f(a0[j]) * u0[j] * wt; o1[j] = silu_f(a1[j]) * u1[j] * wt; }
                st_bf16x8(ACT + (size_t)(u.pm * 256 + rl) * 256 + j2 * 128 + wc * 32 + 8 * fq, o0, o1);
            }
    }
};
struct MoeOrder {
    const LAS int* tp; const unsigned* cnt; const int* LISTTOK; int ncol, G, c; bool gather;
    __device__ bool next(int i, pg8::Unit& u) const {
        const long L = (long)i * G + c; const int ntile = tp[NEXP];
        if (L >= (long)ntile * ncol) return false;
        const int tile = (int)(L / ncol), col = (int)(L % ncol);
        int e = 0;
#pragma unroll 1
        while (tp[e + 1] <= tile) ++e;
        u.pm = tile; u.pn = e * ncol + col; u.e = e; u.r0 = (tile - tp[e]) * 256; return true;
    }
    __device__ __forceinline__ int rowidx(const pg8::Unit& u, int r) const {
        if (!gather) return u.pm * 256 + r;
        const int pos = u.r0 + r;
        return (pos < (int)cnt[u.e * 64]) ? LISTTOK[(size_t)u.e * NT + pos] : 0;
    }
};
__device__ __forceinline__ void moe_tile_table(Frame& F, const unsigned* cnt, LAS int* tp) {
    if (F.tid == 0) { int s = 0; for (int e = 0; e < NEXP; ++e) { tp[e] = s; s += ((int)cnt[e * 64] + 255) >> 8; } tp[NEXP] = s; }
    __syncthreads();
}

__device__ __forceinline__ void p_ki(Frame& F, const Args& a) {
    const float* KIW = (const float*)(F.ws + WS_KIW); bf16_t* KI = (bf16_t*)(F.ws + WS_KI); float* WI = (float*)(F.ws + WS_WI);
    const float* RC = (const float*)(F.ws + WS_ROPEC); const float* RS = (const float*)(F.ws + WS_ROPES);
    const float* g = (const float*)a.in[I_DSA_KG]; const float* bb = (const float*)a.in[I_DSA_KB];
    const int d = F.lane; const float gd = g[d], bd = bb[d]; const int dst = dperm_inv(d);
    for (int t = F.gw; t < NT; t += F.NGW) {
        const float v = KIW[(size_t)t * KIW_P + d];
        const float mu = wave_sum(v) * (1.f / 64.f); const float dv = v - mu;
        const float var = wave_sum(dv * dv) * (1.f / 64.f);
        const float n = dv * (1.f / sqrtf(var + LN_EPS)) * gd + bd;
        const float pr = __shfl_xor(n, 32);
        const float c = RC[(size_t)t * 32 + (d & 31)], s = RS[(size_t)t * 32 + (d & 31)];
        const float o = (d < 32) ? (n * c - pr * s) : (n * c + pr * s);
        KI[(size_t)t * 64 + dst] = (bf16_t)f2bf(o);
        if (d < 8) WI[(size_t)t * 8 + d] = KIW[(size_t)t * KIW_P + 64 + d] * 0.04419417382415922f;
    }
}

__device__ __forceinline__ unsigned ordkey(float f) { const unsigned u = __builtin_bit_cast(unsigned, f); return (u & 0x80000000u) ? ~u : (u | 0x80000000u); }
__device__ __forceinline__ void p_indexer(Frame& F) {
    const bf16_t* QI = (const bf16_t*)(F.ws + WS_QI); const bf16_t* KI = (const bf16_t*)(F.ws + WS_KI); const float* WI = (const float*)(F.ws + WS_WI);
    unsigned long long* MASK = (unsigned long long*)(F.ws + WS_MASK);
    LAS float* sc = (LAS float*)F.lds;
    LAS float* wis = (LAS float*)(F.lds + 131072);
    const int lane = F.lane, r32 = lane & 31, hi = lane >> 5, wave = F.wave;
    for (int i = 0;; ++i) {
        const int U = i * F.G + (int)blockIdx.x; if (U >= NB * 128) break;
        const int b = U >> 7, tl = U & 127, tile = (i & 1) ? 127 - tl : tl;
        const int t0 = tile * 16; const size_t rowbase = (size_t)b * SEQ;
        if (t0 < 256) {
#pragma unroll
            for (int u = 0; u < 2; ++u) { const int t = t0 + 2 * wave + u;
                if (lane < 32) { const int nb = t + 1 - 64 * lane; const unsigned long long m = nb >= 64 ? ~0ull : (nb <= 0 ? 0ull : ((1ull << nb) - 1ull)); MASK[(rowbase + t) * 32 + lane] = m; } }
            continue;
        }
        if (F.tid < 128) wis[F.tid] = WI[(rowbase + t0) * 8 + F.tid];
        bf16x8 af[4][4];
        { const int m = r32, j = m & 3, hp = (m >> 2) & 1, ii = m >> 3, tokl = 2 * hp + (ii >> 1), head = 4 * (ii & 1) + j;
#pragma unroll
          for (int mt = 0; mt < 4; ++mt)
#pragma unroll
            for (int ks = 0; ks < 4; ++ks) af[mt][ks] = *(const bf16x8*)(QI + (rowbase + t0 + 4 * mt + tokl) * 512 + head * 64 + ks * 16 + hi * 8); }
        __syncthreads();
        const int n32 = (t0 + 16 + 31) >> 5;
        for (int kt = wave; kt < n32; kt += NWAVES) {
            const int key = kt * 32 + r32;
            bf16x8 bfr[4];
#pragma unroll
            for (int ks = 0; ks < 4; ++ks) bfr[ks] = *(const bf16x8*)(KI + (rowbase + key) * 64 + ks * 16 + hi * 8);
#pragma unroll
            for (int mt = 0; mt < 4; ++mt) {
                f32x16 acc = {};
#pragma unroll
                for (int ks = 0; ks < 4; ++ks) acc = __builtin_amdgcn_mfma_f32_32x32x16_bf16(af[mt][ks], bfr[ks], acc, 0, 0, 0);
#pragma unroll
                for (int u = 0; u < 2; ++u) { const int tk = 4 * mt + 2 * hi + u;
                    const f32x4 w0 = *(const LAS f32x4*)(wis + tk * 8), w1 = *(const LAS f32x4*)(wis + tk * 8 + 4);
                    float s = 0.f;
#pragma unroll
                    for (int h = 0; h < 4; ++h) { s += w0[h] * fmaxf(acc[8 * u + h], 0.f); }
#pragma unroll
                    for (int h = 0; h < 4; ++h) { s += w1[h] * fmaxf(acc[8 * u + 4 + h], 0.f); }
                    sc[tk * 2048 + key] = s + 0.f; }
            }
        }
        __syncthreads();
#pragma unroll 1
        for (int u = 0; u < 2; ++u) {
            const int tk = 2 * wave + u, t = t0 + tk;
            unsigned key[32];
#pragma unroll
            for (int q = 0; q < 32; ++q) { const int s = lane + 64 * q; key[q] = (s <= t) ? ordkey(sc[tk * 2048 + s]) : 0u; }
            unsigned T = 0u; bool exact = false;
#pragma unroll 1
            for (int bit = 31; bit >= 0; --bit) {
                const unsigned cand = T | (1u << bit); int c = 0;
#pragma unroll
                for (int q = 0; q < 32; ++q) c += __builtin_popcountll(__ballot(key[q] >= cand));
                if (c >= 256) { T = cand; if (c == 256) { exact = true; break; } }
            }
            int need = 0, ceq = 0;
            if (!exact) { int cgt = 0;
#pragma unroll
                for (int q = 0; q < 32; ++q) { cgt += __builtin_popcountll(__ballot(key[q] > T)); ceq += __builtin_popcountll(__ballot(key[q] == T)); }
                need = 256 - cgt; }
            unsigned long long mymask = 0ull;
            if (exact || need == ceq) {
#pragma unroll
                for (int q = 0; q < 32; ++q) { const unsigned long long bal = __ballot(key[q] >= T); if (lane == q) mymask = bal; }
            } else {
#pragma unroll
                for (int q = 0; q < 32; ++q) {
                    unsigned long long eq = __ballot(key[q] == T); const unsigned long long gt = __ballot(key[q] > T);
                    int pc = __builtin_popcountll(eq); const int take = pc < need ? pc : need;
                    while (pc > take) { eq &= ~(1ull << (63 - __builtin_clzll(eq))); --pc; }
                    need -= take;
                    if (lane == q) mymask = gt | eq;
                }
            }
            if (lane < 32) MASK[(rowbase + t) * 32 + lane] = mymask;
        }
        __syncthreads();
    }
}

typedef short v4i16_t __attribute__((ext_vector_type(4)));
__device__ __forceinline__ s16x4 vtr(const LAS unsigned char* p) { return __builtin_bit_cast(s16x4, __builtin_amdgcn_ds_read_tr16_b64_v4i16((LAS v4i16_t*)p)); }
template <bool MASKED>
__device__ __forceinline__ void attn_unit(Frame& F, const bf16_t* Qp, int qpitch, const bf16_t* Kp, const bf16_t* Vp, int kvpitch, int ntiles,
                                          const unsigned long long* maskp, bf16_t* Op, int opitch) {
    const int tid = F.tid, lane = F.lane, r32 = lane & 31, hi = lane >> 5, wave = F.wave;
    LAS unsigned char* lds = F.lds;
    bf16x8 qf[4];
#pragma unroll
    for (int ks = 0; ks < 4; ++ks) qf[ks] = *(const bf16x8*)(Qp + (size_t)(wave * 32 + r32) * qpitch + ks * 16 + hi * 8);
    const unsigned long long* mrow = maskp + (size_t)(wave * 32 + r32) * 32;
    const int kkey = tid & 63, kch = tid >> 6, vkey = tid >> 3, vpc = tid & 7;
    const bf16_t* ksrc = Kp + (size_t)kkey * kvpitch + kch * 8; const bf16_t* vsrc = Vp + (size_t)vkey * kvpitch + vpc * 8;
    const int kdst = kch * 1024 + kkey * 16, vdst = 8192 + (vpc >> 2) * 4096 + vkey * 64 + (vpc & 3) * 16;
    u32x4 kreg = *(const u32x4*)ksrc, vreg = *(const u32x4*)vsrc;
    *(LAS u32x4*)(lds + kdst) = kreg; *(LAS u32x4*)(lds + vdst) = vreg;
    __syncthreads();
    float m_run = -1e30f, l_run = 0.f; f32x16 o0 = {}, o1 = {};
    const int vlane = ((lane >> 4) & 1) * 32 + (lane & 3) * 8 + (4 * hi + ((lane & 15) >> 2)) * 64;
    for (int t = 0; t < ntiles; ++t) {
        const int cb = (t & 1) * 16384, nb = 16384 - cb;
        if (t + 1 < ntiles) { kreg = *(const u32x4*)(ksrc + (size_t)(t + 1) * 64 * kvpitch); vreg = *(const u32x4*)(vsrc + (size_t)(t + 1) * 64 * kvpitch); }
        unsigned long long mw = ~0ull; if (MASKED) mw = mrow[t];
        f32x16 p0 = {}, p1 = {};
#pragma unroll
        for (int ks = 0; ks < 4; ++ks) {
            const bf16x8 a0 = *(const LAS bf16x8*)(lds + cb + (2 * ks + hi) * 1024 + r32 * 16);
            const bf16x8 a1 = *(const LAS bf16x8*)(lds + cb + (2 * ks + hi) * 1024 + (32 + r32) * 16);
            p0 = __builtin_amdgcn_mfma_f32_32x32x16_bf16(a0, qf[ks], p0, 0, 0, 0);
            p1 = __builtin_amdgcn_mfma_f32_32x32x16_bf16(a1, qf[ks], p1, 0, 0, 0);
        }
        if (MASKED) { const unsigned lo = (unsigned)mw >> (4 * hi), hw = (unsigned)(mw >> 32) >> (4 * hi);
#pragma unroll
            for (int r = 0; r < 16; ++r) { const unsigned bit = 1u << ((r & 3) + 8 * (r >> 2)); p0[r] = (lo & bit) ? p0[r] : -1e30f; p1[r] = (hw & bit) ? p1[r] : -1e30f; } }
        float rm = fmaxf(p0[0], p1[0]);
#pragma unroll
        for (int r = 1; r < 16; ++r) rm = fmaxf(rm, fmaxf(p0[r], p1[r]));
        { auto rr = __builtin_amdgcn_permlane32_swap(__float_as_uint(rm), __float_as_uint(rm), false, false); rm = fmaxf(__uint_as_float(rr[0]), __uint_as_float(rr[1])); }
        const float m_new = fmaxf(m_run, rm); const float alpha = fast_exp2(m_run - m_new); m_run = m_new;
        l_run *= alpha;
#pragma unroll
        for (int r = 0; r < 16; ++r) { o0[r] *= alpha; o1[r] *= alpha; }
        float ls = 0.f;
#pragma unroll
        for (int r = 0; r < 16; ++r) { p0[r] = fast_exp2(p0[r] - m_new); p1[r] = fast_exp2(p1[r] - m_new); ls += p0[r] + p1[r]; }
        l_run += ls;
        bf16x8 pw[2][2];
#pragma unroll
        for (int s = 0; s < 2; ++s) {
            u32x4 w; w.x = pg8::cvt_pk_bf16(p0[8 * s + 0], p0[8 * s + 1]); w.y = pg8::cvt_pk_bf16(p0[8 * s + 2], p0[8 * s + 3]); w.z = pg8::cvt_pk_bf16(p0[8 * s + 4], p0[8 * s + 5]); w.w = pg8::cvt_pk_bf16(p0[8 * s + 6], p0[8 * s + 7]);
            pw[0][s] = __builtin_bit_cast(bf16x8, w);
            u32x4 x; x.x = pg8::cvt_pk_bf16(p1[8 * s + 0], p1[8 * s + 1]); x.y = pg8::cvt_pk_bf16(p1[8 * s + 2], p1[8 * s + 3]); x.z = pg8::cvt_pk_bf16(p1[8 * s + 4], p1[8 * s + 5]); x.w = pg8::cvt_pk_bf16(p1[8 * s + 6], p1[8 * s + 7]);
            pw[1][s] = __builtin_bit_cast(bf16x8, x);
        }
        const LAS unsigned char* vb = lds + cb + 8192 + vlane;
#pragma unroll
        for (int kh = 0; kh < 2; ++kh)
#pragma unroll
            for (int s = 0; s < 2; ++s) {
                const int ko = (32 * kh + 16 * s) * 64;
                const s16x4 a_lo0 = vtr(vb + ko), a_hi0 = vtr(vb + ko + 512), a_lo1 = vtr(vb + 4096 + ko), a_hi1 = vtr(vb + 4096 + ko + 512);
                const bf16x8 A0 = (bf16x8){a_lo0[0], a_lo0[1], a_lo0[2], a_lo0[3], a_hi0[0], a_hi0[1], a_hi0[2], a_hi0[3]};
                const bf16x8 A1 = (bf16x8){a_lo1[0], a_lo1[1], a_lo1[2], a_lo1[3], a_hi1[0], a_hi1[1], a_hi1[2], a_hi1[3]};
                o0 = __builtin_amdgcn_mfma_f32_32x32x16_bf16(A0, pw[kh][s], o0, 0, 0, 0);
                o1 = __builtin_amdgcn_mfma_f32_32x32x16_bf16(A1, pw[kh][s], o1, 0, 0, 0);
            }
        if (t + 1 < ntiles) { *(LAS u32x4*)(lds + nb + kdst) = kreg; *(LAS u32x4*)(lds + nb + vdst) = vreg; }
        __syncthreads();
    }
    { auto rr = __builtin_amdgcn_permlane32_swap(__float_as_uint(l_run), __float_as_uint(l_run), false, false); l_run = __uint_as_float(rr[0]) + __uint_as_float(rr[1]); }
    const float inv = 1.f / l_run;
    bf16_t* orow = Op + (size_t)(wave * 32 + r32) * opitch;
#pragma unroll
    for (int rg = 0; rg < 4; ++rg) {
        u32x2 w0, w1;
        w0.x = pg8::cvt_pk_bf16(o0[4 * rg] * inv, o0[4 * rg + 1] * inv); w0.y = pg8::cvt_pk_bf16(o0[4 * rg + 2] * inv, o0[4 * rg + 3] * inv);
        w1.x = pg8::cvt_pk_bf16(o1[4 * rg] * inv, o1[4 * rg + 1] * inv); w1.y = pg8::cvt_pk_bf16(o1[4 * rg + 2] * inv, o1[4 * rg + 3] * inv);
        *(u32x2*)(orow + 8 * rg + 4 * hi) = w0; *(u32x2*)(orow + 32 + 8 * rg + 4 * hi) = w1;
    }
}
__device__ __forceinline__ void mem_attn_units(Frame& F, const bf16_t* QM, int layer, bf16_t* AO) {
    const bf16_t* KVM = (const bf16_t*)(F.ws + WS_KVM);
    for (int mu = blockIdx.x; mu < NB * 32; mu += F.G) {
        const int b = mu >> 5, hm = (mu >> 3) & 3, qb = mu & 7;
        const size_t row0 = (size_t)b * SEQ + qb * 256;
        attn_unit<false>(F, QM + row0 * 256 + hm * 64, 256, KVM + (size_t)b * NMEM * 1024 + layer * 512 + hm * 64, KVM + (size_t)b * NMEM * 1024 + layer * 512 + 256 + hm * 64, 1024, 4,
                         nullptr, AO + row0 * 1024 + 768 + hm * 64, 1024);
    }
}
__device__ __forceinline__ void p_attn_dsa(Frame& F) {
    const bf16_t* Q = (const bf16_t*)(F.ws + WS_Q); const bf16_t* K = (const bf16_t*)(F.ws + WS_K); const bf16_t* V = (const bf16_t*)(F.ws + WS_V);
    const unsigned long long* MASK = (const unsigned long long*)(F.ws + WS_MASK); bf16_t* AO = (bf16_t*)(F.ws + WS_AO0);
    for (int pu = blockIdx.x; pu < NB * 12 * 4; pu += F.G) {
        const int bh = pu >> 2, pr = pu & 3, b = bh / 12, h = bh % 12;
#pragma unroll 1
        for (int z = 0; z < 2; ++z) {
            const int qb = z ? 7 - pr : pr; const size_t rb = (size_t)b * SEQ, row0 = rb + qb * 256;
            attn_unit<true>(F, Q + row0 * 768 + h * 64, 768, K + rb * 768 + h * 64, V + rb * 768 + h * 64, 768, 4 * (qb + 1), MASK + row0 * 32, AO + row0 * 1024 + h * 64, 1024);
        }
    }
    mem_attn_units(F, (const bf16_t*)(F.ws + WS_QM), 0, AO);
}

template <bool RESID_F32>
__device__ __forceinline__ void p_ln1_router(Frame& F, const Args& a, int layer, const void* resid, bf16_t* X1b) {
    const bf16_t* MIX = (const bf16_t*)F.out;
    const float* g1 = (const float*)a.in[I_LN1G] + layer * 1024; const float* b1 = (const float*)a.in[I_LN1B] + layer * 1024;
    const float* wg = (const float*)a.in[I_MOE_WG] + (size_t)layer * 1024 * 4; const float* bg = (const float*)a.in[I_MOE_BG] + layer * 4;
    const float* wr = (const float*)a.in[I_MOE_WR] + (size_t)layer * 4 * 1024 * 8; const float* br = (const float*)a.in[I_MOE_BR] + layer * 32;
    unsigned* cnt = F.ctl + CW_CNT + layer * 2048;
    int* LISTTOK = (int*)(F.ws + WS_LISTTOK); float* LISTW = (float*)(F.ws + WS_LISTW); int* TOKSLOT = (int*)(F.ws + WS_TOKSLOT);
    const int lane = F.lane;
    LAS float* WR = (LAS float*)F.lds;
    for (int i = F.tid; i < 4 * 1024 * 2; i += 512) { const int g = i >> 11, k = (i & 2047) >> 1, hf = i & 1;
        const f32x4 w4 = *(const f32x4*)(wr + ((size_t)g * 1024 + k) * 8 + hf * 4);
#pragma unroll
        for (int c = 0; c < 4; ++c) WR[(g * 8 + hf * 4 + c) * 1024 + k] = w4[c]; }
    __syncthreads();
    f32x4 gv[4], bv[4], wgr[4][4];
#pragma unroll
    for (int j = 0; j < 4; ++j) { gv[j] = *((const f32x4*)g1 + lane + 64 * j); bv[j] = *((const f32x4*)b1 + lane + 64 * j);
#pragma unroll
        for (int c = 0; c < 4; ++c) wgr[j][c] = *(const f32x4*)(wg + (size_t)(256 * j + 4 * lane + c) * 4); }
    LAS int* cntL = (LAS int*)(F.lds + MISC_OFF + 512); LAS int* baseL = cntL + 32; LAS int* tokdat = (LAS int*)(F.lds + MISC_OFF + 1024);
    if (F.tid < 32) cntL[F.tid] = 0;
    __syncthreads();
    int nloc = 0;
    for (int t = F.gw; t < NT; t += F.NGW, ++nloc) {
        const u32x2* mr = (const u32x2*)(MIX + (size_t)t * DM) + lane;
        f32x4 v[4]; float s = 0.f;
#pragma unroll
        for (int j = 0; j < 4; ++j) {
            f32x4 xv;
            if (RESID_F32) xv = *((const f32x4*)((const float*)resid + (size_t)t * DM) + lane + 64 * j);
            else { const u32x2 p = *((const u32x2*)((const bf16_t*)resid + (size_t)t * DM) + lane + 64 * j); xv = (f32x4){bf2f(p.x & 0xffffu), bf2f(p.x >> 16), bf2f(p.y & 0xffffu), bf2f(p.y >> 16)}; }
            const u32x2 m = mr[64 * j];
            v[j] = xv * ALPHA + (f32x4){bf2f(m.x & 0xffffu), bf2f(m.x >> 16), bf2f(m.y & 0xffffu), bf2f(m.y >> 16)};
            s += (v[j].x + v[j].y) + (v[j].z + v[j].w); }
        const float mean = wave_sum(s) * (1.f / DM); float s2 = 0.f;
#pragma unroll
        for (int j = 0; j < 4; ++j) { v[j] = v[j] - mean; s2 += (v[j].x * v[j].x + v[j].y * v[j].y) + (v[j].z * v[j].z + v[j].w * v[j].w); }
        const float rstd = 1.f / sqrtf(wave_sum(s2) * (1.f / DM) + LN_EPS);
        u32x2* ob = (u32x2*)(X1b + (size_t)t * DM) + lane;
#pragma unroll
        for (int j = 0; j < 4; ++j) { v[j] = v[j] * rstd * gv[j] + bv[j]; u32x2 w; w.x = pk2(v[j].x, v[j].y); w.y = pk2(v[j].z, v[j].w); ob[64 * j] = w; }
        float gl[4] = {0.f, 0.f, 0.f, 0.f};
#pragma unroll
        for (int j = 0; j < 4; ++j)
#pragma unroll
            for (int c = 0; c < 4; ++c)
#pragma unroll
                for (int k = 0; k < 4; ++k) gl[k] += v[j][c] * wgr[j][c][k];
#pragma unroll
        for (int k = 0; k < 4; ++k) gl[k] = wave_sum(gl[k]) + bg[k];
        int gsel = 0; float gmax = gl[0];
#pragma unroll
        for (int k = 1; k < 4; ++k) if (gl[k] > gmax) { gmax = gl[k]; gsel = k; }
        float gs = 0.f;
#pragma unroll
        for (int k = 0; k < 4; ++k) gs += __expf(gl[k] - gmax);
        const float pg = 1.f / gs;
        gsel = __builtin_amdgcn_readfirstlane(gsel);
        const LAS float* wrg = WR + gsel * 8 * 1024 + 4 * lane;
        float el[8];
#pragma unroll
        for (int e = 0; e < 8; ++e) { float acc = 0.f;
#pragma unroll
            for (int j = 0; j < 4; ++j) { const f32x4 w4 = *(const LAS f32x4*)(wrg + e * 1024 + 256 * j); acc += (v[j].x * w4.x + v[j].y * w4.y) + (v[j].z * w4.z + v[j].w * w4.w); }
            el[e] = wave_sum(acc) + br[gsel * 8 + e]; }
        int i1 = 0; float v1 = el[0];
#pragma unroll
        for (int k = 1; k < 8; ++k) if (el[k] > v1) { v1 = el[k]; i1 = k; }
        int i2 = -1; float v2 = -INFINITY;
#pragma unroll
        for (int k = 0; k < 8; ++k) if (k != i1 && (i2 < 0 || el[k] > v2)) { v2 = el[k]; i2 = k; }
        const float e2 = __expf(v2 - v1); const float wt1 = pg / (1.f + e2), wt2 = pg * e2 / (1.f + e2);
        if (lane == 0) {
            const int ge1 = gsel * 8 + i1, ge2 = gsel * 8 + i2;
            const int l1 = __hip_atomic_fetch_add(&cntL[ge1], 1, __ATOMIC_RELAXED, __HIP_MEMORY_SCOPE_WORKGROUP), l2 = __hip_atomic_fetch_add(&cntL[ge2], 1, __ATOMIC_RELAXED, __HIP_MEMORY_SCOPE_WORKGROUP);
            LAS int* td = tokdat + (nloc * NWAVES + F.wave) * 8;
            td[0] = t; td[1] = ge1; td[2] = l1; td[3] = __float_as_int(wt1); td[4] = ge2; td[5] = l2; td[6] = __float_as_int(wt2);
        }
    }
    __syncthreads();
    if (F.tid < 32) { const int n = cntL[F.tid]; baseL[F.tid] = n ? (int)atomicAdd(&cnt[F.tid * 64], (unsigned)n) : 0; }
    __syncthreads();
    for (int i = F.tid; i < nloc * NWAVES; i += 512) {
        const LAS int* td = tokdat + i * 8; const int t = td[0], ge1 = td[1], ge2 = td[4]; const int p1 = baseL[ge1] + td[2], p2 = baseL[ge2] + td[5];
        LISTTOK[(size_t)ge1 * NT + p1] = t; LISTW[(size_t)ge1 * NT + p1] = __int_as_float(td[3]);
        LISTTOK[(size_t)ge2 * NT + p2] = t; LISTW[(size_t)ge2 * NT + p2] = __int_as_float(td[6]);
        *(int4*)(TOKSLOT + (size_t)t * 4) = make_int4(ge1, p1, ge2, p2);
    }
}
template <bool OUT_F32>
__device__ __forceinline__ void p_ln2(Frame& F, const Args& a, int layer, const bf16_t* X1b, void* dst) {
    const bf16_t* Y = (const bf16_t*)(F.ws + WS_Y); const int* TOKSLOT = (const int*)(F.ws + WS_TOKSLOT);
    const float* g2 = (const float*)a.in[I_LN2G] + layer * 1024; const float* b2 = (const float*)a.in[I_LN2B] + layer * 1024;
    LAS int* tp = (LAS int*)(F.lds + MISC_OFF + 256);
    moe_tile_table(F, F.ctl + CW_CNT + layer * 2048, tp);
    const int lane = F.lane;
    f32x4 gv[4], bv[4];
#pragma unroll
    for (int j = 0; j < 4; ++j) { gv[j] = *((const f32x4*)g2 + lane + 64 * j); bv[j] = *((const f32x4*)b2 + lane + 64 * j); }
    for (int t = F.gw; t < NT; t += F.NGW) {
        const int4 ts = *(const int4*)(TOKSLOT + (size_t)t * 4);
        const size_t s0 = (size_t)tp[ts.x] * 256 + ts.y, s1 = (size_t)tp[ts.z] * 256 + ts.w;
        const u32x2* xr = (const u32x2*)(X1b + (size_t)t * DM) + lane;
        const u32x2* y0 = (const u32x2*)(Y + s0 * DM) + lane; const u32x2* y1 = (const u32x2*)(Y + s1 * DM) + lane;
        f32x4 v[4]; float s = 0.f;
#pragma unroll
        for (int j = 0; j < 4; ++j) { const u32x2 p = y0[64 * j], q = y1[64 * j], x = xr[64 * j];
            f32x4 yy; yy.x = bf2f(p.x & 0xffffu) + bf2f(q.x & 0xffffu); yy.y = bf2f(p.x >> 16) + bf2f(q.x >> 16); yy.z = bf2f(p.y & 0xffffu) + bf2f(q.y & 0xffffu); yy.w = bf2f(p.y >> 16) + bf2f(q.y >> 16);
            v[j] = (f32x4){bf2f(x.x & 0xffffu), bf2f(x.x >> 16), bf2f(x.y & 0xffffu), bf2f(x.y >> 16)} * ALPHA + yy; s += (v[j].x + v[j].y) + (v[j].z + v[j].w); }
        const float mean = wave_sum(s) * (1.f / DM); float s2 = 0.f;
#pragma unroll
        for (int j = 0; j < 4; ++j) { v[j] = v[j] - mean; s2 += (v[j].x * v[j].x + v[j].y * v[j].y) + (v[j].z * v[j].z + v[j].w * v[j].w); }
        const float rstd = 1.f / sqrtf(wave_sum(s2) * (1.f / DM) + LN_EPS);
#pragma unroll
        for (int j = 0; j < 4; ++j) v[j] = v[j] * rstd * gv[j] + bv[j];
        if (OUT_F32) { f32x4* o4 = (f32x4*)((float*)dst + (size_t)t * DM) + lane;
#pragma unroll
            for (int j = 0; j < 4; ++j) o4[64 * j] = v[j]; }
        else { u32x2* ob = (u32x2*)((bf16_t*)dst + (size_t)t * DM) + lane;
#pragma unroll
            for (int j = 0; j < 4; ++j) { u32x2 w; w.x = pk2(v[j].x, v[j].y); w.y = pk2(v[j].z, v[j].w); ob[64 * j] = w; } }
    }
}

__device__ __forceinline__ bf16x8 pack8(f32x4 lo, f32x4 hi) { u32x4 w; w.x = pg8::cvt_pk_bf16(lo[0], lo[1]); w.y = pg8::cvt_pk_bf16(lo[2], lo[3]); w.z = pg8::cvt_pk_bf16(hi[0], hi[1]); w.w = pg8::cvt_pk_bf16(hi[2], hi[3]); return __builtin_bit_cast(bf16x8, w); }
constexpr int GLA_QP = 208, GLA_VP = 400;
constexpr int GL_WGS = 0, GL_BGS = 6144, GL_Q = 8192, GL_K = 8192 + 13312, GL_V = 8192 + 2 * 13312, GL_ST = GL_V + 25600;
__device__ __forceinline__ void gla_gates(const float* a1row, const LAS float* wgs, const LAS float* bgs, int w, int lane, float (&bq)[12], float (&bl)[12]) {
    f32x4 av[4];
#pragma unroll
    for (int r = 0; r < 4; ++r) av[r] = *(const f32x4*)(a1row + 4 * r);
#pragma unroll
    for (int k = 0; k < 12; ++k) {
        const int d = 12 * w + k; float z = bgs[d];
#pragma unroll
        for (int r = 0; r < 16; ++r) z += av[r >> 2][r & 3] * wgs[r * 96 + d];
        float g = (fminf(z, 0.f) - __logf(1.f + __expf(-fabsf(z)))) * (1.f / 16.f);
#pragma unroll
        for (int o = 1; o < 64; o <<= 1) { const float t = __shfl_up(g, o); if (lane >= o) g += t; }
        bq[k] = g; bl[k] = __shfl(g, 63);
    }
}
__device__ __forceinline__ void gla_stage_common(Frame& F, const Args& a, int h, size_t row0) {
    const float* wgate = (const float*)a.in[I_GLA_WGATE]; const float* bgate = (const float*)a.in[I_GLA_BGATE];
    const bf16_t* GV = (const bf16_t*)(F.ws + WS_GV);
    LAS float* wgs = (LAS float*)(F.lds + GL_WGS); LAS float* bgs = (LAS float*)(F.lds + GL_BGS);
    const int tid = F.tid;
    if (tid < 384) { const int r = tid / 24, d4 = (tid % 24) * 4; *(LAS f32x4*)(wgs + r * 96 + d4) = *(const f32x4*)(wgate + r * 384 + h * 96 + d4); }
    if (tid < 96) bgs[tid] = bgate[h * 96 + tid];
#pragma unroll
    for (int i = 0; i < 3; ++i) { const int p = tid + 512 * i, row = p / 24, pc = p % 24;
        *(LAS u32x4*)(F.lds + GL_V + row * GLA_VP + pc * 16) = *(const u32x4*)(GV + (row0 + row) * 768 + h * 192 + pc * 8); }
}
__device__ __forceinline__ bf16x8 tr2(const LAS unsigned char* p0, const LAS unsigned char* p1) { const s16x4 a = vtr(p0), b = vtr(p1); return (bf16x8){a[0], a[1], a[2], a[3], b[0], b[1], b[2], b[3]}; }
__device__ __forceinline__ u32x2 pack4(f32x4 v) { u32x2 w; w.x = pg8::cvt_pk_bf16(v[0], v[1]); w.y = pg8::cvt_pk_bf16(v[2], v[3]); return w; }
__device__ __forceinline__ void p_gla_u(Frame& F, const Args& a) {
    const bf16_t* GK = (const bf16_t*)(F.ws + WS_GK); const float* A1 = (const float*)(F.ws + WS_A1);
    u32x2* UF = (u32x2*)F.out; float* DEC = (float*)(F.ws + WS_DEC);
    const int lane = F.lane, w = F.wave, fq = lane >> 4, qq = (lane & 15) >> 2, pp = lane & 3;
    for (int U = blockIdx.x; U < NB * 4 * 32; U += F.G) {
        const int c = U & 31, h = (U >> 5) & 3, b = U >> 7; const size_t row0 = (size_t)b * SEQ + c * 64;
        gla_stage_common(F, a, h, row0);
        __syncthreads();
        float bq[12], bl[12];
        gla_gates(A1 + (row0 + lane) * 16, (const LAS float*)(F.lds + GL_WGS), (const LAS float*)(F.lds + GL_BGS), w, lane, bq, bl);
        { const u32x2* kp = (const u32x2*)(GK + (row0 + lane) * 384 + h * 96 + 12 * w);
#pragma unroll
          for (int i = 0; i < 3; ++i) { const u32x2 kv = kp[i]; f32x4 o;
              o[0] = bf2f(kv.x & 0xffffu) * __expf(bl[4 * i] - bq[4 * i]); o[1] = bf2f(kv.x >> 16) * __expf(bl[4 * i + 1] - bq[4 * i + 1]);
              o[2] = bf2f(kv.y & 0xffffu) * __expf(bl[4 * i + 2] - bq[4 * i + 2]); o[3] = bf2f(kv.y >> 16) * __expf(bl[4 * i + 3] - bq[4 * i + 3]);
              *(LAS u32x2*)(F.lds + GL_K + lane * GLA_QP + (12 * w + 4 * i) * 2) = pack4(o); } }
        if (lane == 0) {
#pragma unroll
            for (int i = 0; i < 3; ++i) *(f32x4*)(DEC + (size_t)U * 96 + 12 * w + 4 * i) = (f32x4){__expf(bl[4 * i]), __expf(bl[4 * i + 1]), __expf(bl[4 * i + 2]), __expf(bl[4 * i + 3])}; }
        __syncthreads();
        const int dt0 = 3 * (w >> 2), et0 = 3 * (w & 3);
        bf16x8 af[3][2], bfv[3][2];
#pragma unroll
        for (int ks = 0; ks < 2; ++ks) { const int prow = 32 * ks + 8 * fq + qq;
#pragma unroll
            for (int i = 0; i < 3; ++i) {
                const LAS unsigned char* ka = F.lds + GL_K + prow * GLA_QP + (16 * (dt0 + i) + 4 * pp) * 2; af[i][ks] = tr2(ka, ka + 4 * GLA_QP);
                const LAS unsigned char* va = F.lds + GL_V + prow * GLA_VP + (16 * (et0 + i) + 4 * pp) * 2; bfv[i][ks] = tr2(va, va + 4 * GLA_VP); } }
#pragma unroll
        for (int i = 0; i < 3; ++i)
#pragma unroll
            for (int j = 0; j < 3; ++j) { f32x4 acc = (f32x4){0.f, 0.f, 0.f, 0.f};
#pragma unroll
                for (int ks = 0; ks < 2; ++ks) acc = __builtin_amdgcn_mfma_f32_16x16x32_bf16(af[i][ks], bfv[j][ks], acc, 0, 0, 0);
                UF[((size_t)U * 72 + (dt0 + i) * 12 + (et0 + j)) * 64 + lane] = pack4(acc); }
        __syncthreads();
    }
}
__device__ __forceinline__ void p_gla_scan(Frame& F) {
    u32x2* UF = (u32x2*)F.out; const float* DEC = (const float*)(F.ws + WS_DEC);
    for (int idx = blockIdx.x * 512 + F.tid; idx < 64 * 72 * 64; idx += F.G * 512) {
        const int bh = idx / 4608, rem = idx % 4608, tile = rem >> 6, ln = rem & 63, dt = tile / 12, fq = ln >> 4;
        f32x4 S = (f32x4){0.f, 0.f, 0.f, 0.f};
        u32x2* p = UF + ((size_t)bh * 32 * 72 + tile) * 64 + ln; const float* dp = DEC + (size_t)bh * 32 * 96 + 16 * dt + 4 * fq;
#pragma unroll 4
        for (int c = 0; c < 32; ++c) {
            const u32x2 u = *p; const f32x4 dc = *(const f32x4*)dp;
            *p = pack4(S);
            S[0] = S[0] * dc[0] + bf2f(u.x & 0xffffu); S[1] = S[1] * dc[1] + bf2f(u.x >> 16); S[2] = S[2] * dc[2] + bf2f(u.y & 0xffffu); S[3] = S[3] * dc[3] + bf2f(u.y >> 16);
            p += 72 * 64; dp += 96; }
    }
}
__device__ __forceinline__ void p_gla_out(Frame& F, const Args& a) {
    const bf16_t* GQ = (const bf16_t*)(F.ws + WS_GQ); const bf16_t* GK = (const bf16_t*)(F.ws + WS_GK); const bf16_t* GR = (const bf16_t*)(F.ws + WS_GR); const float* A1 = (const float*)(F.ws + WS_A1);
    const u32x2* SF = (const u32x2*)F.out; bf16_t* AO = (bf16_t*)(F.ws + WS_AO1); const float* ng = (const float*)a.in[I_GLA_NORMG];
    const int lane = F.lane, w = F.wave, li = lane & 15, fq = lane >> 4, qq = li >> 2, pp = lane & 3;
    LAS float* stats = (LAS float*)(F.lds + GL_ST);
    for (int U = blockIdx.x; U < NB * 4 * 32; U += F.G) {
        const int c = U & 31, h = (U >> 5) & 3, b = U >> 7; const size_t row0 = (size_t)b * SEQ + c * 64;
        gla_stage_common(F, a, h, row0);
        __syncthreads();
        { float bq[12], bl[12];
          gla_gates(A1 + (row0 + lane) * 16, (const LAS float*)(F.lds + GL_WGS), (const LAS float*)(F.lds + GL_BGS), w, lane, bq, bl);
          const u32x2* qp = (const u32x2*)(GQ + (row0 + lane) * 384 + h * 96 + 12 * w); const u32x2* kp = (const u32x2*)(GK + (row0 + lane) * 384 + h * 96 + 12 * w);
#pragma unroll
          for (int i = 0; i < 3; ++i) { const u32x2 qv = qp[i], kv = kp[i]; f32x4 oq, ok;
              const float e0 = __expf(bq[4 * i]), e1 = __expf(bq[4 * i + 1]), e2 = __expf(bq[4 * i + 2]), e3 = __expf(bq[4 * i + 3]);
              oq[0] = bf2f(qv.x & 0xffffu) * e0; oq[1] = bf2f(qv.x >> 16) * e1; oq[2] = bf2f(qv.y & 0xffffu) * e2; oq[3] = bf2f(qv.y >> 16) * e3;
              ok[0] = bf2f(kv.x & 0xffffu) * __builtin_amdgcn_rcpf(e0); ok[1] = bf2f(kv.x >> 16) * __builtin_amdgcn_rcpf(e1); ok[2] = bf2f(kv.y & 0xffffu) * __builtin_amdgcn_rcpf(e2); ok[3] = bf2f(kv.y >> 16) * __builtin_amdgcn_rcpf(e3);
              *(LAS u32x2*)(F.lds + GL_Q + lane * GLA_QP + (12 * w + 4 * i) * 2) = pack4(oq);
              *(LAS u32x2*)(F.lds + GL_K + lane * GLA_QP + (12 * w + 4 * i) * 2) = pack4(ok); } }
        __syncthreads();
        const int ip = w >> 2, et0 = 3 * (w & 3);
        f32x4 o[2][3]; float ssq[2][4];
#pragma unroll
        for (int iti = 0; iti < 2; ++iti) {
            const int it = 2 * ip + iti;
            const LAS unsigned char* qrow = F.lds + GL_Q + (16 * it + li) * GLA_QP;
            bf16x8 qB[3], qA[3];
#pragma unroll
            for (int ks = 0; ks < 3; ++ks) { qB[ks] = *(const LAS bf16x8*)(qrow + (32 * ks + 8 * fq) * 2);
                const u32x2 x0 = *(const LAS u32x2*)(qrow + (32 * ks + 4 * fq) * 2), x1 = *(const LAS u32x2*)(qrow + (32 * ks + 16 + 4 * fq) * 2);
                u32x4 x; x.x = x0.x; x.y = x0.y; x.z = x1.x; x.w = x1.y; qA[ks] = __builtin_bit_cast(bf16x8, x); }
            f32x4 tl[4];
#pragma unroll
            for (int jt = 0; jt < 4; ++jt) {
                tl[jt] = (f32x4){0.f, 0.f, 0.f, 0.f};
                if (jt <= it) {
                    const LAS unsigned char* krow = F.lds + GL_K + (16 * jt + li) * GLA_QP;
#pragma unroll
                    for (int ks = 0; ks < 3; ++ks) tl[jt] = __builtin_amdgcn_mfma_f32_16x16x32_bf16(*(const LAS bf16x8*)(krow + (32 * ks + 8 * fq) * 2), qB[ks], tl[jt], 0, 0, 0);
                    if (jt == it) {
#pragma unroll
                        for (int r = 0; r < 4; ++r) if (4 * fq + r > li) tl[jt][r] = 0.f; }
                }
            }
            bf16x8 am[2]; am[0] = pack8(tl[0], tl[1]); am[1] = pack8(tl[2], tl[3]);
#pragma unroll
            for (int eti = 0; eti < 3; ++eti) {
                const int et = et0 + eti;
                f32x4 acc = (f32x4){0.f, 0.f, 0.f, 0.f};
#pragma unroll
                for (int s2 = 0; s2 < 2; ++s2) if (2 * s2 <= it) {
                    const LAS unsigned char* va = F.lds + GL_V + (32 * s2 + 4 * fq + qq) * GLA_VP + (16 * et + 4 * pp) * 2;
                    acc = __builtin_amdgcn_mfma_f32_16x16x32_bf16(am[s2], tr2(va, va + 16 * GLA_VP), acc, 0, 0, 0); }
#pragma unroll
                for (int s = 0; s < 3; ++s) {
                    const u32x2 s0 = SF[((size_t)U * 72 + (2 * s) * 12 + et) * 64 + lane], s1 = SF[((size_t)U * 72 + (2 * s + 1) * 12 + et) * 64 + lane];
                    u32x4 x; x.x = s0.x; x.y = s0.y; x.z = s1.x; x.w = s1.y;
                    acc = __builtin_amdgcn_mfma_f32_16x16x32_bf16(qA[s], __builtin_bit_cast(bf16x8, x), acc, 0, 0, 0); }
                o[iti][eti] = acc;
            }
#pragma unroll
            for (int r = 0; r < 4; ++r) { float q2 = o[iti][0][r] * o[iti][0][r] + o[iti][1][r] * o[iti][1][r] + o[iti][2][r] * o[iti][2][r];
                q2 += __shfl_xor(q2, 1); q2 += __shfl_xor(q2, 2); q2 += __shfl_xor(q2, 4); q2 += __shfl_xor(q2, 8); ssq[iti][r] = q2; }
            if (li == 0) {
#pragma unroll
                for (int r = 0; r < 4; ++r) stats[(16 * it + 4 * fq + r) * 4 + (w & 3)] = ssq[iti][r]; }
        }
        __syncthreads();
#pragma unroll
        for (int iti = 0; iti < 2; ++iti) { const int it = 2 * ip + iti;
#pragma unroll
            for (int r = 0; r < 4; ++r) { const int rl = 16 * it + 4 * fq + r; const f32x4 st = *(const LAS f32x4*)(stats + rl * 4);
                const float rs = 1.f / sqrtf(((st[0] + st[1]) + (st[2] + st[3])) * (1.f / 192.f) + RMS_EPS);
#pragma unroll
                for (int eti = 0; eti < 3; ++eti) { const int e = 16 * (et0 + eti) + li;
                    const float rr = bf2f(GR[(row0 + rl) * 768 + h * 192 + e]);
                    AO[(row0 + rl) * 1024 + h * 192 + e] = (bf16_t)f2bf(o[iti][eti][r] * rs * ng[e] * silu_f(rr)); } } }
        __syncthreads();
    }
}
constexpr int NPHASE = 19;
__device__ __forceinline__ int opaque_int(int v) { asm volatile("" : "+s"(v)); return v; }
#define GEMM_CALL(EpiT, SchedT, g, S, E) pg8::gemm_phase<EpiT, SchedT, true, true>(F.lds, g, S, E)
__device__ __forceinline__ void moe_gemms_up(Frame& F, int layer, const bf16_t* X1b, bf16_t* ACT) {
    LAS int* tp = (LAS int*)(F.lds + MISC_OFF + 256);
    const unsigned* cnt = F.ctl + CW_CNT + layer * 2048;
    moe_tile_table(F, cnt, tp);
    pg8::Gemm g{X1b, (const bf16_t*)(F.ws + WS_W13), SLOT_ROWS, 512, 1024};
    MoeOrder S{tp, cnt, (const int*)(F.ws + WS_LISTTOK), 2, F.G, (int)blockIdx.x, true};
    EpiMoe1 E{ACT, (const float*)(F.ws + WS_LISTW), cnt};
    GEMM_CALL(EpiMoe1, MoeOrder, g, S, E);
}
__device__ __forceinline__ void moe_gemms_down(Frame& F, int layer, const bf16_t* ACT) {
    LAS int* tp = (LAS int*)(F.lds + MISC_OFF + 256);
    const unsigned* cnt = F.ctl + CW_CNT + layer * 2048;
    moe_tile_table(F, cnt, tp);
    pg8::Gemm g{ACT, (const bf16_t*)(F.ws + WS_W2), SLOT_ROWS, 1024, 256};
    MoeOrder S{tp, cnt, nullptr, 4, F.G, (int)blockIdx.x, false};
    EpiBf16Plain E{(bf16_t*)(F.ws + WS_Y), 1024, 3};
    GEMM_CALL(EpiBf16Plain, MoeOrder, g, S, E);
}
__device__ __forceinline__ void out_proj(Frame& F, int layer, const bf16_t* AO) {
    pg8::Gemm g{AO, (const bf16_t*)(F.ws + WS_WO) + (size_t)layer * 1024 * 1024, NT, 1024, 1024};
    pg8::StaticOrder S; S.init(NT, 1024, F.G, (int)blockIdx.x);
    EpiBf16Plain E{(bf16_t*)F.out, 1024, 0x7fffffff};
    GEMM_CALL(EpiBf16Plain, pg8::StaticOrder, g, S, E);
}

__global__ void __launch_bounds__(NWAVES * 64, 2) mk_fwd(Args args) {
    extern __shared__ __attribute__((aligned(16))) unsigned char lds_raw[];
    Frame F;
    F.lds = (LAS unsigned char*)lds_raw; F.ws = args.ws; F.out = args.out; F.ctl = (unsigned*)(args.ws + WS_CTL);
    F.tid = threadIdx.x; F.lane = F.tid & 63; F.wave = __builtin_amdgcn_readfirstlane(F.tid >> 6); F.G = gridDim.x;
    F.gw = blockIdx.x * NWAVES + F.wave; F.NGW = F.G * NWAVES;
    volatile LAS unsigned* MISC = (volatile LAS unsigned*)(F.lds + MISC_OFF);
    if (F.tid < 64) MISC[F.tid] = 0u;
    __syncthreads();
#if N_LAUNCH_MODE == 1
    XcdBarrier bar = xcd_barrier_post(F.ctl + CW_BAR, MISC + 8);
#define SEAM() xcd_barrier(bar)
#else
#define SEAM() do {} while (0)
#endif
    const int lo = args.ph_lo, hi = args.ph_hi;
#ifndef PH_ENABLE
#define PH_ENABLE 0xFFFFFFFFu
#endif
#define IN(k) (((PH_ENABLE >> (k)) & 1u) && lo <= (k) && (k) < hi)
#define ENDPH(k) do { if (IN((k) + 1)) SEAM(); } while (0)
#ifndef REP_MASK
#define REP_MASK 0u
#endif
#define REPS(k) _Pragma("unroll 1") for (int rep_ = 0, nrep_ = ((REP_MASK >> (k)) & 1u) ? opaque_int(2) : 1; rep_ < nrep_; ++rep_)
#define REPSEAM(k) do { if ((REP_MASK >> (k)) & 1u) { if (rep_ == 0) SEAM(); } } while (0)

    if (IN(0)) REPS(0) { p_prologue(F, args); ENDPH(0); }
    if (IN(1)) REPS(1) {
        { pg8::Gemm g{(const bf16_t*)(F.ws + WS_XB), (const bf16_t*)(F.ws + WS_WD), NT, ND, 1024};
          pg8::StaticOrder S; S.init(NT, ND, F.G, (int)blockIdx.x);
          EpiDsaProj E{(bf16_t*)(F.ws + WS_Q), (bf16_t*)(F.ws + WS_K), (bf16_t*)(F.ws + WS_V), (bf16_t*)(F.ws + WS_QI), (bf16_t*)(F.ws + WS_QM), (float*)(F.ws + WS_KIW),
                       (const float*)(F.ws + WS_ROPEC), (const float*)(F.ws + WS_ROPES)};
          GEMM_CALL(EpiDsaProj, pg8::StaticOrder, g, S, E); }
        { pg8::Gemm g{(const bf16_t*)(F.ws + WS_MEMB), (const bf16_t*)(F.ws + WS_WKV), NB * NMEM, 1024, 1024};
          pg8::StaticOrder S; S.init(NB * NMEM, 1024, F.G, (int)blockIdx.x);
          EpiBf16Plain E{(bf16_t*)(F.ws + WS_KVM), 1024, 0x7fffffff};
          GEMM_CALL(EpiBf16Plain, pg8::StaticOrder, g, S, E); }
        ENDPH(1);
    }
    if (IN(2)) REPS(2) { p_ki(F, args); ENDPH(2); }
    if (IN(3)) REPS(3) { p_indexer(F); ENDPH(3); }
    if (IN(4)) REPS(4) { p_attn_dsa(F); ENDPH(4); }
    if (IN(5)) REPS(5) { out_proj(F, 0, (const bf16_t*)(F.ws + WS_AO0)); ENDPH(5); }
    if (IN(6)) { p_ln1_router<true>(F, args, 0, args.in[I_X], (bf16_t*)(F.ws + WS_X1B0)); ENDPH(6); }
    if (IN(7)) REPS(7) { moe_gemms_up(F, 0, (const bf16_t*)(F.ws + WS_X1B0), (bf16_t*)(F.ws + WS_ACT0)); ENDPH(7); }
    if (IN(8)) REPS(8) { moe_gemms_down(F, 0, (const bf16_t*)(F.ws + WS_ACT0)); ENDPH(8); }
    if (IN(9)) { p_ln2<false>(F, args, 0, (const bf16_t*)(F.ws + WS_X1B0), F.ws + WS_C);
                 moe_weight_items(F, (const float*)args.in[I_MOE_W13], (const float*)args.in[I_MOE_W2], 1); ENDPH(9); }
    if (IN(10)) {
        pg8::Gemm g{(const bf16_t*)(F.ws + WS_C), (const bf16_t*)(F.ws + WS_WG), NT, NG, 1024};
        pg8::StaticOrder S; S.init(NT, NG, F.G, (int)blockIdx.x);
        EpiGlaProj E{(bf16_t*)(F.ws + WS_GQ), (bf16_t*)(F.ws + WS_GK), (bf16_t*)(F.ws + WS_GV), (bf16_t*)(F.ws + WS_GR), (bf16_t*)(F.ws + WS_GQM), (float*)(F.ws + WS_A1)};
        GEMM_CALL(EpiGlaProj, pg8::StaticOrder, g, S, E);
#if defined(PROBE_DUP10)
        SEAM(); GEMM_CALL(EpiGlaProj, pg8::StaticOrder, g, S, E);
#endif
        ENDPH(10);
    }
    if (IN(11)) REPS(11) { p_gla_u(F, args); ENDPH(11); }
    if (IN(12)) { p_gla_scan(F); ENDPH(12); }
    if (IN(13)) REPS(13) { p_gla_out(F, args); mem_attn_units(F, (const bf16_t*)(F.ws + WS_GQM), 1, (bf16_t*)(F.ws + WS_AO1)); ENDPH(13); }
    if (IN(14)) REPS(14) { out_proj(F, 1, (const bf16_t*)(F.ws + WS_AO1)); ENDPH(14); }
    if (IN(15)) { p_ln1_router<false>(F, args, 1, F.ws + WS_C, (bf16_t*)(F.ws + WS_X1B1)); ENDPH(15); }
    if (IN(16)) REPS(16) { moe_gemms_up(F, 1, (const bf16_t*)(F.ws + WS_X1B1), (bf16_t*)(F.ws + WS_ACT1)); ENDPH(16); }
    if (IN(17)) REPS(17) { moe_gemms_down(F, 1, (const bf16_t*)(F.ws + WS_ACT1)); ENDPH(17); }
    if (IN(18)) REPS(18) { p_ln2<true>(F, args, 1, (const bf16_t*)(F.ws + WS_X1B1), F.out); }
#undef IN
#undef ENDPH
}

extern "C" void kernel_launch(void* const* d_in, const int* in_sizes, int n_in, void* d_out, int out_size, void* d_ws, size_t ws_size, hipStream_t stream) {
    static int grid = 0;
    if (grid == 0) {
        if (n_in != 22 || out_size != NT * DM || ws_size < WS_END) { fprintf(stderr, "kernel_launch: unexpected shapes: n_in %d out %d ws %zu (need %zu)\n", n_in, out_size, ws_size, (size_t)WS_END); grid = -1; return; }
        int dev = 0, cus = 0, per_cu = 0;
        if (hipGetDevice(&dev) != hipSuccess || hipDeviceGetAttribute(&cus, hipDeviceAttributeMultiprocessorCount, dev) != hipSuccess) { grid = -1; return; }
        if (hipFuncSetAttribute((const void*)mk_fwd, hipFuncAttributeMaxDynamicSharedMemorySize, LDS_BYTES) != hipSuccess) { fprintf(stderr, "kernel_launch: hipFuncSetAttribute failed\n"); grid = -1; return; }
        if (hipOccupancyMaxActiveBlocksPerMultiprocessor(&per_cu, (const void*)mk_fwd, NWAVES * 64, LDS_BYTES) != hipSuccess || per_cu < 1) fprintf(stderr, "kernel_launch: occupancy query reports %d\n", per_cu);
        (void)hipGetLastError();
        grid = cus;
    }
    if (grid < 0) return;
    (void)hipMemsetAsync((char*)d_ws + WS_CTL, 0, CTL_ZERO_BYTES, stream);
    Args a{};
    for (int i = 0; i < 22; ++i) a.in[i] = d_in[i];
    a.out = (float*)d_out; a.ws = (unsigned char*)d_ws;
#if N_LAUNCH_MODE == 1
    a.ph_lo = 0; a.ph_hi = NPHASE;
    hipLaunchKernelGGL(mk_fwd, dim3(grid), dim3(NWAVES * 64), LDS_BYTES, stream, a);
#else
    for (int k = 0; k < NPHASE; ++k) { a.ph_lo = k; a.ph_hi = k + 1; hipLaunchKernelGGL(mk_fwd, dim3(grid), dim3(NWAVES * 64), LDS_BYTES, stream, a); }
#endif
}
```

```cpp
#include <hip/hip_runtime.h>
#include <cstdio>
#include <cstdint>

#define LAS __attribute__((address_space(3)))
#define GAS __attribute__((address_space(1)))
typedef unsigned short bf16_t;
typedef short bf16x8 __attribute__((ext_vector_type(8)));
typedef short s16x4 __attribute__((ext_vector_type(4)));
typedef float f32x4 __attribute__((ext_vector_type(4)));
typedef float f32x2 __attribute__((ext_vector_type(2)));
typedef float f32x16 __attribute__((ext_vector_type(16)));
typedef unsigned u32x4 __attribute__((ext_vector_type(4)));
typedef unsigned u32x2 __attribute__((ext_vector_type(2)));

#ifndef N_LAUNCH_MODE
#define N_LAUNCH_MODE 1
#endif

constexpr int NB = 16, SEQ = 2048, DM = 1024, NT = NB * SEQ;
constexpr int NMEM = 256;
constexpr int ND = 3328;
constexpr int NG = 2816;
constexpr int DSA_W = 3144, GLA_W = 2576;
constexpr int NEXP = 32;
constexpr int SLOT_ROWS = 73728;
constexpr float ALPHA = 1.4142135623730951f;
constexpr float LN_EPS = 1e-5f, RMS_EPS = 1e-6f;
constexpr float LOG2E = 1.4426950408889634f;
constexpr float C2 = 0.125f * LOG2E;
constexpr int NWAVES = 8;

constexpr size_t MiB = 1u << 20;
constexpr size_t WS_CTL = 0, CTL_ZERO_BYTES = 1 * MiB;
constexpr size_t WS_ROPEC = 1 * MiB, WS_ROPES = 5 * MiB;
constexpr size_t WS_DEC = 9 * MiB;
constexpr size_t WS_WD = 10 * MiB, WS_WG = 17 * MiB, WS_WKV = 23 * MiB, WS_WO = 25 * MiB, WS_W13 = 29 * MiB, WS_W2 = 61 * MiB;
constexpr size_t WS_KVM = 77 * MiB;
constexpr size_t WS_MEMB = 85 * MiB;
constexpr size_t WS_LISTTOK = 85 * MiB, WS_LISTW = 89 * MiB;
constexpr size_t WS_TOKSLOT = 93 * MiB;
constexpr size_t WS_A = 96 * MiB;
constexpr size_t WS_B = 160 * MiB;
constexpr size_t WS_C = 288 * MiB;
constexpr size_t WS_D = 352 * MiB;
constexpr size_t WS_END = 500 * MiB;
constexpr size_t WS_XB = WS_A;
constexpr size_t WS_Q = 160 * MiB, WS_K = 208 * MiB, WS_V = 256 * MiB, WS_QI = 304 * MiB, WS_QM = 336 * MiB, WS_KIW = 352 * MiB, WS_KI = 362 * MiB, WS_WI = 366 * MiB, WS_MASK = 368 * MiB, WS_AO0 = 376 * MiB;
constexpr size_t WS_X1 = WS_B, WS_X1B0 = WS_C, WS_ACT0 = WS_A, WS_Y = WS_D;
constexpr size_t WS_GV = 96 * MiB, WS_GQM = 144 * MiB, WS_GQ = 352 * MiB, WS_GK = 376 * MiB, WS_GR = 400 * MiB, WS_A1 = 448 * MiB, WS_KPT = 450 * MiB, WS_VT = WS_C, WS_AO1 = WS_B;
constexpr size_t WS_X1B1 = WS_A, WS_ACT1 = WS_C;
constexpr int KIW_P = 80;

constexpr int CW_CNT = 8192;
constexpr int CW_BAR = 4096;

__device__ __forceinline__ unsigned f2bf(float f) { unsigned u = __builtin_bit_cast(unsigned, f); return (u + 0x7fffu + ((u >> 16) & 1u)) >> 16; }
__device__ __forceinline__ unsigned pk2(float lo, float hi) { return f2bf(lo) | (f2bf(hi) << 16); }
__device__ __forceinline__ float bf2f(unsigned h) { return __builtin_bit_cast(float, h << 16); }
__device__ __forceinline__ float wave_sum(float v) {
#pragma unroll
    for (int o = 1; o < 64; o <<= 1) v += __shfl_xor(v, o);
    return v;
}
__device__ __forceinline__ float fast_exp2(float x) { return __builtin_amdgcn_exp2f(x); }
__device__ __forceinline__ float silu_f(float a) { return a * __builtin_amdgcn_rcpf(1.f + fast_exp2(-a * LOG2E)); }

namespace pg8 {
constexpr int BM = 256, BK = 64, HALF = 128, HTB = HALF * BK * 2, STAGE_BYTES = 8 * HTB, NXCD = 8, WGM = 8;
__host__ __device__ __forceinline__ int lds_byte(int r, int c) { const int st = (r >> 4) * 2 + (c >> 5), rr = r & 15, cc = c & 31, ob = rr * 64 + cc * 2; return st * 1024 + (ob ^ (((ob >> 9) & 1) << 5)); }
__host__ __device__ __forceinline__ void stage_rc(int b, int& R, int& C) { const int st = b / 1024, sb = b % 1024, swz = sb ^ (((sb >> 9) & 1) << 5); R = (st >> 1) * 16 + swz / 64; C = (st & 1) * 32 + (swz % 64) / 2; }
__host__ __device__ __forceinline__ int perm32(int rho) { const int n = rho >> 4, i = rho & 15; return 8 * (i >> 2) + 4 * n + (i & 3); }

struct Unit { int pm, pn, e, r0; };
struct Gemm { const bf16_t* A; const bf16_t* Bt; int M, N, K; };

struct StaticOrder {
    int nM, nN, nwg, G, c;
    __device__ void init(int M, int N, int G_, int c_) { nM = M / BM; nN = N / BM; nwg = nM * nN; G = G_; c = c_; }
    __device__ bool next(int i, Unit& u) const {
        const long L = (long)i * G + c; if (L >= nwg) return false;
        int wgid = (int)L; { const int q = nwg / NXCD, r = nwg % NXCD, xcd = wgid % NXCD, off = wgid / NXCD; wgid = (xcd < r ? xcd * (q + 1) : r * (q + 1) + (xcd - r) * q) + off; }
        const int nig = WGM * nN, gid = wgid / nig, fm = gid * WGM, gsz = (nM - fm) < WGM ? (nM - fm) : WGM;
        u.pm = fm + ((wgid % nig) % gsz); u.pn = (wgid % nig) / gsz; u.e = 0; u.r0 = 0; return true;
    }
    __device__ __forceinline__ int rowidx(const Unit& u, int r) const { return u.pm * BM + r; }
};

typedef __bf16 bf16x2_t __attribute__((ext_vector_type(2)));
__device__ __forceinline__ unsigned cvt_pk_bf16(float lo, float hi) { f32x2 v = {lo, hi}; bf16x2_t b = __builtin_convertvector(v, bf16x2_t); return __builtin_bit_cast(unsigned, b); }

template <class Epi, class Sched, bool ALIGN_EPI, bool SP2>
__device__ __forceinline__ void gemm_phase(LAS unsigned char* lds, const Gemm g, const Sched& S, const Epi& E) {
    const int tid = threadIdx.x, wid = __builtin_amdgcn_readfirstlane(tid >> 6), lane = tid & 63, wr = wid >> 2, wc = wid & 3, fr = lane & 15, fq = lane >> 4;
    const int K = g.K, nt = K / BK;
    int RA[2], CA[2]; unsigned voffB[2];
#pragma unroll
    for (int i = 0; i < 2; ++i) { int R, C; stage_rc(tid * 16 + i * 8192, R, C); const int Rb = (R & ~31) + perm32(R & 31);
        RA[i] = R; CA[i] = C; voffB[i] = (unsigned)(Rb * K + C) * 2u; }
    const size_t kstep = (size_t)(BK * 2);
    const size_t hstep = (size_t)HALF * K * 2;
    const size_t tstep = 2 * hstep;
    const unsigned ldsw = (unsigned)wid * 1024u;
    const int aoff = lds_byte(wr * 64 + fr, fq * 8), boff = lds_byte(wc * 32 + fr, fq * 8);
#define PG8_SA(b, h) (((b) * 2 + (h)) * HTB)
#define PG8_SB(b, h) ((4 + (b) * 2 + (h)) * HTB)
#define PG8_STAGE(bufoff, gbase, voff) do { _Pragma("unroll") for (int _i = 0; _i < 2; ++_i) \
        __builtin_amdgcn_global_load_lds((const unsigned*)((const char*)(gbase) + (voff)[_i]), (LAS unsigned*)(lds + (bufoff) + ldsw + _i * 8192), 16, 0, 0); } while (0)
#define PG8_LDA(dst, b, h) do { _Pragma("unroll") for (int m = 0; m < 4; ++m) _Pragma("unroll") for (int k = 0; k < 2; ++k) dst[m][k] = *(const LAS bf16x8*)(lds + PG8_SA(b, h) + aoff + m * 2048 + k * 1024); } while (0)
#define PG8_LDB(dst, b, h) do { _Pragma("unroll") for (int n = 0; n < 2; ++n) _Pragma("unroll") for (int k = 0; k < 2; ++k) dst[n][k] = *(const LAS bf16x8*)(lds + PG8_SB(b, h) + boff + n * 2048 + k * 1024); } while (0)
#define PG8_MMA(ai, bj, At, Bt) do { __builtin_amdgcn_s_setprio(1); _Pragma("unroll") for (int m = 0; m < 4; ++m) _Pragma("unroll") for (int n = 0; n < 2; ++n) _Pragma("unroll") for (int k = 0; k < 2; ++k) \
        acc[ai][bj][m][n] = __builtin_amdgcn_mfma_f32_16x16x32_bf16(Bt[n][k], At[m][k], acc[ai][bj][m][n], 0, 0, 0); __builtin_amdgcn_s_setprio(0); } while (0)
#define PG8_WAIT_V(n) asm volatile("s_waitcnt vmcnt(" #n ")" ::: "memory")
#define PG8_WAIT_L(n) asm volatile("s_waitcnt lgkmcnt(" #n ")" ::: "memory")
#define PG8_BAR __builtin_amdgcn_s_barrier()
#define PG8_SCHED __builtin_amdgcn_sched_barrier(0)
#define PG8_MKOFF(o0, o1, u) do { _Pragma("unroll") for (int _i = 0; _i < 2; ++_i) { \
        o0[_i] = ((unsigned)S.rowidx(u, RA[_i]) * (unsigned)K + (unsigned)CA[_i]) * 2u; o1[_i] = ((unsigned)S.rowidx(u, HALF + RA[_i]) * (unsigned)K + (unsigned)CA[_i]) * 2u; } } while (0)
    Unit cur, nxt; int ui = 0;
    if (!S.next(0, cur)) return;
    f32x4 acc[2][2][4][2];
#pragma unroll
    for (int a = 0; a < 2; ++a)
#pragma unroll
        for (int b = 0; b < 2; ++b)
#pragma unroll
            for (int m = 0; m < 4; ++m)
#pragma unroll
                for (int n = 0; n < 2; ++n) acc[a][b][m][n] = (f32x4){0.f, 0.f, 0.f, 0.f};
    bf16x8 At[4][2], B0[2][2], B1[2][2];
    const char* const gA = (const char*)g.A;
    unsigned cO0[2], cO1[2], nO0[2], nO1[2];
    PG8_MKOFF(cO0, cO1, cur);
    const char* cB = (const char*)g.Bt + (size_t)cur.pn * tstep;
    if constexpr (SP2) {
        PG8_STAGE(PG8_SB(0, 0), cB, voffB); PG8_STAGE(PG8_SB(0, 1), cB + hstep, voffB); PG8_STAGE(PG8_SA(0, 0), gA, cO0); PG8_STAGE(PG8_SA(0, 1), gA, cO1);
        if (wr == 1) PG8_BAR;
        PG8_WAIT_V(2); PG8_BAR;
        PG8_STAGE(PG8_SB(1, 0), cB + kstep, voffB); PG8_STAGE(PG8_SA(1, 0), gA + kstep, cO0); PG8_STAGE(PG8_SB(1, 1), cB + hstep + kstep, voffB);
        PG8_WAIT_V(6); PG8_BAR;
    } else {
        PG8_STAGE(PG8_SB(0, 0), cB, voffB); PG8_STAGE(PG8_SA(0, 0), gA, cO0); PG8_STAGE(PG8_SB(0, 1), cB + hstep, voffB); PG8_STAGE(PG8_SA(0, 1), gA, cO1);
        if (wr == 1) PG8_BAR;
        PG8_WAIT_V(4); PG8_BAR;
        PG8_STAGE(PG8_SB(1, 0), cB + kstep, voffB); PG8_STAGE(PG8_SA(1, 0), gA + kstep, cO0); PG8_STAGE(PG8_SB(1, 1), cB + hstep + kstep, voffB);
        PG8_WAIT_V(6); PG8_BAR;
    }
    for (;;) {
        const bool has_next = S.next(ui + 1, nxt);
        if (has_next) { PG8_MKOFF(nO0, nO1, nxt); } else {
#pragma unroll
            for (int _i = 0; _i < 2; ++_i) { nO0[_i] = cO0[_i]; nO1[_i] = cO1[_i]; } }
        const char* nB = has_next ? (const char*)g.Bt + (size_t)nxt.pn * tstep : cB;
#pragma unroll 1
        for (int t = 0; t < nt; t += 2) {
            const bool last = (t == nt - 2);
            const char* a1 = gA + (size_t)(t + 1) * kstep;
            const char* a2 = last ? gA : gA + (size_t)(t + 2) * kstep; const char* b2 = last ? nB : cB + (size_t)(t + 2) * kstep;
            const char* a3 = a2 + kstep; const char* b3 = b2 + kstep;
            unsigned x0[2], x1[2];
#pragma unroll
            for (int _i = 0; _i < 2; ++_i) { x0[_i] = last ? nO0[_i] : cO0[_i]; x1[_i] = last ? nO1[_i] : cO1[_i]; }
            if constexpr (SP2) {
            PG8_LDB(B0, 0, 0); PG8_LDB(B1, 0, 1); PG8_SCHED; PG8_LDA(At, 0, 0); PG8_STAGE(PG8_SA(1, 1), a1, cO1);
            PG8_WAIT_V(8); PG8_WAIT_L(0); PG8_BAR; PG8_MMA(0, 0, At, B0); PG8_MMA(0, 1, At, B1); PG8_BAR; PG8_SCHED;
            PG8_LDA(At, 0, 1); PG8_STAGE(PG8_SB(0, 0), b2, voffB); PG8_STAGE(PG8_SB(0, 1), b2 + hstep, voffB); PG8_STAGE(PG8_SA(0, 0), a2, x0);
            PG8_WAIT_V(8); PG8_WAIT_L(0); PG8_BAR; PG8_MMA(1, 0, At, B0); PG8_MMA(1, 1, At, B1); PG8_BAR; PG8_SCHED;
            PG8_LDB(B0, 1, 0); PG8_LDB(B1, 1, 1); PG8_SCHED; PG8_LDA(At, 1, 0); PG8_STAGE(PG8_SA(0, 1), a2, x1);
            PG8_WAIT_V(8); PG8_WAIT_L(0); PG8_BAR; PG8_MMA(0, 0, At, B0); PG8_MMA(0, 1, At, B1); PG8_BAR; PG8_SCHED;
            PG8_LDA(At, 1, 1); PG8_STAGE(PG8_SB(1, 0), b3, voffB); PG8_STAGE(PG8_SB(1, 1), b3 + hstep, voffB); PG8_STAGE(PG8_SA(1, 0), a3, x0);
            PG8_WAIT_V(8); PG8_WAIT_L(0); PG8_BAR; PG8_MMA(1, 0, At, B0); PG8_MMA(1, 1, At, B1); PG8_BAR; PG8_SCHED;
            } else {
            PG8_LDB(B0, 0, 0); PG8_SCHED; PG8_LDA(At, 0, 0); PG8_STAGE(PG8_SA(1, 1), a1, cO1);
            PG8_WAIT_L(8); PG8_BAR; PG8_WAIT_L(0); PG8_MMA(0, 0, At, B0); PG8_BAR; PG8_SCHED;
            PG8_LDB(B1, 0, 1); PG8_STAGE(PG8_SB(0, 0), b2, voffB);
            PG8_BAR; PG8_WAIT_L(0); PG8_MMA(0, 1, At, B1); PG8_BAR;
            PG8_LDA(At, 0, 1); PG8_STAGE(PG8_SA(0, 0), a2, x0);
            PG8_BAR; PG8_WAIT_L(0); PG8_MMA(1, 0, At, B0); PG8_BAR; PG8_SCHED;
            PG8_STAGE(PG8_SB(0, 1), b2 + hstep, voffB);
            PG8_WAIT_V(6); PG8_BAR; PG8_MMA(1, 1, At, B1); PG8_BAR;
            PG8_LDB(B0, 1, 0); PG8_SCHED; PG8_LDA(At, 1, 0); PG8_STAGE(PG8_SA(0, 1), a2, x1);
            PG8_WAIT_L(8); PG8_BAR; PG8_WAIT_L(0); PG8_MMA(0, 0, At, B0); PG8_BAR; PG8_SCHED;
            PG8_LDB(B1, 1, 1); PG8_STAGE(PG8_SB(1, 0), b3, voffB);
            PG8_BAR; PG8_WAIT_L(0); PG8_MMA(0, 1, At, B1); PG8_BAR;
            PG8_LDA(At, 1, 1); PG8_STAGE(PG8_SA(1, 0), a3, x0);
            PG8_BAR; PG8_WAIT_L(0); PG8_MMA(1, 0, At, B0); PG8_BAR; PG8_SCHED;
            PG8_STAGE(PG8_SB(1, 1), b3 + hstep, voffB);
            PG8_WAIT_V(6); PG8_BAR; PG8_MMA(1, 1, At, B1); PG8_BAR;
            }
        }
        if constexpr (ALIGN_EPI) { if (wr == 0) PG8_BAR; }
        E(acc, cur, wr, wc, fr, fq);
        if (!has_next) break;
#pragma unroll
        for (int a = 0; a < 2; ++a)
#pragma unroll
            for (int b = 0; b < 2; ++b)
#pragma unroll
                for (int m = 0; m < 4; ++m)
#pragma unroll
                    for (int n = 0; n < 2; ++n) acc[a][b][m][n] = (f32x4){0.f, 0.f, 0.f, 0.f};
        cur = nxt; cB = nB; ++ui;
#pragma unroll
        for (int _i = 0; _i < 2; ++_i) { cO0[_i] = nO0[_i]; cO1[_i] = nO1[_i]; }
        if constexpr (ALIGN_EPI) { if (wr == 1) PG8_BAR; }
    }
    PG8_WAIT_V(0);
    if constexpr (!ALIGN_EPI) { if (wr == 0) PG8_BAR; }
    PG8_BAR;
#undef PG8_SA
#undef PG8_SB
#undef PG8_STAGE
#undef PG8_LDA
#undef PG8_LDB
#undef PG8_MMA
#undef PG8_WAIT_V
#undef PG8_WAIT_L
#undef PG8_BAR
#undef PG8_SCHED
#undef PG8_MKOFF
}
}

#define XB_TMO      128
#define XB_XCNT(j)  (256  + 64 * (j))
#define XB_XSUB(j)  (1280 + 64 * (j))
#define XB_XGEN(j)  (2304 + 64 * (j))
#define XB_TOP      3328
#define XB_TOPGEN   3392
#define XCD_BAR_WORDS 3456
#define XB_SPIN_CAP (1u << 18)
__device__ __forceinline__ unsigned xb_ld(unsigned* p)              { return __hip_atomic_load(p, __ATOMIC_RELAXED, __HIP_MEMORY_SCOPE_AGENT); }
__device__ __forceinline__ unsigned xb_add(unsigned* p, unsigned v) { return __hip_atomic_fetch_add(p, v, __ATOMIC_RELAXED, __HIP_MEMORY_SCOPE_AGENT); }
__device__ __forceinline__ unsigned xb_xcc_id() { return (unsigned)__builtin_amdgcn_s_getreg((3 << 11) | 20) & 0xFu; }
#define XB_SPIN(cond, bar) do { unsigned _sp = 0; while (cond) { __builtin_amdgcn_s_sleep(1); \
    if ((++_sp & 255u) == 0u) { if (xb_ld(&(bar)[XB_TMO])) break; if (_sp > XB_SPIN_CAP) { atomicAdd(&(bar)[XB_TMO], 1u); break; } } } } while (0)
struct XcdBarrier { unsigned* bar; unsigned x; volatile LAS unsigned* st; };
__device__ __forceinline__ XcdBarrier xcd_barrier_post(unsigned* bar, volatile LAS unsigned* st) {
    XcdBarrier b; b.bar = bar; b.x = xb_xcc_id(); b.st = st;
    if (threadIdx.x == 0) (void)xb_add(&bar[XB_XCNT(b.x)], 1u);
    return b;
}
__device__ __forceinline__ void xcd_barrier_complete(unsigned* bar, unsigned x, unsigned& nloc, unsigned& nx) {
    const unsigned G = gridDim.x * gridDim.y * gridDim.z;
    unsigned sum, cnt, mine, sp = 0u;
    for (;;) {
        sum = 0u; cnt = 0u; mine = 0u;
#pragma unroll
        for (unsigned j = 0; j < 16; ++j) { const unsigned c = xb_ld(&bar[XB_XCNT(j)]); sum += c; cnt += (c > 0u) ? 1u : 0u; mine = (j == x) ? c : mine; }
        if (sum == G) break;
        __builtin_amdgcn_s_sleep(1);
        if ((++sp & 255u) == 0u) { if (xb_ld(&bar[XB_TMO])) break; if (sp > XB_SPIN_CAP) { atomicAdd(&bar[XB_TMO], 1u); break; } }
    }
    nloc = mine > 0u ? mine : 1u; nx = cnt > 0u ? cnt : 1u;
}
__device__ __forceinline__ void xcd_barrier(const XcdBarrier& b) {
    asm volatile("s_waitcnt vmcnt(0)" ::: "memory");
    __syncthreads();
    if (threadIdx.x == 0) {
        unsigned* bar = b.bar;
        __builtin_amdgcn_s_waitcnt(0);
        unsigned nloc = b.st[0], nx = b.st[1];
        if (nloc == 0u) { xcd_barrier_complete(bar, b.x, nloc, nx); b.st[0] = nloc; b.st[1] = nx; }
        const unsigned old = xb_add(&bar[XB_XSUB(b.x)], 1u);
        const unsigned gen = old / nloc;
        if (old + 1u == (gen + 1u) * nloc) {
            __builtin_amdgcn_fence(__ATOMIC_RELEASE, "agent");
            asm volatile("s_waitcnt vmcnt(0)" ::: "memory");
            const unsigned og = xb_add(&bar[XB_TOP], 1u);
            const unsigned tg = og / nx;
            if (og + 1u == (tg + 1u) * nx) xb_add(&bar[XB_TOPGEN], 1u);
            else XB_SPIN(xb_ld(&bar[XB_TOPGEN]) == tg, bar);
            __builtin_amdgcn_fence(__ATOMIC_ACQUIRE, "agent");
            xb_add(&bar[XB_XGEN(b.x)], 1u);
            asm volatile("s_waitcnt vmcnt(0)" ::: "memory");
        } else {
            XB_SPIN(xb_ld(&bar[XB_XGEN(b.x)]) == gen, bar);
            __builtin_amdgcn_fence(__ATOMIC_ACQUIRE, "agent");
            asm volatile("s_waitcnt vmcnt(0)" ::: "memory");
        }
    }
    __syncthreads();
}

constexpr int LDS_BYTES = 147456;
constexpr int MISC_OFF = 135168;
struct Args { const void* in[22]; float* out; unsigned char* ws; int ph_lo, ph_hi; };
struct Frame {
    LAS unsigned char* lds;
    unsigned char* ws; float* out;
    unsigned* ctl;
    int tid, lane, wave, G, gw, NGW;
};
enum { I_X = 0, I_MEM, I_POS, I_DSA_WIN, I_DSA_KG, I_DSA_KB, I_GLA_WIN, I_GLA_WGATE, I_GLA_BGATE, I_GLA_NORMG, I_WMEMKV, I_WOUT, I_LN1G, I_LN1B, I_LN2G, I_LN2B,
       I_MOE_WG, I_MOE_BG, I_MOE_WR, I_MOE_BR, I_MOE_W13, I_MOE_W2 };

__device__ __forceinline__ int dperm(int c) { return ((c >> 2) & 1) * 32 + (c >> 5) * 16 + ((c >> 3) & 3) * 4 + (c & 3); }
__device__ __forceinline__ int dperm_inv(int d) { const int n = d >> 5, i = d & 31; return (i >> 4) * 32 + ((i >> 2) & 3) * 8 + n * 4 + (i & 3); }
__device__ __forceinline__ int dsa_srccol(int n) {
    if (n < 1536) { return (n & ~63) + dperm(n & 63); }
    if (n < 2304) return n;
    if (n < 2816) { return (n & ~63) + dperm(n & 63); }
    if (n < 3072) return 2888 + (n - 2816);
    if (n < 3136) return 2816 + (n - 3072);
    if (n < 3144) return 2880 + (n - 3136);
    return -1;
}
__device__ __forceinline__ int gla_srccol(int n) {
    if (n < 2304) return n;
    if (n < 2560) return 2320 + (n - 2304);
    if (n < 2576) return 2304 + (n - 2560);
    return -1;
}
__device__ __forceinline__ int w13_srccol(int r) { const int pn = r >> 8, bj = (r >> 7) & 1, j = r & 127; return bj * 256 + pn * 128 + j; }
template <int MODE>
__device__ __forceinline__ void transpose_item(const float* W, int K, int ldw, bf16_t* WT, int nrows32, LAS float* scr, int item, int lane) {
    const int kb = item / nrows32, nb = item % nrows32, k0 = 64 * kb, n0 = 32 * nb;
    const int n = n0 + (lane & 31);
    int sc;
    if (MODE == 0) sc = n; else if (MODE == 1) sc = dsa_srccol(n); else if (MODE == 2) sc = gla_srccol(n); else sc = w13_srccol(n);
#pragma unroll 8
    for (int i = 0; i < 32; ++i) { const int kk = 2 * i + (lane >> 5); scr[kk * 33 + (lane & 31)] = (sc >= 0) ? W[(size_t)(k0 + kk) * ldw + sc] : 0.f; }
    asm volatile("s_waitcnt lgkmcnt(0)" ::: "memory");
    const int c = lane & 7;
#pragma unroll
    for (int j = 0; j < 4; ++j) { const int nn = (lane >> 3) + 8 * j; const LAS float* s = scr + (8 * c) * 33 + nn;
        u32x4 o; o.x = pk2(s[0 * 33], s[1 * 33]); o.y = pk2(s[2 * 33], s[3 * 33]); o.z = pk2(s[4 * 33], s[5 * 33]); o.w = pk2(s[6 * 33], s[7 * 33]);
        *(u32x4*)(WT + (size_t)(n0 + nn) * K + k0 + 8 * c) = o; }
    asm volatile("s_waitcnt lgkmcnt(0)" ::: "memory");
}
__device__ __forceinline__ void moe_weight_items(Frame& F, const float* w13, const float* w2, int layer) {
    LAS float* scr = (LAS float*)(F.lds + F.wave * 16384);
    bf16_t* W13 = (bf16_t*)(F.ws + WS_W13); bf16_t* W2 = (bf16_t*)(F.ws + WS_W2);
    constexpr int I13 = (1024 / 64) * (512 / 32), I2 = (256 / 64) * (1024 / 32);
    for (int it = F.gw; it < NEXP * (I13 + I2); it += F.NGW) {
        const int ge = it / (I13 + I2), r = it % (I13 + I2);
        if (r < I13) transpose_item<3>(w13 + ((size_t)layer * NEXP + ge) * 1024 * 512, 1024, 512, W13 + (size_t)ge * 512 * 1024, 16, scr, r, F.lane);
        else transpose_item<0>(w2 + ((size_t)layer * NEXP + ge) * 256 * 1024, 256, 1024, W2 + (size_t)ge * 1024 * 256, 32, scr, r - I13, F.lane);
    }
}
__device__ __forceinline__ void cvt_rows_bf16(Frame& F, const float* src, bf16_t* dst, int rows) {
    for (int m = F.gw; m < rows; m += F.NGW) {
        const f32x4* xr = (const f32x4*)(src + (size_t)m * DM) + F.lane; u32x2* o = (u32x2*)(dst + (size_t)m * DM) + F.lane;
#pragma unroll
        for (int j = 0; j < 4; ++j) { const f32x4 v = xr[64 * j]; u32x2 w; w.x = pk2(v.x, v.y); w.y = pk2(v.z, v.w); o[64 * j] = w; }
    }
}
__device__ __forceinline__ void p_prologue(Frame& F, const Args& a) {
    LAS float* scr = (LAS float*)(F.lds + F.wave * 16384);
    const float* dsa_w = (const float*)a.in[I_DSA_WIN]; const float* gla_w = (const float*)a.in[I_GLA_WIN];
    const float* wkv = (const float*)a.in[I_WMEMKV]; const float* wout = (const float*)a.in[I_WOUT];
    bf16_t* WD = (bf16_t*)(F.ws + WS_WD); bf16_t* WG = (bf16_t*)(F.ws + WS_WG); bf16_t* WKV = (bf16_t*)(F.ws + WS_WKV); bf16_t* WO = (bf16_t*)(F.ws + WS_WO);
    constexpr int ID = 16 * (ND / 32), IG = 16 * (NG / 32), IKV = 16 * (512 / 32), IO = 16 * (1024 / 32);
    constexpr int NIT = ID + IG + 2 * IKV + 2 * IO;
    for (int it = F.gw; it < NIT; it += F.NGW) {
        int r = it;
        if (r < ID) { transpose_item<1>(dsa_w, 1024, DSA_W, WD, ND / 32, scr, r, F.lane); continue; } r -= ID;
        if (r < IG) { transpose_item<2>(gla_w, 1024, GLA_W, WG, NG / 32, scr, r, F.lane); continue; } r -= IG;
        if (r < 2 * IKV) { const int l = r / IKV; transpose_item<0>(wkv + (size_t)l * 1024 * 512, 1024, 512, WKV + (size_t)l * 512 * 1024, 16, scr, r % IKV, F.lane); continue; } r -= 2 * IKV;
        { const int l = r / IO; transpose_item<0>(wout + (size_t)l * 1024 * 1024, 1024, 1024, WO + (size_t)l * 1024 * 1024, 32, scr, r % IO, F.lane); }
    }
    moe_weight_items(F, (const float*)a.in[I_MOE_W13], (const float*)a.in[I_MOE_W2], 0);
    cvt_rows_bf16(F, (const float*)a.in[I_X], (bf16_t*)(F.ws + WS_XB), NT);
    cvt_rows_bf16(F, (const float*)a.in[I_MEM], (bf16_t*)(F.ws + WS_MEMB), NB * NMEM);
    const int* pos = (const int*)a.in[I_POS];
    float* RC = (float*)(F.ws + WS_ROPEC); float* RS = (float*)(F.ws + WS_ROPES);
    __syncthreads();
    LAS float* invs = (LAS float*)F.lds;
    if (F.tid < 32) invs[F.tid] = (float)pow(10000.0, -(double)(2 * F.tid) / 64.0);
    __syncthreads();
    for (int idx = blockIdx.x * 512 + F.tid; idx < NT * 32; idx += F.G * 512) {
        const int t = idx >> 5, i = idx & 31;
        const float ang = (float)pos[t] * invs[i];
        float sn, cs; sincosf(ang, &sn, &cs);
        RC[idx] = cs; RS[idx] = sn;
    }
}
typedef const f32x4 (&AccRef)[2][2][4][2];
__device__ __forceinline__ void st_bf16x8(bf16_t* p, f32x4 v0, f32x4 v1) {
    u32x4 w; w.x = pg8::cvt_pk_bf16(v0[0], v0[1]); w.y = pg8::cvt_pk_bf16(v0[2], v0[3]); w.z = pg8::cvt_pk_bf16(v1[0], v1[1]); w.w = pg8::cvt_pk_bf16(v1[2], v1[3]);
    *(u32x4*)p = w;
}
struct EpiDsaProj {
    bf16_t *Q, *K, *V, *QI, *QM; float* KIW; const float *RC, *RS;
    __device__ __forceinline__ void operator()(AccRef acc, const pg8::Unit& u, int wr, int wc, int fr, int fq) const {
        const int pn = u.pn; const int row0 = u.pm * 256 + wr * 64 + fr;
        const int i0 = 16 * (wc & 1) + 4 * fq;
#pragma unroll
        for (int ai = 0; ai < 2; ++ai)
#pragma unroll
            for (int m = 0; m < 4; ++m) {
                const int row = row0 + ai * 128 + m * 16;
                f32x4 c4 = (f32x4){1.f, 1.f, 1.f, 1.f}, s4 = (f32x4){0.f, 0.f, 0.f, 0.f};
                const bool rope = (pn < 6) || (pn == 9) || (pn == 10);
                if (rope) { c4 = *(const f32x4*)(RC + (size_t)row * 32 + i0); s4 = *(const f32x4*)(RS + (size_t)row * 32 + i0); }
#pragma unroll
                for (int bj = 0; bj < 2; ++bj) {
                    const int gcol = pn * 256 + bj * 128 + wc * 32 + 8 * fq;
                    f32x4 v0 = acc[ai][bj][m][0], v1 = acc[ai][bj][m][1];
                    if (rope) { const f32x4 y0 = v0 * c4 - v1 * s4, y1 = v1 * c4 + v0 * s4; v0 = y0; v1 = y1; }
                    if (pn < 3) { v0 = v0 * C2; v1 = v1 * C2; st_bf16x8(Q + (size_t)row * 768 + gcol, v0, v1); }
                    else if (pn < 6) st_bf16x8(K + (size_t)row * 768 + (gcol - 768), v0, v1);
                    else if (pn < 9) st_bf16x8(V + (size_t)row * 768 + (gcol - 1536), v0, v1);
                    else if (pn < 11) st_bf16x8(QI + (size_t)row * 512 + (gcol - 2304), v0, v1);
                    else if (pn == 11) { v0 = v0 * C2; v1 = v1 * C2; st_bf16x8(QM + (size_t)row * 256 + (gcol - 2816), v0, v1); }
                    else { const int lc = gcol - 3072; if (lc < 72) { float* p = KIW + (size_t)row * KIW_P + lc; *(f32x4*)p = v0; *(f32x4*)(p + 4) = v1; } }
                }
            }
    }
};
struct EpiGlaProj {
    bf16_t *GQ, *GK, *GV, *GR, *GQM; float* A1;
    __device__ __forceinline__ void operator()(AccRef acc, const pg8::Unit& u, int wr, int wc, int fr, int fq) const {
        const int pn = u.pn; const int row0 = u.pm * 256 + wr * 64 + fr;
#pragma unroll
        for (int ai = 0; ai < 2; ++ai)
#pragma unroll
            for (int m = 0; m < 4; ++m) {
                const int row = row0 + ai * 128 + m * 16;
#pragma unroll
                for (int bj = 0; bj < 2; ++bj) {
                    const int gcol = pn * 256 + bj * 128 + wc * 32 + 8 * fq;
                    f32x4 v0 = acc[ai][bj][m][0], v1 = acc[ai][bj][m][1];
                    if (pn < 3) {
                        if (gcol < 384) { v0 = v0 * 0.10206207261596577f; v1 = v1 * 0.10206207261596577f; st_bf16x8(GQ + (size_t)row * 384 + gcol, v0, v1); }
                        else st_bf16x8(GK + (size_t)row * 384 + (gcol - 384), v0, v1);
                    }
                    else if (pn < 6) st_bf16x8(GV + (size_t)row * 768 + (gcol - 768), v0, v1);
                    else if (pn < 9) st_bf16x8(GR + (size_t)row * 768 + (gcol - 1536), v0, v1);
                    else if (pn == 9) { v0 = v0 * C2; v1 = v1 * C2; st_bf16x8(GQM + (size_t)row * 256 + (gcol - 2304), v0, v1); }
                    else { const int lc = gcol - 2560; if (lc < 16) { float* p = A1 + (size_t)row * 16 + lc; *(f32x4*)p = v0; *(f32x4*)(p + 4) = v1; } }
                }
            }
    }
};
struct EpiBf16Plain {
    bf16_t* O; int ldc; int ncolmask;
    __device__ __forceinline__ void operator()(AccRef acc, const pg8::Unit& u, int wr, int wc, int fr, int fq) const {
        const int row0 = u.pm * 256 + wr * 64 + fr; const int colt = (u.pn & ncolmask) * 256 + wc * 32 + 8 * fq;
#pragma unroll
        for (int ai = 0; ai < 2; ++ai)
#pragma unroll
            for (int m = 0; m < 4; ++m) { bf16_t* rowp = O + (size_t)(row0 + ai * 128 + m * 16) * ldc + colt;
#pragma unroll
                for (int bj = 0; bj < 2; ++bj) st_bf16x8(rowp + bj * 128, acc[ai][bj][m][0], acc[ai][bj][m][1]); }
    }
};
struct EpiF32Plain {
    float* C; int ldc;
    __device__ __forceinline__ void operator()(AccRef acc, const pg8::Unit& u, int wr, int wc, int fr, int fq) const {
        const int row0 = u.pm * 256 + wr * 64 + fr; const int colt = u.pn * 256 + wc * 32 + 8 * fq;
#pragma unroll
        for (int ai = 0; ai < 2; ++ai)
#pragma unroll
            for (int m = 0; m < 4; ++m) { float* rowp = C + (size_t)(row0 + ai * 128 + m * 16) * ldc + colt;
#pragma unroll
                for (int bj = 0; bj < 2; ++bj) { *(f32x4*)(rowp + bj * 128) = acc[ai][bj][m][0]; *(f32x4*)(rowp + bj * 128 + 4) = acc[ai][bj][m][1]; } }
    }
};
struct EpiMoe1 {
    bf16_t* ACT; const float* LISTW; const unsigned* cnt;
    __device__ __forceinline__ void operator()(AccRef acc, const pg8::Unit& u, int wr, int wc, int fr, int fq) const {
        const int j2 = u.pn & 1; const int rl0 = wr * 64 + fr; const int ce = (int)cnt[u.e * 64];
#pragma unroll
        for (int ai = 0; ai < 2; ++ai)
#pragma unroll
            for (int m = 0; m < 4; ++m) {
                const int rl = rl0 + ai * 128 + m * 16; const int pos = u.r0 + rl;
                const float wt = (pos < ce) ? LISTW[(size_t)u.e * NT + pos] : 0.f;
                f32x4 a0 = acc[ai][0][m][0], a1 = acc[ai][0][m][1], u0 = acc[ai][1][m][0], u1 = acc[ai][1][m][1], o0, o1;
#pragma unroll
                for (int j = 0; j < 4; ++j) { o0[j] = silu_f(a0[j]) * u0[j] * wt; o1[j] = silu_f(a1[j]) * u1[j] * wt; }
                st_bf16x8(ACT + (size_t)(u.pm * 256 + rl) * 256 + j2 * 128 + wc * 32 + 8 * fq, o0, o1);
            }
    }
};
struct MoeOrder {
    const LAS int* tp; const unsigned* cnt; const int* LISTTOK; int ncol, G, c; bool gather;
    __device__ bool next(int i, pg8::Unit& u) const {
        const long L = (long)i * G + c; const int ntile = tp[NEXP];
        if (L >= (long)ntile * ncol) return false;
        const int tile = (int)(L / ncol), col = (int)(L % ncol);
        int e = 0;
#pragma unroll 1
        while (tp[e + 1] <= tile) ++e;
        u.pm = tile; u.pn = e * ncol + col; u.e = e; u.r0 = (tile - tp[e]) * 256; return true;
    }
    __device__ __forceinline__ int rowidx(const pg8::Unit& u, int r) const {
        if (!gather) return u.pm * 256 + r;
        const int pos = u.r0 + r;
        return (pos < (int)cnt[u.e * 64]) ? LISTTOK[(size_t)u.e * NT + pos] : 0;
    }
};
__device__ __forceinline__ void moe_tile_table(Frame& F, const unsigned* cnt, LAS int* tp) {
    if (F.tid == 0) { int s = 0; for (int e = 0; e < NEXP; ++e) { tp[e] = s; s += ((int)cnt[e * 64] + 255) >> 8; } tp[NEXP] = s; }
    __syncthreads();
}

__device__ __forceinline__ void p_ki(Frame& F, const Args& a) {
    const float* KIW = (const float*)(F.ws + WS_KIW); bf16_t* KI = (bf16_t*)(F.ws + WS_KI); float* WI = (float*)(F.ws + WS_WI);
    const float* RC = (const float*)(F.ws + WS_ROPEC); const float* RS = (const float*)(F.ws + WS_ROPES);
    const float* g = (const float*)a.in[I_DSA_KG]; const float* bb = (const float*)a.in[I_DSA_KB];
    const int d = F.lane; const float gd = g[d], bd = bb[d]; const int dst = dperm_inv(d);
    for (int t = F.gw; t < NT; t += F.NGW) {
        const float v = KIW[(size_t)t * KIW_P + d];
        const float mu = wave_sum(v) * (1.f / 64.f); const float dv = v - mu;
        const float var = wave_sum(dv * dv) * (1.f / 64.f);
        const float n = dv * (1.f / sqrtf(var + LN_EPS)) * gd + bd;
        const float pr = __shfl_xor(n, 32);
        const float c = RC[(size_t)t * 32 + (d & 31)], s = RS[(size_t)t * 32 + (d & 31)];
        const float o = (d < 32) ? (n * c - pr * s) : (n * c + pr * s);
        KI[(size_t)t * 64 + dst] = (bf16_t)f2bf(o);
        if (d < 8) WI[(size_t)t * 8 + d] = KIW[(size_t)t * KIW_P + 64 + d] * 0.04419417382415922f;
    }
}

__device__ __forceinline__ unsigned ordkey(float f) { const unsigned u = __builtin_bit_cast(unsigned, f); return (u & 0x80000000u) ? ~u : (u | 0x80000000u); }
template <int NQ>
__device__ __forceinline__ void topk_select(const LAS float* sc, unsigned long long* MASK, size_t rowbase, int t0, int wave, int lane) {
#pragma unroll 1
    for (int u = 0; u < 2; ++u) {
        const int tk = 2 * wave + u, t = t0 + tk;
        unsigned key[NQ];
#pragma unroll
        for (int q = 0; q < NQ; ++q) { const unsigned k = ordkey(sc[tk * 2048 + lane + 64 * q]); key[q] = (lane + 64 * q <= t) ? k : 0u; }
        unsigned T = 0u; bool exact = false;
#pragma unroll 1
        for (int bit = 31; bit >= 0; --bit) {
            const unsigned cand = T | (1u << bit); int c = 0;
#pragma unroll
            for (int q = 0; q < NQ; ++q) c += __builtin_popcountll(__ballot(key[q] >= cand));
            if (c >= 256) { T = cand; if (c == 256) { exact = true; break; } }
        }
        int need = 0, ceq = 0;
        if (!exact) { int cgt = 0;
#pragma unroll
            for (int q = 0; q < NQ; ++q) { cgt += __builtin_popcountll(__ballot(key[q] > T)); ceq += __builtin_popcountll(__ballot(key[q] == T)); }
            need = 256 - cgt; }
        unsigned long long mymask = 0ull;
        if (exact || need == ceq) {
#pragma unroll
            for (int q = 0; q < NQ; ++q) { const unsigned long long bal = __ballot(key[q] >= T); if (lane == q) mymask = bal; }
        } else {
#pragma unroll 1
            for (int q = 0; q < NQ; ++q) {
                unsigned kq = 0u;
#pragma unroll
                for (int z = 0; z < NQ; ++z) kq = (z == q) ? key[z] : kq;
                unsigned long long eq = __ballot(kq == T); const unsigned long long gt = __ballot(kq > T);
                int pc = __builtin_popcountll(eq); const int take = pc < need ? pc : need;
                while (pc > take) { eq &= ~(1ull << (63 - __builtin_clzll(eq))); --pc; }
                need -= take;
                if (lane == q) mymask = gt | eq;
            }
        }
        if (lane < 32) MASK[(rowbase + t) * 32 + lane] = mymask;
    }
}
__device__ __forceinline__ void p_indexer(Frame& F) {
    const bf16_t* QI = (const bf16_t*)(F.ws + WS_QI); const bf16_t* KI = (const bf16_t*)(F.ws + WS_KI); const float* WI = (const float*)(F.ws + WS_WI);
    unsigned long long* MASK = (unsigned long long*)(F.ws + WS_MASK);
    LAS float* sc = (LAS float*)F.lds;
    LAS float* wis = (LAS float*)(F.lds + 131072);
    const int lane = F.lane, r32 = lane & 31, hi = lane >> 5, wave = F.wave;
    for (int i = 0;; ++i) {
        const int U = i * F.G + (int)blockIdx.x; if (U >= NB * 128) break;
        const int b = U >> 7, tl = U & 127, tile = (i & 1) ? 127 - tl : tl;
        const int t0 = tile * 16; const size_t rowbase = (size_t)b * SEQ;
        if (t0 < 256) {
#pragma unroll
            for (int u = 0; u < 2; ++u) { const int t = t0 + 2 * wave + u;
                if (lane < 32) { const int nb = t + 1 - 64 * lane; const unsigned long long m = nb >= 64 ? ~0ull : (nb <= 0 ? 0ull : ((1ull << nb) - 1ull)); MASK[(rowbase + t) * 32 + lane] = m; } }
            continue;
        }
        if (F.tid < 128) wis[F.tid] = WI[(rowbase + t0) * 8 + F.tid];
        bf16x8 af[4][4];
        { const int m = r32, j = m & 3, hp = (m >> 2) & 1, ii = m >> 3, tokl = 2 * hp + (ii >> 1), head = 4 * (ii & 1) + j;
#pragma unroll
          for (int mt = 0; mt < 4; ++mt)
#pragma unroll
            for (int ks = 0; ks < 4; ++ks) af[mt][ks] = *(const bf16x8*)(QI + (rowbase + t0 + 4 * mt + tokl) * 512 + head * 64 + ks * 16 + hi * 8); }
        __syncthreads();
        const int n32 = (t0 + 16 + 31) >> 5;
        bf16x8 bnx[4];
        if (wave < n32) {
#pragma unroll
            for (int ks = 0; ks < 4; ++ks) bnx[ks] = *(const bf16x8*)(KI + (rowbase + wave * 32 + r32) * 64 + ks * 16 + hi * 8); }
        for (int kt = wave; kt < n32; kt += NWAVES) {
            const int key = kt * 32 + r32;
            bf16x8 bfr[4];
#pragma unroll
            for (int ks = 0; ks < 4; ++ks) bfr[ks] = bnx[ks];
            if (kt + NWAVES < n32) {
#pragma unroll
                for (int ks = 0; ks < 4; ++ks) bnx[ks] = *(const bf16x8*)(KI + (rowbase + key + NWAVES * 32) * 64 + ks * 16 + hi * 8); }
#pragma unroll
            for (int mt = 0; mt < 4; ++mt) {
                f32x16 acc = {};
#pragma unroll
                for (int ks = 0; ks < 4; ++ks) acc = __builtin_amdgcn_mfma_f32_32x32x16_bf16(af[mt][ks], bfr[ks], acc, 0, 0, 0);
#pragma unroll
                for (int u = 0; u < 2; ++u) { const int tk = 4 * mt + 2 * hi + u;
                    const f32x4 w0 = *(const LAS f32x4*)(wis + tk * 8), w1 = *(const LAS f32x4*)(wis + tk * 8 + 4);
                    float s = 0.f;
#pragma unroll
                    for (int h = 0; h < 4; ++h) { s += w0[h] * fmaxf(acc[8 * u + h], 0.f); }
#pragma unroll
                    for (int h = 0; h < 4; ++h) { s += w1[h] * fmaxf(acc[8 * u + 4 + h], 0.f); }
                    sc[tk * 2048 + key] = s + 0.f; }
            }
        }
        __syncthreads();
        { const int nq = ((t0 + 15) >> 6) + 1;
          if (nq <= 8) topk_select<8>(sc, MASK, rowbase, t0, wave, lane);
          else if (nq <= 16) topk_select<16>(sc, MASK, rowbase, t0, wave, lane);
          else if (nq <= 24) topk_select<24>(sc, MASK, rowbase, t0, wave, lane);
          else topk_select<32>(sc, MASK, rowbase, t0, wave, lane); }
        __syncthreads();
    }
}

typedef short v4i16_t __attribute__((ext_vector_type(4)));
__device__ __forceinline__ s16x4 vtr(const LAS unsigned char* p) { return __builtin_bit_cast(s16x4, __builtin_amdgcn_ds_read_tr16_b64_v4i16((LAS v4i16_t*)p)); }
template <bool MASKED>
__device__ __forceinline__ void attn_unit(Frame& F, const bf16_t* Qp, int qpitch, const bf16_t* Kp, const bf16_t* Vp, int kvpitch, int ntiles,
                                          const unsigned long long* maskp, bf16_t* Op, int opitch) {
    const int tid = F.tid, lane = F.lane, r32 = lane & 31, hi = lane >> 5, wave = F.wave;
    LAS unsigned char* lds = F.lds;
    bf16x8 qf[4];
#pragma unroll
    for (int ks = 0; ks < 4; ++ks) qf[ks] = *(const bf16x8*)(Qp + (size_t)(wave * 32 + r32) * qpitch + ks * 16 + hi * 8);
    const unsigned long long* mrow = maskp + (size_t)(wave * 32 + r32) * 32;
    const int kkey = tid & 63, kch = tid >> 6, vkey = tid >> 3, vpc = tid & 7;
    const bf16_t* ksrc = Kp + (size_t)kkey * kvpitch + kch * 8; const bf16_t* vsrc = Vp + (size_t)vkey * kvpitch + vpc * 8;
    const int kdst = kch * 1024 + kkey * 16, vdst = 8192 + (vpc >> 2) * 4096 + vkey * 64 + (vpc & 3) * 16;
    u32x4 kreg = *(const u32x4*)ksrc, vreg = *(const u32x4*)vsrc;
    *(LAS u32x4*)(lds + kdst) = kreg; *(LAS u32x4*)(lds + vdst) = vreg;
    __syncthreads();
    float m_run = 0.f, l_run = 0.f; bool started = false; f32x16 o0 = {}, o1 = {};
    constexpr float THR = 8.f, NEGBIG = -1e30f;
    const int vlane = ((lane >> 4) & 1) * 32 + (lane & 3) * 8 + (4 * hi + ((lane & 15) >> 2)) * 64;
    unsigned long long mw_next = ~0ull; if (MASKED) mw_next = mrow[0];
    for (int t = 0; t < ntiles; ++t) {
        const int cb = (t & 1) * 16384, nb = 16384 - cb;
        if (t + 1 < ntiles) { kreg = *(const u32x4*)(ksrc + (size_t)(t + 1) * 64 * kvpitch); vreg = *(const u32x4*)(vsrc + (size_t)(t + 1) * 64 * kvpitch); }
        const unsigned long long mw = mw_next; if (MASKED && t + 1 < ntiles) mw_next = mrow[t + 1];
        f32x16 p0, p1; const float negm = -m_run;
        if (MASKED) { const int lo = (int)((unsigned)mw >> (4 * hi)), hw = (int)((unsigned)(mw >> 32) >> (4 * hi));
            const int nb_ = __builtin_bit_cast(int, negm), ng_ = __builtin_bit_cast(int, NEGBIG);
#pragma unroll
            for (int r = 0; r < 16; ++r) { const unsigned pos = (r & 3) + 8 * (r >> 2);
                const int m0 = __builtin_amdgcn_sbfe(lo, pos, 1), m1 = __builtin_amdgcn_sbfe(hw, pos, 1);
                p0[r] = __builtin_bit_cast(float, (m0 & nb_) | (~m0 & ng_)); p1[r] = __builtin_bit_cast(float, (m1 & nb_) | (~m1 & ng_)); } }
        else {
#pragma unroll
            for (int r = 0; r < 16; ++r) { p0[r] = negm; p1[r] = negm; } }
#pragma unroll
        for (int ks = 0; ks < 4; ++ks) {
            const bf16x8 a0 = *(const LAS bf16x8*)(lds + cb + (2 * ks + hi) * 1024 + r32 * 16);
            const bf16x8 a1 = *(const LAS bf16x8*)(lds + cb + (2 * ks + hi) * 1024 + (32 + r32) * 16);
            p0 = __builtin_amdgcn_mfma_f32_32x32x16_bf16(a0, qf[ks], p0, 0, 0, 0);
            p1 = __builtin_amdgcn_mfma_f32_32x32x16_bf16(a1, qf[ks], p1, 0, 0, 0);
        }
        float rm;
        { float a = __builtin_fmaxf(__builtin_fmaxf(p0[0], p0[1]), p1[0]), b = __builtin_fmaxf(__builtin_fmaxf(p0[2], p0[3]), p1[1]); a = __builtin_fmaxf(__builtin_fmaxf(a, p1[2]), p1[3]);
#pragma unroll
          for (int r = 4; r < 16; r += 4) { a = __builtin_fmaxf(__builtin_fmaxf(a, p0[r]), p0[r + 1]); b = __builtin_fmaxf(__builtin_fmaxf(b, p0[r + 2]), p0[r + 3]); a = __builtin_fmaxf(__builtin_fmaxf(a, p1[r]), p1[r + 1]); b = __builtin_fmaxf(__builtin_fmaxf(b, p1[r + 2]), p1[r + 3]); }
          rm = __builtin_fmaxf(a, b);
          auto rr = __builtin_amdgcn_permlane32_swap(__float_as_uint(rm), __float_as_uint(rm), false, false); rm = __builtin_fmaxf(__uint_as_float(rr[0]), __uint_as_float(rr[1])); }
        const bool valid = rm > -1e29f, adj = (rm > THR) || (valid && !started);
        if (__any(adj)) {
            const float dl = adj ? rm : 0.f; m_run += dl;
#pragma unroll
            for (int r = 0; r < 16; ++r) { p0[r] -= dl; p1[r] -= dl; }
            const float alpha = started ? fast_exp2(-dl) : 1.f;
            l_run *= alpha;
#pragma unroll
            for (int r = 0; r < 16; ++r) { o0[r] *= alpha; o1[r] *= alpha; }
        }
        started = started || valid;
#pragma unroll
        for (int r = 0; r < 16; ++r) { p0[r] = fast_exp2(p0[r]); p1[r] = fast_exp2(p1[r]); }
        { f32x2 sa[8];
#pragma unroll
          for (int r = 0; r < 8; ++r) sa[r] = (f32x2){p0[2 * r], p0[2 * r + 1]} + (f32x2){p1[2 * r], p1[2 * r + 1]};
          const f32x2 sb = ((sa[0] + sa[1]) + (sa[2] + sa[3])) + ((sa[4] + sa[5]) + (sa[6] + sa[7]));
          l_run += sb.x + sb.y; }
        bf16x8 pw[2][2];
#pragma unroll
        for (int s = 0; s < 2; ++s) {
            u32x4 w; w.x = pg8::cvt_pk_bf16(p0[8 * s + 0], p0[8 * s + 1]); w.y = pg8::cvt_pk_bf16(p0[8 * s + 2], p0[8 * s + 3]); w.z = pg8::cvt_pk_bf16(p0[8 * s + 4], p0[8 * s + 5]); w.w = pg8::cvt_pk_bf16(p0[8 * s + 6], p0[8 * s + 7]);
            pw[0][s] = __builtin_bit_cast(bf16x8, w);
            u32x4 x; x.x = pg8::cvt_pk_bf16(p1[8 * s + 0], p1[8 * s + 1]); x.y = pg8::cvt_pk_bf16(p1[8 * s + 2], p1[8 * s + 3]); x.z = pg8::cvt_pk_bf16(p1[8 * s + 4], p1[8 * s + 5]); x.w = pg8::cvt_pk_bf16(p1[8 * s + 6], p1[8 * s + 7]);
            pw[1][s] = __builtin_bit_cast(bf16x8, x);
        }
        const LAS unsigned char* vb = lds + cb + 8192 + vlane;
#pragma unroll
        for (int kh = 0; kh < 2; ++kh)
#pragma unroll
            for (int s = 0; s < 2; ++s) {
                const int ko = (32 * kh + 16 * s) * 64;
                const s16x4 a_lo0 = vtr(vb + ko), a_hi0 = vtr(vb + ko + 512), a_lo1 = vtr(vb + 4096 + ko), a_hi1 = vtr(vb + 4096 + ko + 512);
                const bf16x8 A0 = (bf16x8){a_lo0[0], a_lo0[1], a_lo0[2], a_lo0[3], a_hi0[0], a_hi0[1], a_hi0[2], a_hi0[3]};
                const bf16x8 A1 = (bf16x8){a_lo1[0], a_lo1[1], a_lo1[2], a_lo1[3], a_hi1[0], a_hi1[1], a_hi1[2], a_hi1[3]};
                o0 = __builtin_amdgcn_mfma_f32_32x32x16_bf16(A0, pw[kh][s], o0, 0, 0, 0);
                o1 = __builtin_amdgcn_mfma_f32_32x32x16_bf16(A1, pw[kh][s], o1, 0, 0, 0);
            }
        if (t + 1 < ntiles) { *(LAS u32x4*)(lds + nb + kdst) = kreg; *(LAS u32x4*)(lds + nb + vdst) = vreg; }
        __syncthreads();
    }
    { auto rr = __builtin_amdgcn_permlane32_swap(__float_as_uint(l_run), __float_as_uint(l_run), false, false); l_run = __uint_as_float(rr[0]) + __uint_as_float(rr[1]); }
    const float inv = 1.f / l_run;
    bf16_t* orow = Op + (size_t)(wave * 32 + r32) * opitch;
#pragma unroll
    for (int rg = 0; rg < 4; ++rg) {
        u32x2 w0, w1;
        w0.x = pg8::cvt_pk_bf16(o0[4 * rg] * inv, o0[4 * rg + 1] * inv); w0.y = pg8::cvt_pk_bf16(o0[4 * rg + 2] * inv, o0[4 * rg + 3] * inv);
        w1.x = pg8::cvt_pk_bf16(o1[4 * rg] * inv, o1[4 * rg + 1] * inv); w1.y = pg8::cvt_pk_bf16(o1[4 * rg + 2] * inv, o1[4 * rg + 3] * inv);
        *(u32x2*)(orow + 8 * rg + 4 * hi) = w0; *(u32x2*)(orow + 32 + 8 * rg + 4 * hi) = w1;
    }
}
__device__ __forceinline__ void mem_attn_units(Frame& F, const bf16_t* QM, int layer, bf16_t* AO) {
    const bf16_t* KVM = (const bf16_t*)(F.ws + WS_KVM);
    for (int mu = blockIdx.x; mu < NB * 32; mu += F.G) {
        const int b = mu >> 5, hm = (mu >> 3) & 3, qb = mu & 7;
        const size_t row0 = (size_t)b * SEQ + qb * 256;
        attn_unit<false>(F, QM + row0 * 256 + hm * 64, 256, KVM + (size_t)b * NMEM * 1024 + layer * 512 + hm * 64, KVM + (size_t)b * NMEM * 1024 + layer * 512 + 256 + hm * 64, 1024, 4,
                         nullptr, AO + row0 * 1024 + 768 + hm * 64, 1024);
    }
}
__device__ __forceinline__ void p_attn_dsa(Frame& F) {
    const bf16_t* Q = (const bf16_t*)(F.ws + WS_Q); const bf16_t* K = (const bf16_t*)(F.ws + WS_K); const bf16_t* V = (const bf16_t*)(F.ws + WS_V);
    const unsigned long long* MASK = (const unsigned long long*)(F.ws + WS_MASK); bf16_t* AO = (bf16_t*)(F.ws + WS_AO0);
    for (int pu = blockIdx.x; pu < NB * 12 * 4; pu += F.G) {
        const int bh = pu >> 2, pr = pu & 3, b = bh / 12, h = bh % 12;
#pragma unroll 1
        for (int z = 0; z < 2; ++z) {
            const int qb = z ? 7 - pr : pr; const size_t rb = (size_t)b * SEQ, row0 = rb + qb * 256;
            attn_unit<true>(F, Q + row0 * 768 + h * 64, 768, K + rb * 768 + h * 64, V + rb * 768 + h * 64, 768, 4 * (qb + 1), MASK + row0 * 32, AO + row0 * 1024 + h * 64, 1024);
        }
    }
    mem_attn_units(F, (const bf16_t*)(F.ws + WS_QM), 0, AO);
}

template <bool RESID_F32>
__device__ __forceinline__ void p_ln1_router(Frame& F, const Args& a, int layer, const void* resid, bf16_t* X1b) {
    const bf16_t* MIX = (const bf16_t*)F.out;
    const float* g1 = (const float*)a.in[I_LN1G] + layer * 1024; const float* b1 = (const float*)a.in[I_LN1B] + layer * 1024;
    const float* wg = (const float*)a.in[I_MOE_WG] + (size_t)layer * 1024 * 4; const float* bg = (const float*)a.in[I_MOE_BG] + layer * 4;
    const float* wr = (const float*)a.in[I_MOE_WR] + (size_t)layer * 4 * 1024 * 8; const float* br = (const float*)a.in[I_MOE_BR] + layer * 32;
    unsigned* cnt = F.ctl + CW_CNT + layer * 2048;
    int* LISTTOK = (int*)(F.ws + WS_LISTTOK); float* LISTW = (float*)(F.ws + WS_LISTW); int* TOKSLOT = (int*)(F.ws + WS_TOKSLOT);
    const int lane = F.lane;
    LAS float* WR = (LAS float*)F.lds;
    for (int i = F.tid; i < 4 * 1024 * 2; i += 512) { const int g = i >> 11, k = (i & 2047) >> 1, hf = i & 1;
        const f32x4 w4 = *(const f32x4*)(wr + ((size_t)g * 1024 + k) * 8 + hf * 4);
#pragma unroll
        for (int c = 0; c < 4; ++c) WR[(g * 8 + hf * 4 + c) * 1024 + k] = w4[c]; }
    __syncthreads();
    f32x4 gv[4], bv[4], wgr[4][4];
#pragma unroll
    for (int j = 0; j < 4; ++j) { gv[j] = *((const f32x4*)g1 + lane + 64 * j); bv[j] = *((const f32x4*)b1 + lane + 64 * j);
#pragma unroll
        for (int c = 0; c < 4; ++c) wgr[j][c] = *(const f32x4*)(wg + (size_t)(256 * j + 4 * lane + c) * 4); }
    LAS int* cntL = (LAS int*)(F.lds + MISC_OFF + 512); LAS int* baseL = cntL + 32; LAS int* tokdat = (LAS int*)(F.lds + MISC_OFF + 1024);
    if (F.tid < 32) cntL[F.tid] = 0;
    __syncthreads();
    int nloc = 0;
    for (int tb = F.gw; tb < NT; tb += 2 * F.NGW) {
      f32x4 vv[2][4];
#pragma unroll
      for (int hh = 0; hh < 2; ++hh) { const int t = tb + hh * F.NGW; if (t < NT) {
        const u32x2* mr = (const u32x2*)(MIX + (size_t)t * DM) + lane;
#pragma unroll
        for (int j = 0; j < 4; ++j) {
            f32x4 xv;
            if (RESID_F32) xv = *((const f32x4*)((const float*)resid + (size_t)t * DM) + lane + 64 * j);
            else { const u32x2 p = *((const u32x2*)((const bf16_t*)resid + (size_t)t * DM) + lane + 64 * j); xv = (f32x4){bf2f(p.x & 0xffffu), bf2f(p.x >> 16), bf2f(p.y & 0xffffu), bf2f(p.y >> 16)}; }
            const u32x2 m = mr[64 * j];
            vv[hh][j] = xv * ALPHA + (f32x4){bf2f(m.x & 0xffffu), bf2f(m.x >> 16), bf2f(m.y & 0xffffu), bf2f(m.y >> 16)}; } } }
#pragma unroll
      for (int hh = 0; hh < 2; ++hh) { const int t = tb + hh * F.NGW; if (t >= NT) break;
        f32x4 v[4]; float s = 0.f;
#pragma unroll
        for (int j = 0; j < 4; ++j) { v[j] = vv[hh][j]; s += (v[j].x + v[j].y) + (v[j].z + v[j].w); }
        const float mean = wave_sum(s) * (1.f / DM); float s2 = 0.f;
#pragma unroll
        for (int j = 0; j < 4; ++j) { v[j] = v[j] - mean; s2 += (v[j].x * v[j].x + v[j].y * v[j].y) + (v[j].z * v[j].z + v[j].w * v[j].w); }
        const float rstd = 1.f / sqrtf(wave_sum(s2) * (1.f / DM) + LN_EPS);
        u32x2* ob = (u32x2*)(X1b + (size_t)t * DM) + lane;
#pragma unroll
        for (int j = 0; j < 4; ++j) { v[j] = v[j] * rstd * gv[j] + bv[j]; u32x2 w; w.x = pk2(v[j].x, v[j].y); w.y = pk2(v[j].z, v[j].w); ob[64 * j] = w; }
        float gl[4] = {0.f, 0.f, 0.f, 0.f};
#pragma unroll
        for (int j = 0; j < 4; ++j)
#pragma unroll
            for (int c = 0; c < 4; ++c)
#pragma unroll
                for (int k = 0; k < 4; ++k) gl[k] += v[j][c] * wgr[j][c][k];
#pragma unroll
        for (int k = 0; k < 4; ++k) gl[k] = wave_sum(gl[k]) + bg[k];
        int gsel = 0; float gmax = gl[0];
#pragma unroll
        for (int k = 1; k < 4; ++k) if (gl[k] > gmax) { gmax = gl[k]; gsel = k; }
        float gs = 0.f;
#pragma unroll
        for (int k = 0; k < 4; ++k) gs += __expf(gl[k] - gmax);
        const float pg = 1.f / gs;
        gsel = __builtin_amdgcn_readfirstlane(gsel);
        const LAS float* wrg = WR + gsel * 8 * 1024 + 4 * lane;
        float el[8];
#pragma unroll
        for (int e = 0; e < 8; ++e) { float acc = 0.f;
#pragma unroll
            for (int j = 0; j < 4; ++j) { const f32x4 w4 = *(const LAS f32x4*)(wrg + e * 1024 + 256 * j); acc += (v[j].x * w4.x + v[j].y * w4.y) + (v[j].z * w4.z + v[j].w * w4.w); }
            el[e] = wave_sum(acc) + br[gsel * 8 + e]; }
        int i1 = 0; float v1 = el[0];
#pragma unroll
        for (int k = 1; k < 8; ++k) if (el[k] > v1) { v1 = el[k]; i1 = k; }
        int i2 = -1; float v2 = -INFINITY;
#pragma unroll
        for (int k = 0; k < 8; ++k) if (k != i1 && (i2 < 0 || el[k] > v2)) { v2 = el[k]; i2 = k; }
        const float e2 = __expf(v2 - v1); const float wt1 = pg / (1.f + e2), wt2 = pg * e2 / (1.f + e2);
        if (lane == 0) {
            const int ge1 = gsel * 8 + i1, ge2 = gsel * 8 + i2;
            const int l1 = __hip_atomic_fetch_add(&cntL[ge1], 1, __ATOMIC_RELAXED, __HIP_MEMORY_SCOPE_WORKGROUP), l2 = __hip_atomic_fetch_add(&cntL[ge2], 1, __ATOMIC_RELAXED, __HIP_MEMORY_SCOPE_WORKGROUP);
            LAS int* td = tokdat + (nloc * NWAVES + F.wave) * 8;
            td[0] = t; td[1] = ge1; td[2] = l1; td[3] = __float_as_int(wt1); td[4] = ge2; td[5] = l2; td[6] = __float_as_int(wt2);
        }
        ++nloc;
      }
    }
    __syncthreads();
    if (F.tid < 32) { const int n = cntL[F.tid]; baseL[F.tid] = n ? (int)atomicAdd(&cnt[F.tid * 64], (unsigned)n) : 0; }
    __syncthreads();
    for (int i = F.tid; i < nloc * NWAVES; i += 512) {
        const LAS int* td = tokdat + i * 8; const int t = td[0], ge1 = td[1], ge2 = td[4]; const int p1 = baseL[ge1] + td[2], p2 = baseL[ge2] + td[5];
        LISTTOK[(size_t)ge1 * NT + p1] = t; LISTW[(size_t)ge1 * NT + p1] = __int_as_float(td[3]);
        LISTTOK[(size_t)ge2 * NT + p2] = t; LISTW[(size_t)ge2 * NT + p2] = __int_as_float(td[6]);
        *(int4*)(TOKSLOT + (size_t)t * 4) = make_int4(ge1, p1, ge2, p2);
    }
}
template <bool OUT_F32>
__device__ __forceinline__ void p_ln2(Frame& F, const Args& a, int layer, const bf16_t* X1b, void* dst) {
    const bf16_t* Y = (const bf16_t*)(F.ws + WS_Y); const int* TOKSLOT = (const int*)(F.ws + WS_TOKSLOT);
    const float* g2 = (const float*)a.in[I_LN2G] + layer * 1024; const float* b2 = (const float*)a.in[I_LN2B] + layer * 1024;
    LAS int* tp = (LAS int*)(F.lds + MISC_OFF + 256);
    moe_tile_table(F, F.ctl + CW_CNT + layer * 2048, tp);
    const int lane = F.lane;
    f32x4 gv[4], bv[4];
#pragma unroll
    for (int j = 0; j < 4; ++j) { gv[j] = *((const f32x4*)g2 + lane + 64 * j); bv[j] = *((const f32x4*)b2 + lane + 64 * j); }
    for (int tb = F.gw; tb < NT; tb += 2 * F.NGW) {
      f32x4 vv[2][4];
#pragma unroll
      for (int hh = 0; hh < 2; ++hh) { const int t = tb + hh * F.NGW; if (t < NT) {
        const int4 ts = *(const int4*)(TOKSLOT + (size_t)t * 4);
        const size_t s0 = (size_t)tp[ts.x] * 256 + ts.y, s1 = (size_t)tp[ts.z] * 256 + ts.w;
        const u32x2* xr = (const u32x2*)(X1b + (size_t)t * DM) + lane;
        const u32x2* y0 = (const u32x2*)(Y + s0 * DM) + lane; const u32x2* y1 = (const u32x2*)(Y + s1 * DM) + lane;
#pragma unroll
        for (int j = 0; j < 4; ++j) { const u32x2 p = y0[64 * j], q = y1[64 * j], x = xr[64 * j];
            f32x4 yy; yy.x = bf2f(p.x & 0xffffu) + bf2f(q.x & 0xffffu); yy.y = bf2f(p.x >> 16) + bf2f(q.x >> 16); yy.z = bf2f(p.y & 0xffffu) + bf2f(q.y & 0xffffu); yy.w = bf2f(p.y >> 16) + bf2f(q.y >> 16);
            vv[hh][j] = (f32x4){bf2f(x.x & 0xffffu), bf2f(x.x >> 16), bf2f(x.y & 0xffffu), bf2f(x.y >> 16)} * ALPHA + yy; } } }
#pragma unroll
      for (int hh = 0; hh < 2; ++hh) { const int t = tb + hh * F.NGW; if (t >= NT) break;
        f32x4 v[4]; float s = 0.f;
#pragma unroll
        for (int j = 0; j < 4; ++j) { v[j] = vv[hh][j]; s += (v[j].x + v[j].y) + (v[j].z + v[j].w); }
        const float mean = wave_sum(s) * (1.f / DM); float s2 = 0.f;
#pragma unroll
        for (int j = 0; j < 4; ++j) { v[j] = v[j] - mean; s2 += (v[j].x * v[j].x + v[j].y * v[j].y) + (v[j].z * v[j].z + v[j].w * v[j].w); }
        const float rstd = 1.f / sqrtf(wave_sum(s2) * (1.f / DM) + LN_EPS);
#pragma unroll
        for (int j = 0; j < 4; ++j) v[j] = v[j] * rstd * gv[j] + bv[j];
        if (OUT_F32) { f32x4* o4 = (f32x4*)((float*)dst + (size_t)t * DM) + lane;
#pragma unroll
            for (int j = 0; j < 4; ++j) o4[64 * j] = v[j]; }
        else { u32x2* ob = (u32x2*)((bf16_t*)dst + (size_t)t * DM) + lane;
#pragma unroll
            for (int j = 0; j < 4; ++j) { u32x2 w; w.x = pk2(v[j].x, v[j].y); w.y = pk2(v[j].z, v[j].w); ob[64 * j] = w; } }
      }
    }
}

__device__ __forceinline__ bf16x8 pack8(f32x4 lo, f32x4 hi) { u32x4 w; w.x = pg8::cvt_pk_bf16(lo[0], lo[1]); w.y = pg8::cvt_pk_bf16(lo[2], lo[3]); w.z = pg8::cvt_pk_bf16(hi[0], hi[1]); w.w = pg8::cvt_pk_bf16(hi[2], hi[3]); return __builtin_bit_cast(bf16x8, w); }
constexpr int GLA_QP = 208, GLA_VP = 400;
constexpr int GL_WGS = 0, GL_BGS = 6144, GL_Q = 8192, GL_K = 8192 + 13312, GL_V = 8192 + 2 * 13312, GL_ST = GL_V + 25600;
__device__ __forceinline__ void gla_gates(const float* a1row, const LAS float* wgs, const LAS float* bgs, int w, int lane, float (&bq)[12], float (&bl)[12]) {
    f32x4 av[4];
#pragma unroll
    for (int r = 0; r < 4; ++r) av[r] = *(const f32x4*)(a1row + 4 * r);
#pragma unroll
    for (int k = 0; k < 12; ++k) {
        const int d = 12 * w + k; float z = bgs[d];
#pragma unroll
        for (int r = 0; r < 16; ++r) z += av[r >> 2][r & 3] * wgs[r * 96 + d];
        float g = (fminf(z, 0.f) - __logf(1.f + __expf(-fabsf(z)))) * (1.f / 16.f);
#pragma unroll
        for (int o = 1; o < 64; o <<= 1) { const float t = __shfl_up(g, o); if (lane >= o) g += t; }
        bq[k] = g; bl[k] = __shfl(g, 63);
    }
}
__device__ __forceinline__ void gla_stage_common(Frame& F, const Args& a, int h, size_t row0) {
    const float* wgate = (const float*)a.in[I_GLA_WGATE]; const float* bgate = (const float*)a.in[I_GLA_BGATE];
    const bf16_t* GV = (const bf16_t*)(F.ws + WS_GV);
    LAS float* wgs = (LAS float*)(F.lds + GL_WGS); LAS float* bgs = (LAS float*)(F.lds + GL_BGS);
    const int tid = F.tid;
    if (tid < 384) { const int r = tid / 24, d4 = (tid % 24) * 4; *(LAS f32x4*)(wgs + r * 96 + d4) = *(const f32x4*)(wgate + r * 384 + h * 96 + d4); }
    if (tid < 96) bgs[tid] = bgate[h * 96 + tid];
#pragma unroll
    for (int i = 0; i < 3; ++i) { const int p = tid + 512 * i, row = p / 24, pc = p % 24;
        *(LAS u32x4*)(F.lds + GL_V + row * GLA_VP + pc * 16) = *(const u32x4*)(GV + (row0 + row) * 768 + h * 192 + pc * 8); }
}
__device__ __forceinline__ bf16x8 tr2(const LAS unsigned char* p0, const LAS unsigned char* p1) { const s16x4 a = vtr(p0), b = vtr(p1); return (bf16x8){a[0], a[1], a[2], a[3], b[0], b[1], b[2], b[3]}; }
__device__ __forceinline__ u32x2 pack4(f32x4 v) { u32x2 w; w.x = pg8::cvt_pk_bf16(v[0], v[1]); w.y = pg8::cvt_pk_bf16(v[2], v[3]); return w; }
__device__ __forceinline__ void p_gla_u(Frame& F, const Args& a) {
    const bf16_t* GK = (const bf16_t*)(F.ws + WS_GK); const float* A1 = (const float*)(F.ws + WS_A1);
    u32x2* UF = (u32x2*)F.out; float* DEC = (float*)(F.ws + WS_DEC);
    const int lane = F.lane, w = F.wave, fq = lane >> 4, qq = (lane & 15) >> 2, pp = lane & 3;
    for (int U = blockIdx.x; U < NB * 4 * 32; U += F.G) {
        const int c = U & 31, h = (U >> 5) & 3, b = U >> 7; const size_t row0 = (size_t)b * SEQ + c * 64;
        gla_stage_common(F, a, h, row0);
        __syncthreads();
        float bq[12], bl[12];
        gla_gates(A1 + (row0 + lane) * 16, (const LAS float*)(F.lds + GL_WGS), (const LAS float*)(F.lds + GL_BGS), w, lane, bq, bl);
        { const u32x2* kp = (const u32x2*)(GK + (row0 + lane) * 384 + h * 96 + 12 * w);
#pragma unroll
          for (int i = 0; i < 3; ++i) { const u32x2 kv = kp[i]; f32x4 o;
              o[0] = bf2f(kv.x & 0xffffu) * __expf(bl[4 * i] - bq[4 * i]); o[1] = bf2f(kv.x >> 16) * __expf(bl[4 * i + 1] - bq[4 * i + 1]);
              o[2] = bf2f(kv.y & 0xffffu) * __expf(bl[4 * i + 2] - bq[4 * i + 2]); o[3] = bf2f(kv.y >> 16) * __expf(bl[4 * i + 3] - bq[4 * i + 3]);
              *(LAS u32x2*)(F.lds + GL_K + lane * GLA_QP + (12 * w + 4 * i) * 2) = pack4(o); } }
        if (lane == 0) {
#pragma unroll
            for (int i = 0; i < 3; ++i) *(f32x4*)(DEC + (size_t)U * 96 + 12 * w + 4 * i) = (f32x4){__expf(bl[4 * i]), __expf(bl[4 * i + 1]), __expf(bl[4 * i + 2]), __expf(bl[4 * i + 3])}; }
        __syncthreads();
        const int dt0 = 3 * (w >> 2), et0 = 3 * (w & 3);
        bf16x8 af[3][2], bfv[3][2];
#pragma unroll
        for (int ks = 0; ks < 2; ++ks) { const int prow = 32 * ks + 8 * fq + qq;
#pragma unroll
            for (int i = 0; i < 3; ++i) {
                const LAS unsigned char* ka = F.lds + GL_K + prow * GLA_QP + (16 * (dt0 + i) + 4 * pp) * 2; af[i][ks] = tr2(ka, ka + 4 * GLA_QP);
                const LAS unsigned char* va = F.lds + GL_V + prow * GLA_VP + (16 * (et0 + i) + 4 * pp) * 2; bfv[i][ks] = tr2(va, va + 4 * GLA_VP); } }
#pragma unroll
        for (int i = 0; i < 3; ++i)
#pragma unroll
            for (int j = 0; j < 3; ++j) { f32x4 acc = (f32x4){0.f, 0.f, 0.f, 0.f};
#pragma unroll
                for (int ks = 0; ks < 2; ++ks) acc = __builtin_amdgcn_mfma_f32_16x16x32_bf16(af[i][ks], bfv[j][ks], acc, 0, 0, 0);
                UF[((size_t)U * 72 + (dt0 + i) * 12 + (et0 + j)) * 64 + lane] = pack4(acc); }
        __syncthreads();
    }
}
__device__ __forceinline__ void p_gla_scan(Frame& F) {
    u32x2* UF = (u32x2*)F.out; const float* DEC = (const float*)(F.ws + WS_DEC);
    for (int idx = blockIdx.x * 512 + F.tid; idx < 64 * 72 * 64; idx += F.G * 512) {
        const int bh = idx / 4608, rem = idx % 4608, tile = rem >> 6, ln = rem & 63, dt = tile / 12, fq = ln >> 4;
        f32x4 S = (f32x4){0.f, 0.f, 0.f, 0.f};
        u32x2* p = UF + ((size_t)bh * 32 * 72 + tile) * 64 + ln; const float* dp = DEC + (size_t)bh * 32 * 96 + 16 * dt + 4 * fq;
#pragma unroll 4
        for (int c = 0; c < 32; ++c) {
            const u32x2 u = *p; const f32x4 dc = *(const f32x4*)dp;
            *p = pack4(S);
            S[0] = S[0] * dc[0] + bf2f(u.x & 0xffffu); S[1] = S[1] * dc[1] + bf2f(u.x >> 16); S[2] = S[2] * dc[2] + bf2f(u.y & 0xffffu); S[3] = S[3] * dc[3] + bf2f(u.y >> 16);
            p += 72 * 64; dp += 96; }
    }
}
__device__ __forceinline__ void p_gla_out(Frame& F, const Args& a) {
    const bf16_t* GQ = (const bf16_t*)(F.ws + WS_GQ); const bf16_t* GK = (const bf16_t*)(F.ws + WS_GK); const bf16_t* GR = (const bf16_t*)(F.ws + WS_GR); const float* A1 = (const float*)(F.ws + WS_A1);
    const u32x2* SF = (const u32x2*)F.out; bf16_t* AO = (bf16_t*)(F.ws + WS_AO1); const float* ng = (const float*)a.in[I_GLA_NORMG];
    const int lane = F.lane, w = F.wave, li = lane & 15, fq = lane >> 4, qq = li >> 2, pp = lane & 3;
    LAS float* stats = (LAS float*)(F.lds + GL_ST);
    for (int U = blockIdx.x; U < NB * 4 * 32; U += F.G) {
        const int c = U & 31, h = (U >> 5) & 3, b = U >> 7; const size_t row0 = (size_t)b * SEQ + c * 64;
        gla_stage_common(F, a, h, row0);
        __syncthreads();
        { float bq[12], bl[12];
          gla_gates(A1 + (row0 + lane) * 16, (const LAS float*)(F.lds + GL_WGS), (const LAS float*)(F.lds + GL_BGS), w, lane, bq, bl);
          const u32x2* qp = (const u32x2*)(GQ + (row0 + lane) * 384 + h * 96 + 12 * w); const u32x2* kp = (const u32x2*)(GK + (row0 + lane) * 384 + h * 96 + 12 * w);
#pragma unroll
          for (int i = 0; i < 3; ++i) { const u32x2 qv = qp[i], kv = kp[i]; f32x4 oq, ok;
              const float e0 = __expf(bq[4 * i]), e1 = __expf(bq[4 * i + 1]), e2 = __expf(bq[4 * i + 2]), e3 = __expf(bq[4 * i + 3]);
              oq[0] = bf2f(qv.x & 0xffffu) * e0; oq[1] = bf2f(qv.x >> 16) * e1; oq[2] = bf2f(qv.y & 0xffffu) * e2; oq[3] = bf2f(qv.y >> 16) * e3;
              ok[0] = bf2f(kv.x & 0xffffu) * __builtin_amdgcn_rcpf(e0); ok[1] = bf2f(kv.x >> 16) * __builtin_amdgcn_rcpf(e1); ok[2] = bf2f(kv.y & 0xffffu) * __builtin_amdgcn_rcpf(e2); ok[3] = bf2f(kv.y >> 16) * __builtin_amdgcn_rcpf(e3);
              *(LAS u32x2*)(F.lds + GL_Q + lane * GLA_QP + (12 * w + 4 * i) * 2) = pack4(oq);
              *(LAS u32x2*)(F.lds + GL_K + lane * GLA_QP + (12 * w + 4 * i) * 2) = pack4(ok); } }
        __syncthreads();
        const int ip = w >> 2, et0 = 3 * (w & 3);
        f32x4 o[2][3]; float ssq[2][4];
#pragma unroll
        for (int iti = 0; iti < 2; ++iti) {
            const int it = 2 * ip + iti;
            const LAS unsigned char* qrow = F.lds + GL_Q + (16 * it + li) * GLA_QP;
            bf16x8 qB[3], qA[3];
#pragma unroll
            for (int ks = 0; ks < 3; ++ks) { qB[ks] = *(const LAS bf16x8*)(qrow + (32 * ks + 8 * fq) * 2);
                const u32x2 x0 = *(const LAS u32x2*)(qrow + (32 * ks + 4 * fq) * 2), x1 = *(const LAS u32x2*)(qrow + (32 * ks + 16 + 4 * fq) * 2);
                u32x4 x; x.x = x0.x; x.y = x0.y; x.z = x1.x; x.w = x1.y; qA[ks] = __builtin_bit_cast(bf16x8, x); }
            f32x4 tl[4];
#pragma unroll
            for (int jt = 0; jt < 4; ++jt) {
                tl[jt] = (f32x4){0.f, 0.f, 0.f, 0.f};
                if (jt <= it) {
                    const LAS unsigned char* krow = F.lds + GL_K + (16 * jt + li) * GLA_QP;
#pragma unroll
                    for (int ks = 0; ks < 3; ++ks) tl[jt] = __builtin_amdgcn_mfma_f32_16x16x32_bf16(*(const LAS bf16x8*)(krow + (32 * ks + 8 * fq) * 2), qB[ks], tl[jt], 0, 0, 0);
                    if (jt == it) {
#pragma unroll
                        for (int r = 0; r < 4; ++r) if (4 * fq + r > li) tl[jt][r] = 0.f; }
                }
            }
            bf16x8 am[2]; am[0] = pack8(tl[0], tl[1]); am[1] = pack8(tl[2], tl[3]);
#pragma unroll
            for (int eti = 0; eti < 3; ++eti) {
                const int et = et0 + eti;
                f32x4 acc = (f32x4){0.f, 0.f, 0.f, 0.f};
#pragma unroll
                for (int s2 = 0; s2 < 2; ++s2) if (2 * s2 <= it) {
                    const LAS unsigned char* va = F.lds + GL_V + (32 * s2 + 4 * fq + qq) * GLA_VP + (16 * et + 4 * pp) * 2;
                    acc = __builtin_amdgcn_mfma_f32_16x16x32_bf16(am[s2], tr2(va, va + 16 * GLA_VP), acc, 0, 0, 0); }
#pragma unroll
                for (int s = 0; s < 3; ++s) {
                    const u32x2 s0 = SF[((size_t)U * 72 + (2 * s) * 12 + et) * 64 + lane], s1 = SF[((size_t)U * 72 + (2 * s + 1) * 12 + et) * 64 + lane];
                    u32x4 x; x.x = s0.x; x.y = s0.y; x.z = s1.x; x.w = s1.y;
                    acc = __builtin_amdgcn_mfma_f32_16x16x32_bf16(qA[s], __builtin_bit_cast(bf16x8, x), acc, 0, 0, 0); }
                o[iti][eti] = acc;
            }
#pragma unroll
            for (int r = 0; r < 4; ++r) { float q2 = o[iti][0][r] * o[iti][0][r] + o[iti][1][r] * o[iti][1][r] + o[iti][2][r] * o[iti][2][r];
                q2 += __shfl_xor(q2, 1); q2 += __shfl_xor(q2, 2); q2 += __shfl_xor(q2, 4); q2 += __shfl_xor(q2, 8); ssq[iti][r] = q2; }
            if (li == 0) {
#pragma unroll
                for (int r = 0; r < 4; ++r) stats[(16 * it + 4 * fq + r) * 4 + (w & 3)] = ssq[iti][r]; }
        }
        __syncthreads();
#pragma unroll
        for (int iti = 0; iti < 2; ++iti) { const int it = 2 * ip + iti;
#pragma unroll
            for (int r = 0; r < 4; ++r) { const int rl = 16 * it + 4 * fq + r; const f32x4 st = *(const LAS f32x4*)(stats + rl * 4);
                const float rs = 1.f / sqrtf(((st[0] + st[1]) + (st[2] + st[3])) * (1.f / 192.f) + RMS_EPS);
#pragma unroll
                for (int eti = 0; eti < 3; ++eti) { const int e = 16 * (et0 + eti) + li;
                    const float rr = bf2f(GR[(row0 + rl) * 768 + h * 192 + e]);
                    AO[(row0 + rl) * 1024 + h * 192 + e] = (bf16_t)f2bf(o[iti][eti][r] * rs * ng[e] * silu_f(rr)); } } }
        __syncthreads();
    }
}
constexpr int NPHASE = 19;
__device__ __forceinline__ int opaque_int(int v) { asm volatile("" : "+s"(v)); return v; }
#define GEMM_CALL(EpiT, SchedT, g, S, E) pg8::gemm_phase<EpiT, SchedT, true, true>(F.lds, g, S, E)
__device__ __forceinline__ void moe_gemms_up(Frame& F, int layer, const bf16_t* X1b, bf16_t* ACT) {
    LAS int* tp = (LAS int*)(F.lds + MISC_OFF + 256);
    const unsigned* cnt = F.ctl + CW_CNT + layer * 2048;
    moe_tile_table(F, cnt, tp);
    pg8::Gemm g{X1b, (const bf16_t*)(F.ws + WS_W13), SLOT_ROWS, 512, 1024};
    MoeOrder S{tp, cnt, (const int*)(F.ws + WS_LISTTOK), 2, F.G, (int)blockIdx.x, true};
    EpiMoe1 E{ACT, (const float*)(F.ws + WS_LISTW), cnt};
    GEMM_CALL(EpiMoe1, MoeOrder, g, S, E);
}
__device__ __forceinline__ void moe_gemms_down(Frame& F, int layer, const bf16_t* ACT) {
    LAS int* tp = (LAS int*)(F.lds + MISC_OFF + 256);
    const unsigned* cnt = F.ctl + CW_CNT + layer * 2048;
    moe_tile_table(F, cnt, tp);
    pg8::Gemm g{ACT, (const bf16_t*)(F.ws + WS_W2), SLOT_ROWS, 1024, 256};
    MoeOrder S{tp, cnt, nullptr, 4, F.G, (int)blockIdx.x, false};
    EpiBf16Plain E{(bf16_t*)(F.ws + WS_Y), 1024, 3};
    GEMM_CALL(EpiBf16Plain, MoeOrder, g, S, E);
}
__device__ __forceinline__ void out_proj(Frame& F, int layer, const bf16_t* AO) {
    pg8::Gemm g{AO, (const bf16_t*)(F.ws + WS_WO) + (size_t)layer * 1024 * 1024, NT, 1024, 1024};
    pg8::StaticOrder S; S.init(NT, 1024, F.G, (int)blockIdx.x);
    EpiBf16Plain E{(bf16_t*)F.out, 1024, 0x7fffffff};
    GEMM_CALL(EpiBf16Plain, pg8::StaticOrder, g, S, E);
}

__global__ void __launch_bounds__(NWAVES * 64, 2) mk_fwd(Args args) {
    extern __shared__ __attribute__((aligned(16))) unsigned char lds_raw[];
    Frame F;
    F.lds = (LAS unsigned char*)lds_raw; F.ws = args.ws; F.out = args.out; F.ctl = (unsigned*)(args.ws + WS_CTL);
    F.tid = threadIdx.x; F.lane = F.tid & 63; F.wave = __builtin_amdgcn_readfirstlane(F.tid >> 6); F.G = gridDim.x;
    F.gw = blockIdx.x * NWAVES + F.wave; F.NGW = F.G * NWAVES;
    volatile LAS unsigned* MISC = (volatile LAS unsigned*)(F.lds + MISC_OFF);
    if (F.tid < 64) MISC[F.tid] = 0u;
    __syncthreads();
#if N_LAUNCH_MODE == 1
    XcdBarrier bar = xcd_barrier_post(F.ctl + CW_BAR, MISC + 8);
#define SEAM() xcd_barrier(bar)
#else
#define SEAM() do {} while (0)
#endif
    const int lo = args.ph_lo, hi = args.ph_hi;
#ifndef PH_ENABLE
#define PH_ENABLE 0xFFFFFFFFu
#endif
#define IN(k) (((PH_ENABLE >> (k)) & 1u) && lo <= (k) && (k) < hi)
#define ENDPH(k) do { if (IN((k) + 1)) SEAM(); } while (0)
#ifndef REP_MASK
#define REP_MASK 0u
#endif
#define REPS(k) _Pragma("unroll 1") for (int rep_ = 0, nrep_ = ((REP_MASK >> (k)) & 1u) ? opaque_int(2) : 1; rep_ < nrep_; ++rep_)
#define REPSEAM(k) do { if ((REP_MASK >> (k)) & 1u) { if (rep_ == 0) SEAM(); } } while (0)

    if (IN(0)) REPS(0) { p_prologue(F, args); ENDPH(0); }
    if (IN(1)) REPS(1) {
        { pg8::Gemm g{(const bf16_t*)(F.ws + WS_XB), (const bf16_t*)(F.ws + WS_WD), NT, ND, 1024};
          pg8::StaticOrder S; S.init(NT, ND, F.G, (int)blockIdx.x);
          EpiDsaProj E{(bf16_t*)(F.ws + WS_Q), (bf16_t*)(F.ws + WS_K), (bf16_t*)(F.ws + WS_V), (bf16_t*)(F.ws + WS_QI), (bf16_t*)(F.ws + WS_QM), (float*)(F.ws + WS_KIW),
                       (const float*)(F.ws + WS_ROPEC), (const float*)(F.ws + WS_ROPES)};
          GEMM_CALL(EpiDsaProj, pg8::StaticOrder, g, S, E); }
        { pg8::Gemm g{(const bf16_t*)(F.ws + WS_MEMB), (const bf16_t*)(F.ws + WS_WKV), NB * NMEM, 1024, 1024};
          pg8::StaticOrder S; S.init(NB * NMEM, 1024, F.G, (int)blockIdx.x);
          EpiBf16Plain E{(bf16_t*)(F.ws + WS_KVM), 1024, 0x7fffffff};
          GEMM_CALL(EpiBf16Plain, pg8::StaticOrder, g, S, E); }
        ENDPH(1);
    }
    if (IN(2)) REPS(2) { p_ki(F, args); ENDPH(2); }
    if (IN(3)) REPS(3) { p_indexer(F); ENDPH(3); }
    if (IN(4)) REPS(4) { p_attn_dsa(F); ENDPH(4); }
    if (IN(5)) REPS(5) { out_proj(F, 0, (const bf16_t*)(F.ws + WS_AO0)); ENDPH(5); }
    if (IN(6)) { p_ln1_router<true>(F, args, 0, args.in[I_X], (bf16_t*)(F.ws + WS_X1B0)); ENDPH(6); }
    if (IN(7)) REPS(7) { moe_gemms_up(F, 0, (const bf16_t*)(F.ws + WS_X1B0), (bf16_t*)(F.ws + WS_ACT0)); ENDPH(7); }
    if (IN(8)) REPS(8) { moe_gemms_down(F, 0, (const bf16_t*)(F.ws + WS_ACT0)); ENDPH(8); }
    if (IN(9)) { p_ln2<false>(F, args, 0, (const bf16_t*)(F.ws + WS_X1B0), F.ws + WS_C);
                 moe_weight_items(F, (const float*)args.in[I_MOE_W13], (const float*)args.in[I_MOE_W2], 1); ENDPH(9); }
    if (IN(10)) {
        pg8::Gemm g{(const bf16_t*)(F.ws + WS_C), (const bf16_t*)(F.ws + WS_WG), NT, NG, 1024};
        pg8::StaticOrder S; S.init(NT, NG, F.G, (int)blockIdx.x);
        EpiGlaProj E{(bf16_t*)(F.ws + WS_GQ), (bf16_t*)(F.ws + WS_GK), (bf16_t*)(F.ws + WS_GV), (bf16_t*)(F.ws + WS_GR), (bf16_t*)(F.ws + WS_GQM), (float*)(F.ws + WS_A1)};
        GEMM_CALL(EpiGlaProj, pg8::StaticOrder, g, S, E);
#if defined(PROBE_DUP10)
        SEAM(); GEMM_CALL(EpiGlaProj, pg8::StaticOrder, g, S, E);
#endif
        ENDPH(10);
    }
    if (IN(11)) REPS(11) { p_gla_u(F, args); ENDPH(11); }
    if (IN(12)) { p_gla_scan(F); ENDPH(12); }
    if (IN(13)) REPS(13) { p_gla_out(F, args); mem_attn_units(F, (const bf16_t*)(F.ws + WS_GQM), 1, (bf16_t*)(F.ws + WS_AO1)); ENDPH(13); }
    if (IN(14)) REPS(14) { out_proj(F, 1, (const bf16_t*)(F.ws + WS_AO1)); ENDPH(14); }
    if (IN(15)) { p_ln1_router<false>(F, args, 1, F.ws + WS_C, (bf16_t*)(F.ws + WS_X1B1)); ENDPH(15); }
    if (IN(16)) REPS(16) { moe_gemms_up(F, 1, (const bf16_t*)(F.ws + WS_X1B1), (bf16_t*)(F.ws + WS_ACT1)); ENDPH(16); }
    if (IN(17)) REPS(17) { moe_gemms_down(F, 1, (const bf16_t*)(F.ws + WS_ACT1)); ENDPH(17); }
    if (IN(18)) REPS(18) { p_ln2<true>(F, args, 1, (const bf16_t*)(F.ws + WS_X1B1), F.out); }
#undef IN
#undef ENDPH
}

extern "C" void kernel_launch(void* const* d_in, const int* in_sizes, int n_in, void* d_out, int out_size, void* d_ws, size_t ws_size, hipStream_t stream) {
    static int grid = 0;
    if (grid == 0) {
        if (n_in != 22 || out_size != NT * DM || ws_size < WS_END) { fprintf(stderr, "kernel_launch: unexpected shapes: n_in %d out %d ws %zu (need %zu)\n", n_in, out_size, ws_size, (size_t)WS_END); grid = -1; return; }
        int dev = 0, cus = 0, per_cu = 0;
        if (hipGetDevice(&dev) != hipSuccess || hipDeviceGetAttribute(&cus, hipDeviceAttributeMultiprocessorCount, dev) != hipSuccess) { grid = -1; return; }
        if (hipFuncSetAttribute((const void*)mk_fwd, hipFuncAttributeMaxDynamicSharedMemorySize, LDS_BYTES) != hipSuccess) { fprintf(stderr, "kernel_launch: hipFuncSetAttribute failed\n"); grid = -1; return; }
        if (hipOccupancyMaxActiveBlocksPerMultiprocessor(&per_cu, (const void*)mk_fwd, NWAVES * 64, LDS_BYTES) != hipSuccess || per_cu < 1) fprintf(stderr, "kernel_launch: occupancy query reports %d\n", per_cu);
        (void)hipGetLastError();
        grid = cus;
    }
    if (grid < 0) return;
    (void)hipMemsetAsync((char*)d_ws + WS_CTL, 0, CTL_ZERO_BYTES, stream);
    Args a{};
    for (int i = 0; i < 22; ++i) a.in[i] = d_in[i];
    a.out = (float*)d_out; a.ws = (unsigned char*)d_ws;
#if N_LAUNCH_MODE == 1
    a.ph_lo = 0; a.ph_hi = NPHASE;
    hipLaunchKernelGGL(mk_fwd, dim3(grid), dim3(NWAVES * 64), LDS_BYTES, stream, a);
#else
    for (int k = 0; k < NPHASE; ++k) { a.ph_lo = k; a.ph_hi = k + 1; hipLaunchKernelGGL(mk_fwd, dim3(grid), dim3(NWAVES * 64), LDS_BYTES, stream, a); }
#endif
}
```

```cpp
#include <hip/hip_runtime.h>
#include <cstdio>
#include <cstdint>

#define LAS __attribute__((address_space(3)))
#define GAS __attribute__((address_space(1)))
typedef unsigned short bf16_t;
typedef short bf16x8 __attribute__((ext_vector_type(8)));
typedef short s16x4 __attribute__((ext_vector_type(4)));
typedef float f32x4 __attribute__((ext_vector_type(4)));
typedef float f32x2 __attribute__((ext_vector_type(2)));
typedef float f32x16 __attribute__((ext_vector_type(16)));
typedef unsigned u32x4 __attribute__((ext_vector_type(4)));
typedef unsigned u32x2 __attribute__((ext_vector_type(2)));

#ifndef N_LAUNCH_MODE
#define N_LAUNCH_MODE 1
#endif

constexpr int NB = 16, SEQ = 2048, DM = 1024, NT = NB * SEQ;
constexpr int NMEM = 256;
constexpr int ND = 3328;
constexpr int NG = 2816;
constexpr int DSA_W = 3144, GLA_W = 2576;
constexpr int NEXP = 32;
constexpr int SLOT_ROWS = 73728;
constexpr float ALPHA = 1.4142135623730951f;
constexpr float LN_EPS = 1e-5f, RMS_EPS = 1e-6f;
constexpr float LOG2E = 1.4426950408889634f;
constexpr float C2 = 0.125f * LOG2E;
constexpr int NWAVES = 8;

constexpr size_t MiB = 1u << 20;
constexpr size_t WS_CTL = 0, CTL_ZERO_BYTES = 1 * MiB;
constexpr size_t WS_ROPEC = 1 * MiB, WS_ROPES = 5 * MiB;
constexpr size_t WS_DEC = 9 * MiB;
constexpr size_t WS_WD = 10 * MiB, WS_WG = 17 * MiB, WS_WKV = 23 * MiB, WS_WO = 25 * MiB, WS_W13 = 29 * MiB, WS_W2 = 61 * MiB;
constexpr size_t WS_KVM = 77 * MiB;
constexpr size_t WS_MEMB = 85 * MiB;
constexpr size_t WS_LISTTOK = 85 * MiB, WS_LISTW = 89 * MiB;
constexpr size_t WS_TOKSLOT = 93 * MiB;
constexpr size_t WS_A = 96 * MiB;
constexpr size_t WS_B = 160 * MiB;
constexpr size_t WS_C = 288 * MiB;
constexpr size_t WS_D = 352 * MiB;
constexpr size_t WS_END = 500 * MiB;
constexpr size_t WS_XB = WS_A;
constexpr size_t WS_Q = 160 * MiB, WS_K = 208 * MiB, WS_V = 256 * MiB, WS_QI = 304 * MiB, WS_QM = 336 * MiB, WS_KIW = 352 * MiB, WS_KI = 362 * MiB, WS_WI = 366 * MiB, WS_MASK = 368 * MiB, WS_AO0 = 376 * MiB;
constexpr size_t WS_X1 = WS_B, WS_X1B0 = WS_C, WS_ACT0 = WS_A, WS_Y = WS_D;
constexpr size_t WS_GV = 96 * MiB, WS_GQM = 144 * MiB, WS_GQ = 352 * MiB, WS_GK = 376 * MiB, WS_GR = 400 * MiB, WS_A1 = 448 * MiB, WS_KPT = 450 * MiB, WS_VT = WS_C, WS_AO1 = WS_B;
constexpr size_t WS_X1B1 = WS_A, WS_ACT1 = WS_C;
constexpr int KIW_P = 80;

constexpr int CW_CNT = 8192;
constexpr int CW_BAR = 4096;

__device__ __forceinline__ unsigned f2bf(float f) { unsigned u = __builtin_bit_cast(unsigned, f); return (u + 0x7fffu + ((u >> 16) & 1u)) >> 16; }
__device__ __forceinline__ unsigned pk2(float lo, float hi) { return f2bf(lo) | (f2bf(hi) << 16); }
__device__ __forceinline__ float bf2f(unsigned h) { return __builtin_bit_cast(float, h << 16); }
__device__ __forceinline__ float wave_sum(float v) {
#pragma unroll
    for (int o = 1; o < 64; o <<= 1) v += __shfl_xor(v, o);
    return v;
}
__device__ __forceinline__ float fast_exp2(float x) { return __builtin_amdgcn_exp2f(x); }
__device__ __forceinline__ float silu_f(float a) { return a * __builtin_amdgcn_rcpf(1.f + fast_exp2(-a * LOG2E)); }

namespace pg8 {
constexpr int BM = 256, BK = 64, HALF = 128, HTB = HALF * BK * 2, STAGE_BYTES = 8 * HTB, NXCD = 8, WGM = 8;
__host__ __device__ __forceinline__ int lds_byte(int r, int c) { const int st = (r >> 4) * 2 + (c >> 5), rr = r & 15, cc = c & 31, ob = rr * 64 + cc * 2; return st * 1024 + (ob ^ (((ob >> 9) & 1) << 5)); }
__host__ __device__ __forceinline__ void stage_rc(int b, int& R, int& C) { const int st = b / 1024, sb = b % 1024, swz = sb ^ (((sb >> 9) & 1) << 5); R = (st >> 1) * 16 + swz / 64; C = (st & 1) * 32 + (swz % 64) / 2; }
__host__ __device__ __forceinline__ int perm32(int rho) { const int n = rho >> 4, i = rho & 15; return 8 * (i >> 2) + 4 * n + (i & 3); }

struct Unit { int pm, pn, e, r0; };
struct Gemm { const bf16_t* A; const bf16_t* Bt; int M, N, K; };

struct StaticOrder {
    int nM, nN, nwg, G, c;
    __device__ void init(int M, int N, int G_, int c_) { nM = M / BM; nN = N / BM; nwg = nM * nN; G = G_; c = c_; }
    __device__ bool next(int i, Unit& u) const {
        const long L = (long)i * G + c; if (L >= nwg) return false;
        int wgid = (int)L; { const int q = nwg / NXCD, r = nwg % NXCD, xcd = wgid % NXCD, off = wgid / NXCD; wgid = (xcd < r ? xcd * (q + 1) : r * (q + 1) + (xcd - r) * q) + off; }
        const int nig = WGM * nN, gid = wgid / nig, fm = gid * WGM, gsz = (nM - fm) < WGM ? (nM - fm) : WGM;
        u.pm = fm + ((wgid % nig) % gsz); u.pn = (wgid % nig) / gsz; u.e = 0; u.r0 = 0; return true;
    }
    __device__ __forceinline__ int rowidx(const Unit& u, int r) const { return u.pm * BM + r; }
};

typedef __bf16 bf16x2_t __attribute__((ext_vector_type(2)));
__device__ __forceinline__ unsigned cvt_pk_bf16(float lo, float hi) { f32x2 v = {lo, hi}; bf16x2_t b = __builtin_convertvector(v, bf16x2_t); return __builtin_bit_cast(unsigned, b); }

template <class Epi, class Sched, bool ALIGN_EPI, bool SP2>
__device__ __forceinline__ void gemm_phase(LAS unsigned char* lds, const Gemm g, const Sched& S, const Epi& E) {
    const int tid = threadIdx.x, wid = __builtin_amdgcn_readfirstlane(tid >> 6), lane = tid & 63, wr = wid >> 2, wc = wid & 3, fr = lane & 15, fq = lane >> 4;
    const int K = g.K, nt = K / BK;
    int RA[2], CA[2]; unsigned voffB[2];
#pragma unroll
    for (int i = 0; i < 2; ++i) { int R, C; stage_rc(tid * 16 + i * 8192, R, C); const int Rb = (R & ~31) + perm32(R & 31);
        RA[i] = R; CA[i] = C; voffB[i] = (unsigned)(Rb * K + C) * 2u; }
    const size_t kstep = (size_t)(BK * 2);
    const size_t hstep = (size_t)HALF * K * 2;
    const size_t tstep = 2 * hstep;
    const unsigned ldsw = (unsigned)wid * 1024u;
    const int aoff = lds_byte(wr * 64 + fr, fq * 8), boff = lds_byte(wc * 32 + fr, fq * 8);
#define PG8_SA(b, h) (((b) * 2 + (h)) * HTB)
#define PG8_SB(b, h) ((4 + (b) * 2 + (h)) * HTB)
#define PG8_STAGE(bufoff, gbase, voff) do { _Pragma("unroll") for (int _i = 0; _i < 2; ++_i) \
        __builtin_amdgcn_global_load_lds((const unsigned*)((const char*)(gbase) + (voff)[_i]), (LAS unsigned*)(lds + (bufoff) + ldsw + _i * 8192), 16, 0, 0); } while (0)
#define PG8_LDA(dst, b, h) do { _Pragma("unroll") for (int m = 0; m < 4; ++m) _Pragma("unroll") for (int k = 0; k < 2; ++k) dst[m][k] = *(const LAS bf16x8*)(lds + PG8_SA(b, h) + aoff + m * 2048 + k * 1024); } while (0)
#define PG8_LDB(dst, b, h) do { _Pragma("unroll") for (int n = 0; n < 2; ++n) _Pragma("unroll") for (int k = 0; k < 2; ++k) dst[n][k] = *(const LAS bf16x8*)(lds + PG8_SB(b, h) + boff + n * 2048 + k * 1024); } while (0)
#define PG8_MMA(ai, bj, At, Bt) do { __builtin_amdgcn_s_setprio(1); _Pragma("unroll") for (int m = 0; m < 4; ++m) _Pragma("unroll") for (int n = 0; n < 2; ++n) _Pragma("unroll") for (int k = 0; k < 2; ++k) \
        acc[ai][bj][m][n] = __builtin_amdgcn_mfma_f32_16x16x32_bf16(Bt[n][k], At[m][k], acc[ai][bj][m][n], 0, 0, 0); __builtin_amdgcn_s_setprio(0); } while (0)
#define PG8_WAIT_V(n) asm volatile("s_waitcnt vmcnt(" #n ")" ::: "memory")
#define PG8_WAIT_L(n) asm volatile("s_waitcnt lgkmcnt(" #n ")" ::: "memory")
#define PG8_BAR __builtin_amdgcn_s_barrier()
#define PG8_SCHED __builtin_amdgcn_sched_barrier(0)
#define PG8_MKOFF(o0, o1, u) do { _Pragma("unroll") for (int _i = 0; _i < 2; ++_i) { \
        o0[_i] = ((unsigned)S.rowidx(u, RA[_i]) * (unsigned)K + (unsigned)CA[_i]) * 2u; o1[_i] = ((unsigned)S.rowidx(u, HALF + RA[_i]) * (unsigned)K + (unsigned)CA[_i]) * 2u; } } while (0)
    Unit cur, nxt; int ui = 0;
    if (!S.next(0, cur)) return;
    f32x4 acc[2][2][4][2];
#pragma unroll
    for (int a = 0; a < 2; ++a)
#pragma unroll
        for (int b = 0; b < 2; ++b)
#pragma unroll
            for (int m = 0; m < 4; ++m)
#pragma unroll
                for (int n = 0; n < 2; ++n) acc[a][b][m][n] = (f32x4){0.f, 0.f, 0.f, 0.f};
    bf16x8 At[4][2], B0[2][2], B1[2][2];
    const char* const gA = (const char*)g.A;
    unsigned cO0[2], cO1[2], nO0[2], nO1[2];
    PG8_MKOFF(cO0, cO1, cur);
    const char* cB = (const char*)g.Bt + (size_t)cur.pn * tstep;
    if constexpr (SP2) {
        PG8_STAGE(PG8_SB(0, 0), cB, voffB); PG8_STAGE(PG8_SB(0, 1), cB + hstep, voffB); PG8_STAGE(PG8_SA(0, 0), gA, cO0); PG8_STAGE(PG8_SA(0, 1), gA, cO1);
        if (wr == 1) PG8_BAR;
        PG8_WAIT_V(2); PG8_BAR;
        PG8_STAGE(PG8_SB(1, 0), cB + kstep, voffB); PG8_STAGE(PG8_SA(1, 0), gA + kstep, cO0); PG8_STAGE(PG8_SB(1, 1), cB + hstep + kstep, voffB);
        PG8_WAIT_V(6); PG8_BAR;
    } else {
        PG8_STAGE(PG8_SB(0, 0), cB, voffB); PG8_STAGE(PG8_SA(0, 0), gA, cO0); PG8_STAGE(PG8_SB(0, 1), cB + hstep, voffB); PG8_STAGE(PG8_SA(0, 1), gA, cO1);
        if (wr == 1) PG8_BAR;
        PG8_WAIT_V(4); PG8_BAR;
        PG8_STAGE(PG8_SB(1, 0), cB + kstep, voffB); PG8_STAGE(PG8_SA(1, 0), gA + kstep, cO0); PG8_STAGE(PG8_SB(1, 1), cB + hstep + kstep, voffB);
        PG8_WAIT_V(6); PG8_BAR;
    }
    for (;;) {
        const bool has_next = S.next(ui + 1, nxt);
        if (has_next) { PG8_MKOFF(nO0, nO1, nxt); } else {
#pragma unroll
            for (int _i = 0; _i < 2; ++_i) { nO0[_i] = cO0[_i]; nO1[_i] = cO1[_i]; } }
        const char* nB = has_next ? (const char*)g.Bt + (size_t)nxt.pn * tstep : cB;
#pragma unroll 1
        for (int t = 0; t < nt; t += 2) {
            const bool last = (t == nt - 2);
            const char* a1 = gA + (size_t)(t + 1) * kstep;
            const char* a2 = last ? gA : gA + (size_t)(t + 2) * kstep; const char* b2 = last ? nB : cB + (size_t)(t + 2) * kstep;
            const char* a3 = a2 + kstep; const char* b3 = b2 + kstep;
            unsigned x0[2], x1[2];
#pragma unroll
            for (int _i = 0; _i < 2; ++_i) { x0[_i] = last ? nO0[_i] : cO0[_i]; x1[_i] = last ? nO1[_i] : cO1[_i]; }
            if constexpr (SP2) {
            PG8_LDB(B0, 0, 0); PG8_LDB(B1, 0, 1); PG8_SCHED; PG8_LDA(At, 0, 0); PG8_STAGE(PG8_SA(1, 1), a1, cO1);
            PG8_WAIT_V(8); PG8_WAIT_L(0); PG8_BAR; PG8_MMA(0, 0, At, B0); PG8_MMA(0, 1, At, B1); PG8_BAR; PG8_SCHED;
            PG8_LDA(At, 0, 1); PG8_STAGE(PG8_SB(0, 0), b2, voffB); PG8_STAGE(PG8_SB(0, 1), b2 + hstep, voffB); PG8_STAGE(PG8_SA(0, 0), a2, x0);
            PG8_WAIT_V(8); PG8_WAIT_L(0); PG8_BAR; PG8_MMA(1, 0, At, B0); PG8_MMA(1, 1, At, B1); PG8_BAR; PG8_SCHED;
            PG8_LDB(B0, 1, 0); PG8_LDB(B1, 1, 1); PG8_SCHED; PG8_LDA(At, 1, 0); PG8_STAGE(PG8_SA(0, 1), a2, x1);
            PG8_WAIT_V(8); PG8_WAIT_L(0); PG8_BAR; PG8_MMA(0, 0, At, B0); PG8_MMA(0, 1, At, B1); PG8_BAR; PG8_SCHED;
            PG8_LDA(At, 1, 1); PG8_STAGE(PG8_SB(1, 0), b3, voffB); PG8_STAGE(PG8_SB(1, 1), b3 + hstep, voffB); PG8_STAGE(PG8_SA(1, 0), a3, x0);
            PG8_WAIT_V(8); PG8_WAIT_L(0); PG8_BAR; PG8_MMA(1, 0, At, B0); PG8_MMA(1, 1, At, B1); PG8_BAR; PG8_SCHED;
            } else {
            PG8_LDB(B0, 0, 0); PG8_SCHED; PG8_LDA(At, 0, 0); PG8_STAGE(PG8_SA(1, 1), a1, cO1);
            PG8_WAIT_L(8); PG8_BAR; PG8_WAIT_L(0); PG8_MMA(0, 0, At, B0); PG8_BAR; PG8_SCHED;
            PG8_LDB(B1, 0, 1); PG8_STAGE(PG8_SB(0, 0), b2, voffB);
            PG8_BAR; PG8_WAIT_L(0); PG8_MMA(0, 1, At, B1); PG8_BAR;
            PG8_LDA(At, 0, 1); PG8_STAGE(PG8_SA(0, 0), a2, x0);
            PG8_BAR; PG8_WAIT_L(0); PG8_MMA(1, 0, At, B0); PG8_BAR; PG8_SCHED;
            PG8_STAGE(PG8_SB(0, 1), b2 + hstep, voffB);
            PG8_WAIT_V(6); PG8_BAR; PG8_MMA(1, 1, At, B1); PG8_BAR;
            PG8_LDB(B0, 1, 0); PG8_SCHED; PG8_LDA(At, 1, 0); PG8_STAGE(PG8_SA(0, 1), a2, x1);
            PG8_WAIT_L(8); PG8_BAR; PG8_WAIT_L(0); PG8_MMA(0, 0, At, B0); PG8_BAR; PG8_SCHED;
            PG8_LDB(B1, 1, 1); PG8_STAGE(PG8_SB(1, 0), b3, voffB);
            PG8_BAR; PG8_WAIT_L(0); PG8_MMA(0, 1, At, B1); PG8_BAR;
            PG8_LDA(At, 1, 1); PG8_STAGE(PG8_SA(1, 0), a3, x0);
            PG8_BAR; PG8_WAIT_L(0); PG8_MMA(1, 0, At, B0); PG8_BAR; PG8_SCHED;
            PG8_STAGE(PG8_SB(1, 1), b3 + hstep, voffB);
            PG8_WAIT_V(6); PG8_BAR; PG8_MMA(1, 1, At, B1); PG8_BAR;
            }
        }
        if constexpr (ALIGN_EPI) { if (wr == 0) PG8_BAR; }
        E(acc, cur, wr, wc, fr, fq);
        if (!has_next) break;
#pragma unroll
        for (int a = 0; a < 2; ++a)
#pragma unroll
            for (int b = 0; b < 2; ++b)
#pragma unroll
                for (int m = 0; m < 4; ++m)
#pragma unroll
                    for (int n = 0; n < 2; ++n) acc[a][b][m][n] = (f32x4){0.f, 0.f, 0.f, 0.f};
        cur = nxt; cB = nB; ++ui;
#pragma unroll
        for (int _i = 0; _i < 2; ++_i) { cO0[_i] = nO0[_i]; cO1[_i] = nO1[_i]; }
        if constexpr (ALIGN_EPI) { if (wr == 1) PG8_BAR; }
    }
    PG8_WAIT_V(0);
    if constexpr (!ALIGN_EPI) { if (wr == 0) PG8_BAR; }
    PG8_BAR;
#undef PG8_SA
#undef PG8_SB
#undef PG8_STAGE
#undef PG8_LDA
#undef PG8_LDB
#undef PG8_MMA
#undef PG8_WAIT_V
#undef PG8_WAIT_L
#undef PG8_BAR
#undef PG8_SCHED
#undef PG8_MKOFF
}
}

#define XB_TMO      128
#define XB_XCNT(j)  (256  + 64 * (j))
#define XB_XSUB(j)  (1280 + 64 * (j))
#define XB_XGEN(j)  (2304 + 64 * (j))
#define XB_TOP      3328
#define XB_TOPGEN   3392
#define XCD_BAR_WORDS 3456
#define XB_SPIN_CAP (1u << 18)
__device__ __forceinline__ unsigned xb_ld(unsigned* p)              { return __hip_atomic_load(p, __ATOMIC_RELAXED, __HIP_MEMORY_SCOPE_AGENT); }
__device__ __forceinline__ unsigned xb_add(unsigned* p, unsigned v) { return __hip_atomic_fetch_add(p, v, __ATOMIC_RELAXED, __HIP_MEMORY_SCOPE_AGENT); }
__device__ __forceinline__ unsigned xb_xcc_id() { return (unsigned)__builtin_amdgcn_s_getreg((3 << 11) | 20) & 0xFu; }
#define XB_SPIN(cond, bar) do { unsigned _sp = 0; while (cond) { __builtin_amdgcn_s_sleep(1); \
    if ((++_sp & 255u) == 0u) { if (xb_ld(&(bar)[XB_TMO])) break; if (_sp > XB_SPIN_CAP) { atomicAdd(&(bar)[XB_TMO], 1u); break; } } } } while (0)
struct XcdBarrier { unsigned* bar; unsigned x; volatile LAS unsigned* st; };
__device__ __forceinline__ XcdBarrier xcd_barrier_post(unsigned* bar, volatile LAS unsigned* st) {
    XcdBarrier b; b.bar = bar; b.x = xb_xcc_id(); b.st = st;
    if (threadIdx.x == 0) (void)xb_add(&bar[XB_XCNT(b.x)], 1u);
    return b;
}
__device__ __forceinline__ void xcd_barrier_complete(unsigned* bar, unsigned x, unsigned& nloc, unsigned& nx) {
    const unsigned G = gridDim.x * gridDim.y * gridDim.z;
    unsigned sum, cnt, mine, sp = 0u;
    for (;;) {
        sum = 0u; cnt = 0u; mine = 0u;
#pragma unroll
        for (unsigned j = 0; j < 16; ++j) { const unsigned c = xb_ld(&bar[XB_XCNT(j)]); sum += c; cnt += (c > 0u) ? 1u : 0u; mine = (j == x) ? c : mine; }
        if (sum == G) break;
        __builtin_amdgcn_s_sleep(1);
        if ((++sp & 255u) == 0u) { if (xb_ld(&bar[XB_TMO])) break; if (sp > XB_SPIN_CAP) { atomicAdd(&bar[XB_TMO], 1u); break; } }
    }
    nloc = mine > 0u ? mine : 1u; nx = cnt > 0u ? cnt : 1u;
}
__device__ __forceinline__ void xcd_barrier(const XcdBarrier& b) {
    asm volatile("s_waitcnt vmcnt(0)" ::: "memory");
    __syncthreads();
    if (threadIdx.x == 0) {
        unsigned* bar = b.bar;
        __builtin_amdgcn_s_waitcnt(0);
        unsigned nloc = b.st[0], nx = b.st[1];
        if (nloc == 0u) { xcd_barrier_complete(bar, b.x, nloc, nx); b.st[0] = nloc; b.st[1] = nx; }
        const unsigned old = xb_add(&bar[XB_XSUB(b.x)], 1u);
        const unsigned gen = old / nloc;
        if (old + 1u == (gen + 1u) * nloc) {
            __builtin_amdgcn_fence(__ATOMIC_RELEASE, "agent");
            asm volatile("s_waitcnt vmcnt(0)" ::: "memory");
            const unsigned og = xb_add(&bar[XB_TOP], 1u);
            const unsigned tg = og / nx;
            if (og + 1u == (tg + 1u) * nx) xb_add(&bar[XB_TOPGEN], 1u);
            else XB_SPIN(xb_ld(&bar[XB_TOPGEN]) == tg, bar);
            __builtin_amdgcn_fence(__ATOMIC_ACQUIRE, "agent");
            xb_add(&bar[XB_XGEN(b.x)], 1u);
            asm volatile("s_waitcnt vmcnt(0)" ::: "memory");
        } else {
            XB_SPIN(xb_ld(&bar[XB_XGEN(b.x)]) == gen, bar);
            __builtin_amdgcn_fence(__ATOMIC_ACQUIRE, "agent");
            asm volatile("s_waitcnt vmcnt(0)" ::: "memory");
        }
    }
    __syncthreads();
}

constexpr int LDS_BYTES = 147456;
constexpr int MISC_OFF = 135168;
struct Args { const void* in[22]; float* out; unsigned char* ws; int ph_lo, ph_hi; };
struct Frame {
    LAS unsigned char* lds;
    unsigned char* ws; float* out;
    unsigned* ctl;
    int tid, lane, wave, G, gw, NGW;
};
enum { I_X = 0, I_MEM, I_POS, I_DSA_WIN, I_DSA_KG, I_DSA_KB, I_GLA_WIN, I_GLA_WGATE, I_GLA_BGATE, I_GLA_NORMG, I_WMEMKV, I_WOUT, I_LN1G, I_LN1B, I_LN2G, I_LN2B,
       I_MOE_WG, I_MOE_BG, I_MOE_WR, I_MOE_BR, I_MOE_W13, I_MOE_W2 };

__device__ __forceinline__ int dperm(int c) { return ((c >> 2) & 1) * 32 + (c >> 5) * 16 + ((c >> 3) & 3) * 4 + (c & 3); }
__device__ __forceinline__ int dperm_inv(int d) { const int n = d >> 5, i = d & 31; return (i >> 4) * 32 + ((i >> 2) & 3) * 8 + n * 4 + (i & 3); }
__device__ __forceinline__ int dsa_srccol(int n) {
    if (n < 1536) { return (n & ~63) + dperm(n & 63); }
    if (n < 2304) return n;
    if (n < 2816) { return (n & ~63) + dperm(n & 63); }
    if (n < 3072) return 2888 + (n - 2816);
    if (n < 3136) return 2816 + dperm(n - 3072);
    if (n < 3144) return 2880 + (n - 3136);
    return -1;
}
__device__ __forceinline__ int gla_srccol(int n) {
    if (n < 2304) return n;
    if (n < 2560) return 2320 + (n - 2304);
    if (n < 2576) return 2304 + (n - 2560);
    return -1;
}
__device__ __forceinline__ int w13_srccol(int r) { const int pn = r >> 8, bj = (r >> 7) & 1, j = r & 127; return bj * 256 + pn * 128 + j; }
template <int MODE>
__device__ __forceinline__ void transpose_item(const float* W, int K, int ldw, bf16_t* WT, int nrows32, LAS float* scr, int item, int lane) {
    const int kb = item / nrows32, nb = item % nrows32, k0 = 64 * kb, n0 = 32 * nb;
    const int n = n0 + (lane & 31);
    int sc;
    if (MODE == 0) sc = n; else if (MODE == 1) sc = dsa_srccol(n); else if (MODE == 2) sc = gla_srccol(n); else sc = w13_srccol(n);
#pragma unroll 8
    for (int i = 0; i < 32; ++i) { const int kk = 2 * i + (lane >> 5); scr[kk * 33 + (lane & 31)] = (sc >= 0) ? W[(size_t)(k0 + kk) * ldw + sc] : 0.f; }
    asm volatile("s_waitcnt lgkmcnt(0)" ::: "memory");
    const int c = lane & 7;
#pragma unroll
    for (int j = 0; j < 4; ++j) { const int nn = (lane >> 3) + 8 * j; const LAS float* s = scr + (8 * c) * 33 + nn;
        u32x4 o; o.x = pk2(s[0 * 33], s[1 * 33]); o.y = pk2(s[2 * 33], s[3 * 33]); o.z = pk2(s[4 * 33], s[5 * 33]); o.w = pk2(s[6 * 33], s[7 * 33]);
        *(u32x4*)(WT + (size_t)(n0 + nn) * K + k0 + 8 * c) = o; }
    asm volatile("s_waitcnt lgkmcnt(0)" ::: "memory");
}
__device__ __forceinline__ void moe_weight_items(Frame& F, const float* w13, const float* w2, int layer) {
    LAS float* scr = (LAS float*)(F.lds + F.wave * 16384);
    bf16_t* W13 = (bf16_t*)(F.ws + WS_W13); bf16_t* W2 = (bf16_t*)(F.ws + WS_W2);
    constexpr int I13 = (1024 / 64) * (512 / 32), I2 = (256 / 64) * (1024 / 32);
    for (int it = F.gw; it < NEXP * (I13 + I2); it += F.NGW) {
        const int ge = it / (I13 + I2), r = it % (I13 + I2);
        if (r < I13) transpose_item<3>(w13 + ((size_t)layer * NEXP + ge) * 1024 * 512, 1024, 512, W13 + (size_t)ge * 512 * 1024, 16, scr, r, F.lane);
        else transpose_item<0>(w2 + ((size_t)layer * NEXP + ge) * 256 * 1024, 256, 1024, W2 + (size_t)ge * 1024 * 256, 32, scr, r - I13, F.lane);
    }
}
__device__ __forceinline__ void cvt_rows_bf16(Frame& F, const float* src, bf16_t* dst, int rows) {
    for (int m = F.gw; m < rows; m += F.NGW) {
        const f32x4* xr = (const f32x4*)(src + (size_t)m * DM) + F.lane; u32x2* o = (u32x2*)(dst + (size_t)m * DM) + F.lane;
#pragma unroll
        for (int j = 0; j < 4; ++j) { const f32x4 v = xr[64 * j]; u32x2 w; w.x = pk2(v.x, v.y); w.y = pk2(v.z, v.w); o[64 * j] = w; }
    }
}
__device__ __forceinline__ void p_prologue(Frame& F, const Args& a) {
    LAS float* scr = (LAS float*)(F.lds + F.wave * 16384);
    const float* dsa_w = (const float*)a.in[I_DSA_WIN]; const float* gla_w = (const float*)a.in[I_GLA_WIN];
    const float* wkv = (const float*)a.in[I_WMEMKV]; const float* wout = (const float*)a.in[I_WOUT];
    bf16_t* WD = (bf16_t*)(F.ws + WS_WD); bf16_t* WG = (bf16_t*)(F.ws + WS_WG); bf16_t* WKV = (bf16_t*)(F.ws + WS_WKV); bf16_t* WO = (bf16_t*)(F.ws + WS_WO);
    constexpr int ID = 16 * (ND / 32), IG = 16 * (NG / 32), IKV = 16 * (512 / 32), IO = 16 * (1024 / 32);
    constexpr int NIT = ID + IG + 2 * IKV + 2 * IO;
    for (int it = F.gw; it < NIT; it += F.NGW) {
        int r = it;
        if (r < ID) { transpose_item<1>(dsa_w, 1024, DSA_W, WD, ND / 32, scr, r, F.lane); continue; } r -= ID;
        if (r < IG) { transpose_item<2>(gla_w, 1024, GLA_W, WG, NG / 32, scr, r, F.lane); continue; } r -= IG;
        if (r < 2 * IKV) { const int l = r / IKV; transpose_item<0>(wkv + (size_t)l * 1024 * 512, 1024, 512, WKV + (size_t)l * 512 * 1024, 16, scr, r % IKV, F.lane); continue; } r -= 2 * IKV;
        { const int l = r / IO; transpose_item<0>(wout + (size_t)l * 1024 * 1024, 1024, 1024, WO + (size_t)l * 1024 * 1024, 32, scr, r % IO, F.lane); }
    }
    moe_weight_items(F, (const float*)a.in[I_MOE_W13], (const float*)a.in[I_MOE_W2], 0);
    cvt_rows_bf16(F, (const float*)a.in[I_X], (bf16_t*)(F.ws + WS_XB), NT);
    cvt_rows_bf16(F, (const float*)a.in[I_MEM], (bf16_t*)(F.ws + WS_MEMB), NB * NMEM);
    const int* pos = (const int*)a.in[I_POS];
    float* RC = (float*)(F.ws + WS_ROPEC); float* RS = (float*)(F.ws + WS_ROPES);
    __syncthreads();
    LAS float* invs = (LAS float*)F.lds;
    if (F.tid < 32) invs[F.tid] = (float)pow(10000.0, -(double)(2 * F.tid) / 64.0);
    __syncthreads();
    for (int idx = blockIdx.x * 512 + F.tid; idx < NT * 32; idx += F.G * 512) {
        const int t = idx >> 5, i = idx & 31;
        const float ang = (float)pos[t] * invs[i];
        float sn, cs; sincosf(ang, &sn, &cs);
        RC[idx] = cs; RS[idx] = sn;
    }
}
typedef const f32x4 (&AccRef)[2][2][4][2];
__device__ __forceinline__ void st_bf16x8(bf16_t* p, f32x4 v0, f32x4 v1) {
    u32x4 w; w.x = pg8::cvt_pk_bf16(v0[0], v0[1]); w.y = pg8::cvt_pk_bf16(v0[2], v0[3]); w.z = pg8::cvt_pk_bf16(v1[0], v1[1]); w.w = pg8::cvt_pk_bf16(v1[2], v1[3]);
    *(u32x4*)p = w;
}
struct EpiDsaProj {
    bf16_t *Q, *K, *V, *QI, *QM, *KI; float* WI; const float *RC, *RS, *kg, *kb; LAS unsigned char* xlds;
    __device__ __forceinline__ void operator()(AccRef acc, const pg8::Unit& u, int wr, int wc, int fr, int fq) const {
        const int pn = u.pn; const int row0 = u.pm * 256 + wr * 64 + fr;
        const int i0 = 16 * (wc & 1) + 4 * fq;
#pragma unroll
        for (int ai = 0; ai < 2; ++ai)
#pragma unroll
            for (int m = 0; m < 4; ++m) {
                const int row = row0 + ai * 128 + m * 16;
                f32x4 c4 = (f32x4){1.f, 1.f, 1.f, 1.f}, s4 = (f32x4){0.f, 0.f, 0.f, 0.f};
                const bool rope = (pn < 6) || (pn == 9) || (pn == 10);
                if (rope) { c4 = *(const f32x4*)(RC + (size_t)row * 32 + i0); s4 = *(const f32x4*)(RS + (size_t)row * 32 + i0); }
#pragma unroll
                for (int bj = 0; bj < 2; ++bj) {
                    const int gcol = pn * 256 + bj * 128 + wc * 32 + 8 * fq;
                    f32x4 v0 = acc[ai][bj][m][0], v1 = acc[ai][bj][m][1];
                    if (rope) { const f32x4 y0 = v0 * c4 - v1 * s4, y1 = v1 * c4 + v0 * s4; v0 = y0; v1 = y1; }
                    if (pn < 3) { v0 = v0 * C2; v1 = v1 * C2; st_bf16x8(Q + (size_t)row * 768 + gcol, v0, v1); }
                    else if (pn < 6) st_bf16x8(K + (size_t)row * 768 + (gcol - 768), v0, v1);
                    else if (pn < 9) st_bf16x8(V + (size_t)row * 768 + (gcol - 1536), v0, v1);
                    else if (pn < 11) st_bf16x8(QI + (size_t)row * 512 + (gcol - 2304), v0, v1);
                    else if (pn == 11) { v0 = v0 * C2; v1 = v1 * C2; st_bf16x8(QM + (size_t)row * 256 + (gcol - 2816), v0, v1); }
                }
            }
        if (pn == 12) ki_tile(acc, u, wr, wc, fr, fq);
    }
    __device__ __forceinline__ void ki_tile(AccRef acc, const pg8::Unit& u, int wr, int wc, int fr, int fq) const {
        LAS f32x2* xch = (LAS f32x2*)xlds;
        const int row0 = u.pm * 256 + wr * 64 + fr;
        if (wc < 2) {
#pragma unroll
            for (int ai = 0; ai < 2; ++ai)
#pragma unroll
                for (int m = 0; m < 4; ++m) { const f32x4 v0 = acc[ai][0][m][0], v1 = acc[ai][0][m][1];
                    float a = ((v0[0] + v0[1]) + (v0[2] + v0[3])) + ((v1[0] + v1[1]) + (v1[2] + v1[3]));
                    float b = ((v0[0] * v0[0] + v0[1] * v0[1]) + (v0[2] * v0[2] + v0[3] * v0[3])) + ((v1[0] * v1[0] + v1[1] * v1[1]) + (v1[2] * v1[2] + v1[3] * v1[3]));
                    a += __shfl_xor(a, 16); b += __shfl_xor(b, 16); a += __shfl_xor(a, 32); b += __shfl_xor(b, 32);
                    if (fq == 0) xch[(((wr * 2 + wc) * 2 + ai) * 4 + m) * 16 + fr] = (f32x2){a, b}; }
        }
        asm volatile("s_waitcnt lgkmcnt(0)" ::: "memory"); __builtin_amdgcn_s_barrier(); asm volatile("" ::: "memory");
        if (wc < 2) {
            const int c0 = 32 * wc + 8 * fq, i0 = 16 * wc + 4 * fq;
            f32x4 g0, g1, b0, b1;
#pragma unroll
            for (int j = 0; j < 4; ++j) { g0[j] = kg[dperm(c0 + j)]; g1[j] = kg[dperm(c0 + 4 + j)]; b0[j] = kb[dperm(c0 + j)]; b1[j] = kb[dperm(c0 + 4 + j)]; }
#pragma unroll
            for (int ai = 0; ai < 2; ++ai)
#pragma unroll
                for (int m = 0; m < 4; ++m) { const int row = row0 + ai * 128 + m * 16;
                    const f32x2 ot = xch[(((wr * 2 + 1) * 2 + ai) * 4 + m) * 16 + fr], ow = xch[(((wr * 2 + 0) * 2 + ai) * 4 + m) * 16 + fr];
                    const float mu = (ow.x + ot.x) * (1.f / 64.f); const float var = fmaxf((ow.y + ot.y) * (1.f / 64.f) - mu * mu, 0.f);
                    const float rs = 1.f / sqrtf(var + LN_EPS);
                    const f32x4 n0 = (acc[ai][0][m][0] - mu) * rs * g0 + b0, n1 = (acc[ai][0][m][1] - mu) * rs * g1 + b1;
                    const f32x4 c4 = *(const f32x4*)(RC + (size_t)row * 32 + i0), s4 = *(const f32x4*)(RS + (size_t)row * 32 + i0);
                    st_bf16x8(KI + (size_t)row * 64 + c0, n0 * c4 - n1 * s4, n1 * c4 + n0 * s4); }
        } else if (wc == 2 && fq == 0) {
#pragma unroll
            for (int ai = 0; ai < 2; ++ai)
#pragma unroll
                for (int m = 0; m < 4; ++m) { float* p = WI + (size_t)(row0 + ai * 128 + m * 16) * 8;
                    *(f32x4*)p = acc[ai][0][m][0] * 0.04419417382415922f; *(f32x4*)(p + 4) = acc[ai][0][m][1] * 0.04419417382415922f; }
        }
        asm volatile("s_waitcnt lgkmcnt(0)" ::: "memory"); __builtin_amdgcn_s_barrier(); asm volatile("" ::: "memory");
    }
};
struct EpiGlaProj {
    bf16_t *GQ, *GK, *GV, *GR, *GQM; float* A1;
    __device__ __forceinline__ void operator()(AccRef acc, const pg8::Unit& u, int wr, int wc, int fr, int fq) const {
        const int pn = u.pn; const int row0 = u.pm * 256 + wr * 64 + fr;
#pragma unroll
        for (int ai = 0; ai < 2; ++ai)
#pragma unroll
            for (int m = 0; m < 4; ++m) {
                const int row = row0 + ai * 128 + m * 16;
#pragma unroll
                for (int bj = 0; bj < 2; ++bj) {
                    const int gcol = pn * 256 + bj * 128 + wc * 32 + 8 * fq;
                    f32x4 v0 = acc[ai][bj][m][0], v1 = acc[ai][bj][m][1];
                    if (pn < 3) {
                        if (gcol < 384) { v0 = v0 * 0.10206207261596577f; v1 = v1 * 0.10206207261596577f; st_bf16x8(GQ + (size_t)row * 384 + gcol, v0, v1); }
                        else st_bf16x8(GK + (size_t)row * 384 + (gcol - 384), v0, v1);
                    }
                    else if (pn < 6) st_bf16x8(GV + (size_t)row * 768 + (gcol - 768), v0, v1);
                    else if (pn < 9) st_bf16x8(GR + (size_t)row * 768 + (gcol - 1536), v0, v1);
                    else if (pn == 9) { v0 = v0 * C2; v1 = v1 * C2; st_bf16x8(GQM + (size_t)row * 256 + (gcol - 2304), v0, v1); }
                    else { const int lc = gcol - 2560; if (lc < 16) { float* p = A1 + (size_t)row * 16 + lc; *(f32x4*)p = v0; *(f32x4*)(p + 4) = v1; } }
                }
            }
    }
};
struct EpiBf16Plain {
    bf16_t* O; int ldc; int ncolmask;
    __device__ __forceinline__ void operator()(AccRef acc, const pg8::Unit& u, int wr, int wc, int fr, int fq) const {
        const int row0 = u.pm * 256 + wr * 64 + fr; const int colt = (u.pn & ncolmask) * 256 + wc * 32 + 8 * fq;
#pragma unroll
        for (int ai = 0; ai < 2; ++ai)
#pragma unroll
            for (int m = 0; m < 4; ++m) { bf16_t* rowp = O + (size_t)(row0 + ai * 128 + m * 16) * ldc + colt;
#pragma unroll
                for (int bj = 0; bj < 2; ++bj) st_bf16x8(rowp + bj * 128, acc[ai][bj][m][0], acc[ai][bj][m][1]); }
    }
};
struct EpiF32Plain {
    float* C; int ldc;
    __device__ __forceinline__ void operator()(AccRef acc, const pg8::Unit& u, int wr, int wc, int fr, int fq) const {
        const int row0 = u.pm * 256 + wr * 64 + fr; const int colt = u.pn * 256 + wc * 32 + 8 * fq;
#pragma unroll
        for (int ai = 0; ai < 2; ++ai)
#pragma unroll
            for (int m = 0; m < 4; ++m) { float* rowp = C + (size_t)(row0 + ai * 128 + m * 16) * ldc + colt;
#pragma unroll
                for (int bj = 0; bj < 2; ++bj) { *(f32x4*)(rowp + bj * 128) = acc[ai][bj][m][0]; *(f32x4*)(rowp + bj * 128 + 4) = acc[ai][bj][m][1]; } }
    }
};

struct DsaKvmOrder {
    pg8::StaticOrder so; int G, c;
    __device__ void init(int G_, int c_) { so.init(NT, ND, G_, c_); G = G_; c = c_; }
    __device__ bool next(int i, pg8::Unit& u) const {
        const long L = (long)i * G + c;
        if (L < so.nwg) { so.next(i, u); u.e = 0; u.r0 = u.pn; u.pn += (int)(WS_WD / (512 * 1024)); return true; }
        const int k = (int)(L - so.nwg); if (k >= 64) return false;
        u.pm = k >> 2; u.r0 = k & 3; u.pn = (int)(WS_WKV / (512 * 1024)) + (k & 3); u.e = 1; return true;
    }
    __device__ __forceinline__ int rowidx(const pg8::Unit& u, int r) const { return (u.e ? (int)(WS_MEMB / 2048) : (int)(WS_XB / 2048)) + u.pm * 256 + r; }
};
struct EpiDsaKvm {
    EpiDsaProj d; EpiBf16Plain k;
    __device__ __forceinline__ void operator()(AccRef acc, const pg8::Unit& u, int wr, int wc, int fr, int fq) const {
        pg8::Unit v = u; v.pn = u.r0;
        if (u.e == 0) d(acc, v, wr, wc, fr, fq); else k(acc, v, wr, wc, fr, fq);
    }
};
struct EpiMoe1 {
    bf16_t* ACT; const float* LISTW; const unsigned* cnt;
    __device__ __forceinline__ void operator()(AccRef acc, const pg8::Unit& u, int wr, int wc, int fr, int fq) const {
        const int j2 = u.pn & 1; const int rl0 = wr * 64 + fr; const int ce = (int)cnt[u.e * 64];
#pragma unroll
        for (int ai = 0; ai < 2; ++ai)
#pragma unroll
            for (int m = 0; m < 4; ++m) {
                const int rl = rl0 + ai * 128 + m * 16; const int pos = u.r0 + rl;
                const float wt = (pos < ce) ? LISTW[(size_t)u.e * NT + pos] : 0.f;
                f32x4 a0 = acc[ai][0][m][0], a1 = acc[ai][0][m][1], u0 = acc[ai][1][m][0], u1 = acc[ai][1][m][1], o0, o1;
#pragma unroll
                for (int j = 0; j < 4; ++j) { o0[j] = silu_f(a0[j]) * u0[j] * wt; o1[j] = silu_f(a1[j]) * u1[j] * wt; }
                st_bf16x8(ACT + (size_t)(u.pm * 256 + rl) * 256 + j2 * 128 + wc * 32 + 8 * fq, o0, o1);
            }
    }
};
struct MoeOrder {
    const LAS int* tp; const unsigned* cnt; const int* LISTTOK; int ncol, G, c; bool gather;
    __device__ bool next(int i, pg8::Unit& u) const {
        const long L = (long)i * G + c; const int ntile = tp[NEXP];
        if (L >= (long)ntile * ncol) return false;
        const int tile = (int)(L / ncol), col = (int)(L % ncol);
        int e = 0;
#pragma unroll 1
        while (tp[e + 1] <= tile) ++e;
        u.pm = tile; u.pn = e * ncol + col; u.e = e; u.r0 = (tile - tp[e]) * 256; return true;
    }
    __device__ __forceinline__ int rowidx(const pg8::Unit& u, int r) const {
        if (!gather) return u.pm * 256 + r;
        const int pos = u.r0 + r;
        return (pos < (int)cnt[u.e * 64]) ? LISTTOK[(size_t)u.e * NT + pos] : 0;
    }
};
__device__ __forceinline__ void moe_tile_table(Frame& F, const unsigned* cnt, LAS int* tp) {
    if (F.tid == 0) { int s = 0; for (int e = 0; e < NEXP; ++e) { tp[e] = s; s += ((int)cnt[e * 64] + 255) >> 8; } tp[NEXP] = s; }
    __syncthreads();
}

__device__ __forceinline__ void p_ki(Frame& F, const Args& a) {
    const float* KIW = (const float*)(F.ws + WS_KIW); bf16_t* KI = (bf16_t*)(F.ws + WS_KI); float* WI = (float*)(F.ws + WS_WI);
    const float* RC = (const float*)(F.ws + WS_ROPEC); const float* RS = (const float*)(F.ws + WS_ROPES);
    const float* g = (const float*)a.in[I_DSA_KG]; const float* bb = (const float*)a.in[I_DSA_KB];
    const int d = F.lane; const float gd = g[d], bd = bb[d]; const int dst = dperm_inv(d);
    for (int t = F.gw; t < NT; t += F.NGW) {
        const float v = KIW[(size_t)t * KIW_P + d];
        const float mu = wave_sum(v) * (1.f / 64.f); const float dv = v - mu;
        const float var = wave_sum(dv * dv) * (1.f / 64.f);
        const float n = dv * (1.f / sqrtf(var + LN_EPS)) * gd + bd;
        const float pr = __shfl_xor(n, 32);
        const float c = RC[(size_t)t * 32 + (d & 31)], s = RS[(size_t)t * 32 + (d & 31)];
        const float o = (d < 32) ? (n * c - pr * s) : (n * c + pr * s);
        KI[(size_t)t * 64 + dst] = (bf16_t)f2bf(o);
        if (d < 8) WI[(size_t)t * 8 + d] = KIW[(size_t)t * KIW_P + 64 + d] * 0.04419417382415922f;
    }
}

__device__ __forceinline__ unsigned ordkey(float f) { const unsigned u = __builtin_bit_cast(unsigned, f); return (u & 0x80000000u) ? ~u : (u | 0x80000000u); }
template <int NQ>
__device__ __forceinline__ void topk_select(const LAS float* sc, unsigned long long* MASK, size_t rowbase, int t0, int wave, int lane) {
#pragma unroll 1
    for (int u = 0; u < 2; ++u) {
        const int tk = 2 * wave + u, t = t0 + tk;
        unsigned key[NQ];
#pragma unroll
        for (int q = 0; q < NQ; ++q) { const unsigned k = ordkey(sc[tk * 2048 + lane + 64 * q]); key[q] = (lane + 64 * q <= t) ? k : 0u; }
        unsigned T = 0u; bool exact = false;
#pragma unroll 1
        for (int bit = 31; bit >= 0; --bit) {
            const unsigned cand = T | (1u << bit); int c = 0;
#pragma unroll
            for (int q = 0; q < NQ; ++q) c += __builtin_popcountll(__ballot(key[q] >= cand));
            if (c >= 256) { T = cand; if (c == 256) { exact = true; break; } }
        }
        int need = 0, ceq = 0;
        if (!exact) { int cgt = 0;
#pragma unroll
            for (int q = 0; q < NQ; ++q) { cgt += __builtin_popcountll(__ballot(key[q] > T)); ceq += __builtin_popcountll(__ballot(key[q] == T)); }
            need = 256 - cgt; }
        unsigned long long mymask = 0ull;
        if (exact || need == ceq) {
#pragma unroll
            for (int q = 0; q < NQ; ++q) { const unsigned long long bal = __ballot(key[q] >= T); if (lane == q) mymask = bal; }
        } else {
#pragma unroll 1
            for (int q = 0; q < NQ; ++q) {
                unsigned kq = 0u;
#pragma unroll
                for (int z = 0; z < NQ; ++z) kq = (z == q) ? key[z] : kq;
                unsigned long long eq = __ballot(kq == T); const unsigned long long gt = __ballot(kq > T);
                int pc = __builtin_popcountll(eq); const int take = pc < need ? pc : need;
                while (pc > take) { eq &= ~(1ull << (63 - __builtin_clzll(eq))); --pc; }
                need -= take;
                if (lane == q) mymask = gt | eq;
            }
        }
        if (lane < 32) MASK[(rowbase + t) * 32 + lane] = mymask;
    }
}
__device__ __forceinline__ void p_indexer(Frame& F) {
    const bf16_t* QI = (const bf16_t*)(F.ws + WS_QI); const bf16_t* KI = (const bf16_t*)(F.ws + WS_KI); const float* WI = (const float*)(F.ws + WS_WI);
    unsigned long long* MASK = (unsigned long long*)(F.ws + WS_MASK);
    LAS float* sc = (LAS float*)F.lds;
    LAS float* wis = (LAS float*)(F.lds + 131072);
    const int lane = F.lane, r32 = lane & 31, hi = lane >> 5, wave = F.wave;
    for (int i = 0;; ++i) {
        const int U = i * F.G + (int)blockIdx.x; if (U >= NB * 128) break;
        const int b = U >> 7, tl = U & 127, tile = (i & 1) ? 127 - tl : tl;
        const int t0 = tile * 16; const size_t rowbase = (size_t)b * SEQ;
        if (t0 < 256) {
#pragma unroll
            for (int u = 0; u < 2; ++u) { const int t = t0 + 2 * wave + u;
                if (lane < 32) { const int nb = t + 1 - 64 * lane; const unsigned long long m = nb >= 64 ? ~0ull : (nb <= 0 ? 0ull : ((1ull << nb) - 1ull)); MASK[(rowbase + t) * 32 + lane] = m; } }
            continue;
        }
        if (F.tid < 128) wis[F.tid] = WI[(rowbase + t0) * 8 + F.tid];
        bf16x8 af[4][4];
        { const int m = r32, j = m & 3, hp = (m >> 2) & 1, ii = m >> 3, tokl = 2 * hp + (ii >> 1), head = 4 * (ii & 1) + j;
#pragma unroll
          for (int mt = 0; mt < 4; ++mt)
#pragma unroll
            for (int ks = 0; ks < 4; ++ks) af[mt][ks] = *(const bf16x8*)(QI + (rowbase + t0 + 4 * mt + tokl) * 512 + head * 64 + ks * 16 + hi * 8); }
        __syncthreads();
        const int n32 = (t0 + 16 + 31) >> 5;
        bf16x8 bnx[4];
        if (wave < n32) {
#pragma unroll
            for (int ks = 0; ks < 4; ++ks) bnx[ks] = *(const bf16x8*)(KI + (rowbase + wave * 32 + r32) * 64 + ks * 16 + hi * 8); }
        for (int kt = wave; kt < n32; kt += NWAVES) {
            const int key = kt * 32 + r32;
            bf16x8 bfr[4];
#pragma unroll
            for (int ks = 0; ks < 4; ++ks) bfr[ks] = bnx[ks];
            if (kt + NWAVES < n32) {
#pragma unroll
                for (int ks = 0; ks < 4; ++ks) bnx[ks] = *(const bf16x8*)(KI + (rowbase + key + NWAVES * 32) * 64 + ks * 16 + hi * 8); }
#pragma unroll
            for (int mt = 0; mt < 4; ++mt) {
                f32x16 acc = {};
#pragma unroll
                for (int ks = 0; ks < 4; ++ks) acc = __builtin_amdgcn_mfma_f32_32x32x16_bf16(af[mt][ks], bfr[ks], acc, 0, 0, 0);
#pragma unroll
                for (int u = 0; u < 2; ++u) { const int tk = 4 * mt + 2 * hi + u;
                    const f32x4 w0 = *(const LAS f32x4*)(wis + tk * 8), w1 = *(const LAS f32x4*)(wis + tk * 8 + 4);
                    float s = 0.f;
#pragma unroll
                    for (int h = 0; h < 4; ++h) { s += w0[h] * fmaxf(acc[8 * u + h], 0.f); }
#pragma unroll
                    for (int h = 0; h < 4; ++h) { s += w1[h] * fmaxf(acc[8 * u + 4 + h], 0.f); }
                    sc[tk * 2048 + key] = s + 0.f; }
            }
        }
        __syncthreads();
        { const int nq = ((t0 + 15) >> 6) + 1;
          if (nq <= 8) topk_select<8>(sc, MASK, rowbase, t0, wave, lane);
          else if (nq <= 16) topk_select<16>(sc, MASK, rowbase, t0, wave, lane);
          else if (nq <= 24) topk_select<24>(sc, MASK, rowbase, t0, wave, lane);
          else topk_select<32>(sc, MASK, rowbase, t0, wave, lane); }
        __syncthreads();
    }
}

typedef short v4i16_t __attribute__((ext_vector_type(4)));
__device__ __forceinline__ s16x4 vtr(const LAS unsigned char* p) { return __builtin_bit_cast(s16x4, __builtin_amdgcn_ds_read_tr16_b64_v4i16((LAS v4i16_t*)p)); }
template <bool MASKED>
__device__ __forceinline__ void attn_unit(Frame& F, const bf16_t* Qp, int qpitch, const bf16_t* Kp, const bf16_t* Vp, int kvpitch, int ntiles,
                                          const unsigned long long* maskp, bf16_t* Op, int opitch) {
    const int tid = F.tid, lane = F.lane, r32 = lane & 31, hi = lane >> 5, wave = F.wave;
    LAS unsigned char* lds = F.lds;
    bf16x8 qf[4];
#pragma unroll
    for (int ks = 0; ks < 4; ++ks) qf[ks] = *(const bf16x8*)(Qp + (size_t)(wave * 32 + r32) * qpitch + ks * 16 + hi * 8);
    const unsigned long long* mrow = maskp + (size_t)(wave * 32 + r32) * 32;
    const int kkey = tid & 63, kch = tid >> 6, vkey = tid >> 3, vpc = tid & 7;
    const bf16_t* ksrc = Kp + (size_t)kkey * kvpitch + kch * 8; const bf16_t* vsrc = Vp + (size_t)vkey * kvpitch + vpc * 8;
    const int kdst = kch * 1024 + kkey * 16, vdst = 8192 + (vpc >> 2) * 4096 + vkey * 64 + (vpc & 3) * 16;
    u32x4 kreg = *(const u32x4*)ksrc, vreg = *(const u32x4*)vsrc;
    *(LAS u32x4*)(lds + kdst) = kreg; *(LAS u32x4*)(lds + vdst) = vreg;
    __syncthreads();
    float m_run = 0.f, l_run = 0.f; bool started = false; f32x16 o0 = {}, o1 = {};
    constexpr float THR = 8.f, NEGBIG = -1e30f;
    const int vlane = ((lane >> 4) & 1) * 32 + (lane & 3) * 8 + (4 * hi + ((lane & 15) >> 2)) * 64;
    unsigned long long mw_next = ~0ull; if (MASKED) mw_next = mrow[0];
    for (int t = 0; t < ntiles; ++t) {
        const int cb = (t & 1) * 16384, nb = 16384 - cb;
        if (t + 1 < ntiles) { kreg = *(const u32x4*)(ksrc + (size_t)(t + 1) * 64 * kvpitch); vreg = *(const u32x4*)(vsrc + (size_t)(t + 1) * 64 * kvpitch); }
        const unsigned long long mw = mw_next; if (MASKED && t + 1 < ntiles) mw_next = mrow[t + 1];
        f32x16 p0, p1; const float negm = -m_run;
        if (MASKED) { const int lo = (int)((unsigned)mw >> (4 * hi)), hw = (int)((unsigned)(mw >> 32) >> (4 * hi));
            const int nb_ = __builtin_bit_cast(int, negm), ng_ = __builtin_bit_cast(int, NEGBIG);
#pragma unroll
            for (int r = 0; r < 16; ++r) { const unsigned pos = (r & 3) + 8 * (r >> 2);
                const int m0 = __builtin_amdgcn_sbfe(lo, pos, 1), m1 = __builtin_amdgcn_sbfe(hw, pos, 1);
                p0[r] = __builtin_bit_cast(float, __builtin_amdgcn_bitop3_b32(m0, nb_, ng_, 0xCA)); p1[r] = __builtin_bit_cast(float, __builtin_amdgcn_bitop3_b32(m1, nb_, ng_, 0xCA)); } }
        else {
#pragma unroll
            for (int r = 0; r < 16; ++r) { p0[r] = negm; p1[r] = negm; } }
#pragma unroll
        for (int ks = 0; ks < 4; ++ks) {
            const bf16x8 a0 = *(const LAS bf16x8*)(lds + cb + (2 * ks + hi) * 1024 + r32 * 16);
            const bf16x8 a1 = *(const LAS bf16x8*)(lds + cb + (2 * ks + hi) * 1024 + (32 + r32) * 16);
            p0 = __builtin_amdgcn_mfma_f32_32x32x16_bf16(a0, qf[ks], p0, 0, 0, 0);
            p1 = __builtin_amdgcn_mfma_f32_32x32x16_bf16(a1, qf[ks], p1, 0, 0, 0);
        }
        float rm;
        { float a = __builtin_fmaxf(__builtin_fmaxf(p0[0], p0[1]), p1[0]), b = __builtin_fmaxf(__builtin_fmaxf(p0[2], p0[3]), p1[1]); a = __builtin_fmaxf(__builtin_fmaxf(a, p1[2]), p1[3]);
#pragma unroll
          for (int r = 4; r < 16; r += 4) { a = __builtin_fmaxf(__builtin_fmaxf(a, p0[r]), p0[r + 1]); b = __builtin_fmaxf(__builtin_fmaxf(b, p0[r + 2]), p0[r + 3]); a = __builtin_fmaxf(__builtin_fmaxf(a, p1[r]), p1[r + 1]); b = __builtin_fmaxf(__builtin_fmaxf(b, p1[r + 2]), p1[r + 3]); }
          rm = __builtin_fmaxf(a, b);
          auto rr = __builtin_amdgcn_permlane32_swap(__float_as_uint(rm), __float_as_uint(rm), false, false); rm = __builtin_fmaxf(__uint_as_float(rr[0]), __uint_as_float(rr[1])); }
        const bool valid = rm > -1e29f, adj = (rm > THR) || (valid && !started);
        if (__any(adj)) {
            const float dl = adj ? rm : 0.f; m_run += dl;
#pragma unroll
            for (int r = 0; r < 16; ++r) { p0[r] -= dl; p1[r] -= dl; }
            const float alpha = started ? fast_exp2(-dl) : 1.f;
            l_run *= alpha;
#pragma unroll
            for (int r = 0; r < 16; ++r) { o0[r] *= alpha; o1[r] *= alpha; }
        }
        started = started || valid;
#pragma unroll
        for (int r = 0; r < 16; ++r) { p0[r] = fast_exp2(p0[r]); p1[r] = fast_exp2(p1[r]); }
        { f32x2 sa[8];
#pragma unroll
          for (int r = 0; r < 8; ++r) sa[r] = (f32x2){p0[2 * r], p0[2 * r + 1]} + (f32x2){p1[2 * r], p1[2 * r + 1]};
          const f32x2 sb = ((sa[0] + sa[1]) + (sa[2] + sa[3])) + ((sa[4] + sa[5]) + (sa[6] + sa[7]));
          l_run += sb.x + sb.y; }
        bf16x8 pw[2][2];
#pragma unroll
        for (int s = 0; s < 2; ++s) {
            u32x4 w; w.x = pg8::cvt_pk_bf16(p0[8 * s + 0], p0[8 * s + 1]); w.y = pg8::cvt_pk_bf16(p0[8 * s + 2], p0[8 * s + 3]); w.z = pg8::cvt_pk_bf16(p0[8 * s + 4], p0[8 * s + 5]); w.w = pg8::cvt_pk_bf16(p0[8 * s + 6], p0[8 * s + 7]);
            pw[0][s] = __builtin_bit_cast(bf16x8, w);
            u32x4 x; x.x = pg8::cvt_pk_bf16(p1[8 * s + 0], p1[8 * s + 1]); x.y = pg8::cvt_pk_bf16(p1[8 * s + 2], p1[8 * s + 3]); x.z = pg8::cvt_pk_bf16(p1[8 * s + 4], p1[8 * s + 5]); x.w = pg8::cvt_pk_bf16(p1[8 * s + 6], p1[8 * s + 7]);
            pw[1][s] = __builtin_bit_cast(bf16x8, x);
        }
        const LAS unsigned char* vb = lds + cb + 8192 + vlane;
#pragma unroll
        for (int kh = 0; kh < 2; ++kh)
#pragma unroll
            for (int s = 0; s < 2; ++s) {
                const int ko = (32 * kh + 16 * s) * 64;
                const s16x4 a_lo0 = vtr(vb + ko), a_hi0 = vtr(vb + ko + 512), a_lo1 = vtr(vb + 4096 + ko), a_hi1 = vtr(vb + 4096 + ko + 512);
                const bf16x8 A0 = (bf16x8){a_lo0[0], a_lo0[1], a_lo0[2], a_lo0[3], a_hi0[0], a_hi0[1], a_hi0[2], a_hi0[3]};
                const bf16x8 A1 = (bf16x8){a_lo1[0], a_lo1[1], a_lo1[2], a_lo1[3], a_hi1[0], a_hi1[1], a_hi1[2], a_hi1[3]};
                o0 = __builtin_amdgcn_mfma_f32_32x32x16_bf16(A0, pw[kh][s], o0, 0, 0, 0);
                o1 = __builtin_amdgcn_mfma_f32_32x32x16_bf16(A1, pw[kh][s], o1, 0, 0, 0);
            }
        if (t + 1 < ntiles) { *(LAS u32x4*)(lds + nb + kdst) = kreg; *(LAS u32x4*)(lds + nb + vdst) = vreg; }
        __syncthreads();
    }
    { auto rr = __builtin_amdgcn_permlane32_swap(__float_as_uint(l_run), __float_as_uint(l_run), false, false); l_run = __uint_as_float(rr[0]) + __uint_as_float(rr[1]); }
    const float inv = 1.f / l_run;
    bf16_t* orow = Op + (size_t)(wave * 32 + r32) * opitch;
#pragma unroll
    for (int rg = 0; rg < 4; ++rg) {
        u32x2 w0, w1;
        w0.x = pg8::cvt_pk_bf16(o0[4 * rg] * inv, o0[4 * rg + 1] * inv); w0.y = pg8::cvt_pk_bf16(o0[4 * rg + 2] * inv, o0[4 * rg + 3] * inv);
        w1.x = pg8::cvt_pk_bf16(o1[4 * rg] * inv, o1[4 * rg + 1] * inv); w1.y = pg8::cvt_pk_bf16(o1[4 * rg + 2] * inv, o1[4 * rg + 3] * inv);
        *(u32x2*)(orow + 8 * rg + 4 * hi) = w0; *(u32x2*)(orow + 32 + 8 * rg + 4 * hi) = w1;
    }
}
__device__ __forceinline__ void mem_attn_units(Frame& F, const bf16_t* QM, int layer, bf16_t* AO) {
    const bf16_t* KVM = (const bf16_t*)(F.ws + WS_KVM);
    for (int mu = blockIdx.x; mu < NB * 32; mu += F.G) {
        const int b = mu >> 5, hm = (mu >> 3) & 3, qb = mu & 7;
        const size_t row0 = (size_t)b * SEQ + qb * 256;
        attn_unit<false>(F, QM + row0 * 256 + hm * 64, 256, KVM + (size_t)b * NMEM * 1024 + layer * 512 + hm * 64, KVM + (size_t)b * NMEM * 1024 + layer * 512 + 256 + hm * 64, 1024, 4,
                         nullptr, AO + row0 * 1024 + 768 + hm * 64, 1024);
    }
}
__device__ __forceinline__ void p_attn_dsa(Frame& F) {
    const bf16_t* Q = (const bf16_t*)(F.ws + WS_Q); const bf16_t* K = (const bf16_t*)(F.ws + WS_K); const bf16_t* V = (const bf16_t*)(F.ws + WS_V);
    const unsigned long long* MASK = (const unsigned long long*)(F.ws + WS_MASK); bf16_t* AO = (bf16_t*)(F.ws + WS_AO0);
    for (int pu = blockIdx.x; pu < NB * 12 * 4; pu += F.G) {
        const int bh = pu >> 2, pr = pu & 3, b = bh / 12, h = bh % 12;
#pragma unroll 1
        for (int z = 0; z < 2; ++z) {
            const int qb = z ? 7 - pr : pr; const size_t rb = (size_t)b * SEQ, row0 = rb + qb * 256;
            attn_unit<true>(F, Q + row0 * 768 + h * 64, 768, K + rb * 768 + h * 64, V + rb * 768 + h * 64, 768, 4 * (qb + 1), MASK + row0 * 32, AO + row0 * 1024 + h * 64, 1024);
        }
    }
    mem_attn_units(F, (const bf16_t*)(F.ws + WS_QM), 0, AO);
}

template <bool RESID_F32>
__device__ __forceinline__ void p_ln1_router(Frame& F, const Args& a, int layer, const void* resid, bf16_t* X1b) {
    const bf16_t* MIX = (const bf16_t*)F.out;
    const float* g1 = (const float*)a.in[I_LN1G] + layer * 1024; const float* b1 = (const float*)a.in[I_LN1B] + layer * 1024;
    const float* wg = (const float*)a.in[I_MOE_WG] + (size_t)layer * 1024 * 4; const float* bg = (const float*)a.in[I_MOE_BG] + layer * 4;
    const float* wr = (const float*)a.in[I_MOE_WR] + (size_t)layer * 4 * 1024 * 8; const float* br = (const float*)a.in[I_MOE_BR] + layer * 32;
    unsigned* cnt = F.ctl + CW_CNT + layer * 2048;
    int* LISTTOK = (int*)(F.ws + WS_LISTTOK); float* LISTW = (float*)(F.ws + WS_LISTW); int* TOKSLOT = (int*)(F.ws + WS_TOKSLOT);
    const int lane = F.lane;
    LAS float* WR = (LAS float*)F.lds;
    for (int i = F.tid; i < 4 * 1024 * 2; i += 512) { const int g = i >> 11, k = (i & 2047) >> 1, hf = i & 1;
        const f32x4 w4 = *(const f32x4*)(wr + ((size_t)g * 1024 + k) * 8 + hf * 4);
#pragma unroll
        for (int c = 0; c < 4; ++c) WR[(g * 8 + hf * 4 + c) * 1024 + k] = w4[c]; }
    __syncthreads();
    f32x4 gv[4], bv[4], wgr[4][4];
#pragma unroll
    for (int j = 0; j < 4; ++j) { gv[j] = *((const f32x4*)g1 + lane + 64 * j); bv[j] = *((const f32x4*)b1 + lane + 64 * j);
#pragma unroll
        for (int c = 0; c < 4; ++c) wgr[j][c] = *(const f32x4*)(wg + (size_t)(256 * j + 4 * lane + c) * 4); }
    LAS int* cntL = (LAS int*)(F.lds + MISC_OFF + 512); LAS int* baseL = cntL + 32; LAS int* tokdat = (LAS int*)(F.lds + MISC_OFF + 1024);
    if (F.tid < 32) cntL[F.tid] = 0;
    __syncthreads();
    int nloc = 0;
    for (int tb = F.gw; tb < NT; tb += 2 * F.NGW) {
      f32x4 vv[2][4];
#pragma unroll
      for (int hh = 0; hh < 2; ++hh) { const int t = tb + hh * F.NGW; if (t < NT) {
        const u32x2* mr = (const u32x2*)(MIX + (size_t)t * DM) + lane;
#pragma unroll
        for (int j = 0; j < 4; ++j) {
            f32x4 xv;
            if (RESID_F32) xv = *((const f32x4*)((const float*)resid + (size_t)t * DM) + lane + 64 * j);
            else { const u32x2 p = *((const u32x2*)((const bf16_t*)resid + (size_t)t * DM) + lane + 64 * j); xv = (f32x4){bf2f(p.x & 0xffffu), bf2f(p.x >> 16), bf2f(p.y & 0xffffu), bf2f(p.y >> 16)}; }
            const u32x2 m = mr[64 * j];
            vv[hh][j] = xv * ALPHA + (f32x4){bf2f(m.x & 0xffffu), bf2f(m.x >> 16), bf2f(m.y & 0xffffu), bf2f(m.y >> 16)}; } } }
#pragma unroll
      for (int hh = 0; hh < 2; ++hh) { const int t = tb + hh * F.NGW; if (t >= NT) break;
        f32x4 v[4]; float s = 0.f;
#pragma unroll
        for (int j = 0; j < 4; ++j) { v[j] = vv[hh][j]; s += (v[j].x + v[j].y) + (v[j].z + v[j].w); }
        const float mean = wave_sum(s) * (1.f / DM); float s2 = 0.f;
#pragma unroll
        for (int j = 0; j < 4; ++j) { v[j] = v[j] - mean; s2 += (v[j].x * v[j].x + v[j].y * v[j].y) + (v[j].z * v[j].z + v[j].w * v[j].w); }
        const float rstd = 1.f / sqrtf(wave_sum(s2) * (1.f / DM) + LN_EPS);
        u32x2* ob = (u32x2*)(X1b + (size_t)t * DM) + lane;
#pragma unroll
        for (int j = 0; j < 4; ++j) { v[j] = v[j] * rstd * gv[j] + bv[j]; u32x2 w; w.x = pk2(v[j].x, v[j].y); w.y = pk2(v[j].z, v[j].w); ob[64 * j] = w; }
        float gl[4] = {0.f, 0.f, 0.f, 0.f};
#pragma unroll
        for (int j = 0; j < 4; ++j)
#pragma unroll
            for (int c = 0; c < 4; ++c)
#pragma unroll
                for (int k = 0; k < 4; ++k) gl[k] += v[j][c] * wgr[j][c][k];
#pragma unroll
        for (int k = 0; k < 4; ++k) gl[k] = wave_sum(gl[k]) + bg[k];
        int gsel = 0; float gmax = gl[0];
#pragma unroll
        for (int k = 1; k < 4; ++k) if (gl[k] > gmax) { gmax = gl[k]; gsel = k; }
        float gs = 0.f;
#pragma unroll
        for (int k = 0; k < 4; ++k) gs += __expf(gl[k] - gmax);
        const float pg = 1.f / gs;
        gsel = __builtin_amdgcn_readfirstlane(gsel);
        const LAS float* wrg = WR + gsel * 8 * 1024 + 4 * lane;
        float el[8];
#pragma unroll
        for (int e = 0; e < 8; ++e) { float acc = 0.f;
#pragma unroll
            for (int j = 0; j < 4; ++j) { const f32x4 w4 = *(const LAS f32x4*)(wrg + e * 1024 + 256 * j); acc += (v[j].x * w4.x + v[j].y * w4.y) + (v[j].z * w4.z + v[j].w * w4.w); }
            el[e] = wave_sum(acc) + br[gsel * 8 + e]; }
        int i1 = 0; float v1 = el[0];
#pragma unroll
        for (int k = 1; k < 8; ++k) if (el[k] > v1) { v1 = el[k]; i1 = k; }
        int i2 = -1; float v2 = -INFINITY;
#pragma unroll
        for (int k = 0; k < 8; ++k) if (k != i1 && (i2 < 0 || el[k] > v2)) { v2 = el[k]; i2 = k; }
        const float e2 = __expf(v2 - v1); const float wt1 = pg / (1.f + e2), wt2 = pg * e2 / (1.f + e2);
        if (lane == 0) {
            const int ge1 = gsel * 8 + i1, ge2 = gsel * 8 + i2;
            const int l1 = __hip_atomic_fetch_add(&cntL[ge1], 1, __ATOMIC_RELAXED, __HIP_MEMORY_SCOPE_WORKGROUP), l2 = __hip_atomic_fetch_add(&cntL[ge2], 1, __ATOMIC_RELAXED, __HIP_MEMORY_SCOPE_WORKGROUP);
            LAS int* td = tokdat + (nloc * NWAVES + F.wave) * 8;
            td[0] = t; td[1] = ge1; td[2] = l1; td[3] = __float_as_int(wt1); td[4] = ge2; td[5] = l2; td[6] = __float_as_int(wt2);
        }
        ++nloc;
      }
    }
    __syncthreads();
    if (F.tid < 32) { const int n = cntL[F.tid]; baseL[F.tid] = n ? (int)atomicAdd(&cnt[F.tid * 64], (unsigned)n) : 0; }
    __syncthreads();
    for (int i = F.tid; i < nloc * NWAVES; i += 512) {
        const LAS int* td = tokdat + i * 8; const int t = td[0], ge1 = td[1], ge2 = td[4]; const int p1 = baseL[ge1] + td[2], p2 = baseL[ge2] + td[5];
        LISTTOK[(size_t)ge1 * NT + p1] = t; LISTW[(size_t)ge1 * NT + p1] = __int_as_float(td[3]);
        LISTTOK[(size_t)ge2 * NT + p2] = t; LISTW[(size_t)ge2 * NT + p2] = __int_as_float(td[6]);
        *(int4*)(TOKSLOT + (size_t)t * 4) = make_int4(ge1, p1, ge2, p2);
    }
}
template <bool OUT_F32>
__device__ __forceinline__ void p_ln2(Frame& F, const Args& a, int layer, const bf16_t* X1b, void* dst) {
    const bf16_t* Y = (const bf16_t*)(F.ws + WS_Y); const int* TOKSLOT = (const int*)(F.ws + WS_TOKSLOT);
    const float* g2 = (const float*)a.in[I_LN2G] + layer * 1024; const float* b2 = (const float*)a.in[I_LN2B] + layer * 1024;
    LAS int* tp = (LAS int*)(F.lds + MISC_OFF + 256);
    moe_tile_table(F, F.ctl + CW_CNT + layer * 2048, tp);
    const int lane = F.lane;
    f32x4 gv[4], bv[4];
#pragma unroll
    for (int j = 0; j < 4; ++j) { gv[j] = *((const f32x4*)g2 + lane + 64 * j); bv[j] = *((const f32x4*)b2 + lane + 64 * j); }
    for (int tb = F.gw; tb < NT; tb += 2 * F.NGW) {
      f32x4 vv[2][4];
#pragma unroll
      for (int hh = 0; hh < 2; ++hh) { const int t = tb + hh * F.NGW; if (t < NT) {
        const int4 ts = *(const int4*)(TOKSLOT + (size_t)t * 4);
        const size_t s0 = (size_t)tp[ts.x] * 256 + ts.y, s1 = (size_t)tp[ts.z] * 256 + ts.w;
        const u32x2* xr = (const u32x2*)(X1b + (size_t)t * DM) + lane;
        const u32x2* y0 = (const u32x2*)(Y + s0 * DM) + lane; const u32x2* y1 = (const u32x2*)(Y + s1 * DM) + lane;
#pragma unroll
        for (int j = 0; j < 4; ++j) { const u32x2 p = y0[64 * j], q = y1[64 * j], x = xr[64 * j];
            f32x4 yy; yy.x = bf2f(p.x & 0xffffu) + bf2f(q.x & 0xffffu); yy.y = bf2f(p.x >> 16) + bf2f(q.x >> 16); yy.z = bf2f(p.y & 0xffffu) + bf2f(q.y & 0xffffu); yy.w = bf2f(p.y >> 16) + bf2f(q.y >> 16);
            vv[hh][j] = (f32x4){bf2f(x.x & 0xffffu), bf2f(x.x >> 16), bf2f(x.y & 0xffffu), bf2f(x.y >> 16)} * ALPHA + yy; } } }
#pragma unroll
      for (int hh = 0; hh < 2; ++hh) { const int t = tb + hh * F.NGW; if (t >= NT) break;
        f32x4 v[4]; float s = 0.f;
#pragma unroll
        for (int j = 0; j < 4; ++j) { v[j] = vv[hh][j]; s += (v[j].x + v[j].y) + (v[j].z + v[j].w); }
        const float mean = wave_sum(s) * (1.f / DM); float s2 = 0.f;
#pragma unroll
        for (int j = 0; j < 4; ++j) { v[j] = v[j] - mean; s2 += (v[j].x * v[j].x + v[j].y * v[j].y) + (v[j].z * v[j].z + v[j].w * v[j].w); }
        const float rstd = 1.f / sqrtf(wave_sum(s2) * (1.f / DM) + LN_EPS);
#pragma unroll
        for (int j = 0; j < 4; ++j) v[j] = v[j] * rstd * gv[j] + bv[j];
        if (OUT_F32) { f32x4* o4 = (f32x4*)((float*)dst + (size_t)t * DM) + lane;
#pragma unroll
            for (int j = 0; j < 4; ++j) o4[64 * j] = v[j]; }
        else { u32x2* ob = (u32x2*)((bf16_t*)dst + (size_t)t * DM) + lane;
#pragma unroll
            for (int j = 0; j < 4; ++j) { u32x2 w; w.x = pk2(v[j].x, v[j].y); w.y = pk2(v[j].z, v[j].w); ob[64 * j] = w; } }
      }
    }
}

__device__ __forceinline__ bf16x8 pack8(f32x4 lo, f32x4 hi) { u32x4 w; w.x = pg8::cvt_pk_bf16(lo[0], lo[1]); w.y = pg8::cvt_pk_bf16(lo[2], lo[3]); w.z = pg8::cvt_pk_bf16(hi[0], hi[1]); w.w = pg8::cvt_pk_bf16(hi[2], hi[3]); return __builtin_bit_cast(bf16x8, w); }
constexpr int GLA_QP = 208, GLA_VP = 400;
constexpr int GL_WGS = 0, GL_BGS = 6144, GL_Q = 8192, GL_K = 8192 + 13312, GL_V = 8192 + 2 * 13312, GL_ST = GL_V + 25600;
__device__ __forceinline__ void gla_gates(const float* a1row, const LAS float* wgs, const LAS float* bgs, int w, int lane, float (&bq)[12], float (&bl)[12]) {
    f32x4 av[4];
#pragma unroll
    for (int r = 0; r < 4; ++r) av[r] = *(const f32x4*)(a1row + 4 * r);
#pragma unroll
    for (int k = 0; k < 12; ++k) {
        const int d = 12 * w + k; float z = bgs[d];
#pragma unroll
        for (int r = 0; r < 16; ++r) z += av[r >> 2][r & 3] * wgs[r * 96 + d];
        float g = (fminf(z, 0.f) - __logf(1.f + __expf(-fabsf(z)))) * (1.f / 16.f);
#pragma unroll
        for (int o = 1; o < 64; o <<= 1) { const float t = __shfl_up(g, o); if (lane >= o) g += t; }
        bq[k] = g; bl[k] = __shfl(g, 63);
    }
}
__device__ __forceinline__ void gla_stage_common(Frame& F, const Args& a, int h, size_t row0) {
    const float* wgate = (const float*)a.in[I_GLA_WGATE]; const float* bgate = (const float*)a.in[I_GLA_BGATE];
    const bf16_t* GV = (const bf16_t*)(F.ws + WS_GV);
    LAS float* wgs = (LAS float*)(F.lds + GL_WGS); LAS float* bgs = (LAS float*)(F.lds + GL_BGS);
    const int tid = F.tid;
    if (tid < 384) { const int r = tid / 24, d4 = (tid % 24) * 4; *(LAS f32x4*)(wgs + r * 96 + d4) = *(const f32x4*)(wgate + r * 384 + h * 96 + d4); }
    if (tid < 96) bgs[tid] = bgate[h * 96 + tid];
#pragma unroll
    for (int i = 0; i < 3; ++i) { const int p = tid + 512 * i, row = p / 24, pc = p % 24;
        *(LAS u32x4*)(F.lds + GL_V + row * GLA_VP + pc * 16) = *(const u32x4*)(GV + (row0 + row) * 768 + h * 192 + pc * 8); }
}
__device__ __forceinline__ bf16x8 tr2(const LAS unsigned char* p0, const LAS unsigned char* p1) { const s16x4 a = vtr(p0), b = vtr(p1); return (bf16x8){a[0], a[1], a[2], a[3], b[0], b[1], b[2], b[3]}; }
__device__ __forceinline__ u32x2 pack4(f32x4 v) { u32x2 w; w.x = pg8::cvt_pk_bf16(v[0], v[1]); w.y = pg8::cvt_pk_bf16(v[2], v[3]); return w; }
__device__ __forceinline__ void p_gla_u(Frame& F, const Args& a) {
    const bf16_t* GK = (const bf16_t*)(F.ws + WS_GK); const float* A1 = (const float*)(F.ws + WS_A1);
    u32x2* UF = (u32x2*)F.out; float* DEC = (float*)(F.ws + WS_DEC);
    const int lane = F.lane, w = F.wave, fq = lane >> 4, qq = (lane & 15) >> 2, pp = lane & 3;
    for (int U = blockIdx.x; U < NB * 4 * 32; U += F.G) {
        const int c = U & 31, h = (U >> 5) & 3, b = U >> 7; const size_t row0 = (size_t)b * SEQ + c * 64;
        gla_stage_common(F, a, h, row0);
        u32x2 kpre[3];
        { const u32x2* kp = (const u32x2*)(GK + (row0 + lane) * 384 + h * 96 + 12 * w);
#pragma unroll
          for (int i = 0; i < 3; ++i) kpre[i] = kp[i]; }
        __syncthreads();
        float bq[12], bl[12];
        gla_gates(A1 + (row0 + lane) * 16, (const LAS float*)(F.lds + GL_WGS), (const LAS float*)(F.lds + GL_BGS), w, lane, bq, bl);
        {
#pragma unroll
          for (int i = 0; i < 3; ++i) { const u32x2 kv = kpre[i]; f32x4 o;
              o[0] = bf2f(kv.x & 0xffffu) * __expf(bl[4 * i] - bq[4 * i]); o[1] = bf2f(kv.x >> 16) * __expf(bl[4 * i + 1] - bq[4 * i + 1]);
              o[2] = bf2f(kv.y & 0xffffu) * __expf(bl[4 * i + 2] - bq[4 * i + 2]); o[3] = bf2f(kv.y >> 16) * __expf(bl[4 * i + 3] - bq[4 * i + 3]);
              *(LAS u32x2*)(F.lds + GL_K + lane * GLA_QP + (12 * w + 4 * i) * 2) = pack4(o); } }
        if (lane == 0) {
#pragma unroll
            for (int i = 0; i < 3; ++i) *(f32x4*)(DEC + (size_t)U * 96 + 12 * w + 4 * i) = (f32x4){__expf(bl[4 * i]), __expf(bl[4 * i + 1]), __expf(bl[4 * i + 2]), __expf(bl[4 * i + 3])}; }
        __syncthreads();
        const int dt0 = 3 * (w >> 2), et0 = 3 * (w & 3);
        bf16x8 af[3][2], bfv[3][2];
#pragma unroll
        for (int ks = 0; ks < 2; ++ks) { const int prow = 32 * ks + 8 * fq + qq;
#pragma unroll
            for (int i = 0; i < 3; ++i) {
                const LAS unsigned char* ka = F.lds + GL_K + prow * GLA_QP + (16 * (dt0 + i) + 4 * pp) * 2; af[i][ks] = tr2(ka, ka + 4 * GLA_QP);
                const LAS unsigned char* va = F.lds + GL_V + prow * GLA_VP + (16 * (et0 + i) + 4 * pp) * 2; bfv[i][ks] = tr2(va, va + 4 * GLA_VP); } }
#pragma unroll
        for (int i = 0; i < 3; ++i)
#pragma unroll
            for (int j = 0; j < 3; ++j) { f32x4 acc = (f32x4){0.f, 0.f, 0.f, 0.f};
#pragma unroll
                for (int ks = 0; ks < 2; ++ks) acc = __builtin_amdgcn_mfma_f32_16x16x32_bf16(af[i][ks], bfv[j][ks], acc, 0, 0, 0);
                UF[((size_t)U * 72 + (dt0 + i) * 12 + (et0 + j)) * 64 + lane] = pack4(acc); }
        __syncthreads();
    }
}
__device__ __forceinline__ void p_gla_scan(Frame& F) {
    u32x2* UF = (u32x2*)F.out; const float* DEC = (const float*)(F.ws + WS_DEC);
    for (int idx = blockIdx.x * 512 + F.tid; idx < 64 * 72 * 64; idx += F.G * 512) {
        const int bh = idx / 4608, rem = idx % 4608, tile = rem >> 6, ln = rem & 63, dt = tile / 12, fq = ln >> 4;
        f32x4 S = (f32x4){0.f, 0.f, 0.f, 0.f};
        u32x2* p = UF + ((size_t)bh * 32 * 72 + tile) * 64 + ln; const float* dp = DEC + (size_t)bh * 32 * 96 + 16 * dt + 4 * fq;
#pragma unroll 4
        for (int c = 0; c < 32; ++c) {
            const u32x2 u = *p; const f32x4 dc = *(const f32x4*)dp;
            *p = pack4(S);
            S[0] = S[0] * dc[0] + bf2f(u.x & 0xffffu); S[1] = S[1] * dc[1] + bf2f(u.x >> 16); S[2] = S[2] * dc[2] + bf2f(u.y & 0xffffu); S[3] = S[3] * dc[3] + bf2f(u.y >> 16);
            p += 72 * 64; dp += 96; }
    }
}
__device__ __forceinline__ void p_gla_out(Frame& F, const Args& a) {
    const bf16_t* GQ = (const bf16_t*)(F.ws + WS_GQ); const bf16_t* GK = (const bf16_t*)(F.ws + WS_GK); const bf16_t* GR = (const bf16_t*)(F.ws + WS_GR); const float* A1 = (const float*)(F.ws + WS_A1);
    const u32x2* SF = (const u32x2*)F.out; bf16_t* AO = (bf16_t*)(F.ws + WS_AO1); const float* ng = (const float*)a.in[I_GLA_NORMG];
    const int lane = F.lane, w = F.wave, li = lane & 15, fq = lane >> 4, qq = li >> 2, pp = lane & 3;
    LAS float* stats = (LAS float*)(F.lds + GL_ST);
    for (int U = blockIdx.x; U < NB * 4 * 32; U += F.G) {
        const int c = U & 31, h = (U >> 5) & 3, b = U >> 7; const size_t row0 = (size_t)b * SEQ + c * 64;
        gla_stage_common(F, a, h, row0);
        const int ip = w >> 2, et0 = 3 * (w & 3);
        u32x2 sfr[3][3][2]; bf16_t grv[2][4][3];
#pragma unroll
        for (int eti = 0; eti < 3; ++eti)
#pragma unroll
            for (int sx = 0; sx < 3; ++sx) { sfr[eti][sx][0] = SF[((size_t)U * 72 + (2 * sx) * 12 + et0 + eti) * 64 + lane]; sfr[eti][sx][1] = SF[((size_t)U * 72 + (2 * sx + 1) * 12 + et0 + eti) * 64 + lane]; }
#pragma unroll
        for (int iti = 0; iti < 2; ++iti)
#pragma unroll
            for (int r = 0; r < 4; ++r)
#pragma unroll
                for (int eti = 0; eti < 3; ++eti) grv[iti][r][eti] = GR[(row0 + 16 * (2 * ip + iti) + 4 * fq + r) * 768 + h * 192 + 16 * (et0 + eti) + li];
        __syncthreads();
        { float bq[12], bl[12];
          gla_gates(A1 + (row0 + lane) * 16, (const LAS float*)(F.lds + GL_WGS), (const LAS float*)(F.lds + GL_BGS), w, lane, bq, bl);
          const u32x2* qp = (const u32x2*)(GQ + (row0 + lane) * 384 + h * 96 + 12 * w); const u32x2* kp = (const u32x2*)(GK + (row0 + lane) * 384 + h * 96 + 12 * w);
#pragma unroll
          for (int i = 0; i < 3; ++i) { const u32x2 qv = qp[i], kv = kp[i]; f32x4 oq, ok;
              const float e0 = __expf(bq[4 * i]), e1 = __expf(bq[4 * i + 1]), e2 = __expf(bq[4 * i + 2]), e3 = __expf(bq[4 * i + 3]);
              oq[0] = bf2f(qv.x & 0xffffu) * e0; oq[1] = bf2f(qv.x >> 16) * e1; oq[2] = bf2f(qv.y & 0xffffu) * e2; oq[3] = bf2f(qv.y >> 16) * e3;
              ok[0] = bf2f(kv.x & 0xffffu) * __builtin_amdgcn_rcpf(e0); ok[1] = bf2f(kv.x >> 16) * __builtin_amdgcn_rcpf(e1); ok[2] = bf2f(kv.y & 0xffffu) * __builtin_amdgcn_rcpf(e2); ok[3] = bf2f(kv.y >> 16) * __builtin_amdgcn_rcpf(e3);
              *(LAS u32x2*)(F.lds + GL_Q + lane * GLA_QP + (12 * w + 4 * i) * 2) = pack4(oq);
              *(LAS u32x2*)(F.lds + GL_K + lane * GLA_QP + (12 * w + 4 * i) * 2) = pack4(ok); } }
        __syncthreads();
        f32x4 o[2][3]; float ssq[2][4];
#pragma unroll
        for (int iti = 0; iti < 2; ++iti) {
            const int it = 2 * ip + iti;
            const LAS unsigned char* qrow = F.lds + GL_Q + (16 * it + li) * GLA_QP;
            bf16x8 qB[3], qA[3];
#pragma unroll
            for (int ks = 0; ks < 3; ++ks) { qB[ks] = *(const LAS bf16x8*)(qrow + (32 * ks + 8 * fq) * 2);
                const u32x2 x0 = *(const LAS u32x2*)(qrow + (32 * ks + 4 * fq) * 2), x1 = *(const LAS u32x2*)(qrow + (32 * ks + 16 + 4 * fq) * 2);
                u32x4 x; x.x = x0.x; x.y = x0.y; x.z = x1.x; x.w = x1.y; qA[ks] = __builtin_bit_cast(bf16x8, x); }
            f32x4 tl[4];
#pragma unroll
            for (int jt = 0; jt < 4; ++jt) {
                tl[jt] = (f32x4){0.f, 0.f, 0.f, 0.f};
                if (jt <= it) {
                    const LAS unsigned char* krow = F.lds + GL_K + (16 * jt + li) * GLA_QP;
#pragma unroll
                    for (int ks = 0; ks < 3; ++ks) tl[jt] = __builtin_amdgcn_mfma_f32_16x16x32_bf16(*(const LAS bf16x8*)(krow + (32 * ks + 8 * fq) * 2), qB[ks], tl[jt], 0, 0, 0);
                    if (jt == it) {
#pragma unroll
                        for (int r = 0; r < 4; ++r) if (4 * fq + r > li) tl[jt][r] = 0.f; }
                }
            }
            bf16x8 am[2]; am[0] = pack8(tl[0], tl[1]); am[1] = pack8(tl[2], tl[3]);
#pragma unroll
            for (int eti = 0; eti < 3; ++eti) {
                const int et = et0 + eti;
                f32x4 acc = (f32x4){0.f, 0.f, 0.f, 0.f};
#pragma unroll
                for (int s2 = 0; s2 < 2; ++s2) if (2 * s2 <= it) {
                    const LAS unsigned char* va = F.lds + GL_V + (32 * s2 + 4 * fq + qq) * GLA_VP + (16 * et + 4 * pp) * 2;
                    acc = __builtin_amdgcn_mfma_f32_16x16x32_bf16(am[s2], tr2(va, va + 16 * GLA_VP), acc, 0, 0, 0); }
#pragma unroll
                for (int s = 0; s < 3; ++s) {
                    const u32x2 s0 = sfr[eti][s][0], s1 = sfr[eti][s][1];
                    u32x4 x; x.x = s0.x; x.y = s0.y; x.z = s1.x; x.w = s1.y;
                    acc = __builtin_amdgcn_mfma_f32_16x16x32_bf16(qA[s], __builtin_bit_cast(bf16x8, x), acc, 0, 0, 0); }
                o[iti][eti] = acc;
            }
#pragma unroll
            for (int r = 0; r < 4; ++r) { float q2 = o[iti][0][r] * o[iti][0][r] + o[iti][1][r] * o[iti][1][r] + o[iti][2][r] * o[iti][2][r];
                q2 += __shfl_xor(q2, 1); q2 += __shfl_xor(q2, 2); q2 += __shfl_xor(q2, 4); q2 += __shfl_xor(q2, 8); ssq[iti][r] = q2; }
            if (li == 0) {
#pragma unroll
                for (int r = 0; r < 4; ++r) stats[(16 * it + 4 * fq + r) * 4 + (w & 3)] = ssq[iti][r]; }
        }
        __syncthreads();
#pragma unroll
        for (int iti = 0; iti < 2; ++iti) { const int it = 2 * ip + iti;
#pragma unroll
            for (int r = 0; r < 4; ++r) { const int rl = 16 * it + 4 * fq + r; const f32x4 st = *(const LAS f32x4*)(stats + rl * 4);
                const float rs = 1.f / sqrtf(((st[0] + st[1]) + (st[2] + st[3])) * (1.f / 192.f) + RMS_EPS);
#pragma unroll
                for (int eti = 0; eti < 3; ++eti) { const int e = 16 * (et0 + eti) + li;
                    const float rr = bf2f(grv[iti][r][eti]);
                    AO[(row0 + rl) * 1024 + h * 192 + e] = (bf16_t)f2bf(o[iti][eti][r] * rs * ng[e] * silu_f(rr)); } } }
        __syncthreads();
    }
}
constexpr int NPHASE = 19;
__device__ __forceinline__ int opaque_int(int v) { asm volatile("" : "+s"(v)); return v; }
#define GEMM_CALL(EpiT, SchedT, g, S, E) pg8::gemm_phase<EpiT, SchedT, true, true>(F.lds, g, S, E)
__device__ __forceinline__ void moe_gemms_up(Frame& F, int layer, const bf16_t* X1b, bf16_t* ACT) {
    LAS int* tp = (LAS int*)(F.lds + MISC_OFF + 256);
    const unsigned* cnt = F.ctl + CW_CNT + layer * 2048;
    moe_tile_table(F, cnt, tp);
    pg8::Gemm g{X1b, (const bf16_t*)(F.ws + WS_W13), SLOT_ROWS, 512, 1024};
    MoeOrder S{tp, cnt, (const int*)(F.ws + WS_LISTTOK), 2, F.G, (int)blockIdx.x, true};
    EpiMoe1 E{ACT, (const float*)(F.ws + WS_LISTW), cnt};
    GEMM_CALL(EpiMoe1, MoeOrder, g, S, E);
}
__device__ __forceinline__ void moe_gemms_down(Frame& F, int layer, const bf16_t* ACT) {
    LAS int* tp = (LAS int*)(F.lds + MISC_OFF + 256);
    const unsigned* cnt = F.ctl + CW_CNT + layer * 2048;
    moe_tile_table(F, cnt, tp);
    pg8::Gemm g{ACT, (const bf16_t*)(F.ws + WS_W2), SLOT_ROWS, 1024, 256};
    MoeOrder S{tp, cnt, nullptr, 4, F.G, (int)blockIdx.x, false};
    EpiBf16Plain E{(bf16_t*)(F.ws + WS_Y), 1024, 3};
    GEMM_CALL(EpiBf16Plain, MoeOrder, g, S, E);
}
__device__ __forceinline__ void out_proj(Frame& F, int layer, const bf16_t* AO) {
    pg8::Gemm g{AO, (const bf16_t*)(F.ws + WS_WO) + (size_t)layer * 1024 * 1024, NT, 1024, 1024};
    pg8::StaticOrder S; S.init(NT, 1024, F.G, (int)blockIdx.x);
    EpiBf16Plain E{(bf16_t*)F.out, 1024, 0x7fffffff};
    GEMM_CALL(EpiBf16Plain, pg8::StaticOrder, g, S, E);
}

__global__ void __launch_bounds__(NWAVES * 64, 2) mk_fwd(Args args) {
    extern __shared__ __attribute__((aligned(16))) unsigned char lds_raw[];
    Frame F;
    F.lds = (LAS unsigned char*)lds_raw; F.ws = args.ws; F.out = args.out; F.ctl = (unsigned*)(args.ws + WS_CTL);
    F.tid = threadIdx.x; F.lane = F.tid & 63; F.wave = __builtin_amdgcn_readfirstlane(F.tid >> 6); F.G = gridDim.x;
    F.gw = blockIdx.x * NWAVES + F.wave; F.NGW = F.G * NWAVES;
    volatile LAS unsigned* MISC = (volatile LAS unsigned*)(F.lds + MISC_OFF);
    if (F.tid < 64) MISC[F.tid] = 0u;
    __syncthreads();
#if N_LAUNCH_MODE == 1
    XcdBarrier bar = xcd_barrier_post(F.ctl + CW_BAR, MISC + 8);
#define SEAM() xcd_barrier(bar)
#else
#define SEAM() do {} while (0)
#endif
    const int lo = args.ph_lo, hi = args.ph_hi;
#ifndef PH_ENABLE
#define PH_ENABLE 0xFFFFFFFFu
#endif
#define IN(k) (((PH_ENABLE >> (k)) & 1u) && lo <= (k) && (k) < hi)
#define ENDPH(k) do { if (IN((k) + 1)) SEAM(); } while (0)
#ifndef REP_MASK
#define REP_MASK 0u
#endif
#define REPS(k) _Pragma("unroll 1") for (int rep_ = 0, nrep_ = ((REP_MASK >> (k)) & 1u) ? opaque_int(2) : 1; rep_ < nrep_; ++rep_)
#define REPSEAM(k) do { if ((REP_MASK >> (k)) & 1u) { if (rep_ == 0) SEAM(); } } while (0)

    if (IN(0)) REPS(0) { p_prologue(F, args); ENDPH(0); }
    if (IN(1)) REPS(1) {
        { pg8::Gemm g{(const bf16_t*)F.ws, (const bf16_t*)F.ws, NT, ND, 1024};
          DsaKvmOrder S; S.init(F.G, (int)blockIdx.x);
          EpiDsaKvm E{{(bf16_t*)(F.ws + WS_Q), (bf16_t*)(F.ws + WS_K), (bf16_t*)(F.ws + WS_V), (bf16_t*)(F.ws + WS_QI), (bf16_t*)(F.ws + WS_QM), (bf16_t*)(F.ws + WS_KI), (float*)(F.ws + WS_WI),
                       (const float*)(F.ws + WS_ROPEC), (const float*)(F.ws + WS_ROPES), (const float*)args.in[I_DSA_KG], (const float*)args.in[I_DSA_KB], F.lds + MISC_OFF + 8192}, {(bf16_t*)(F.ws + WS_KVM), 1024, 0x7fffffff}};
          GEMM_CALL(EpiDsaKvm, DsaKvmOrder, g, S, E); }
        ENDPH(1);
    }
    if (IN(3)) REPS(3) { p_indexer(F); ENDPH(3); }
    if (IN(4)) REPS(4) { p_attn_dsa(F); ENDPH(4); }
    if (IN(5)) REPS(5) { out_proj(F, 0, (const bf16_t*)(F.ws + WS_AO0)); ENDPH(5); }
    if (IN(6)) { p_ln1_router<true>(F, args, 0, args.in[I_X], (bf16_t*)(F.ws + WS_X1B0)); ENDPH(6); }
    if (IN(7)) REPS(7) { moe_gemms_up(F, 0, (const bf16_t*)(F.ws + WS_X1B0), (bf16_t*)(F.ws + WS_ACT0)); ENDPH(7); }
    if (IN(8)) REPS(8) { moe_gemms_down(F, 0, (const bf16_t*)(F.ws + WS_ACT0)); ENDPH(8); }
    if (IN(9)) { p_ln2<false>(F, args, 0, (const bf16_t*)(F.ws + WS_X1B0), F.ws + WS_C);
                 moe_weight_items(F, (const float*)args.in[I_MOE_W13], (const float*)args.in[I_MOE_W2], 1); ENDPH(9); }
    if (IN(10)) {
        pg8::Gemm g{(const bf16_t*)(F.ws + WS_C), (const bf16_t*)(F.ws + WS_WG), NT, NG, 1024};
        pg8::StaticOrder S; S.init(NT, NG, F.G, (int)blockIdx.x);
        EpiGlaProj E{(bf16_t*)(F.ws + WS_GQ), (bf16_t*)(F.ws + WS_GK), (bf16_t*)(F.ws + WS_GV), (bf16_t*)(F.ws + WS_GR), (bf16_t*)(F.ws + WS_GQM), (float*)(F.ws + WS_A1)};
        GEMM_CALL(EpiGlaProj, pg8::StaticOrder, g, S, E);
#if defined(PROBE_DUP10)
        SEAM(); GEMM_CALL(EpiGlaProj, pg8::StaticOrder, g, S, E);
#endif
        ENDPH(10);
    }
    if (IN(11)) REPS(11) { p_gla_u(F, args); ENDPH(11); }
    if (IN(12)) { p_gla_scan(F); ENDPH(12); }
    if (IN(13)) REPS(13) { p_gla_out(F, args); mem_attn_units(F, (const bf16_t*)(F.ws + WS_GQM), 1, (bf16_t*)(F.ws + WS_AO1)); ENDPH(13); }
    if (IN(14)) REPS(14) { out_proj(F, 1, (const bf16_t*)(F.ws + WS_AO1)); ENDPH(14); }
    if (IN(15)) { p_ln1_router<false>(F, args, 1, F.ws + WS_C, (bf16_t*)(F.ws + WS_X1B1)); ENDPH(15); }
    if (IN(16)) REPS(16) { moe_gemms_up(F, 1, (const bf16_t*)(F.ws + WS_X1B1), (bf16_t*)(F.ws + WS_ACT1)); ENDPH(16); }
    if (IN(17)) REPS(17) { moe_gemms_down(F, 1, (const bf16_t*)(F.ws + WS_ACT1)); ENDPH(17); }
    if (IN(18)) REPS(18) { p_ln2<true>(F, args, 1, (const bf16_t*)(F.ws + WS_X1B1), F.out); }
#undef IN
#undef ENDPH
}

extern "C" void kernel_launch(void* const* d_in, const int* in_sizes, int n_in, void* d_out, int out_size, void* d_ws, size_t ws_size, hipStream_t stream) {
    static int grid = 0;
    if (grid == 0) {
        if (n_in != 22 || out_size != NT * DM || ws_size < WS_END) { fprintf(stderr, "kernel_launch: unexpected shapes: n_in %d out %d ws %zu (need %zu)\n", n_in, out_size, ws_size, (size_t)WS_END); grid = -1; return; }
        int dev = 0, cus = 0, per_cu = 0;
        if (hipGetDevice(&dev) != hipSuccess || hipDeviceGetAttribute(&cus, hipDeviceAttributeMultiprocessorCount, dev) != hipSuccess) { grid = -1; return; }
        if (hipFuncSetAttribute((const void*)mk_fwd, hipFuncAttributeMaxDynamicSharedMemorySize, LDS_BYTES) != hipSuccess) { fprintf(stderr, "kernel_launch: hipFuncSetAttribute failed\n"); grid = -1; return; }
        if (hipOccupancyMaxActiveBlocksPerMultiprocessor(&per_cu, (const void*)mk_fwd, NWAVES * 64, LDS_BYTES) != hipSuccess || per_cu < 1) fprintf(stderr, "kernel_launch: occupancy query reports %d\n", per_cu);
        (void)hipGetLastError();
        grid = cus;
    }
    if (grid < 0) return;
    (void)hipMemsetAsync((char*)d_ws + WS_CTL, 0, CTL_ZERO_BYTES, stream);
    Args a{};
    for (int i = 0; i < 22; ++i) a.in[i] = d_in[i];
    a.out = (float*)d_out; a.ws = (unsigned char*)d_ws;
#if N_LAUNCH_MODE == 1
    a.ph_lo = 0; a.ph_hi = NPHASE;
    hipLaunchKernelGGL(mk_fwd, dim3(grid), dim3(NWAVES * 64), LDS_BYTES, stream, a);
#else
    for (int k = 0; k < NPHASE; ++k) { a.ph_lo = k; a.ph_hi = k + 1; hipLaunchKernelGGL(mk_fwd, dim3(grid), dim3(NWAVES * 64), LDS_BYTES, stream, a); }
#endif
}
```

```cpp
#include <hip/hip_runtime.h>
#include <cstdio>
#include <cstdint>

#define LAS __attribute__((address_space(3)))
#define GAS __attribute__((address_space(1)))
typedef unsigned short bf16_t;
typedef short bf16x8 __attribute__((ext_vector_type(8)));
typedef short s16x4 __attribute__((ext_vector_type(4)));
typedef float f32x4 __attribute__((ext_vector_type(4)));
typedef float f32x2 __attribute__((ext_vector_type(2)));
typedef float f32x16 __attribute__((ext_vector_type(16)));
typedef unsigned u32x4 __attribute__((ext_vector_type(4)));
typedef unsigned u32x2 __attribute__((ext_vector_type(2)));

#ifndef N_LAUNCH_MODE
#define N_LAUNCH_MODE 1
#endif

constexpr int NB = 16, SEQ = 2048, DM = 1024, NT = NB * SEQ;
constexpr int NMEM = 256;
constexpr int ND = 3328;
constexpr int NG = 2816;
constexpr int DSA_W = 3144, GLA_W = 2576;
constexpr int NEXP = 32;
constexpr int SLOT_ROWS = 73728;
constexpr float ALPHA = 1.4142135623730951f;
constexpr float LN_EPS = 1e-5f, RMS_EPS = 1e-6f;
constexpr float LOG2E = 1.4426950408889634f;
constexpr float C2 = 0.125f * LOG2E;
constexpr int NWAVES = 8;

constexpr size_t MiB = 1u << 20;
constexpr size_t WS_CTL = 0, CTL_ZERO_BYTES = 1 * MiB;
constexpr size_t WS_ROPEC = 1 * MiB, WS_ROPES = 5 * MiB;
constexpr size_t WS_DEC = 9 * MiB;
constexpr size_t WS_WD = 10 * MiB, WS_WG = 17 * MiB, WS_WKV = 23 * MiB, WS_WO = 25 * MiB, WS_W13 = 29 * MiB, WS_W2 = 61 * MiB;
constexpr size_t WS_KVM = 77 * MiB;
constexpr size_t WS_MEMB = 85 * MiB;
constexpr size_t WS_LISTTOK = 85 * MiB, WS_LISTW = 89 * MiB;
constexpr size_t WS_TOKSLOT = 93 * MiB;
constexpr size_t WS_A = 96 * MiB;
constexpr size_t WS_B = 160 * MiB;
constexpr size_t WS_C = 288 * MiB;
constexpr size_t WS_D = 352 * MiB;
constexpr size_t WS_END = 500 * MiB;
constexpr size_t WS_XB = WS_A;
constexpr size_t WS_Q = 160 * MiB, WS_K = 208 * MiB, WS_V = 256 * MiB, WS_QI = 304 * MiB, WS_QM = 336 * MiB, WS_KIW = 352 * MiB, WS_KI = 362 * MiB, WS_WI = 366 * MiB, WS_MASK = 368 * MiB, WS_AO0 = 376 * MiB;
constexpr size_t WS_X1 = WS_B, WS_X1B0 = WS_C, WS_ACT0 = WS_A, WS_Y = WS_D;
constexpr size_t WS_GV = 96 * MiB, WS_GQM = 144 * MiB, WS_GQ = 352 * MiB, WS_GK = 376 * MiB, WS_GR = 400 * MiB, WS_A1 = 448 * MiB, WS_KPT = 450 * MiB, WS_VT = WS_C, WS_AO1 = WS_B;
constexpr size_t WS_X1B1 = WS_A, WS_ACT1 = WS_C;
constexpr int KIW_P = 80;

constexpr int CW_CNT = 8192;
constexpr int CW_BAR = 4096;

__device__ __forceinline__ unsigned f2bf(float f) { unsigned u = __builtin_bit_cast(unsigned, f); return (u + 0x7fffu + ((u >> 16) & 1u)) >> 16; }
__device__ __forceinline__ unsigned pk2(float lo, float hi) { return f2bf(lo) | (f2bf(hi) << 16); }
__device__ __forceinline__ float bf2f(unsigned h) { return __builtin_bit_cast(float, h << 16); }
__device__ __forceinline__ float wave_sum(float v) {
#pragma unroll
    for (int o = 1; o < 64; o <<= 1) v += __shfl_xor(v, o);
    return v;
}
__device__ __forceinline__ float fast_exp2(float x) { return __builtin_amdgcn_exp2f(x); }
__device__ __forceinline__ float silu_f(float a) { return a * __builtin_amdgcn_rcpf(1.f + fast_exp2(-a * LOG2E)); }

namespace pg8 {
constexpr int BM = 256, BK = 64, HALF = 128, HTB = HALF * BK * 2, STAGE_BYTES = 8 * HTB, NXCD = 8, WGM = 8;
__host__ __device__ __forceinline__ int lds_byte(int r, int c) { const int st = (r >> 4) * 2 + (c >> 5), rr = r & 15, cc = c & 31, ob = rr * 64 + cc * 2; return st * 1024 + (ob ^ (((ob >> 9) & 1) << 5)); }
__host__ __device__ __forceinline__ void stage_rc(int b, int& R, int& C) { const int st = b / 1024, sb = b % 1024, swz = sb ^ (((sb >> 9) & 1) << 5); R = (st >> 1) * 16 + swz / 64; C = (st & 1) * 32 + (swz % 64) / 2; }
__host__ __device__ __forceinline__ int perm32(int rho) { const int n = rho >> 4, i = rho & 15; return 8 * (i >> 2) + 4 * n + (i & 3); }

struct Unit { int pm, pn, e, r0; };
struct Gemm { const bf16_t* A; const bf16_t* Bt; int M, N, K; };

struct StaticOrder {
    int nM, nN, nwg, G, c;
    __device__ void init(int M, int N, int G_, int c_) { nM = M / BM; nN = N / BM; nwg = nM * nN; G = G_; c = c_; }
    __device__ bool next(int i, Unit& u) const {
        const long L = (long)i * G + c; if (L >= nwg) return false;
        int wgid = (int)L; { const int q = nwg / NXCD, r = nwg % NXCD, xcd = wgid % NXCD, off = wgid / NXCD; wgid = (xcd < r ? xcd * (q + 1) : r * (q + 1) + (xcd - r) * q) + off; }
        const int nig = WGM * nN, gid = wgid / nig, fm = gid * WGM, gsz = (nM - fm) < WGM ? (nM - fm) : WGM;
        u.pm = fm + ((wgid % nig) % gsz); u.pn = (wgid % nig) / gsz; u.e = 0; u.r0 = 0; return true;
    }
    __device__ __forceinline__ int rowidx(const Unit& u, int r) const { return u.pm * BM + r; }
};

typedef __bf16 bf16x2_t __attribute__((ext_vector_type(2)));
__device__ __forceinline__ unsigned cvt_pk_bf16(float lo, float hi) { f32x2 v = {lo, hi}; bf16x2_t b = __builtin_convertvector(v, bf16x2_t); return __builtin_bit_cast(unsigned, b); }

template <class Epi, class Sched, bool ALIGN_EPI, bool SP2>
__device__ __forceinline__ void gemm_phase(LAS unsigned char* lds, const Gemm g, const Sched& S, const Epi& E) {
    const int tid = threadIdx.x, wid = __builtin_amdgcn_readfirstlane(tid >> 6), lane = tid & 63, wr = wid >> 2, wc = wid & 3, fr = lane & 15, fq = lane >> 4;
    const int K = g.K, nt = K / BK;
    int RA[2], CA[2]; unsigned voffB[2];
#pragma unroll
    for (int i = 0; i < 2; ++i) { int R, C; stage_rc(tid * 16 + i * 8192, R, C); const int Rb = (R & ~31) + perm32(R & 31);
        RA[i] = R; CA[i] = C; voffB[i] = (unsigned)(Rb * K + C) * 2u; }
    const size_t kstep = (size_t)(BK * 2);
    const size_t hstep = (size_t)HALF * K * 2;
    const size_t tstep = 2 * hstep;
    const unsigned ldsw = (unsigned)wid * 1024u;
    const int aoff = lds_byte(wr * 64 + fr, fq * 8), boff = lds_byte(wc * 32 + fr, fq * 8);
#define PG8_SA(b, h) (((b) * 2 + (h)) * HTB)
#define PG8_SB(b, h) ((4 + (b) * 2 + (h)) * HTB)
#define PG8_STAGE(bufoff, gbase, voff) do { _Pragma("unroll") for (int _i = 0; _i < 2; ++_i) \
        __builtin_amdgcn_global_load_lds((const unsigned*)((const char*)(gbase) + (voff)[_i]), (LAS unsigned*)(lds + (bufoff) + ldsw + _i * 8192), 16, 0, 0); } while (0)
#define PG8_LDA(dst, b, h) do { _Pragma("unroll") for (int m = 0; m < 4; ++m) _Pragma("unroll") for (int k = 0; k < 2; ++k) dst[m][k] = *(const LAS bf16x8*)(lds + PG8_SA(b, h) + aoff + m * 2048 + k * 1024); } while (0)
#define PG8_LDB(dst, b, h) do { _Pragma("unroll") for (int n = 0; n < 2; ++n) _Pragma("unroll") for (int k = 0; k < 2; ++k) dst[n][k] = *(const LAS bf16x8*)(lds + PG8_SB(b, h) + boff + n * 2048 + k * 1024); } while (0)
#define PG8_MMA(ai, bj, At, Bt) do { __builtin_amdgcn_s_setprio(1); _Pragma("unroll") for (int m = 0; m < 4; ++m) _Pragma("unroll") for (int n = 0; n < 2; ++n) _Pragma("unroll") for (int k = 0; k < 2; ++k) \
        acc[ai][bj][m][n] = __builtin_amdgcn_mfma_f32_16x16x32_bf16(Bt[n][k], At[m][k], acc[ai][bj][m][n], 0, 0, 0); __builtin_amdgcn_s_setprio(0); } while (0)
#define PG8_WAIT_V(n) asm volatile("s_waitcnt vmcnt(" #n ")" ::: "memory")
#define PG8_WAIT_L(n) asm volatile("s_waitcnt lgkmcnt(" #n ")" ::: "memory")
#define PG8_BAR __builtin_amdgcn_s_barrier()
#define PG8_SCHED __builtin_amdgcn_sched_barrier(0)
#define PG8_MKOFF(o0, o1, u) do { _Pragma("unroll") for (int _i = 0; _i < 2; ++_i) { \
        o0[_i] = ((unsigned)S.rowidx(u, RA[_i]) * (unsigned)K + (unsigned)CA[_i]) * 2u; o1[_i] = ((unsigned)S.rowidx(u, HALF + RA[_i]) * (unsigned)K + (unsigned)CA[_i]) * 2u; } } while (0)
    Unit cur, nxt; int ui = 0;
    if (!S.next(0, cur)) return;
    f32x4 acc[2][2][4][2];
#pragma unroll
    for (int a = 0; a < 2; ++a)
#pragma unroll
        for (int b = 0; b < 2; ++b)
#pragma unroll
            for (int m = 0; m < 4; ++m)
#pragma unroll
                for (int n = 0; n < 2; ++n) acc[a][b][m][n] = (f32x4){0.f, 0.f, 0.f, 0.f};
    bf16x8 At[4][2], B0[2][2], B1[2][2];
    const char* const gA = (const char*)g.A;
    unsigned cO0[2], cO1[2], nO0[2], nO1[2];
    PG8_MKOFF(cO0, cO1, cur);
    const char* cB = (const char*)g.Bt + (size_t)cur.pn * tstep;
    if constexpr (SP2) {
        PG8_STAGE(PG8_SB(0, 0), cB, voffB); PG8_STAGE(PG8_SB(0, 1), cB + hstep, voffB); PG8_STAGE(PG8_SA(0, 0), gA, cO0); PG8_STAGE(PG8_SA(0, 1), gA, cO1);
        if (wr == 1) PG8_BAR;
        PG8_WAIT_V(2); PG8_BAR;
        PG8_STAGE(PG8_SB(1, 0), cB + kstep, voffB); PG8_STAGE(PG8_SA(1, 0), gA + kstep, cO0); PG8_STAGE(PG8_SB(1, 1), cB + hstep + kstep, voffB);
        PG8_WAIT_V(6); PG8_BAR;
    } else {
        PG8_STAGE(PG8_SB(0, 0), cB, voffB); PG8_STAGE(PG8_SA(0, 0), gA, cO0); PG8_STAGE(PG8_SB(0, 1), cB + hstep, voffB); PG8_STAGE(PG8_SA(0, 1), gA, cO1);
        if (wr == 1) PG8_BAR;
        PG8_WAIT_V(4); PG8_BAR;
        PG8_STAGE(PG8_SB(1, 0), cB + kstep, voffB); PG8_STAGE(PG8_SA(1, 0), gA + kstep, cO0); PG8_STAGE(PG8_SB(1, 1), cB + hstep + kstep, voffB);
        PG8_WAIT_V(6); PG8_BAR;
    }
    for (;;) {
        const bool has_next = S.next(ui + 1, nxt);
        if (has_next) { PG8_MKOFF(nO0, nO1, nxt); } else {
#pragma unroll
            for (int _i = 0; _i < 2; ++_i) { nO0[_i] = cO0[_i]; nO1[_i] = cO1[_i]; } }
        const char* nB = has_next ? (const char*)g.Bt + (size_t)nxt.pn * tstep : cB;
#pragma unroll 1
        for (int t = 0; t < nt; t += 2) {
            const bool last = (t == nt - 2);
            const char* a1 = gA + (size_t)(t + 1) * kstep;
            const char* a2 = last ? gA : gA + (size_t)(t + 2) * kstep; const char* b2 = last ? nB : cB + (size_t)(t + 2) * kstep;
            const char* a3 = a2 + kstep; const char* b3 = b2 + kstep;
            unsigned x0[2], x1[2];
#pragma unroll
            for (int _i = 0; _i < 2; ++_i) { x0[_i] = last ? nO0[_i] : cO0[_i]; x1[_i] = last ? nO1[_i] : cO1[_i]; }
            if constexpr (SP2) {
            PG8_LDB(B0, 0, 0); PG8_LDB(B1, 0, 1); PG8_SCHED; PG8_LDA(At, 0, 0); PG8_STAGE(PG8_SA(1, 1), a1, cO1);
            PG8_WAIT_V(8); PG8_WAIT_L(0); PG8_BAR; PG8_MMA(0, 0, At, B0); PG8_MMA(0, 1, At, B1); PG8_BAR; PG8_SCHED;
            PG8_LDA(At, 0, 1); PG8_STAGE(PG8_SB(0, 0), b2, voffB); PG8_STAGE(PG8_SB(0, 1), b2 + hstep, voffB); PG8_STAGE(PG8_SA(0, 0), a2, x0);
            PG8_WAIT_V(8); PG8_WAIT_L(0); PG8_BAR; PG8_MMA(1, 0, At, B0); PG8_MMA(1, 1, At, B1); PG8_BAR; PG8_SCHED;
            PG8_LDB(B0, 1, 0); PG8_LDB(B1, 1, 1); PG8_SCHED; PG8_LDA(At, 1, 0); PG8_STAGE(PG8_SA(0, 1), a2, x1);
            PG8_WAIT_V(8); PG8_WAIT_L(0); PG8_BAR; PG8_MMA(0, 0, At, B0); PG8_MMA(0, 1, At, B1); PG8_BAR; PG8_SCHED;
            PG8_LDA(At, 1, 1); PG8_STAGE(PG8_SB(1, 0), b3, voffB); PG8_STAGE(PG8_SB(1, 1), b3 + hstep, voffB); PG8_STAGE(PG8_SA(1, 0), a3, x0);
            PG8_WAIT_V(8); PG8_WAIT_L(0); PG8_BAR; PG8_MMA(1, 0, At, B0); PG8_MMA(1, 1, At, B1); PG8_BAR; PG8_SCHED;
            } else {
            PG8_LDB(B0, 0, 0); PG8_SCHED; PG8_LDA(At, 0, 0); PG8_STAGE(PG8_SA(1, 1), a1, cO1);
            PG8_WAIT_L(8); PG8_BAR; PG8_WAIT_L(0); PG8_MMA(0, 0, At, B0); PG8_BAR; PG8_SCHED;
            PG8_LDB(B1, 0, 1); PG8_STAGE(PG8_SB(0, 0), b2, voffB);
            PG8_BAR; PG8_WAIT_L(0); PG8_MMA(0, 1, At, B1); PG8_BAR;
            PG8_LDA(At, 0, 1); PG8_STAGE(PG8_SA(0, 0), a2, x0);
            PG8_BAR; PG8_WAIT_L(0); PG8_MMA(1, 0, At, B0); PG8_BAR; PG8_SCHED;
            PG8_STAGE(PG8_SB(0, 1), b2 + hstep, voffB);
            PG8_WAIT_V(6); PG8_BAR; PG8_MMA(1, 1, At, B1); PG8_BAR;
            PG8_LDB(B0, 1, 0); PG8_SCHED; PG8_LDA(At, 1, 0); PG8_STAGE(PG8_SA(0, 1), a2, x1);
            PG8_WAIT_L(8); PG8_BAR; PG8_WAIT_L(0); PG8_MMA(0, 0, At, B0); PG8_BAR; PG8_SCHED;
            PG8_LDB(B1, 1, 1); PG8_STAGE(PG8_SB(1, 0), b3, voffB);
            PG8_BAR; PG8_WAIT_L(0); PG8_MMA(0, 1, At, B1); PG8_BAR;
            PG8_LDA(At, 1, 1); PG8_STAGE(PG8_SA(1, 0), a3, x0);
            PG8_BAR; PG8_WAIT_L(0); PG8_MMA(1, 0, At, B0); PG8_BAR; PG8_SCHED;
            PG8_STAGE(PG8_SB(1, 1), b3 + hstep, voffB);
            PG8_WAIT_V(6); PG8_BAR; PG8_MMA(1, 1, At, B1); PG8_BAR;
            }
        }
        if constexpr (ALIGN_EPI) { if (wr == 0) PG8_BAR; }
        E(acc, cur, wr, wc, fr, fq);
        if (!has_next) break;
#pragma unroll
        for (int a = 0; a < 2; ++a)
#pragma unroll
            for (int b = 0; b < 2; ++b)
#pragma unroll
                for (int m = 0; m < 4; ++m)
#pragma unroll
                    for (int n = 0; n < 2; ++n) acc[a][b][m][n] = (f32x4){0.f, 0.f, 0.f, 0.f};
        cur = nxt; cB = nB; ++ui;
#pragma unroll
        for (int _i = 0; _i < 2; ++_i) { cO0[_i] = nO0[_i]; cO1[_i] = nO1[_i]; }
        if constexpr (ALIGN_EPI) { if (wr == 1) PG8_BAR; }
    }
    PG8_WAIT_V(0);
    if constexpr (!ALIGN_EPI) { if (wr == 0) PG8_BAR; }
    PG8_BAR;
#undef PG8_SA
#undef PG8_SB
#undef PG8_STAGE
#undef PG8_LDA
#undef PG8_LDB
#undef PG8_MMA
#undef PG8_WAIT_V
#undef PG8_WAIT_L
#undef PG8_BAR
#undef PG8_SCHED
#undef PG8_MKOFF
}
}

#define XB_TMO      128
#define XB_XCNT(j)  (256  + 64 * (j))
#define XB_XSUB(j)  (1280 + 64 * (j))
#define XB_XGEN(j)  (2304 + 64 * (j))
#define XB_TOP      3328
#define XB_TOPGEN   3392
#define XCD_BAR_WORDS 3456
#define XB_SPIN_CAP (1u << 18)
__device__ __forceinline__ unsigned xb_ld(unsigned* p)              { return __hip_atomic_load(p, __ATOMIC_RELAXED, __HIP_MEMORY_SCOPE_AGENT); }
__device__ __forceinline__ unsigned xb_add(unsigned* p, unsigned v) { return __hip_atomic_fetch_add(p, v, __ATOMIC_RELAXED, __HIP_MEMORY_SCOPE_AGENT); }
__device__ __forceinline__ unsigned xb_xcc_id() { return (unsigned)__builtin_amdgcn_s_getreg((3 << 11) | 20) & 0xFu; }
#define XB_SPIN(cond, bar) do { unsigned _sp = 0; while (cond) { __builtin_amdgcn_s_sleep(1); \
    if ((++_sp & 255u) == 0u) { if (xb_ld(&(bar)[XB_TMO])) break; if (_sp > XB_SPIN_CAP) { atomicAdd(&(bar)[XB_TMO], 1u); break; } } } } while (0)
struct XcdBarrier { unsigned* bar; unsigned x; volatile LAS unsigned* st; };
__device__ __forceinline__ XcdBarrier xcd_barrier_post(unsigned* bar, volatile LAS unsigned* st) {
    XcdBarrier b; b.bar = bar; b.x = xb_xcc_id(); b.st = st;
    if (threadIdx.x == 0) (void)xb_add(&bar[XB_XCNT(b.x)], 1u);
    return b;
}
__device__ __forceinline__ void xcd_barrier_complete(unsigned* bar, unsigned x, unsigned& nloc, unsigned& nx) {
    const unsigned G = gridDim.x * gridDim.y * gridDim.z;
    unsigned sum, cnt, mine, sp = 0u;
    for (;;) {
        sum = 0u; cnt = 0u; mine = 0u;
#pragma unroll
        for (unsigned j = 0; j < 16; ++j) { const unsigned c = xb_ld(&bar[XB_XCNT(j)]); sum += c; cnt += (c > 0u) ? 1u : 0u; mine = (j == x) ? c : mine; }
        if (sum == G) break;
        __builtin_amdgcn_s_sleep(1);
        if ((++sp & 255u) == 0u) { if (xb_ld(&bar[XB_TMO])) break; if (sp > XB_SPIN_CAP) { atomicAdd(&bar[XB_TMO], 1u); break; } }
    }
    nloc = mine > 0u ? mine : 1u; nx = cnt > 0u ? cnt : 1u;
}
__device__ __forceinline__ void xcd_barrier(const XcdBarrier& b) {
    asm volatile("s_waitcnt vmcnt(0)" ::: "memory");
    __syncthreads();
    if (threadIdx.x == 0) {
        unsigned* bar = b.bar;
        __builtin_amdgcn_s_waitcnt(0);
        unsigned nloc = b.st[0], nx = b.st[1];
        if (nloc == 0u) { xcd_barrier_complete(bar, b.x, nloc, nx); b.st[0] = nloc; b.st[1] = nx; }
        const unsigned old = xb_add(&bar[XB_XSUB(b.x)], 1u);
        const unsigned gen = old / nloc;
        if (old + 1u == (gen + 1u) * nloc) {
            __builtin_amdgcn_fence(__ATOMIC_RELEASE, "agent");
            asm volatile("s_waitcnt vmcnt(0)" ::: "memory");
            const unsigned og = xb_add(&bar[XB_TOP], 1u);
            const unsigned tg = og / nx;
            if (og + 1u == (tg + 1u) * nx) xb_add(&bar[XB_TOPGEN], 1u);
            else XB_SPIN(xb_ld(&bar[XB_TOPGEN]) == tg, bar);
            __builtin_amdgcn_fence(__ATOMIC_ACQUIRE, "agent");
            xb_add(&bar[XB_XGEN(b.x)], 1u);
            asm volatile("s_waitcnt vmcnt(0)" ::: "memory");
        } else {
            XB_SPIN(xb_ld(&bar[XB_XGEN(b.x)]) == gen, bar);
            __builtin_amdgcn_fence(__ATOMIC_ACQUIRE, "agent");
            asm volatile("s_waitcnt vmcnt(0)" ::: "memory");
        }
    }
    __syncthreads();
}

constexpr int LDS_BYTES = 147456;
constexpr int MISC_OFF = 135168;
struct Args { const void* in[22]; float* out; unsigned char* ws; int ph_lo, ph_hi; };
struct Frame {
    LAS unsigned char* lds;
    unsigned char* ws; float* out;
    unsigned* ctl;
    int tid, lane, wave, G, gw, NGW;
};
enum { I_X = 0, I_MEM, I_POS, I_DSA_WIN, I_DSA_KG, I_DSA_KB, I_GLA_WIN, I_GLA_WGATE, I_GLA_BGATE, I_GLA_NORMG, I_WMEMKV, I_WOUT, I_LN1G, I_LN1B, I_LN2G, I_LN2B,
       I_MOE_WG, I_MOE_BG, I_MOE_WR, I_MOE_BR, I_MOE_W13, I_MOE_W2 };

__device__ __forceinline__ int dperm(int c) { return ((c >> 2) & 1) * 32 + (c >> 5) * 16 + ((c >> 3) & 3) * 4 + (c & 3); }
__device__ __forceinline__ int dperm_inv(int d) { const int n = d >> 5, i = d & 31; return (i >> 4) * 32 + ((i >> 2) & 3) * 8 + n * 4 + (i & 3); }
__device__ __forceinline__ int dsa_srccol(int n) {
    if (n < 1536) { return (n & ~63) + dperm(n & 63); }
    if (n < 2304) return n;
    if (n < 2816) { return (n & ~63) + dperm(n & 63); }
    if (n < 3072) return 2888 + (n - 2816);
    if (n < 3136) return 2816 + dperm(n - 3072);
    if (n < 3144) return 2880 + (n - 3136);
    return -1;
}
__device__ __forceinline__ int gla_srccol(int n) {
    if (n < 2304) return n;
    if (n < 2560) return 2320 + (n - 2304);
    if (n < 2576) return 2304 + (n - 2560);
    return -1;
}
__device__ __forceinline__ int w13_srccol(int r) { const int pn = r >> 8, bj = (r >> 7) & 1, j = r & 127; return bj * 256 + pn * 128 + j; }
template <int MODE>
__device__ __forceinline__ void transpose_item(const float* W, int K, int ldw, bf16_t* WT, int nrows32, LAS float* scr, int item, int lane) {
    const int kb = item / nrows32, nb = item % nrows32, k0 = 64 * kb, n0 = 32 * nb;
    const int n = n0 + (lane & 31);
    int sc;
    if (MODE == 0) sc = n; else if (MODE == 1) sc = dsa_srccol(n); else if (MODE == 2) sc = gla_srccol(n); else sc = w13_srccol(n);
#pragma unroll
    for (int i = 0; i < 32; ++i) { const int kk = 2 * i + (lane >> 5); scr[kk * 33 + (lane & 31)] = (sc >= 0) ? W[(size_t)(k0 + kk) * ldw + sc] : 0.f; }
    asm volatile("s_waitcnt lgkmcnt(0)" ::: "memory");
    const int c = lane & 7;
#pragma unroll
    for (int j = 0; j < 4; ++j) { const int nn = (lane >> 3) + 8 * j; const LAS float* s = scr + (8 * c) * 33 + nn;
        u32x4 o; o.x = pk2(s[0 * 33], s[1 * 33]); o.y = pk2(s[2 * 33], s[3 * 33]); o.z = pk2(s[4 * 33], s[5 * 33]); o.w = pk2(s[6 * 33], s[7 * 33]);
        *(u32x4*)(WT + (size_t)(n0 + nn) * K + k0 + 8 * c) = o; }
    asm volatile("s_waitcnt lgkmcnt(0)" ::: "memory");
}
__device__ __forceinline__ void moe_weight_items(Frame& F, const float* w13, const float* w2, int layer) {
    LAS float* scr = (LAS float*)(F.lds + F.wave * 16384);
    bf16_t* W13 = (bf16_t*)(F.ws + WS_W13); bf16_t* W2 = (bf16_t*)(F.ws + WS_W2);
    constexpr int I13 = (1024 / 64) * (512 / 32), I2 = (256 / 64) * (1024 / 32);
    for (int it = F.gw; it < NEXP * (I13 + I2); it += F.NGW) {
        const int ge = it / (I13 + I2), r = it % (I13 + I2);
        if (r < I13) transpose_item<3>(w13 + ((size_t)layer * NEXP + ge) * 1024 * 512, 1024, 512, W13 + (size_t)ge * 512 * 1024, 16, scr, r, F.lane);
        else transpose_item<0>(w2 + ((size_t)layer * NEXP + ge) * 256 * 1024, 256, 1024, W2 + (size_t)ge * 1024 * 256, 32, scr, r - I13, F.lane);
    }
}
__device__ __forceinline__ void cvt_rows_bf16(Frame& F, const float* src, bf16_t* dst, int rows) {
    for (int m0 = F.gw; m0 < rows; m0 += 4 * F.NGW) {
        f32x4 v[4][4];
#pragma unroll
        for (int q = 0; q < 4; ++q) { const int m = m0 + q * F.NGW; if (m < rows) { const f32x4* xr = (const f32x4*)(src + (size_t)m * DM) + F.lane;
#pragma unroll
            for (int j = 0; j < 4; ++j) v[q][j] = xr[64 * j]; } }
#pragma unroll
        for (int q = 0; q < 4; ++q) { const int m = m0 + q * F.NGW; if (m < rows) { u32x2* o = (u32x2*)(dst + (size_t)m * DM) + F.lane;
#pragma unroll
            for (int j = 0; j < 4; ++j) { u32x2 w; w.x = pk2(v[q][j].x, v[q][j].y); w.y = pk2(v[q][j].z, v[q][j].w); o[64 * j] = w; } } }
    }
}
__device__ __forceinline__ void p_prologue(Frame& F, const Args& a) {
    LAS float* scr = (LAS float*)(F.lds + F.wave * 16384);
    const float* dsa_w = (const float*)a.in[I_DSA_WIN]; const float* gla_w = (const float*)a.in[I_GLA_WIN];
    const float* wkv = (const float*)a.in[I_WMEMKV]; const float* wout = (const float*)a.in[I_WOUT];
    bf16_t* WD = (bf16_t*)(F.ws + WS_WD); bf16_t* WG = (bf16_t*)(F.ws + WS_WG); bf16_t* WKV = (bf16_t*)(F.ws + WS_WKV); bf16_t* WO = (bf16_t*)(F.ws + WS_WO);
    constexpr int ID = 16 * (ND / 32), IG = 16 * (NG / 32), IKV = 16 * (512 / 32), IO = 16 * (1024 / 32);
    constexpr int NIT = ID + IG + 2 * IKV + 2 * IO;
    for (int it = F.gw; it < NIT; it += F.NGW) {
        int r = it;
        if (r < ID) { transpose_item<1>(dsa_w, 1024, DSA_W, WD, ND / 32, scr, r, F.lane); continue; } r -= ID;
        if (r < IG) { transpose_item<2>(gla_w, 1024, GLA_W, WG, NG / 32, scr, r, F.lane); continue; } r -= IG;
        if (r < 2 * IKV) { const int l = r / IKV; transpose_item<0>(wkv + (size_t)l * 1024 * 512, 1024, 512, WKV + (size_t)l * 512 * 1024, 16, scr, r % IKV, F.lane); continue; } r -= 2 * IKV;
        { const int l = r / IO; transpose_item<0>(wout + (size_t)l * 1024 * 1024, 1024, 1024, WO + (size_t)l * 1024 * 1024, 32, scr, r % IO, F.lane); }
    }
    moe_weight_items(F, (const float*)a.in[I_MOE_W13], (const float*)a.in[I_MOE_W2], 0);
    cvt_rows_bf16(F, (const float*)a.in[I_X], (bf16_t*)(F.ws + WS_XB), NT);
    cvt_rows_bf16(F, (const float*)a.in[I_MEM], (bf16_t*)(F.ws + WS_MEMB), NB * NMEM);
    const int* pos = (const int*)a.in[I_POS];
    float* RC = (float*)(F.ws + WS_ROPEC); float* RS = (float*)(F.ws + WS_ROPES);
    __syncthreads();
    LAS float* invs = (LAS float*)F.lds;
    if (F.tid < 32) invs[F.tid] = (float)pow(10000.0, -(double)(2 * F.tid) / 64.0);
    __syncthreads();
    for (int idx = blockIdx.x * 512 + F.tid; idx < NT * 32; idx += F.G * 512) {
        const int t = idx >> 5, i = idx & 31;
        const float ang = (float)pos[t] * invs[i];
        float sn, cs; sincosf(ang, &sn, &cs);
        RC[idx] = cs; RS[idx] = sn;
    }
}
typedef const f32x4 (&AccRef)[2][2][4][2];
__device__ __forceinline__ void st_bf16x8(bf16_t* p, f32x4 v0, f32x4 v1) {
    u32x4 w; w.x = pg8::cvt_pk_bf16(v0[0], v0[1]); w.y = pg8::cvt_pk_bf16(v0[2], v0[3]); w.z = pg8::cvt_pk_bf16(v1[0], v1[1]); w.w = pg8::cvt_pk_bf16(v1[2], v1[3]);
    *(u32x4*)p = w;
}
struct EpiDsaProj {
    bf16_t *Q, *K, *V, *QI, *QM, *KI; float* WI; const float *RC, *RS, *kg, *kb; LAS unsigned char* xlds;
    __device__ __forceinline__ void operator()(AccRef acc, const pg8::Unit& u, int wr, int wc, int fr, int fq) const {
        const int pn = u.pn; const int row0 = u.pm * 256 + wr * 64 + fr;
        const int i0 = 16 * (wc & 1) + 4 * fq;
#pragma unroll
        for (int ai = 0; ai < 2; ++ai)
#pragma unroll
            for (int m = 0; m < 4; ++m) {
                const int row = row0 + ai * 128 + m * 16;
                f32x4 c4 = (f32x4){1.f, 1.f, 1.f, 1.f}, s4 = (f32x4){0.f, 0.f, 0.f, 0.f};
                const bool rope = (pn < 6) || (pn == 9) || (pn == 10);
                if (rope) { c4 = *(const f32x4*)(RC + (size_t)row * 32 + i0); s4 = *(const f32x4*)(RS + (size_t)row * 32 + i0); }
#pragma unroll
                for (int bj = 0; bj < 2; ++bj) {
                    const int gcol = pn * 256 + bj * 128 + wc * 32 + 8 * fq;
                    f32x4 v0 = acc[ai][bj][m][0], v1 = acc[ai][bj][m][1];
                    if (rope) { const f32x4 y0 = v0 * c4 - v1 * s4, y1 = v1 * c4 + v0 * s4; v0 = y0; v1 = y1; }
                    if (pn < 3) { v0 = v0 * C2; v1 = v1 * C2; st_bf16x8(Q + (size_t)row * 768 + gcol, v0, v1); }
                    else if (pn < 6) st_bf16x8(K + (size_t)row * 768 + (gcol - 768), v0, v1);
                    else if (pn < 9) st_bf16x8(V + (size_t)row * 768 + (gcol - 1536), v0, v1);
                    else if (pn < 11) st_bf16x8(QI + (size_t)row * 512 + (gcol - 2304), v0, v1);
                    else if (pn == 11) { v0 = v0 * C2; v1 = v1 * C2; st_bf16x8(QM + (size_t)row * 256 + (gcol - 2816), v0, v1); }
                }
            }
        if (pn == 12) ki_tile(acc, u, wr, wc, fr, fq);
    }
    __device__ __forceinline__ void ki_tile(AccRef acc, const pg8::Unit& u, int wr, int wc, int fr, int fq) const {
        LAS f32x2* xch = (LAS f32x2*)xlds;
        const int row0 = u.pm * 256 + wr * 64 + fr;
        if (wc < 2) {
#pragma unroll
            for (int ai = 0; ai < 2; ++ai)
#pragma unroll
                for (int m = 0; m < 4; ++m) { const f32x4 v0 = acc[ai][0][m][0], v1 = acc[ai][0][m][1];
                    float a = ((v0[0] + v0[1]) + (v0[2] + v0[3])) + ((v1[0] + v1[1]) + (v1[2] + v1[3]));
                    float b = ((v0[0] * v0[0] + v0[1] * v0[1]) + (v0[2] * v0[2] + v0[3] * v0[3])) + ((v1[0] * v1[0] + v1[1] * v1[1]) + (v1[2] * v1[2] + v1[3] * v1[3]));
                    a += __shfl_xor(a, 16); b += __shfl_xor(b, 16); a += __shfl_xor(a, 32); b += __shfl_xor(b, 32);
                    if (fq == 0) xch[(((wr * 2 + wc) * 2 + ai) * 4 + m) * 16 + fr] = (f32x2){a, b}; }
        }
        asm volatile("s_waitcnt lgkmcnt(0)" ::: "memory"); __builtin_amdgcn_s_barrier(); asm volatile("" ::: "memory");
        if (wc < 2) {
            const int c0 = 32 * wc + 8 * fq, i0 = 16 * wc + 4 * fq;
            f32x4 g0, g1, b0, b1;
#pragma unroll
            for (int j = 0; j < 4; ++j) { g0[j] = kg[dperm(c0 + j)]; g1[j] = kg[dperm(c0 + 4 + j)]; b0[j] = kb[dperm(c0 + j)]; b1[j] = kb[dperm(c0 + 4 + j)]; }
#pragma unroll
            for (int ai = 0; ai < 2; ++ai)
#pragma unroll
                for (int m = 0; m < 4; ++m) { const int row = row0 + ai * 128 + m * 16;
                    const f32x2 ot = xch[(((wr * 2 + 1) * 2 + ai) * 4 + m) * 16 + fr], ow = xch[(((wr * 2 + 0) * 2 + ai) * 4 + m) * 16 + fr];
                    const float mu = (ow.x + ot.x) * (1.f / 64.f); const float var = fmaxf((ow.y + ot.y) * (1.f / 64.f) - mu * mu, 0.f);
                    const float rs = 1.f / sqrtf(var + LN_EPS);
                    const f32x4 n0 = (acc[ai][0][m][0] - mu) * rs * g0 + b0, n1 = (acc[ai][0][m][1] - mu) * rs * g1 + b1;
                    const f32x4 c4 = *(const f32x4*)(RC + (size_t)row * 32 + i0), s4 = *(const f32x4*)(RS + (size_t)row * 32 + i0);
                    st_bf16x8(KI + (size_t)row * 64 + c0, n0 * c4 - n1 * s4, n1 * c4 + n0 * s4); }
        } else if (wc == 2 && fq == 0) {
#pragma unroll
            for (int ai = 0; ai < 2; ++ai)
#pragma unroll
                for (int m = 0; m < 4; ++m) { float* p = WI + (size_t)(row0 + ai * 128 + m * 16) * 8;
                    *(f32x4*)p = acc[ai][0][m][0] * 0.04419417382415922f; *(f32x4*)(p + 4) = acc[ai][0][m][1] * 0.04419417382415922f; }
        }
        asm volatile("s_waitcnt lgkmcnt(0)" ::: "memory"); __builtin_amdgcn_s_barrier(); asm volatile("" ::: "memory");
    }
};
struct EpiGlaProj {
    bf16_t *GQ, *GK, *GV, *GR, *GQM; float* A1;
    __device__ __forceinline__ void operator()(AccRef acc, const pg8::Unit& u, int wr, int wc, int fr, int fq) const {
        const int pn = u.pn; const int row0 = u.pm * 256 + wr * 64 + fr;
#pragma unroll
        for (int ai = 0; ai < 2; ++ai)
#pragma unroll
            for (int m = 0; m < 4; ++m) {
                const int row = row0 + ai * 128 + m * 16;
#pragma unroll
                for (int bj = 0; bj < 2; ++bj) {
                    const int gcol = pn * 256 + bj * 128 + wc * 32 + 8 * fq;
                    f32x4 v0 = acc[ai][bj][m][0], v1 = acc[ai][bj][m][1];
                    if (pn < 3) {
                        if (gcol < 384) { v0 = v0 * 0.10206207261596577f; v1 = v1 * 0.10206207261596577f; st_bf16x8(GQ + (size_t)row * 384 + gcol, v0, v1); }
                        else st_bf16x8(GK + (size_t)row * 384 + (gcol - 384), v0, v1);
                    }
                    else if (pn < 6) st_bf16x8(GV + (size_t)row * 768 + (gcol - 768), v0, v1);
                    else if (pn < 9) st_bf16x8(GR + (size_t)row * 768 + (gcol - 1536), v0, v1);
                    else if (pn == 9) { v0 = v0 * C2; v1 = v1 * C2; st_bf16x8(GQM + (size_t)row * 256 + (gcol - 2304), v0, v1); }
                    else { const int lc = gcol - 2560; if (lc < 16) { float* p = A1 + (size_t)row * 16 + lc; *(f32x4*)p = v0; *(f32x4*)(p + 4) = v1; } }
                }
            }
    }
};
struct EpiBf16Plain {
    bf16_t* O; int ldc; int ncolmask;
    __device__ __forceinline__ void operator()(AccRef acc, const pg8::Unit& u, int wr, int wc, int fr, int fq) const {
        const int row0 = u.pm * 256 + wr * 64 + fr; const int colt = (u.pn & ncolmask) * 256 + wc * 32 + 8 * fq;
#pragma unroll
        for (int ai = 0; ai < 2; ++ai)
#pragma unroll
            for (int m = 0; m < 4; ++m) { bf16_t* rowp = O + (size_t)(row0 + ai * 128 + m * 16) * ldc + colt;
#pragma unroll
                for (int bj = 0; bj < 2; ++bj) st_bf16x8(rowp + bj * 128, acc[ai][bj][m][0], acc[ai][bj][m][1]); }
    }
};
struct EpiF32Plain {
    float* C; int ldc;
    __device__ __forceinline__ void operator()(AccRef acc, const pg8::Unit& u, int wr, int wc, int fr, int fq) const {
        const int row0 = u.pm * 256 + wr * 64 + fr; const int colt = u.pn * 256 + wc * 32 + 8 * fq;
#pragma unroll
        for (int ai = 0; ai < 2; ++ai)
#pragma unroll
            for (int m = 0; m < 4; ++m) { float* rowp = C + (size_t)(row0 + ai * 128 + m * 16) * ldc + colt;
#pragma unroll
                for (int bj = 0; bj < 2; ++bj) { *(f32x4*)(rowp + bj * 128) = acc[ai][bj][m][0]; *(f32x4*)(rowp + bj * 128 + 4) = acc[ai][bj][m][1]; } }
    }
};

struct DsaKvmOrder {
    pg8::StaticOrder so; int G, c;
    __device__ void init(int G_, int c_) { so.init(NT, ND, G_, c_); G = G_; c = c_; }
    __device__ bool next(int i, pg8::Unit& u) const {
        const long L = (long)i * G + c;
        if (L < so.nwg) { so.next(i, u); u.e = 0; u.r0 = u.pn; u.pn += (int)(WS_WD / (512 * 1024)); return true; }
        const int k = (int)(L - so.nwg); if (k >= 64) return false;
        u.pm = k >> 2; u.r0 = k & 3; u.pn = (int)(WS_WKV / (512 * 1024)) + (k & 3); u.e = 1; return true;
    }
    __device__ __forceinline__ int rowidx(const pg8::Unit& u, int r) const { return (u.e ? (int)(WS_MEMB / 2048) : (int)(WS_XB / 2048)) + u.pm * 256 + r; }
};
struct EpiDsaKvm {
    EpiDsaProj d; EpiBf16Plain k;
    __device__ __forceinline__ void operator()(AccRef acc, const pg8::Unit& u, int wr, int wc, int fr, int fq) const {
        pg8::Unit v = u; v.pn = u.r0;
        if (u.e == 0) d(acc, v, wr, wc, fr, fq); else k(acc, v, wr, wc, fr, fq);
    }
};
struct EpiMoe1 {
    bf16_t* ACT; const float* LISTW; const unsigned* cnt;
    __device__ __forceinline__ void operator()(AccRef acc, const pg8::Unit& u, int wr, int wc, int fr, int fq) const {
        const int j2 = u.pn & 1; const int rl0 = wr * 64 + fr; const int ce = (int)cnt[u.e * 64];
#pragma unroll
        for (int ai = 0; ai < 2; ++ai)
#pragma unroll
            for (int m = 0; m < 4; ++m) {
                const int rl = rl0 + ai * 128 + m * 16; const int pos = u.r0 + rl;
                const float wt = (pos < ce) ? LISTW[(size_t)u.e * NT + pos] : 0.f;
                f32x4 a0 = acc[ai][0][m][0], a1 = acc[ai][0][m][1], u0 = acc[ai][1][m][0], u1 = acc[ai][1][m][1], o0, o1;
#pragma unroll
                for (int j = 0; j < 4; ++j) { o0[j] = silu_f(a0[j]) * u0[j] * wt; o1[j] = silu_f(a1[j]) * u1[j] * wt; }
                st_bf16x8(ACT + (size_t)(u.pm * 256 + rl) * 256 + j2 * 128 + wc * 32 + 8 * fq, o0, o1);
            }
    }
};
struct MoeOrder {
    const LAS int* tp; const unsigned* cnt; const int* LISTTOK; int ncol, G, c; bool gather;
    __device__ bool next(int i, pg8::Unit& u) const {
        const long L = (long)i * G + c; const int ntile = tp[NEXP];
        if (L >= (long)ntile * ncol) return false;
        const int tile = (int)(L / ncol), col = (int)(L % ncol);
        int e = 0;
#pragma unroll 1
        while (tp[e + 1] <= tile) ++e;
        u.pm = tile; u.pn = e * ncol + col; u.e = e; u.r0 = (tile - tp[e]) * 256; return true;
    }
    __device__ __forceinline__ int rowidx(const pg8::Unit& u, int r) const {
        if (!gather) return u.pm * 256 + r;
        const int pos = u.r0 + r;
        return (pos < (int)cnt[u.e * 64]) ? LISTTOK[(size_t)u.e * NT + pos] : 0;
    }
};
__device__ __forceinline__ void moe_tile_table(Frame& F, const unsigned* cnt, LAS int* tp) {
    if (F.tid == 0) { int s = 0; for (int e = 0; e < NEXP; ++e) { tp[e] = s; s += ((int)cnt[e * 64] + 255) >> 8; } tp[NEXP] = s; }
    __syncthreads();
}

__device__ __forceinline__ void p_ki(Frame& F, const Args& a) {
    const float* KIW = (const float*)(F.ws + WS_KIW); bf16_t* KI = (bf16_t*)(F.ws + WS_KI); float* WI = (float*)(F.ws + WS_WI);
    const float* RC = (const float*)(F.ws + WS_ROPEC); const float* RS = (const float*)(F.ws + WS_ROPES);
    const float* g = (const float*)a.in[I_DSA_KG]; const float* bb = (const float*)a.in[I_DSA_KB];
    const int d = F.lane; const float gd = g[d], bd = bb[d]; const int dst = dperm_inv(d);
    for (int t = F.gw; t < NT; t += F.NGW) {
        const float v = KIW[(size_t)t * KIW_P + d];
        const float mu = wave_sum(v) * (1.f / 64.f); const float dv = v - mu;
        const float var = wave_sum(dv * dv) * (1.f / 64.f);
        const float n = dv * (1.f / sqrtf(var + LN_EPS)) * gd + bd;
        const float pr = __shfl_xor(n, 32);
        const float c = RC[(size_t)t * 32 + (d & 31)], s = RS[(size_t)t * 32 + (d & 31)];
        const float o = (d < 32) ? (n * c - pr * s) : (n * c + pr * s);
        KI[(size_t)t * 64 + dst] = (bf16_t)f2bf(o);
        if (d < 8) WI[(size_t)t * 8 + d] = KIW[(size_t)t * KIW_P + 64 + d] * 0.04419417382415922f;
    }
}

__device__ __forceinline__ unsigned ordkey(float f) { const unsigned u = __builtin_bit_cast(unsigned, f); return (u & 0x80000000u) ? ~u : (u | 0x80000000u); }
template <int NQ>
__device__ __forceinline__ void topk_select(const LAS float* sc, unsigned long long* MASK, size_t rowbase, int t0, int wave, int lane) {
#pragma unroll 1
    for (int u = 0; u < 2; ++u) {
        const int tk = 2 * wave + u, t = t0 + tk;
        unsigned key[NQ];
#pragma unroll
        for (int q = 0; q < NQ; ++q) { const unsigned k = ordkey(sc[tk * 2048 + lane + 64 * q]); key[q] = (lane + 64 * q <= t) ? k : 0u; }
        unsigned T = 0u; bool exact = false;
#pragma unroll 1
        for (int bit = 31; bit >= 0; --bit) {
            const unsigned cand = T | (1u << bit); int c = 0;
#pragma unroll
            for (int q = 0; q < NQ; ++q) c += __builtin_popcountll(__ballot(key[q] >= cand));
            if (c >= 256) { T = cand; if (c == 256) { exact = true; break; } }
        }
        int need = 0, ceq = 0;
        if (!exact) { int cgt = 0;
#pragma unroll
            for (int q = 0; q < NQ; ++q) { cgt += __builtin_popcountll(__ballot(key[q] > T)); ceq += __builtin_popcountll(__ballot(key[q] == T)); }
            need = 256 - cgt; }
        unsigned long long mymask = 0ull;
        if (exact || need == ceq) {
#pragma unroll
            for (int q = 0; q < NQ; ++q) { const unsigned long long bal = __ballot(key[q] >= T); if (lane == q) mymask = bal; }
        } else {
#pragma unroll 1
            for (int q = 0; q < NQ; ++q) {
                unsigned kq = 0u;
#pragma unroll
                for (int z = 0; z < NQ; ++z) kq = (z == q) ? key[z] : kq;
                unsigned long long eq = __ballot(kq == T); const unsigned long long gt = __ballot(kq > T);
                int pc = __builtin_popcountll(eq); const int take = pc < need ? pc : need;
                while (pc > take) { eq &= ~(1ull << (63 - __builtin_clzll(eq))); --pc; }
                need -= take;
                if (lane == q) mymask = gt | eq;
            }
        }
        if (lane < 32) MASK[(rowbase + t) * 32 + lane] = mymask;
    }
}
__device__ __forceinline__ void p_indexer(Frame& F) {
    const bf16_t* QI = (const bf16_t*)(F.ws + WS_QI); const bf16_t* KI = (const bf16_t*)(F.ws + WS_KI); const float* WI = (const float*)(F.ws + WS_WI);
    unsigned long long* MASK = (unsigned long long*)(F.ws + WS_MASK);
    LAS float* sc = (LAS float*)F.lds;
    LAS float* wis = (LAS float*)(F.lds + 131072);
    const int lane = F.lane, r32 = lane & 31, hi = lane >> 5, wave = F.wave;
    for (int i = 0;; ++i) {
        const int U = i * F.G + (int)blockIdx.x; if (U >= NB * 128) break;
        const int b = U >> 7, tl = U & 127, tile = (i & 1) ? 127 - tl : tl;
        const int t0 = tile * 16; const size_t rowbase = (size_t)b * SEQ;
        if (t0 < 256) {
#pragma unroll
            for (int u = 0; u < 2; ++u) { const int t = t0 + 2 * wave + u;
                if (lane < 32) { const int nb = t + 1 - 64 * lane; const unsigned long long m = nb >= 64 ? ~0ull : (nb <= 0 ? 0ull : ((1ull << nb) - 1ull)); MASK[(rowbase + t) * 32 + lane] = m; } }
            continue;
        }
        if (F.tid < 128) wis[F.tid] = WI[(rowbase + t0) * 8 + F.tid];
        bf16x8 af[4][4];
        { const int m = r32, j = m & 3, hp = (m >> 2) & 1, ii = m >> 3, tokl = 2 * hp + (ii >> 1), head = 4 * (ii & 1) + j;
#pragma unroll
          for (int mt = 0; mt < 4; ++mt)
#pragma unroll
            for (int ks = 0; ks < 4; ++ks) af[mt][ks] = *(const bf16x8*)(QI + (rowbase + t0 + 4 * mt + tokl) * 512 + head * 64 + ks * 16 + hi * 8); }
        __syncthreads();
        const int n32 = (t0 + 16 + 31) >> 5;
        bf16x8 bnx[4];
        if (wave < n32) {
#pragma unroll
            for (int ks = 0; ks < 4; ++ks) bnx[ks] = *(const bf16x8*)(KI + (rowbase + wave * 32 + r32) * 64 + ks * 16 + hi * 8); }
        for (int kt = wave; kt < n32; kt += NWAVES) {
            const int key = kt * 32 + r32;
            bf16x8 bfr[4];
#pragma unroll
            for (int ks = 0; ks < 4; ++ks) bfr[ks] = bnx[ks];
            if (kt + NWAVES < n32) {
#pragma unroll
                for (int ks = 0; ks < 4; ++ks) bnx[ks] = *(const bf16x8*)(KI + (rowbase + key + NWAVES * 32) * 64 + ks * 16 + hi * 8); }
#pragma unroll
            for (int mt = 0; mt < 4; ++mt) {
                f32x16 acc = {};
#pragma unroll
                for (int ks = 0; ks < 4; ++ks) acc = __builtin_amdgcn_mfma_f32_32x32x16_bf16(af[mt][ks], bfr[ks], acc, 0, 0, 0);
#pragma unroll
                for (int u = 0; u < 2; ++u) { const int tk = 4 * mt + 2 * hi + u;
                    const f32x4 w0 = *(const LAS f32x4*)(wis + tk * 8), w1 = *(const LAS f32x4*)(wis + tk * 8 + 4);
                    float s = 0.f;
#pragma unroll
                    for (int h = 0; h < 4; ++h) { s += w0[h] * fmaxf(acc[8 * u + h], 0.f); }
#pragma unroll
                    for (int h = 0; h < 4; ++h) { s += w1[h] * fmaxf(acc[8 * u + 4 + h], 0.f); }
                    sc[tk * 2048 + key] = s + 0.f; }
            }
        }
        __syncthreads();
        { const int nq = ((t0 + 15) >> 6) + 1;
          if (nq <= 8) topk_select<8>(sc, MASK, rowbase, t0, wave, lane);
          else if (nq <= 16) topk_select<16>(sc, MASK, rowbase, t0, wave, lane);
          else if (nq <= 24) topk_select<24>(sc, MASK, rowbase, t0, wave, lane);
          else topk_select<32>(sc, MASK, rowbase, t0, wave, lane); }
        __syncthreads();
    }
}

typedef short v4i16_t __attribute__((ext_vector_type(4)));
__device__ __forceinline__ s16x4 vtr(const LAS unsigned char* p) { return __builtin_bit_cast(s16x4, __builtin_amdgcn_ds_read_tr16_b64_v4i16((LAS v4i16_t*)p)); }
template <bool MASKED>
__device__ __forceinline__ void attn_unit(Frame& F, const bf16_t* Qp, int qpitch, const bf16_t* Kp, const bf16_t* Vp, int kvpitch, int ntiles,
                                          const unsigned long long* maskp, bf16_t* Op, int opitch) {
    const int tid = F.tid, lane = F.lane, r32 = lane & 31, hi = lane >> 5, wave = F.wave;
    LAS unsigned char* lds = F.lds;
    bf16x8 qf[4];
#pragma unroll
    for (int ks = 0; ks < 4; ++ks) qf[ks] = *(const bf16x8*)(Qp + (size_t)(wave * 32 + r32) * qpitch + ks * 16 + hi * 8);
    const unsigned long long* mrow = maskp + (size_t)(wave * 32 + r32) * 32;
    const int kkey = tid & 63, kch = tid >> 6, vkey = tid >> 3, vpc = tid & 7;
    const bf16_t* ksrc = Kp + (size_t)kkey * kvpitch + kch * 8; const bf16_t* vsrc = Vp + (size_t)vkey * kvpitch + vpc * 8;
    const int kdst = kch * 1024 + kkey * 16, vdst = 8192 + (vpc >> 2) * 4096 + vkey * 64 + (vpc & 3) * 16;
    u32x4 kreg = *(const u32x4*)ksrc, vreg = *(const u32x4*)vsrc;
    *(LAS u32x4*)(lds + kdst) = kreg; *(LAS u32x4*)(lds + vdst) = vreg;
    __syncthreads();
    float m_run = 0.f, l_run = 0.f; bool started = false; f32x16 o0 = {}, o1 = {};
    constexpr float THR = 8.f, NEGBIG = -1e30f;
    const int vlane = ((lane >> 4) & 1) * 32 + (lane & 3) * 8 + (4 * hi + ((lane & 15) >> 2)) * 64;
    unsigned long long mw_next = ~0ull; if (MASKED) mw_next = mrow[0];
    for (int t = 0; t < ntiles; ++t) {
        const int cb = (t & 1) * 16384, nb = 16384 - cb;
        if (t + 1 < ntiles) { kreg = *(const u32x4*)(ksrc + (size_t)(t + 1) * 64 * kvpitch); vreg = *(const u32x4*)(vsrc + (size_t)(t + 1) * 64 * kvpitch); }
        const unsigned long long mw = mw_next; if (MASKED && t + 1 < ntiles) mw_next = mrow[t + 1];
        f32x16 p0, p1; const float negm = -m_run;
        if (MASKED) { const int lo = (int)((unsigned)mw >> (4 * hi)), hw = (int)((unsigned)(mw >> 32) >> (4 * hi));
            const int nb_ = __builtin_bit_cast(int, negm), ng_ = __builtin_bit_cast(int, NEGBIG);
#pragma unroll
            for (int r = 0; r < 16; ++r) { const unsigned pos = (r & 3) + 8 * (r >> 2);
                const int m0 = __builtin_amdgcn_sbfe(lo, pos, 1), m1 = __builtin_amdgcn_sbfe(hw, pos, 1);
                p0[r] = __builtin_bit_cast(float, __builtin_amdgcn_bitop3_b32(m0, nb_, ng_, 0xCA)); p1[r] = __builtin_bit_cast(float, __builtin_amdgcn_bitop3_b32(m1, nb_, ng_, 0xCA)); } }
        else {
#pragma unroll
            for (int r = 0; r < 16; ++r) { p0[r] = negm; p1[r] = negm; } }
#pragma unroll
        for (int ks = 0; ks < 4; ++ks) {
            const bf16x8 a0 = *(const LAS bf16x8*)(lds + cb + (2 * ks + hi) * 1024 + r32 * 16);
            const bf16x8 a1 = *(const LAS bf16x8*)(lds + cb + (2 * ks + hi) * 1024 + (32 + r32) * 16);
            p0 = __builtin_amdgcn_mfma_f32_32x32x16_bf16(a0, qf[ks], p0, 0, 0, 0);
            p1 = __builtin_amdgcn_mfma_f32_32x32x16_bf16(a1, qf[ks], p1, 0, 0, 0);
        }
        float rm;
        { float a = __builtin_fmaxf(__builtin_fmaxf(p0[0], p0[1]), p1[0]), b = __builtin_fmaxf(__builtin_fmaxf(p0[2], p0[3]), p1[1]); a = __builtin_fmaxf(__builtin_fmaxf(a, p1[2]), p1[3]);
#pragma unroll
          for (int r = 4; r < 16; r += 4) { a = __builtin_fmaxf(__builtin_fmaxf(a, p0[r]), p0[r + 1]); b = __builtin_fmaxf(__builtin_fmaxf(b, p0[r + 2]), p0[r + 3]); a = __builtin_fmaxf(__builtin_fmaxf(a, p1[r]), p1[r + 1]); b = __builtin_fmaxf(__builtin_fmaxf(b, p1[r + 2]), p1[r + 3]); }
          rm = __builtin_fmaxf(a, b);
          auto rr = __builtin_amdgcn_permlane32_swap(__float_as_uint(rm), __float_as_uint(rm), false, false); rm = __builtin_fmaxf(__uint_as_float(rr[0]), __uint_as_float(rr[1])); }
        const bool valid = rm > -1e29f, adj = (rm > THR) || (valid && !started);
        if (__any(adj)) {
            const float dl = adj ? rm : 0.f; m_run += dl;
#pragma unroll
            for (int r = 0; r < 16; ++r) { p0[r] -= dl; p1[r] -= dl; }
            const float alpha = started ? fast_exp2(-dl) : 1.f;
            l_run *= alpha;
#pragma unroll
            for (int r = 0; r < 16; ++r) { o0[r] *= alpha; o1[r] *= alpha; }
        }
        started = started || valid;
#pragma unroll
        for (int r = 0; r < 16; ++r) { p0[r] = fast_exp2(p0[r]); p1[r] = fast_exp2(p1[r]); }
        { f32x2 sa[8];
#pragma unroll
          for (int r = 0; r < 8; ++r) sa[r] = (f32x2){p0[2 * r], p0[2 * r + 1]} + (f32x2){p1[2 * r], p1[2 * r + 1]};
          const f32x2 sb = ((sa[0] + sa[1]) + (sa[2] + sa[3])) + ((sa[4] + sa[5]) + (sa[6] + sa[7]));
          l_run += sb.x + sb.y; }
        bf16x8 pw[2][2];
#pragma unroll
        for (int s = 0; s < 2; ++s) {
            u32x4 w; w.x = pg8::cvt_pk_bf16(p0[8 * s + 0], p0[8 * s + 1]); w.y = pg8::cvt_pk_bf16(p0[8 * s + 2], p0[8 * s + 3]); w.z = pg8::cvt_pk_bf16(p0[8 * s + 4], p0[8 * s + 5]); w.w = pg8::cvt_pk_bf16(p0[8 * s + 6], p0[8 * s + 7]);
            pw[0][s] = __builtin_bit_cast(bf16x8, w);
            u32x4 x; x.x = pg8::cvt_pk_bf16(p1[8 * s + 0], p1[8 * s + 1]); x.y = pg8::cvt_pk_bf16(p1[8 * s + 2], p1[8 * s + 3]); x.z = pg8::cvt_pk_bf16(p1[8 * s + 4], p1[8 * s + 5]); x.w = pg8::cvt_pk_bf16(p1[8 * s + 6], p1[8 * s + 7]);
            pw[1][s] = __builtin_bit_cast(bf16x8, x);
        }
        const LAS unsigned char* vb = lds + cb + 8192 + vlane;
#pragma unroll
        for (int kh = 0; kh < 2; ++kh)
#pragma unroll
            for (int s = 0; s < 2; ++s) {
                const int ko = (32 * kh + 16 * s) * 64;
                const s16x4 a_lo0 = vtr(vb + ko), a_hi0 = vtr(vb + ko + 512), a_lo1 = vtr(vb + 4096 + ko), a_hi1 = vtr(vb + 4096 + ko + 512);
                const bf16x8 A0 = (bf16x8){a_lo0[0], a_lo0[1], a_lo0[2], a_lo0[3], a_hi0[0], a_hi0[1], a_hi0[2], a_hi0[3]};
                const bf16x8 A1 = (bf16x8){a_lo1[0], a_lo1[1], a_lo1[2], a_lo1[3], a_hi1[0], a_hi1[1], a_hi1[2], a_hi1[3]};
                o0 = __builtin_amdgcn_mfma_f32_32x32x16_bf16(A0, pw[kh][s], o0, 0, 0, 0);
                o1 = __builtin_amdgcn_mfma_f32_32x32x16_bf16(A1, pw[kh][s], o1, 0, 0, 0);
            }
        if (t + 1 < ntiles) { *(LAS u32x4*)(lds + nb + kdst) = kreg; *(LAS u32x4*)(lds + nb + vdst) = vreg; }
        __syncthreads();
    }
    { auto rr = __builtin_amdgcn_permlane32_swap(__float_as_uint(l_run), __float_as_uint(l_run), false, false); l_run = __uint_as_float(rr[0]) + __uint_as_float(rr[1]); }
    const float inv = 1.f / l_run;
    bf16_t* orow = Op + (size_t)(wave * 32 + r32) * opitch;
#pragma unroll
    for (int rg = 0; rg < 4; ++rg) {
        u32x2 w0, w1;
        w0.x = pg8::cvt_pk_bf16(o0[4 * rg] * inv, o0[4 * rg + 1] * inv); w0.y = pg8::cvt_pk_bf16(o0[4 * rg + 2] * inv, o0[4 * rg + 3] * inv);
        w1.x = pg8::cvt_pk_bf16(o1[4 * rg] * inv, o1[4 * rg + 1] * inv); w1.y = pg8::cvt_pk_bf16(o1[4 * rg + 2] * inv, o1[4 * rg + 3] * inv);
        *(u32x2*)(orow + 8 * rg + 4 * hi) = w0; *(u32x2*)(orow + 32 + 8 * rg + 4 * hi) = w1;
    }
}
__device__ __forceinline__ void mem_attn_units(Frame& F, const bf16_t* QM, int layer, bf16_t* AO) {
    const bf16_t* KVM = (const bf16_t*)(F.ws + WS_KVM);
    for (int mu = blockIdx.x; mu < NB * 32; mu += F.G) {
        const int b = mu >> 5, hm = (mu >> 3) & 3, qb = mu & 7;
        const size_t row0 = (size_t)b * SEQ + qb * 256;
        attn_unit<false>(F, QM + row0 * 256 + hm * 64, 256, KVM + (size_t)b * NMEM * 1024 + layer * 512 + hm * 64, KVM + (size_t)b * NMEM * 1024 + layer * 512 + 256 + hm * 64, 1024, 4,
                         nullptr, AO + row0 * 1024 + 768 + hm * 64, 1024);
    }
}
__device__ __forceinline__ void p_attn_dsa(Frame& F) {
    const bf16_t* Q = (const bf16_t*)(F.ws + WS_Q); const bf16_t* K = (const bf16_t*)(F.ws + WS_K); const bf16_t* V = (const bf16_t*)(F.ws + WS_V);
    const unsigned long long* MASK = (const unsigned long long*)(F.ws + WS_MASK); bf16_t* AO = (bf16_t*)(F.ws + WS_AO0);
    for (int pu = blockIdx.x; pu < NB * 12 * 4; pu += F.G) {
        const int bh = pu >> 2, pr = pu & 3, b = bh / 12, h = bh % 12;
#pragma unroll 1
        for (int z = 0; z < 2; ++z) {
            const int qb = z ? 7 - pr : pr; const size_t rb = (size_t)b * SEQ, row0 = rb + qb * 256;
            attn_unit<true>(F, Q + row0 * 768 + h * 64, 768, K + rb * 768 + h * 64, V + rb * 768 + h * 64, 768, 4 * (qb + 1), MASK + row0 * 32, AO + row0 * 1024 + h * 64, 1024);
        }
    }
    mem_attn_units(F, (const bf16_t*)(F.ws + WS_QM), 0, AO);
}

template <bool RESID_F32>
__device__ __forceinline__ void p_ln1_router(Frame& F, const Args& a, int layer, const void* resid, bf16_t* X1b) {
    const bf16_t* MIX = (const bf16_t*)F.out;
    const float* g1 = (const float*)a.in[I_LN1G] + layer * 1024; const float* b1 = (const float*)a.in[I_LN1B] + layer * 1024;
    const float* wg = (const float*)a.in[I_MOE_WG] + (size_t)layer * 1024 * 4; const float* bg = (const float*)a.in[I_MOE_BG] + layer * 4;
    const float* wr = (const float*)a.in[I_MOE_WR] + (size_t)layer * 4 * 1024 * 8; const float* br = (const float*)a.in[I_MOE_BR] + layer * 32;
    unsigned* cnt = F.ctl + CW_CNT + layer * 2048;
    int* LISTTOK = (int*)(F.ws + WS_LISTTOK); float* LISTW = (float*)(F.ws + WS_LISTW); int* TOKSLOT = (int*)(F.ws + WS_TOKSLOT);
    const int lane = F.lane;
    LAS float* WR = (LAS float*)F.lds;
    for (int i = F.tid; i < 4 * 1024 * 2; i += 512) { const int g = i >> 11, k = (i & 2047) >> 1, hf = i & 1;
        const f32x4 w4 = *(const f32x4*)(wr + ((size_t)g * 1024 + k) * 8 + hf * 4);
#pragma unroll
        for (int c = 0; c < 4; ++c) WR[(g * 8 + hf * 4 + c) * 1024 + k] = w4[c]; }
    __syncthreads();
    f32x4 gv[4], bv[4], wgr[4][4];
#pragma unroll
    for (int j = 0; j < 4; ++j) { gv[j] = *((const f32x4*)g1 + lane + 64 * j); bv[j] = *((const f32x4*)b1 + lane + 64 * j);
#pragma unroll
        for (int c = 0; c < 4; ++c) wgr[j][c] = *(const f32x4*)(wg + (size_t)(256 * j + 4 * lane + c) * 4); }
    LAS int* cntL = (LAS int*)(F.lds + MISC_OFF + 512); LAS int* baseL = cntL + 32; LAS int* tokdat = (LAS int*)(F.lds + MISC_OFF + 1024);
    if (F.tid < 32) cntL[F.tid] = 0;
    __syncthreads();
    int nloc = 0;
    for (int tb = F.gw; tb < NT; tb += 2 * F.NGW) {
      f32x4 vv[2][4];
#pragma unroll
      for (int hh = 0; hh < 2; ++hh) { const int t = tb + hh * F.NGW; if (t < NT) {
        const u32x2* mr = (const u32x2*)(MIX + (size_t)t * DM) + lane;
#pragma unroll
        for (int j = 0; j < 4; ++j) {
            f32x4 xv;
            if (RESID_F32) xv = *((const f32x4*)((const float*)resid + (size_t)t * DM) + lane + 64 * j);
            else { const u32x2 p = *((const u32x2*)((const bf16_t*)resid + (size_t)t * DM) + lane + 64 * j); xv = (f32x4){bf2f(p.x & 0xffffu), bf2f(p.x >> 16), bf2f(p.y & 0xffffu), bf2f(p.y >> 16)}; }
            const u32x2 m = mr[64 * j];
            vv[hh][j] = xv * ALPHA + (f32x4){bf2f(m.x & 0xffffu), bf2f(m.x >> 16), bf2f(m.y & 0xffffu), bf2f(m.y >> 16)}; } } }
#pragma unroll
      for (int hh = 0; hh < 2; ++hh) { const int t = tb + hh * F.NGW; if (t >= NT) break;
        f32x4 v[4]; float s = 0.f;
#pragma unroll
        for (int j = 0; j < 4; ++j) { v[j] = vv[hh][j]; s += (v[j].x + v[j].y) + (v[j].z + v[j].w); }
        const float mean = wave_sum(s) * (1.f / DM); float s2 = 0.f;
#pragma unroll
        for (int j = 0; j < 4; ++j) { v[j] = v[j] - mean; s2 += (v[j].x * v[j].x + v[j].y * v[j].y) + (v[j].z * v[j].z + v[j].w * v[j].w); }
        const float rstd = 1.f / sqrtf(wave_sum(s2) * (1.f / DM) + LN_EPS);
        u32x2* ob = (u32x2*)(X1b + (size_t)t * DM) + lane;
#pragma unroll
        for (int j = 0; j < 4; ++j) { v[j] = v[j] * rstd * gv[j] + bv[j]; u32x2 w; w.x = pk2(v[j].x, v[j].y); w.y = pk2(v[j].z, v[j].w); ob[64 * j] = w; }
        float gl[4] = {0.f, 0.f, 0.f, 0.f};
#pragma unroll
        for (int j = 0; j < 4; ++j)
#pragma unroll
            for (int c = 0; c < 4; ++c)
#pragma unroll
                for (int k = 0; k < 4; ++k) gl[k] += v[j][c] * wgr[j][c][k];
#pragma unroll
        for (int k = 0; k < 4; ++k) gl[k] = wave_sum(gl[k]) + bg[k];
        int gsel = 0; float gmax = gl[0];
#pragma unroll
        for (int k = 1; k < 4; ++k) if (gl[k] > gmax) { gmax = gl[k]; gsel = k; }
        float gs = 0.f;
#pragma unroll
        for (int k = 0; k < 4; ++k) gs += __expf(gl[k] - gmax);
        const float pg = 1.f / gs;
        gsel = __builtin_amdgcn_readfirstlane(gsel);
        const LAS float* wrg = WR + gsel * 8 * 1024 + 4 * lane;
        float el[8];
#pragma unroll
        for (int e = 0; e < 8; ++e) { float acc = 0.f;
#pragma unroll
            for (int j = 0; j < 4; ++j) { const f32x4 w4 = *(const LAS f32x4*)(wrg + e * 1024 + 256 * j); acc += (v[j].x * w4.x + v[j].y * w4.y) + (v[j].z * w4.z + v[j].w * w4.w); }
            el[e] = wave_sum(acc) + br[gsel * 8 + e]; }
        int i1 = 0; float v1 = el[0];
#pragma unroll
        for (int k = 1; k < 8; ++k) if (el[k] > v1) { v1 = el[k]; i1 = k; }
        int i2 = -1; float v2 = -INFINITY;
#pragma unroll
        for (int k = 0; k < 8; ++k) if (k != i1 && (i2 < 0 || el[k] > v2)) { v2 = el[k]; i2 = k; }
        const float e2 = __expf(v2 - v1); const float wt1 = pg / (1.f + e2), wt2 = pg * e2 / (1.f + e2);
        if (lane == 0) {
            const int ge1 = gsel * 8 + i1, ge2 = gsel * 8 + i2;
            const int l1 = __hip_atomic_fetch_add(&cntL[ge1], 1, __ATOMIC_RELAXED, __HIP_MEMORY_SCOPE_WORKGROUP), l2 = __hip_atomic_fetch_add(&cntL[ge2], 1, __ATOMIC_RELAXED, __HIP_MEMORY_SCOPE_WORKGROUP);
            LAS int* td = tokdat + (nloc * NWAVES + F.wave) * 8;
            td[0] = t; td[1] = ge1; td[2] = l1; td[3] = __float_as_int(wt1); td[4] = ge2; td[5] = l2; td[6] = __float_as_int(wt2);
        }
        ++nloc;
      }
    }
    __syncthreads();
    if (F.tid < 32) { const int n = cntL[F.tid]; baseL[F.tid] = n ? (int)atomicAdd(&cnt[F.tid * 64], (unsigned)n) : 0; }
    __syncthreads();
    for (int i = F.tid; i < nloc * NWAVES; i += 512) {
        const LAS int* td = tokdat + i * 8; const int t = td[0], ge1 = td[1], ge2 = td[4]; const int p1 = baseL[ge1] + td[2], p2 = baseL[ge2] + td[5];
        LISTTOK[(size_t)ge1 * NT + p1] = t; LISTW[(size_t)ge1 * NT + p1] = __int_as_float(td[3]);
        LISTTOK[(size_t)ge2 * NT + p2] = t; LISTW[(size_t)ge2 * NT + p2] = __int_as_float(td[6]);
        *(int4*)(TOKSLOT + (size_t)t * 4) = make_int4(ge1, p1, ge2, p2);
    }
}
template <bool OUT_F32>
__device__ __forceinline__ void p_ln2(Frame& F, const Args& a, int layer, const bf16_t* X1b, void* dst) {
    const bf16_t* Y = (const bf16_t*)(F.ws + WS_Y); const int* TOKSLOT = (const int*)(F.ws + WS_TOKSLOT);
    const float* g2 = (const float*)a.in[I_LN2G] + layer * 1024; const float* b2 = (const float*)a.in[I_LN2B] + layer * 1024;
    LAS int* tp = (LAS int*)(F.lds + MISC_OFF + 256);
    moe_tile_table(F, F.ctl + CW_CNT + layer * 2048, tp);
    const int lane = F.lane;
    f32x4 gv[4], bv[4];
#pragma unroll
    for (int j = 0; j < 4; ++j) { gv[j] = *((const f32x4*)g2 + lane + 64 * j); bv[j] = *((const f32x4*)b2 + lane + 64 * j); }
    for (int tb = F.gw; tb < NT; tb += 2 * F.NGW) {
      f32x4 vv[2][4];
#pragma unroll
      for (int hh = 0; hh < 2; ++hh) { const int t = tb + hh * F.NGW; if (t < NT) {
        const int4 ts = *(const int4*)(TOKSLOT + (size_t)t * 4);
        const size_t s0 = (size_t)tp[ts.x] * 256 + ts.y, s1 = (size_t)tp[ts.z] * 256 + ts.w;
        const u32x2* xr = (const u32x2*)(X1b + (size_t)t * DM) + lane;
        const u32x2* y0 = (const u32x2*)(Y + s0 * DM) + lane; const u32x2* y1 = (const u32x2*)(Y + s1 * DM) + lane;
#pragma unroll
        for (int j = 0; j < 4; ++j) { const u32x2 p = y0[64 * j], q = y1[64 * j], x = xr[64 * j];
            f32x4 yy; yy.x = bf2f(p.x & 0xffffu) + bf2f(q.x & 0xffffu); yy.y = bf2f(p.x >> 16) + bf2f(q.x >> 16); yy.z = bf2f(p.y & 0xffffu) + bf2f(q.y & 0xffffu); yy.w = bf2f(p.y >> 16) + bf2f(q.y >> 16);
            vv[hh][j] = (f32x4){bf2f(x.x & 0xffffu), bf2f(x.x >> 16), bf2f(x.y & 0xffffu), bf2f(x.y >> 16)} * ALPHA + yy; } } }
#pragma unroll
      for (int hh = 0; hh < 2; ++hh) { const int t = tb + hh * F.NGW; if (t >= NT) break;
        f32x4 v[4]; float s = 0.f;
#pragma unroll
        for (int j = 0; j < 4; ++j) { v[j] = vv[hh][j]; s += (v[j].x + v[j].y) + (v[j].z + v[j].w); }
        const float mean = wave_sum(s) * (1.f / DM); float s2 = 0.f;
#pragma unroll
        for (int j = 0; j < 4; ++j) { v[j] = v[j] - mean; s2 += (v[j].x * v[j].x + v[j].y * v[j].y) + (v[j].z * v[j].z + v[j].w * v[j].w); }
        const float rstd = 1.f / sqrtf(wave_sum(s2) * (1.f / DM) + LN_EPS);
#pragma unroll
        for (int j = 0; j < 4; ++j) v[j] = v[j] * rstd * gv[j] + bv[j];
        if (OUT_F32) { f32x4* o4 = (f32x4*)((float*)dst + (size_t)t * DM) + lane;
#pragma unroll
            for (int j = 0; j < 4; ++j) o4[64 * j] = v[j]; }
        else { u32x2* ob = (u32x2*)((bf16_t*)dst + (size_t)t * DM) + lane;
#pragma unroll
            for (int j = 0; j < 4; ++j) { u32x2 w; w.x = pk2(v[j].x, v[j].y); w.y = pk2(v[j].z, v[j].w); ob[64 * j] = w; } }
      }
    }
}

__device__ __forceinline__ bf16x8 pack8(f32x4 lo, f32x4 hi) { u32x4 w; w.x = pg8::cvt_pk_bf16(lo[0], lo[1]); w.y = pg8::cvt_pk_bf16(lo[2], lo[3]); w.z = pg8::cvt_pk_bf16(hi[0], hi[1]); w.w = pg8::cvt_pk_bf16(hi[2], hi[3]); return __builtin_bit_cast(bf16x8, w); }
constexpr int GLA_QP = 208, GLA_VP = 400;
constexpr int GL_WGS = 0, GL_BGS = 6144, GL_Q = 8192, GL_K = 8192 + 13312, GL_V = 8192 + 2 * 13312, GL_ST = GL_V + 25600;
__device__ __forceinline__ void gla_gates(const float* a1row, const LAS float* wgs, const LAS float* bgs, int w, int lane, float (&bq)[12], float (&bl)[12]) {
    f32x4 av[4];
#pragma unroll
    for (int r = 0; r < 4; ++r) av[r] = *(const f32x4*)(a1row + 4 * r);
#pragma unroll
    for (int k = 0; k < 12; ++k) {
        const int d = 12 * w + k; float z = bgs[d];
#pragma unroll
        for (int r = 0; r < 16; ++r) z += av[r >> 2][r & 3] * wgs[r * 96 + d];
        float g = (fminf(z, 0.f) - __logf(1.f + __expf(-fabsf(z)))) * (1.f / 16.f);
#pragma unroll
        for (int o = 1; o < 64; o <<= 1) { const float t = __shfl_up(g, o); if (lane >= o) g += t; }
        bq[k] = g; bl[k] = __shfl(g, 63);
    }
}
__device__ __forceinline__ void gla_stage_common(Frame& F, const Args& a, int h, size_t row0) {
    const float* wgate = (const float*)a.in[I_GLA_WGATE]; const float* bgate = (const float*)a.in[I_GLA_BGATE];
    const bf16_t* GV = (const bf16_t*)(F.ws + WS_GV);
    LAS float* wgs = (LAS float*)(F.lds + GL_WGS); LAS float* bgs = (LAS float*)(F.lds + GL_BGS);
    const int tid = F.tid;
    if (tid < 384) { const int r = tid / 24, d4 = (tid % 24) * 4; *(LAS f32x4*)(wgs + r * 96 + d4) = *(const f32x4*)(wgate + r * 384 + h * 96 + d4); }
    if (tid < 96) bgs[tid] = bgate[h * 96 + tid];
#pragma unroll
    for (int i = 0; i < 3; ++i) { const int p = tid + 512 * i, row = p / 24, pc = p % 24;
        *(LAS u32x4*)(F.lds + GL_V + row * GLA_VP + pc * 16) = *(const u32x4*)(GV + (row0 + row) * 768 + h * 192 + pc * 8); }
}
__device__ __forceinline__ bf16x8 tr2(const LAS unsigned char* p0, const LAS unsigned char* p1) { const s16x4 a = vtr(p0), b = vtr(p1); return (bf16x8){a[0], a[1], a[2], a[3], b[0], b[1], b[2], b[3]}; }
__device__ __forceinline__ u32x2 pack4(f32x4 v) { u32x2 w; w.x = pg8::cvt_pk_bf16(v[0], v[1]); w.y = pg8::cvt_pk_bf16(v[2], v[3]); return w; }
__device__ __forceinline__ void p_gla_u(Frame& F, const Args& a) {
    const bf16_t* GK = (const bf16_t*)(F.ws + WS_GK); const float* A1 = (const float*)(F.ws + WS_A1);
    u32x2* UF = (u32x2*)F.out; float* DEC = (float*)(F.ws + WS_DEC);
    const int lane = F.lane, w = F.wave, fq = lane >> 4, qq = (lane & 15) >> 2, pp = lane & 3;
    for (int U = blockIdx.x; U < NB * 4 * 32; U += F.G) {
        const int c = U & 31, h = (U >> 5) & 3, b = U >> 7; const size_t row0 = (size_t)b * SEQ + c * 64;
        gla_stage_common(F, a, h, row0);
        u32x2 kpre[3];
        { const u32x2* kp = (const u32x2*)(GK + (row0 + lane) * 384 + h * 96 + 12 * w);
#pragma unroll
          for (int i = 0; i < 3; ++i) kpre[i] = kp[i]; }
        __syncthreads();
        float bq[12], bl[12];
        gla_gates(A1 + (row0 + lane) * 16, (const LAS float*)(F.lds + GL_WGS), (const LAS float*)(F.lds + GL_BGS), w, lane, bq, bl);
        {
#pragma unroll
          for (int i = 0; i < 3; ++i) { const u32x2 kv = kpre[i]; f32x4 o;
              o[0] = bf2f(kv.x & 0xffffu) * __expf(bl[4 * i] - bq[4 * i]); o[1] = bf2f(kv.x >> 16) * __expf(bl[4 * i + 1] - bq[4 * i + 1]);
              o[2] = bf2f(kv.y & 0xffffu) * __expf(bl[4 * i + 2] - bq[4 * i + 2]); o[3] = bf2f(kv.y >> 16) * __expf(bl[4 * i + 3] - bq[4 * i + 3]);
              *(LAS u32x2*)(F.lds + GL_K + lane * GLA_QP + (12 * w + 4 * i) * 2) = pack4(o); } }
        if (lane == 0) {
#pragma unroll
            for (int i = 0; i < 3; ++i) *(f32x4*)(DEC + (size_t)U * 96 + 12 * w + 4 * i) = (f32x4){__expf(bl[4 * i]), __expf(bl[4 * i + 1]), __expf(bl[4 * i + 2]), __expf(bl[4 * i + 3])}; }
        __syncthreads();
        const int dt0 = 3 * (w >> 2), et0 = 3 * (w & 3);
        bf16x8 af[3][2], bfv[3][2];
#pragma unroll
        for (int ks = 0; ks < 2; ++ks) { const int prow = 32 * ks + 8 * fq + qq;
#pragma unroll
            for (int i = 0; i < 3; ++i) {
                const LAS unsigned char* ka = F.lds + GL_K + prow * GLA_QP + (16 * (dt0 + i) + 4 * pp) * 2; af[i][ks] = tr2(ka, ka + 4 * GLA_QP);
                const LAS unsigned char* va = F.lds + GL_V + prow * GLA_VP + (16 * (et0 + i) + 4 * pp) * 2; bfv[i][ks] = tr2(va, va + 4 * GLA_VP); } }
#pragma unroll
        for (int i = 0; i < 3; ++i)
#pragma unroll
            for (int j = 0; j < 3; ++j) { f32x4 acc = (f32x4){0.f, 0.f, 0.f, 0.f};
#pragma unroll
                for (int ks = 0; ks < 2; ++ks) acc = __builtin_amdgcn_mfma_f32_16x16x32_bf16(af[i][ks], bfv[j][ks], acc, 0, 0, 0);
                UF[((size_t)U * 72 + (dt0 + i) * 12 + (et0 + j)) * 64 + lane] = pack4(acc); }
        __syncthreads();
    }
}
__device__ __forceinline__ void p_gla_scan(Frame& F) {
    u32x2* UF = (u32x2*)F.out; const float* DEC = (const float*)(F.ws + WS_DEC);
    for (int idx = blockIdx.x * 512 + F.tid; idx < 64 * 72 * 64; idx += F.G * 512) {
        const int bh = idx / 4608, rem = idx % 4608, tile = rem >> 6, ln = rem & 63, dt = tile / 12, fq = ln >> 4;
        f32x4 S = (f32x4){0.f, 0.f, 0.f, 0.f};
        u32x2* p = UF + ((size_t)bh * 32 * 72 + tile) * 64 + ln; const float* dp = DEC + (size_t)bh * 32 * 96 + 16 * dt + 4 * fq;
#pragma unroll 8
        for (int c = 0; c < 32; ++c) {
            const u32x2 u = *p; const f32x4 dc = *(const f32x4*)dp;
            *p = pack4(S);
            S[0] = S[0] * dc[0] + bf2f(u.x & 0xffffu); S[1] = S[1] * dc[1] + bf2f(u.x >> 16); S[2] = S[2] * dc[2] + bf2f(u.y & 0xffffu); S[3] = S[3] * dc[3] + bf2f(u.y >> 16);
            p += 72 * 64; dp += 96; }
    }
}
__device__ __forceinline__ void p_gla_out(Frame& F, const Args& a) {
    const bf16_t* GQ = (const bf16_t*)(F.ws + WS_GQ); const bf16_t* GK = (const bf16_t*)(F.ws + WS_GK); const bf16_t* GR = (const bf16_t*)(F.ws + WS_GR); const float* A1 = (const float*)(F.ws + WS_A1);
    const u32x2* SF = (const u32x2*)F.out; bf16_t* AO = (bf16_t*)(F.ws + WS_AO1); const float* ng = (const float*)a.in[I_GLA_NORMG];
    const int lane = F.lane, w = F.wave, li = lane & 15, fq = lane >> 4, qq = li >> 2, pp = lane & 3;
    LAS float* stats = (LAS float*)(F.lds + GL_ST);
    for (int U = blockIdx.x; U < NB * 4 * 32; U += F.G) {
        const int c = U & 31, h = (U >> 5) & 3, b = U >> 7; const size_t row0 = (size_t)b * SEQ + c * 64;
        gla_stage_common(F, a, h, row0);
        const int ip = w >> 2, et0 = 3 * (w & 3);
        u32x2 sfr[3][3][2]; bf16_t grv[2][4][3];
#pragma unroll
        for (int eti = 0; eti < 3; ++eti)
#pragma unroll
            for (int sx = 0; sx < 3; ++sx) { sfr[eti][sx][0] = SF[((size_t)U * 72 + (2 * sx) * 12 + et0 + eti) * 64 + lane]; sfr[eti][sx][1] = SF[((size_t)U * 72 + (2 * sx + 1) * 12 + et0 + eti) * 64 + lane]; }
#pragma unroll
        for (int iti = 0; iti < 2; ++iti)
#pragma unroll
            for (int r = 0; r < 4; ++r)
#pragma unroll
                for (int eti = 0; eti < 3; ++eti) grv[iti][r][eti] = GR[(row0 + 16 * (2 * ip + iti) + 4 * fq + r) * 768 + h * 192 + 16 * (et0 + eti) + li];
        __syncthreads();
        { float bq[12], bl[12];
          gla_gates(A1 + (row0 + lane) * 16, (const LAS float*)(F.lds + GL_WGS), (const LAS float*)(F.lds + GL_BGS), w, lane, bq, bl);
          const u32x2* qp = (const u32x2*)(GQ + (row0 + lane) * 384 + h * 96 + 12 * w); const u32x2* kp = (const u32x2*)(GK + (row0 + lane) * 384 + h * 96 + 12 * w);
#pragma unroll
          for (int i = 0; i < 3; ++i) { const u32x2 qv = qp[i], kv = kp[i]; f32x4 oq, ok;
              const float e0 = __expf(bq[4 * i]), e1 = __expf(bq[4 * i + 1]), e2 = __expf(bq[4 * i + 2]), e3 = __expf(bq[4 * i + 3]);
              oq[0] = bf2f(qv.x & 0xffffu) * e0; oq[1] = bf2f(qv.x >> 16) * e1; oq[2] = bf2f(qv.y & 0xffffu) * e2; oq[3] = bf2f(qv.y >> 16) * e3;
              ok[0] = bf2f(kv.x & 0xffffu) * __builtin_amdgcn_rcpf(e0); ok[1] = bf2f(kv.x >> 16) * __builtin_amdgcn_rcpf(e1); ok[2] = bf2f(kv.y & 0xffffu) * __builtin_amdgcn_rcpf(e2); ok[3] = bf2f(kv.y >> 16) * __builtin_amdgcn_rcpf(e3);
              *(LAS u32x2*)(F.lds + GL_Q + lane * GLA_QP + (12 * w + 4 * i) * 2) = pack4(oq);
              *(LAS u32x2*)(F.lds + GL_K + lane * GLA_QP + (12 * w + 4 * i) * 2) = pack4(ok); } }
        __syncthreads();
        f32x4 o[2][3]; float ssq[2][4];
#pragma unroll
        for (int iti = 0; iti < 2; ++iti) {
            const int it = 2 * ip + iti;
            const LAS unsigned char* qrow = F.lds + GL_Q + (16 * it + li) * GLA_QP;
            bf16x8 qB[3], qA[3];
#pragma unroll
            for (int ks = 0; ks < 3; ++ks) { qB[ks] = *(const LAS bf16x8*)(qrow + (32 * ks + 8 * fq) * 2);
                const u32x2 x0 = *(const LAS u32x2*)(qrow + (32 * ks + 4 * fq) * 2), x1 = *(const LAS u32x2*)(qrow + (32 * ks + 16 + 4 * fq) * 2);
                u32x4 x; x.x = x0.x; x.y = x0.y; x.z = x1.x; x.w = x1.y; qA[ks] = __builtin_bit_cast(bf16x8, x); }
            f32x4 tl[4];
#pragma unroll
            for (int jt = 0; jt < 4; ++jt) {
                tl[jt] = (f32x4){0.f, 0.f, 0.f, 0.f};
                if (jt <= it) {
                    const LAS unsigned char* krow = F.lds + GL_K + (16 * jt + li) * GLA_QP;
#pragma unroll
                    for (int ks = 0; ks < 3; ++ks) tl[jt] = __builtin_amdgcn_mfma_f32_16x16x32_bf16(*(const LAS bf16x8*)(krow + (32 * ks + 8 * fq) * 2), qB[ks], tl[jt], 0, 0, 0);
                    if (jt == it) {
#pragma unroll
                        for (int r = 0; r < 4; ++r) if (4 * fq + r > li) tl[jt][r] = 0.f; }
                }
            }
            bf16x8 am[2]; am[0] = pack8(tl[0], tl[1]); am[1] = pack8(tl[2], tl[3]);
#pragma unroll
            for (int eti = 0; eti < 3; ++eti) {
                const int et = et0 + eti;
                f32x4 acc = (f32x4){0.f, 0.f, 0.f, 0.f};
#pragma unroll
                for (int s2 = 0; s2 < 2; ++s2) if (2 * s2 <= it) {
                    const LAS unsigned char* va = F.lds + GL_V + (32 * s2 + 4 * fq + qq) * GLA_VP + (16 * et + 4 * pp) * 2;
                    acc = __builtin_amdgcn_mfma_f32_16x16x32_bf16(am[s2], tr2(va, va + 16 * GLA_VP), acc, 0, 0, 0); }
#pragma unroll
                for (int s = 0; s < 3; ++s) {
                    const u32x2 s0 = sfr[eti][s][0], s1 = sfr[eti][s][1];
                    u32x4 x; x.x = s0.x; x.y = s0.y; x.z = s1.x; x.w = s1.y;
                    acc = __builtin_amdgcn_mfma_f32_16x16x32_bf16(qA[s], __builtin_bit_cast(bf16x8, x), acc, 0, 0, 0); }
                o[iti][eti] = acc;
            }
#pragma unroll
            for (int r = 0; r < 4; ++r) { float q2 = o[iti][0][r] * o[iti][0][r] + o[iti][1][r] * o[iti][1][r] + o[iti][2][r] * o[iti][2][r];
                q2 += __shfl_xor(q2, 1); q2 += __shfl_xor(q2, 2); q2 += __shfl_xor(q2, 4); q2 += __shfl_xor(q2, 8); ssq[iti][r] = q2; }
            if (li == 0) {
#pragma unroll
                for (int r = 0; r < 4; ++r) stats[(16 * it + 4 * fq + r) * 4 + (w & 3)] = ssq[iti][r]; }
        }
        __syncthreads();
#pragma unroll
        for (int iti = 0; iti < 2; ++iti) { const int it = 2 * ip + iti;
#pragma unroll
            for (int r = 0; r < 4; ++r) { const int rl = 16 * it + 4 * fq + r; const f32x4 st = *(const LAS f32x4*)(stats + rl * 4);
                const float rs = 1.f / sqrtf(((st[0] + st[1]) + (st[2] + st[3])) * (1.f / 192.f) + RMS_EPS);
#pragma unroll
                for (int eti = 0; eti < 3; ++eti) { const int e = 16 * (et0 + eti) + li;
                    const float rr = bf2f(grv[iti][r][eti]);
                    AO[(row0 + rl) * 1024 + h * 192 + e] = (bf16_t)f2bf(o[iti][eti][r] * rs * ng[e] * silu_f(rr)); } } }
        __syncthreads();
    }
}
constexpr int NPHASE = 19;
__device__ __forceinline__ int opaque_int(int v) { asm volatile("" : "+s"(v)); return v; }
#define GEMM_CALL(EpiT, SchedT, g, S, E) pg8::gemm_phase<EpiT, SchedT, true, true>(F.lds, g, S, E)
__device__ __forceinline__ void moe_gemms_up(Frame& F, int layer, const bf16_t* X1b, bf16_t* ACT) {
    LAS int* tp = (LAS int*)(F.lds + MISC_OFF + 256);
    const unsigned* cnt = F.ctl + CW_CNT + layer * 2048;
    moe_tile_table(F, cnt, tp);
    pg8::Gemm g{X1b, (const bf16_t*)(F.ws + WS_W13), SLOT_ROWS, 512, 1024};
    MoeOrder S{tp, cnt, (const int*)(F.ws + WS_LISTTOK), 2, F.G, (int)blockIdx.x, true};
    EpiMoe1 E{ACT, (const float*)(F.ws + WS_LISTW), cnt};
    GEMM_CALL(EpiMoe1, MoeOrder, g, S, E);
}
__device__ __forceinline__ void moe_gemms_down(Frame& F, int layer, const bf16_t* ACT) {
    LAS int* tp = (LAS int*)(F.lds + MISC_OFF + 256);
    const unsigned* cnt = F.ctl + CW_CNT + layer * 2048;
    moe_tile_table(F, cnt, tp);
    pg8::Gemm g{ACT, (const bf16_t*)(F.ws + WS_W2), SLOT_ROWS, 1024, 256};
    MoeOrder S{tp, cnt, nullptr, 4, F.G, (int)blockIdx.x, false};
    EpiBf16Plain E{(bf16_t*)(F.ws + WS_Y), 1024, 3};
    GEMM_CALL(EpiBf16Plain, MoeOrder, g, S, E);
}
__device__ __forceinline__ void out_proj(Frame& F, int layer, const bf16_t* AO) {
    pg8::Gemm g{AO, (const bf16_t*)(F.ws + WS_WO) + (size_t)layer * 1024 * 1024, NT, 1024, 1024};
    pg8::StaticOrder S; S.init(NT, 1024, F.G, (int)blockIdx.x);
    EpiBf16Plain E{(bf16_t*)F.out, 1024, 0x7fffffff};
    GEMM_CALL(EpiBf16Plain, pg8::StaticOrder, g, S, E);
}

__global__ void __launch_bounds__(NWAVES * 64, 2) mk_fwd(Args args) {
    extern __shared__ __attribute__((aligned(16))) unsigned char lds_raw[];
    Frame F;
    F.lds = (LAS unsigned char*)lds_raw; F.ws = args.ws; F.out = args.out; F.ctl = (unsigned*)(args.ws + WS_CTL);
    F.tid = threadIdx.x; F.lane = F.tid & 63; F.wave = __builtin_amdgcn_readfirstlane(F.tid >> 6); F.G = gridDim.x;
    F.gw = blockIdx.x * NWAVES + F.wave; F.NGW = F.G * NWAVES;
    volatile LAS unsigned* MISC = (volatile LAS unsigned*)(F.lds + MISC_OFF);
    if (F.tid < 64) MISC[F.tid] = 0u;
    __syncthreads();
#if N_LAUNCH_MODE == 1
    XcdBarrier bar = xcd_barrier_post(F.ctl + CW_BAR, MISC + 8);
#define SEAM() xcd_barrier(bar)
#else
#define SEAM() do {} while (0)
#endif
    const int lo = args.ph_lo, hi = args.ph_hi;
#ifndef PH_ENABLE
#define PH_ENABLE 0xFFFFFFFFu
#endif
#define IN(k) (((PH_ENABLE >> (k)) & 1u) && lo <= (k) && (k) < hi)
#define ENDPH(k) do { if (IN((k) + 1)) SEAM(); } while (0)
#ifndef REP_MASK
#define REP_MASK 0u
#endif
#define REPS(k) _Pragma("unroll 1") for (int rep_ = 0, nrep_ = ((REP_MASK >> (k)) & 1u) ? opaque_int(2) : 1; rep_ < nrep_; ++rep_)
#define REPSEAM(k) do { if ((REP_MASK >> (k)) & 1u) { if (rep_ == 0) SEAM(); } } while (0)

    if (IN(0)) REPS(0) { p_prologue(F, args); ENDPH(0); }
    if (IN(1)) REPS(1) {
        { pg8::Gemm g{(const bf16_t*)F.ws, (const bf16_t*)F.ws, NT, ND, 1024};
          DsaKvmOrder S; S.init(F.G, (int)blockIdx.x);
          EpiDsaKvm E{{(bf16_t*)(F.ws + WS_Q), (bf16_t*)(F.ws + WS_K), (bf16_t*)(F.ws + WS_V), (bf16_t*)(F.ws + WS_QI), (bf16_t*)(F.ws + WS_QM), (bf16_t*)(F.ws + WS_KI), (float*)(F.ws + WS_WI),
                       (const float*)(F.ws + WS_ROPEC), (const float*)(F.ws + WS_ROPES), (const float*)args.in[I_DSA_KG], (const float*)args.in[I_DSA_KB], F.lds + MISC_OFF + 8192}, {(bf16_t*)(F.ws + WS_KVM), 1024, 0x7fffffff}};
          GEMM_CALL(EpiDsaKvm, DsaKvmOrder, g, S, E); }
        ENDPH(1);
    }
    if (IN(3)) REPS(3) { p_indexer(F); ENDPH(3); }
    if (IN(4)) REPS(4) { p_attn_dsa(F); ENDPH(4); }
    if (IN(5)) REPS(5) { out_proj(F, 0, (const bf16_t*)(F.ws + WS_AO0)); ENDPH(5); }
    if (IN(6)) { p_ln1_router<true>(F, args, 0, args.in[I_X], (bf16_t*)(F.ws + WS_X1B0)); ENDPH(6); }
    if (IN(7)) REPS(7) { moe_gemms_up(F, 0, (const bf16_t*)(F.ws + WS_X1B0), (bf16_t*)(F.ws + WS_ACT0)); ENDPH(7); }
    if (IN(8)) REPS(8) { moe_gemms_down(F, 0, (const bf16_t*)(F.ws + WS_ACT0)); ENDPH(8); }
    if (IN(9)) { p_ln2<false>(F, args, 0, (const bf16_t*)(F.ws + WS_X1B0), F.ws + WS_C);
                 moe_weight_items(F, (const float*)args.in[I_MOE_W13], (const float*)args.in[I_MOE_W2], 1); ENDPH(9); }
    if (IN(10)) {
        pg8::Gemm g{(const bf16_t*)(F.ws + WS_C), (const bf16_t*)(F.ws + WS_WG), NT, NG, 1024};
        pg8::StaticOrder S; S.init(NT, NG, F.G, (int)blockIdx.x);
        EpiGlaProj E{(bf16_t*)(F.ws + WS_GQ), (bf16_t*)(F.ws + WS_GK), (bf16_t*)(F.ws + WS_GV), (bf16_t*)(F.ws + WS_GR), (bf16_t*)(F.ws + WS_GQM), (float*)(F.ws + WS_A1)};
        GEMM_CALL(EpiGlaProj, pg8::StaticOrder, g, S, E);
#if defined(PROBE_DUP10)
        SEAM(); GEMM_CALL(EpiGlaProj, pg8::StaticOrder, g, S, E);
#endif
        ENDPH(10);
    }
    if (IN(11)) REPS(11) { p_gla_u(F, args); ENDPH(11); }
    if (IN(12)) { p_gla_scan(F); ENDPH(12); }
    if (IN(13)) REPS(13) { p_gla_out(F, args); mem_attn_units(F, (const bf16_t*)(F.ws + WS_GQM), 1, (bf16_t*)(F.ws + WS_AO1)); ENDPH(13); }
    if (IN(14)) REPS(14) { out_proj(F, 1, (const bf16_t*)(F.ws + WS_AO1)); ENDPH(14); }
    if (IN(15)) { p_ln1_router<false>(F, args, 1, F.ws + WS_C, (bf16_t*)(F.ws + WS_X1B1)); ENDPH(15); }
    if (IN(16)) REPS(16) { moe_gemms_up(F, 1, (const bf16_t*)(F.ws + WS_X1B1), (bf16_t*)(F.ws + WS_ACT1)); ENDPH(16); }
    if (IN(17)) REPS(17) { moe_gemms_down(F, 1, (const bf16_t*)(F.ws + WS_ACT1)); ENDPH(17); }
    if (IN(18)) REPS(18) { p_ln2<true>(F, args, 1, (const bf16_t*)(F.ws + WS_X1B1), F.out); }
#undef IN
#undef ENDPH
}

extern "C" void kernel_launch(void* const* d_in, const int* in_sizes, int n_in, void* d_out, int out_size, void* d_ws, size_t ws_size, hipStream_t stream) {
    static int grid = 0;
    if (grid == 0) {
        if (n_in != 22 || out_size != NT * DM || ws_size < WS_END) { fprintf(stderr, "kernel_launch: unexpected shapes: n_in %d out %d ws %zu (need %zu)\n", n_in, out_size, ws_size, (size_t)WS_END); grid = -1; return; }
        int dev = 0, cus = 0, per_cu = 0;
        if (hipGetDevice(&dev) != hipSuccess || hipDeviceGetAttribute(&cus, hipDeviceAttributeMultiprocessorCount, dev) != hipSuccess) { grid = -1; return; }
        if (hipFuncSetAttribute((const void*)mk_fwd, hipFuncAttributeMaxDynamicSharedMemorySize, LDS_BYTES) != hipSuccess) { fprintf(stderr, "kernel_launch: hipFuncSetAttribute failed\n"); grid = -1; return; }
        if (hipOccupancyMaxActiveBlocksPerMultiprocessor(&per_cu, (const void*)mk_fwd, NWAVES * 64, LDS_BYTES) != hipSuccess || per_cu < 1) fprintf(stderr, "kernel_launch: occupancy query reports %d\n", per_cu);
        (void)hipGetLastError();
        grid = cus;
    }
    if (grid < 0) return;
    (void)hipMemsetAsync((char*)d_ws + WS_CTL, 0, CTL_ZERO_BYTES, stream);
    Args a{};
    for (int i = 0; i < 22; ++i) a.in[i] = d_in[i];
    a.out = (float*)d_out; a.ws = (unsigned char*)d_ws;
#if N_LAUNCH_MODE == 1
    a.ph_lo = 0; a.ph_hi = NPHASE;
    hipLaunchKernelGGL(mk_fwd, dim3(grid), dim3(NWAVES * 64), LDS_BYTES, stream, a);
#else
    for (int k = 0; k < NPHASE; ++k) { a.ph_lo = k; a.ph_hi = k + 1; hipLaunchKernelGGL(mk_fwd, dim3(grid), dim3(NWAVES * 64), LDS_BYTES, stream, a); }
#endif
}
```

```cpp
#include <hip/hip_runtime.h>
#include <cstdio>
#include <cstdint>

#define LAS __attribute__((address_space(3)))
#define GAS __attribute__((address_space(1)))
typedef unsigned short bf16_t;
typedef short bf16x8 __attribute__((ext_vector_type(8)));
typedef short s16x4 __attribute__((ext_vector_type(4)));
typedef float f32x4 __attribute__((ext_vector_type(4)));
typedef float f32x2 __attribute__((ext_vector_type(2)));
typedef float f32x16 __attribute__((ext_vector_type(16)));
typedef unsigned u32x4 __attribute__((ext_vector_type(4)));
typedef unsigned u32x2 __attribute__((ext_vector_type(2)));

#ifndef N_LAUNCH_MODE
#define N_LAUNCH_MODE 1
#endif

constexpr int NB = 16, SEQ = 2048, DM = 1024, NT = NB * SEQ;
constexpr int NMEM = 256;
constexpr int ND = 3328;
constexpr int NG = 2816;
constexpr int DSA_W = 3144, GLA_W = 2576;
constexpr int NEXP = 32;
constexpr int SLOT_ROWS = 73728;
constexpr float ALPHA = 1.4142135623730951f;
constexpr float LN_EPS = 1e-5f, RMS_EPS = 1e-6f;
constexpr float LOG2E = 1.4426950408889634f;
constexpr float C2 = 0.125f * LOG2E;
constexpr int NWAVES = 8;

constexpr size_t MiB = 1u << 20;
constexpr size_t WS_CTL = 0, CTL_ZERO_BYTES = 1 * MiB;
constexpr size_t WS_ROPEC = 1 * MiB, WS_ROPES = 5 * MiB;
constexpr size_t WS_DEC = 9 * MiB;
constexpr size_t WS_WD = 10 * MiB, WS_WG = 17 * MiB, WS_WKV = 23 * MiB, WS_WO = 25 * MiB, WS_W13 = 29 * MiB, WS_W2 = 61 * MiB;
constexpr size_t WS_KVM = 77 * MiB;
constexpr size_t WS_MEMB = 85 * MiB;
constexpr size_t WS_LISTTOK = 85 * MiB, WS_LISTW = 89 * MiB;
constexpr size_t WS_TOKSLOT = 93 * MiB;
constexpr size_t WS_A = 96 * MiB;
constexpr size_t WS_B = 160 * MiB;
constexpr size_t WS_C = 288 * MiB;
constexpr size_t WS_D = 352 * MiB;
constexpr size_t WS_END = 500 * MiB;
constexpr size_t WS_XB = WS_A;
constexpr size_t WS_Q = 160 * MiB, WS_K = 208 * MiB, WS_V = 256 * MiB, WS_QI = 304 * MiB, WS_QM = 336 * MiB, WS_KIW = 352 * MiB, WS_KI = 362 * MiB, WS_WI = 366 * MiB, WS_MASK = 368 * MiB, WS_AO0 = 376 * MiB;
constexpr size_t WS_X1 = WS_B, WS_X1B0 = WS_C, WS_ACT0 = WS_A, WS_Y = WS_D;
constexpr size_t WS_GV = 96 * MiB, WS_GQM = 144 * MiB, WS_GQ = 352 * MiB, WS_GK = 376 * MiB, WS_GR = 400 * MiB, WS_A1 = 448 * MiB, WS_KPT = 450 * MiB, WS_VT = WS_C, WS_AO1 = WS_B;
constexpr size_t WS_X1B1 = WS_A, WS_ACT1 = WS_C;
constexpr int KIW_P = 80;

constexpr int CW_CNT = 8192;
constexpr int CW_BAR = 4096;

__device__ __forceinline__ unsigned f2bf(float f) { unsigned u = __builtin_bit_cast(unsigned, f); return (u + 0x7fffu + ((u >> 16) & 1u)) >> 16; }
__device__ __forceinline__ unsigned pk2(float lo, float hi) { return f2bf(lo) | (f2bf(hi) << 16); }
__device__ __forceinline__ float bf2f(unsigned h) { return __builtin_bit_cast(float, h << 16); }
__device__ __forceinline__ float wave_sum(float v) {
#pragma unroll
    for (int o = 1; o < 64; o <<= 1) v += __shfl_xor(v, o);
    return v;
}
__device__ __forceinline__ float fast_exp2(float x) { return __builtin_amdgcn_exp2f(x); }
__device__ __forceinline__ float silu_f(float a) { return a * __builtin_amdgcn_rcpf(1.f + fast_exp2(-a * LOG2E)); }

namespace pg8 {
constexpr int BM = 256, BK = 64, HALF = 128, HTB = HALF * BK * 2, STAGE_BYTES = 8 * HTB, NXCD = 8, WGM = 8;
__host__ __device__ __forceinline__ int lds_byte(int r, int c) { const int st = (r >> 4) * 2 + (c >> 5), rr = r & 15, cc = c & 31, ob = rr * 64 + cc * 2; return st * 1024 + (ob ^ (((ob >> 9) & 1) << 5)); }
__host__ __device__ __forceinline__ void stage_rc(int b, int& R, int& C) { const int st = b / 1024, sb = b % 1024, swz = sb ^ (((sb >> 9) & 1) << 5); R = (st >> 1) * 16 + swz / 64; C = (st & 1) * 32 + (swz % 64) / 2; }
__host__ __device__ __forceinline__ int perm32(int rho) { const int n = rho >> 4, i = rho & 15; return 8 * (i >> 2) + 4 * n + (i & 3); }

struct Unit { int pm, pn, e, r0; };
struct Gemm { const bf16_t* A; const bf16_t* Bt; int M, N, K; };

struct StaticOrder {
    int nM, nN, nwg, G, c;
    __device__ void init(int M, int N, int G_, int c_) { nM = M / BM; nN = N / BM; nwg = nM * nN; G = G_; c = c_; }
    __device__ bool next(int i, Unit& u) const {
        const long L = (long)i * G + c; if (L >= nwg) return false;
        int wgid = (int)L; { const int q = nwg / NXCD, r = nwg % NXCD, xcd = wgid % NXCD, off = wgid / NXCD; wgid = (xcd < r ? xcd * (q + 1) : r * (q + 1) + (xcd - r) * q) + off; }
        const int nig = WGM * nN, gid = wgid / nig, fm = gid * WGM, gsz = (nM - fm) < WGM ? (nM - fm) : WGM;
        u.pm = fm + ((wgid % nig) % gsz); u.pn = (wgid % nig) / gsz; u.e = 0; u.r0 = 0; return true;
    }
    __device__ __forceinline__ int rowidx(const Unit& u, int r) const { return u.pm * BM + r; }
};

typedef __bf16 bf16x2_t __attribute__((ext_vector_type(2)));
__device__ __forceinline__ unsigned cvt_pk_bf16(float lo, float hi) { f32x2 v = {lo, hi}; bf16x2_t b = __builtin_convertvector(v, bf16x2_t); return __builtin_bit_cast(unsigned, b); }

template <class Epi, class Sched, bool ALIGN_EPI, bool SP2>
__device__ __forceinline__ void gemm_phase(LAS unsigned char* lds, const Gemm g, const Sched& S, const Epi& E) {
    const int tid = threadIdx.x, wid = __builtin_amdgcn_readfirstlane(tid >> 6), lane = tid & 63, wr = wid >> 2, wc = wid & 3, fr = lane & 15, fq = lane >> 4;
    const int K = g.K, nt = K / BK;
    int RA[2], CA[2]; unsigned voffB[2];
#pragma unroll
    for (int i = 0; i < 2; ++i) { int R, C; stage_rc(tid * 16 + i * 8192, R, C); const int Rb = (R & ~31) + perm32(R & 31);
        RA[i] = R; CA[i] = C; voffB[i] = (unsigned)(Rb * K + C) * 2u; }
    const size_t kstep = (size_t)(BK * 2);
    const size_t hstep = (size_t)HALF * K * 2;
    const size_t tstep = 2 * hstep;
    const unsigned ldsw = (unsigned)wid * 1024u;
    const int aoff = lds_byte(wr * 64 + fr, fq * 8), boff = lds_byte(wc * 32 + fr, fq * 8);
#define PG8_SA(b, h) (((b) * 2 + (h)) * HTB)
#define PG8_SB(b, h) ((4 + (b) * 2 + (h)) * HTB)
#define PG8_STAGE(bufoff, gbase, voff) do { _Pragma("unroll") for (int _i = 0; _i < 2; ++_i) \
        __builtin_amdgcn_global_load_lds((const unsigned*)((const char*)(gbase) + (voff)[_i]), (LAS unsigned*)(lds + (bufoff) + ldsw + _i * 8192), 16, 0, 0); } while (0)
#define PG8_LDA(dst, b, h) do { _Pragma("unroll") for (int m = 0; m < 4; ++m) _Pragma("unroll") for (int k = 0; k < 2; ++k) dst[m][k] = *(const LAS bf16x8*)(lds + PG8_SA(b, h) + aoff + m * 2048 + k * 1024); } while (0)
#define PG8_LDB(dst, b, h) do { _Pragma("unroll") for (int n = 0; n < 2; ++n) _Pragma("unroll") for (int k = 0; k < 2; ++k) dst[n][k] = *(const LAS bf16x8*)(lds + PG8_SB(b, h) + boff + n * 2048 + k * 1024); } while (0)
#define PG8_MMA(ai, bj, At, Bt) do { __builtin_amdgcn_s_setprio(1); _Pragma("unroll") for (int m = 0; m < 4; ++m) _Pragma("unroll") for (int n = 0; n < 2; ++n) _Pragma("unroll") for (int k = 0; k < 2; ++k) \
        acc[ai][bj][m][n] = __builtin_amdgcn_mfma_f32_16x16x32_bf16(Bt[n][k], At[m][k], acc[ai][bj][m][n], 0, 0, 0); __builtin_amdgcn_s_setprio(0); } while (0)
#define PG8_WAIT_V(n) asm volatile("s_waitcnt vmcnt(" #n ")" ::: "memory")
#define PG8_WAIT_L(n) asm volatile("s_waitcnt lgkmcnt(" #n ")" ::: "memory")
#define PG8_BAR __builtin_amdgcn_s_barrier()
#define PG8_SCHED __builtin_amdgcn_sched_barrier(0)
#define PG8_MKOFF(o0, o1, u) do { _Pragma("unroll") for (int _i = 0; _i < 2; ++_i) { \
        o0[_i] = ((unsigned)S.rowidx(u, RA[_i]) * (unsigned)K + (unsigned)CA[_i]) * 2u; o1[_i] = ((unsigned)S.rowidx(u, HALF + RA[_i]) * (unsigned)K + (unsigned)CA[_i]) * 2u; } } while (0)
    Unit cur, nxt; int ui = 0;
    if (!S.next(0, cur)) return;
    f32x4 acc[2][2][4][2];
#pragma unroll
    for (int a = 0; a < 2; ++a)
#pragma unroll
        for (int b = 0; b < 2; ++b)
#pragma unroll
            for (int m = 0; m < 4; ++m)
#pragma unroll
                for (int n = 0; n < 2; ++n) acc[a][b][m][n] = (f32x4){0.f, 0.f, 0.f, 0.f};
    bf16x8 At[4][2], B0[2][2], B1[2][2];
    const char* const gA = (const char*)g.A;
    unsigned cO0[2], cO1[2], nO0[2], nO1[2];
    PG8_MKOFF(cO0, cO1, cur);
    const char* cB = (const char*)g.Bt + (size_t)cur.pn * tstep;
    if constexpr (SP2) {
        PG8_STAGE(PG8_SB(0, 0), cB, voffB); PG8_STAGE(PG8_SB(0, 1), cB + hstep, voffB); PG8_STAGE(PG8_SA(0, 0), gA, cO0); PG8_STAGE(PG8_SA(0, 1), gA, cO1);
        if (wr == 1) PG8_BAR;
        PG8_WAIT_V(2); PG8_BAR;
        PG8_STAGE(PG8_SB(1, 0), cB + kstep, voffB); PG8_STAGE(PG8_SA(1, 0), gA + kstep, cO0); PG8_STAGE(PG8_SB(1, 1), cB + hstep + kstep, voffB);
        PG8_WAIT_V(6); PG8_BAR;
    } else {
        PG8_STAGE(PG8_SB(0, 0), cB, voffB); PG8_STAGE(PG8_SA(0, 0), gA, cO0); PG8_STAGE(PG8_SB(0, 1), cB + hstep, voffB); PG8_STAGE(PG8_SA(0, 1), gA, cO1);
        if (wr == 1) PG8_BAR;
        PG8_WAIT_V(4); PG8_BAR;
        PG8_STAGE(PG8_SB(1, 0), cB + kstep, voffB); PG8_STAGE(PG8_SA(1, 0), gA + kstep, cO0); PG8_STAGE(PG8_SB(1, 1), cB + hstep + kstep, voffB);
        PG8_WAIT_V(6); PG8_BAR;
    }
    for (;;) {
        const bool has_next = S.next(ui + 1, nxt);
        if (has_next) { PG8_MKOFF(nO0, nO1, nxt); } else {
#pragma unroll
            for (int _i = 0; _i < 2; ++_i) { nO0[_i] = cO0[_i]; nO1[_i] = cO1[_i]; } }
        const char* nB = has_next ? (const char*)g.Bt + (size_t)nxt.pn * tstep : cB;
#pragma unroll 1
        for (int t = 0; t < nt; t += 2) {
            const bool last = (t == nt - 2);
            const char* a1 = gA + (size_t)(t + 1) * kstep;
            const char* a2 = last ? gA : gA + (size_t)(t + 2) * kstep; const char* b2 = last ? nB : cB + (size_t)(t + 2) * kstep;
            const char* a3 = a2 + kstep; const char* b3 = b2 + kstep;
            unsigned x0[2], x1[2];
#pragma unroll
            for (int _i = 0; _i < 2; ++_i) { x0[_i] = last ? nO0[_i] : cO0[_i]; x1[_i] = last ? nO1[_i] : cO1[_i]; }
            if constexpr (SP2) {
            PG8_LDB(B0, 0, 0); PG8_LDB(B1, 0, 1); PG8_SCHED; PG8_LDA(At, 0, 0); PG8_STAGE(PG8_SA(1, 1), a1, cO1);
            PG8_WAIT_V(8); PG8_WAIT_L(0); PG8_BAR; PG8_MMA(0, 0, At, B0); PG8_MMA(0, 1, At, B1); PG8_BAR; PG8_SCHED;
            PG8_LDA(At, 0, 1); PG8_STAGE(PG8_SB(0, 0), b2, voffB); PG8_STAGE(PG8_SB(0, 1), b2 + hstep, voffB); PG8_STAGE(PG8_SA(0, 0), a2, x0);
            PG8_WAIT_V(8); PG8_WAIT_L(0); PG8_BAR; PG8_MMA(1, 0, At, B0); PG8_MMA(1, 1, At, B1); PG8_BAR; PG8_SCHED;
            PG8_LDB(B0, 1, 0); PG8_LDB(B1, 1, 1); PG8_SCHED; PG8_LDA(At, 1, 0); PG8_STAGE(PG8_SA(0, 1), a2, x1);
            PG8_WAIT_V(8); PG8_WAIT_L(0); PG8_BAR; PG8_MMA(0, 0, At, B0); PG8_MMA(0, 1, At, B1); PG8_BAR; PG8_SCHED;
            PG8_LDA(At, 1, 1); PG8_STAGE(PG8_SB(1, 0), b3, voffB); PG8_STAGE(PG8_SB(1, 1), b3 + hstep, voffB); PG8_STAGE(PG8_SA(1, 0), a3, x0);
            PG8_WAIT_V(8); PG8_WAIT_L(0); PG8_BAR; PG8_MMA(1, 0, At, B0); PG8_MMA(1, 1, At, B1); PG8_BAR; PG8_SCHED;
            } else {
            PG8_LDB(B0, 0, 0); PG8_SCHED; PG8_LDA(At, 0, 0); PG8_STAGE(PG8_SA(1, 1), a1, cO1);
            PG8_WAIT_L(8); PG8_BAR; PG8_WAIT_L(0); PG8_MMA(0, 0, At, B0); PG8_BAR; PG8_SCHED;
            PG8_LDB(B1, 0, 1); PG8_STAGE(PG8_SB(0, 0), b2, voffB);
            PG8_BAR; PG8_WAIT_L(0); PG8_MMA(0, 1, At, B1); PG8_BAR;
            PG8_LDA(At, 0, 1); PG8_STAGE(PG8_SA(0, 0), a2, x0);
            PG8_BAR; PG8_WAIT_L(0); PG8_MMA(1, 0, At, B0); PG8_BAR; PG8_SCHED;
            PG8_STAGE(PG8_SB(0, 1), b2 + hstep, voffB);
            PG8_WAIT_V(6); PG8_BAR; PG8_MMA(1, 1, At, B1); PG8_BAR;
            PG8_LDB(B0, 1, 0); PG8_SCHED; PG8_LDA(At, 1, 0); PG8_STAGE(PG8_SA(0, 1), a2, x1);
            PG8_WAIT_L(8); PG8_BAR; PG8_WAIT_L(0); PG8_MMA(0, 0, At, B0); PG8_BAR; PG8_SCHED;
            PG8_LDB(B1, 1, 1); PG8_STAGE(PG8_SB(1, 0), b3, voffB);
            PG8_BAR; PG8_WAIT_L(0); PG8_MMA(0, 1, At, B1); PG8_BAR;
            PG8_LDA(At, 1, 1); PG8_STAGE(PG8_SA(1, 0), a3, x0);
            PG8_BAR; PG8_WAIT_L(0); PG8_MMA(1, 0, At, B0); PG8_BAR; PG8_SCHED;
            PG8_STAGE(PG8_SB(1, 1), b3 + hstep, voffB);
            PG8_WAIT_V(6); PG8_BAR; PG8_MMA(1, 1, At, B1); PG8_BAR;
            }
        }
        if constexpr (ALIGN_EPI) { if (wr == 0) PG8_BAR; }
        E(acc, cur, wr, wc, fr, fq);
        if (!has_next) break;
#pragma unroll
        for (int a = 0; a < 2; ++a)
#pragma unroll
            for (int b = 0; b < 2; ++b)
#pragma unroll
                for (int m = 0; m < 4; ++m)
#pragma unroll
                    for (int n = 0; n < 2; ++n) acc[a][b][m][n] = (f32x4){0.f, 0.f, 0.f, 0.f};
        cur = nxt; cB = nB; ++ui;
#pragma unroll
        for (int _i = 0; _i < 2; ++_i) { cO0[_i] = nO0[_i]; cO1[_i] = nO1[_i]; }
        if constexpr (ALIGN_EPI) { if (wr == 1) PG8_BAR; }
    }
    PG8_WAIT_V(0);
    if constexpr (!ALIGN_EPI) { if (wr == 0) PG8_BAR; }
    PG8_BAR;
#undef PG8_SA
#undef PG8_SB
#undef PG8_STAGE
#undef PG8_LDA
#undef PG8_LDB
#undef PG8_MMA
#undef PG8_WAIT_V
#undef PG8_WAIT_L
#undef PG8_BAR
#undef PG8_SCHED
#undef PG8_MKOFF
}
}

#define XB_TMO      128
#define XB_XCNT(j)  (256  + 64 * (j))
#define XB_XSUB(j)  (1280 + 64 * (j))
#define XB_XGEN(j)  (2304 + 64 * (j))
#define XB_TOP      3328
#define XB_TOPGEN   3392
#define XCD_BAR_WORDS 3456
#define XB_SPIN_CAP (1u << 18)
__device__ __forceinline__ unsigned xb_ld(unsigned* p)              { return __hip_atomic_load(p, __ATOMIC_RELAXED, __HIP_MEMORY_SCOPE_AGENT); }
__device__ __forceinline__ unsigned xb_add(unsigned* p, unsigned v) { return __hip_atomic_fetch_add(p, v, __ATOMIC_RELAXED, __HIP_MEMORY_SCOPE_AGENT); }
__device__ __forceinline__ unsigned xb_xcc_id() { return (unsigned)__builtin_amdgcn_s_getreg((3 << 11) | 20) & 0xFu; }
#define XB_SPIN(cond, bar) do { unsigned _sp = 0; while (cond) { __builtin_amdgcn_s_sleep(1); \
    if ((++_sp & 255u) == 0u) { if (xb_ld(&(bar)[XB_TMO])) break; if (_sp > XB_SPIN_CAP) { atomicAdd(&(bar)[XB_TMO], 1u); break; } } } } while (0)
struct XcdBarrier { unsigned* bar; unsigned x; volatile LAS unsigned* st; };
__device__ __forceinline__ XcdBarrier xcd_barrier_post(unsigned* bar, volatile LAS unsigned* st) {
    XcdBarrier b; b.bar = bar; b.x = xb_xcc_id(); b.st = st;
    if (threadIdx.x == 0) (void)xb_add(&bar[XB_XCNT(b.x)], 1u);
    return b;
}
__device__ __forceinline__ void xcd_barrier_complete(unsigned* bar, unsigned x, unsigned& nloc, unsigned& nx) {
    const unsigned G = gridDim.x * gridDim.y * gridDim.z;
    unsigned sum, cnt, mine, sp = 0u;
    for (;;) {
        sum = 0u; cnt = 0u; mine = 0u;
#pragma unroll
        for (unsigned j = 0; j < 16; ++j) { const unsigned c = xb_ld(&bar[XB_XCNT(j)]); sum += c; cnt += (c > 0u) ? 1u : 0u; mine = (j == x) ? c : mine; }
        if (sum == G) break;
        __builtin_amdgcn_s_sleep(1);
        if ((++sp & 255u) == 0u) { if (xb_ld(&bar[XB_TMO])) break; if (sp > XB_SPIN_CAP) { atomicAdd(&bar[XB_TMO], 1u); break; } }
    }
    nloc = mine > 0u ? mine : 1u; nx = cnt > 0u ? cnt : 1u;
}
__device__ __forceinline__ void xcd_barrier(const XcdBarrier& b) {
    asm volatile("s_waitcnt vmcnt(0)" ::: "memory");
    __syncthreads();
    if (threadIdx.x == 0) {
        unsigned* bar = b.bar;
        __builtin_amdgcn_s_waitcnt(0);
        unsigned nloc = b.st[0], nx = b.st[1];
        if (nloc == 0u) { xcd_barrier_complete(bar, b.x, nloc, nx); b.st[0] = nloc; b.st[1] = nx; }
        const unsigned old = xb_add(&bar[XB_XSUB(b.x)], 1u);
        const unsigned gen = old / nloc;
        if (old + 1u == (gen + 1u) * nloc) {
            __builtin_amdgcn_fence(__ATOMIC_RELEASE, "agent");
            asm volatile("s_waitcnt vmcnt(0)" ::: "memory");
            const unsigned og = xb_add(&bar[XB_TOP], 1u);
            const unsigned tg = og / nx;
            if (og + 1u == (tg + 1u) * nx) xb_add(&bar[XB_TOPGEN], 1u);
            else XB_SPIN(xb_ld(&bar[XB_TOPGEN]) == tg, bar);
            __builtin_amdgcn_fence(__ATOMIC_ACQUIRE, "agent");
            xb_add(&bar[XB_XGEN(b.x)], 1u);
            asm volatile("s_waitcnt vmcnt(0)" ::: "memory");
        } else {
            XB_SPIN(xb_ld(&bar[XB_XGEN(b.x)]) == gen, bar);
            __builtin_amdgcn_fence(__ATOMIC_ACQUIRE, "agent");
            asm volatile("s_waitcnt vmcnt(0)" ::: "memory");
        }
    }
    __syncthreads();
}

constexpr int LDS_BYTES = 147456;
constexpr int MISC_OFF = 135168;
struct Args { const void* in[22]; float* out; unsigned char* ws; int ph_lo, ph_hi; };
struct Frame {
    LAS unsigned char* lds;
    unsigned char* ws; float* out;
    unsigned* ctl;
    int tid, lane, wave, G, gw, NGW;
};
enum { I_X = 0, I_MEM, I_POS, I_DSA_WIN, I_DSA_KG, I_DSA_KB, I_GLA_WIN, I_GLA_WGATE, I_GLA_BGATE, I_GLA_NORMG, I_WMEMKV, I_WOUT, I_LN1G, I_LN1B, I_LN2G, I_LN2B,
       I_MOE_WG, I_MOE_BG, I_MOE_WR, I_MOE_BR, I_MOE_W13, I_MOE_W2 };

__device__ __forceinline__ int dperm(int c) { return ((c >> 2) & 1) * 32 + (c >> 5) * 16 + ((c >> 3) & 3) * 4 + (c & 3); }
__device__ __forceinline__ int dperm_inv(int d) { const int n = d >> 5, i = d & 31; return (i >> 4) * 32 + ((i >> 2) & 3) * 8 + n * 4 + (i & 3); }
__device__ __forceinline__ int dsa_srccol(int n) {
    if (n < 1536) { return (n & ~63) + dperm(n & 63); }
    if (n < 2304) return n;
    if (n < 2816) { return (n & ~63) + dperm(n & 63); }
    if (n < 3072) return 2888 + (n - 2816);
    if (n < 3136) return 2816 + dperm(n - 3072);
    if (n < 3144) return 2880 + (n - 3136);
    return -1;
}
__device__ __forceinline__ int gla_srccol(int n) {
    if (n < 2304) return n;
    if (n < 2560) return 2320 + (n - 2304);
    if (n < 2576) return 2304 + (n - 2560);
    return -1;
}
__device__ __forceinline__ int w13_srccol(int r) { const int pn = r >> 8, bj = (r >> 7) & 1, j = r & 127; return bj * 256 + pn * 128 + j; }
template <int MODE>
__device__ __forceinline__ void transpose_item(const float* W, int K, int ldw, bf16_t* WT, int nrows32, LAS float* scr, int item, int lane) {
    const int kb = item / nrows32, nb = item % nrows32, k0 = 64 * kb, n0 = 32 * nb;
    const int n = n0 + (lane & 31);
    int sc;
    if (MODE == 0) sc = n; else if (MODE == 1) sc = dsa_srccol(n); else if (MODE == 2) sc = gla_srccol(n); else sc = w13_srccol(n);
#pragma unroll
    for (int i = 0; i < 32; ++i) { const int kk = 2 * i + (lane >> 5); scr[kk * 33 + (lane & 31)] = (sc >= 0) ? W[(size_t)(k0 + kk) * ldw + sc] : 0.f; }
    asm volatile("s_waitcnt lgkmcnt(0)" ::: "memory");
    const int c = lane & 7;
#pragma unroll
    for (int j = 0; j < 4; ++j) { const int nn = (lane >> 3) + 8 * j; const LAS float* s = scr + (8 * c) * 33 + nn;
        u32x4 o; o.x = pk2(s[0 * 33], s[1 * 33]); o.y = pk2(s[2 * 33], s[3 * 33]); o.z = pk2(s[4 * 33], s[5 * 33]); o.w = pk2(s[6 * 33], s[7 * 33]);
        *(u32x4*)(WT + (size_t)(n0 + nn) * K + k0 + 8 * c) = o; }
    asm volatile("s_waitcnt lgkmcnt(0)" ::: "memory");
}
__device__ __forceinline__ void moe_weight_items(Frame& F, const float* w13, const float* w2, int layer) {
    LAS float* scr = (LAS float*)(F.lds + F.wave * 16384);
    bf16_t* W13 = (bf16_t*)(F.ws + WS_W13); bf16_t* W2 = (bf16_t*)(F.ws + WS_W2);
    constexpr int I13 = (1024 / 64) * (512 / 32), I2 = (256 / 64) * (1024 / 32);
    for (int it = F.gw; it < NEXP * (I13 + I2); it += F.NGW) {
        const int ge = it / (I13 + I2), r = it % (I13 + I2);
        if (r < I13) transpose_item<3>(w13 + ((size_t)layer * NEXP + ge) * 1024 * 512, 1024, 512, W13 + (size_t)ge * 512 * 1024, 16, scr, r, F.lane);
        else transpose_item<0>(w2 + ((size_t)layer * NEXP + ge) * 256 * 1024, 256, 1024, W2 + (size_t)ge * 1024 * 256, 32, scr, r - I13, F.lane);
    }
}
__device__ __forceinline__ void cvt_rows_bf16(Frame& F, const float* src, bf16_t* dst, int rows) {
    for (int m0 = F.gw; m0 < rows; m0 += 4 * F.NGW) {
        f32x4 v[4][4];
#pragma unroll
        for (int q = 0; q < 4; ++q) { const int m = m0 + q * F.NGW; if (m < rows) { const f32x4* xr = (const f32x4*)(src + (size_t)m * DM) + F.lane;
#pragma unroll
            for (int j = 0; j < 4; ++j) v[q][j] = xr[64 * j]; } }
#pragma unroll
        for (int q = 0; q < 4; ++q) { const int m = m0 + q * F.NGW; if (m < rows) { u32x2* o = (u32x2*)(dst + (size_t)m * DM) + F.lane;
#pragma unroll
            for (int j = 0; j < 4; ++j) { u32x2 w; w.x = pk2(v[q][j].x, v[q][j].y); w.y = pk2(v[q][j].z, v[q][j].w); o[64 * j] = w; } } }
    }
}
__device__ __forceinline__ void p_prologue(Frame& F, const Args& a) {
    LAS float* scr = (LAS float*)(F.lds + F.wave * 16384);
    const float* dsa_w = (const float*)a.in[I_DSA_WIN]; const float* gla_w = (const float*)a.in[I_GLA_WIN];
    const float* wkv = (const float*)a.in[I_WMEMKV]; const float* wout = (const float*)a.in[I_WOUT];
    bf16_t* WD = (bf16_t*)(F.ws + WS_WD); bf16_t* WG = (bf16_t*)(F.ws + WS_WG); bf16_t* WKV = (bf16_t*)(F.ws + WS_WKV); bf16_t* WO = (bf16_t*)(F.ws + WS_WO);
    constexpr int ID = 16 * (ND / 32), IG = 16 * (NG / 32), IKV = 16 * (512 / 32), IO = 16 * (1024 / 32);
    constexpr int NIT = ID + IG + 2 * IKV + 2 * IO;
    for (int it = F.gw; it < NIT; it += F.NGW) {
        int r = it;
        if (r < ID) { transpose_item<1>(dsa_w, 1024, DSA_W, WD, ND / 32, scr, r, F.lane); continue; } r -= ID;
        if (r < IG) { transpose_item<2>(gla_w, 1024, GLA_W, WG, NG / 32, scr, r, F.lane); continue; } r -= IG;
        if (r < 2 * IKV) { const int l = r / IKV; transpose_item<0>(wkv + (size_t)l * 1024 * 512, 1024, 512, WKV + (size_t)l * 512 * 1024, 16, scr, r % IKV, F.lane); continue; } r -= 2 * IKV;
        { const int l = r / IO; transpose_item<0>(wout + (size_t)l * 1024 * 1024, 1024, 1024, WO + (size_t)l * 1024 * 1024, 32, scr, r % IO, F.lane); }
    }
    moe_weight_items(F, (const float*)a.in[I_MOE_W13], (const float*)a.in[I_MOE_W2], 0);
    cvt_rows_bf16(F, (const float*)a.in[I_X], (bf16_t*)(F.ws + WS_XB), NT);
    cvt_rows_bf16(F, (const float*)a.in[I_MEM], (bf16_t*)(F.ws + WS_MEMB), NB * NMEM);
    const int* pos = (const int*)a.in[I_POS];
    float* RC = (float*)(F.ws + WS_ROPEC); float* RS = (float*)(F.ws + WS_ROPES);
    __syncthreads();
    LAS float* invs = (LAS float*)F.lds;
    if (F.tid < 32) invs[F.tid] = (float)pow(10000.0, -(double)(2 * F.tid) / 64.0);
    __syncthreads();
    for (int idx = blockIdx.x * 512 + F.tid; idx < NT * 32; idx += F.G * 512) {
        const int t = idx >> 5, i = idx & 31;
        const float ang = (float)pos[t] * invs[i];
        float sn, cs; sincosf(ang, &sn, &cs);
        RC[idx] = cs; RS[idx] = sn;
    }
}
typedef const f32x4 (&AccRef)[2][2][4][2];
__device__ __forceinline__ void st_bf16x8(bf16_t* p, f32x4 v0, f32x4 v1) {
    u32x4 w; w.x = pg8::cvt_pk_bf16(v0[0], v0[1]); w.y = pg8::cvt_pk_bf16(v0[2], v0[3]); w.z = pg8::cvt_pk_bf16(v1[0], v1[1]); w.w = pg8::cvt_pk_bf16(v1[2], v1[3]);
    *(u32x4*)p = w;
}
struct EpiDsaProj {
    bf16_t *Q, *K, *V, *QI, *QM, *KI; float* WI; const float *RC, *RS, *kg, *kb; LAS unsigned char* xlds;
    __device__ __forceinline__ void operator()(AccRef acc, const pg8::Unit& u, int wr, int wc, int fr, int fq) const {
        const int pn = u.pn; const int row0 = u.pm * 256 + wr * 64 + fr;
        const int i0 = 16 * (wc & 1) + 4 * fq;
#pragma unroll
        for (int ai = 0; ai < 2; ++ai)
#pragma unroll
            for (int m = 0; m < 4; ++m) {
                const int row = row0 + ai * 128 + m * 16;
                f32x4 c4 = (f32x4){1.f, 1.f, 1.f, 1.f}, s4 = (f32x4){0.f, 0.f, 0.f, 0.f};
                const bool rope = (pn < 6) || (pn == 9) || (pn == 10);
                if (rope) { c4 = *(const f32x4*)(RC + (size_t)row * 32 + i0); s4 = *(const f32x4*)(RS + (size_t)row * 32 + i0); }
#pragma unroll
                for (int bj = 0; bj < 2; ++bj) {
                    const int gcol = pn * 256 + bj * 128 + wc * 32 + 8 * fq;
                    f32x4 v0 = acc[ai][bj][m][0], v1 = acc[ai][bj][m][1];
                    if (rope) { const f32x4 y0 = v0 * c4 - v1 * s4, y1 = v1 * c4 + v0 * s4; v0 = y0; v1 = y1; }
                    if (pn < 3) { v0 = v0 * C2; v1 = v1 * C2; st_bf16x8(Q + (size_t)row * 768 + gcol, v0, v1); }
                    else if (pn < 6) st_bf16x8(K + (size_t)row * 768 + (gcol - 768), v0, v1);
                    else if (pn < 9) st_bf16x8(V + (size_t)row * 768 + (gcol - 1536), v0, v1);
                    else if (pn < 11) st_bf16x8(QI + (size_t)row * 512 + (gcol - 2304), v0, v1);
                    else if (pn == 11) { v0 = v0 * C2; v1 = v1 * C2; st_bf16x8(QM + (size_t)row * 256 + (gcol - 2816), v0, v1); }
                }
            }
        if (pn == 12) ki_tile(acc, u, wr, wc, fr, fq);
    }
    __device__ __forceinline__ void ki_tile(AccRef acc, const pg8::Unit& u, int wr, int wc, int fr, int fq) const {
        LAS f32x2* xch = (LAS f32x2*)xlds;
        const int row0 = u.pm * 256 + wr * 64 + fr;
        if (wc < 2) {
#pragma unroll
            for (int ai = 0; ai < 2; ++ai)
#pragma unroll
                for (int m = 0; m < 4; ++m) { const f32x4 v0 = acc[ai][0][m][0], v1 = acc[ai][0][m][1];
                    float a = ((v0[0] + v0[1]) + (v0[2] + v0[3])) + ((v1[0] + v1[1]) + (v1[2] + v1[3]));
                    float b = ((v0[0] * v0[0] + v0[1] * v0[1]) + (v0[2] * v0[2] + v0[3] * v0[3])) + ((v1[0] * v1[0] + v1[1] * v1[1]) + (v1[2] * v1[2] + v1[3] * v1[3]));
                    a += __shfl_xor(a, 16); b += __shfl_xor(b, 16); a += __shfl_xor(a, 32); b += __shfl_xor(b, 32);
                    if (fq == 0) xch[(((wr * 2 + wc) * 2 + ai) * 4 + m) * 16 + fr] = (f32x2){a, b}; }
        }
        asm volatile("s_waitcnt lgkmcnt(0)" ::: "memory"); __builtin_amdgcn_s_barrier(); asm volatile("" ::: "memory");
        if (wc < 2) {
            const int c0 = 32 * wc + 8 * fq, i0 = 16 * wc + 4 * fq;
            f32x4 g0, g1, b0, b1;
#pragma unroll
            for (int j = 0; j < 4; ++j) { g0[j] = kg[dperm(c0 + j)]; g1[j] = kg[dperm(c0 + 4 + j)]; b0[j] = kb[dperm(c0 + j)]; b1[j] = kb[dperm(c0 + 4 + j)]; }
#pragma unroll
            for (int ai = 0; ai < 2; ++ai)
#pragma unroll
                for (int m = 0; m < 4; ++m) { const int row = row0 + ai * 128 + m * 16;
                    const f32x2 ot = xch[(((wr * 2 + 1) * 2 + ai) * 4 + m) * 16 + fr], ow = xch[(((wr * 2 + 0) * 2 + ai) * 4 + m) * 16 + fr];
                    const float mu = (ow.x + ot.x) * (1.f / 64.f); const float var = fmaxf((ow.y + ot.y) * (1.f / 64.f) - mu * mu, 0.f);
                    const float rs = 1.f / sqrtf(var + LN_EPS);
                    const f32x4 n0 = (acc[ai][0][m][0] - mu) * rs * g0 + b0, n1 = (acc[ai][0][m][1] - mu) * rs * g1 + b1;
                    const f32x4 c4 = *(const f32x4*)(RC + (size_t)row * 32 + i0), s4 = *(const f32x4*)(RS + (size_t)row * 32 + i0);
                    st_bf16x8(KI + (size_t)row * 64 + c0, n0 * c4 - n1 * s4, n1 * c4 + n0 * s4); }
        } else if (wc == 2 && fq == 0) {
#pragma unroll
            for (int ai = 0; ai < 2; ++ai)
#pragma unroll
                for (int m = 0; m < 4; ++m) { float* p = WI + (size_t)(row0 + ai * 128 + m * 16) * 8;
                    *(f32x4*)p = acc[ai][0][m][0] * 0.04419417382415922f; *(f32x4*)(p + 4) = acc[ai][0][m][1] * 0.04419417382415922f; }
        }
        asm volatile("s_waitcnt lgkmcnt(0)" ::: "memory"); __builtin_amdgcn_s_barrier(); asm volatile("" ::: "memory");
    }
};
struct EpiGlaProj {
    bf16_t *GQ, *GK, *GV, *GR, *GQM; float* A1;
    __device__ __forceinline__ void operator()(AccRef acc, const pg8::Unit& u, int wr, int wc, int fr, int fq) const {
        const int pn = u.pn; const int row0 = u.pm * 256 + wr * 64 + fr;
#pragma unroll
        for (int ai = 0; ai < 2; ++ai)
#pragma unroll
            for (int m = 0; m < 4; ++m) {
                const int row = row0 + ai * 128 + m * 16;
#pragma unroll
                for (int bj = 0; bj < 2; ++bj) {
                    const int gcol = pn * 256 + bj * 128 + wc * 32 + 8 * fq;
                    f32x4 v0 = acc[ai][bj][m][0], v1 = acc[ai][bj][m][1];
                    if (pn < 3) {
                        if (gcol < 384) { v0 = v0 * 0.10206207261596577f; v1 = v1 * 0.10206207261596577f; st_bf16x8(GQ + (size_t)row * 384 + gcol, v0, v1); }
                        else st_bf16x8(GK + (size_t)row * 384 + (gcol - 384), v0, v1);
                    }
                    else if (pn < 6) st_bf16x8(GV + (size_t)row * 768 + (gcol - 768), v0, v1);
                    else if (pn < 9) st_bf16x8(GR + (size_t)row * 768 + (gcol - 1536), v0, v1);
                    else if (pn == 9) { v0 = v0 * C2; v1 = v1 * C2; st_bf16x8(GQM + (size_t)row * 256 + (gcol - 2304), v0, v1); }
                    else { const int lc = gcol - 2560; if (lc < 16) { float* p = A1 + (size_t)row * 16 + lc; *(f32x4*)p = v0; *(f32x4*)(p + 4) = v1; } }
                }
            }
    }
};
struct EpiBf16Plain {
    bf16_t* O; int ldc; int ncolmask;
    __device__ __forceinline__ void operator()(AccRef acc, const pg8::Unit& u, int wr, int wc, int fr, int fq) const {
        const int row0 = u.pm * 256 + wr * 64 + fr; const int colt = (u.pn & ncolmask) * 256 + wc * 32 + 8 * fq;
#pragma unroll
        for (int ai = 0; ai < 2; ++ai)
#pragma unroll
            for (int m = 0; m < 4; ++m) { bf16_t* rowp = O + (size_t)(row0 + ai * 128 + m * 16) * ldc + colt;
#pragma unroll
                for (int bj = 0; bj < 2; ++bj) st_bf16x8(rowp + bj * 128, acc[ai][bj][m][0], acc[ai][bj][m][1]); }
    }
};
struct EpiF32Plain {
    float* C; int ldc;
    __device__ __forceinline__ void operator()(AccRef acc, const pg8::Unit& u, int wr, int wc, int fr, int fq) const {
        const int row0 = u.pm * 256 + wr * 64 + fr; const int colt = u.pn * 256 + wc * 32 + 8 * fq;
#pragma unroll
        for (int ai = 0; ai < 2; ++ai)
#pragma unroll
            for (int m = 0; m < 4; ++m) { float* rowp = C + (size_t)(row0 + ai * 128 + m * 16) * ldc + colt;
#pragma unroll
                for (int bj = 0; bj < 2; ++bj) { *(f32x4*)(rowp + bj * 128) = acc[ai][bj][m][0]; *(f32x4*)(rowp + bj * 128 + 4) = acc[ai][bj][m][1]; } }
    }
};

struct DsaKvmOrder {
    pg8::StaticOrder so; int G, c;
    __device__ void init(int G_, int c_) { so.init(NT, ND, G_, c_); G = G_; c = c_; }
    __device__ bool next(int i, pg8::Unit& u) const {
        const long L = (long)i * G + c;
        if (L < so.nwg) { so.next(i, u); u.e = 0; u.r0 = u.pn; u.pn += (int)(WS_WD / (512 * 1024)); return true; }
        const int k = (int)(L - so.nwg); if (k >= 64) return false;
        u.pm = k >> 2; u.r0 = k & 3; u.pn = (int)(WS_WKV / (512 * 1024)) + (k & 3); u.e = 1; return true;
    }
    __device__ __forceinline__ int rowidx(const pg8::Unit& u, int r) const { return (u.e ? (int)(WS_MEMB / 2048) : (int)(WS_XB / 2048)) + u.pm * 256 + r; }
};
struct EpiDsaKvm {
    EpiDsaProj d; EpiBf16Plain k;
    __device__ __forceinline__ void operator()(AccRef acc, const pg8::Unit& u, int wr, int wc, int fr, int fq) const {
        pg8::Unit v = u; v.pn = u.r0;
        if (u.e == 0) d(acc, v, wr, wc, fr, fq); else k(acc, v, wr, wc, fr, fq);
    }
};
struct EpiMoe1 {
    bf16_t* ACT; const float* LISTW; const unsigned* cnt;
    __device__ __forceinline__ void operator()(AccRef acc, const pg8::Unit& u, int wr, int wc, int fr, int fq) const {
        const int j2 = u.pn & 1; const int rl0 = wr * 64 + fr; const int ce = (int)cnt[u.e * 64];
#pragma unroll
        for (int ai = 0; ai < 2; ++ai)
#pragma unroll
            for (int m = 0; m < 4; ++m) {
                const int rl = rl0 + ai * 128 + m * 16; const int pos = u.r0 + rl;
                const float wt = (pos < ce) ? LISTW[(size_t)u.e * NT + pos] : 0.f;
                f32x4 a0 = acc[ai][0][m][0], a1 = acc[ai][0][m][1], u0 = acc[ai][1][m][0], u1 = acc[ai][1][m][1], o0, o1;
#pragma unroll
                for (int j = 0; j < 4; ++j) { o0[j] = silu_f(a0[j]) * u0[j] * wt; o1[j] = silu_f(a1[j]) * u1[j] * wt; }
                st_bf16x8(ACT + (size_t)(u.pm * 256 + rl) * 256 + j2 * 128 + wc * 32 + 8 * fq, o0, o1);
            }
    }
};
struct MoeOrder {
    const LAS int* tp; const unsigned* cnt; const int* LISTTOK; int ncol, G, c; bool gather;
    __device__ bool next(int i, pg8::Unit& u) const {
        const long L = (long)i * G + c; const int ntile = tp[NEXP];
        if (L >= (long)ntile * ncol) return false;
        const int tile = (int)(L / ncol), col = (int)(L % ncol);
        int e = 0;
#pragma unroll 1
        while (tp[e + 1] <= tile) ++e;
        u.pm = tile; u.pn = e * ncol + col; u.e = e; u.r0 = (tile - tp[e]) * 256; return true;
    }
    __device__ __forceinline__ int rowidx(const pg8::Unit& u, int r) const {
        if (!gather) return u.pm * 256 + r;
        const int pos = u.r0 + r;
        return (pos < (int)cnt[u.e * 64]) ? LISTTOK[(size_t)u.e * NT + pos] : 0;
    }
};
__device__ __forceinline__ void moe_tile_table(Frame& F, const unsigned* cnt, LAS int* tp) {
    if (F.tid == 0) { int s = 0; for (int e = 0; e < NEXP; ++e) { tp[e] = s; s += ((int)cnt[e * 64] + 255) >> 8; } tp[NEXP] = s; }
    __syncthreads();
}

__device__ __forceinline__ void p_ki(Frame& F, const Args& a) {
    const float* KIW = (const float*)(F.ws + WS_KIW); bf16_t* KI = (bf16_t*)(F.ws + WS_KI); float* WI = (float*)(F.ws + WS_WI);
    const float* RC = (const float*)(F.ws + WS_ROPEC); const float* RS = (const float*)(F.ws + WS_ROPES);
    const float* g = (const float*)a.in[I_DSA_KG]; const float* bb = (const float*)a.in[I_DSA_KB];
    const int d = F.lane; const float gd = g[d], bd = bb[d]; const int dst = dperm_inv(d);
    for (int t = F.gw; t < NT; t += F.NGW) {
        const float v = KIW[(size_t)t * KIW_P + d];
        const float mu = wave_sum(v) * (1.f / 64.f); const float dv = v - mu;
        const float var = wave_sum(dv * dv) * (1.f / 64.f);
        const float n = dv * (1.f / sqrtf(var + LN_EPS)) * gd + bd;
        const float pr = __shfl_xor(n, 32);
        const float c = RC[(size_t)t * 32 + (d & 31)], s = RS[(size_t)t * 32 + (d & 31)];
        const float o = (d < 32) ? (n * c - pr * s) : (n * c + pr * s);
        KI[(size_t)t * 64 + dst] = (bf16_t)f2bf(o);
        if (d < 8) WI[(size_t)t * 8 + d] = KIW[(size_t)t * KIW_P + 64 + d] * 0.04419417382415922f;
    }
}

__device__ __forceinline__ unsigned ordkey(float f) { const unsigned u = __builtin_bit_cast(unsigned, f); return (u & 0x80000000u) ? ~u : (u | 0x80000000u); }
__device__ __forceinline__ int wave_sum_i(int v) {
    v += __builtin_amdgcn_update_dpp(0, v, 0x111, 0xf, 0xf, false);
    v += __builtin_amdgcn_update_dpp(0, v, 0x112, 0xf, 0xf, false);
    v += __builtin_amdgcn_update_dpp(0, v, 0x114, 0xf, 0xf, false);
    v += __builtin_amdgcn_update_dpp(0, v, 0x118, 0xf, 0xf, false);
    v += __builtin_amdgcn_update_dpp(0, v, 0x142, 0xa, 0xf, false);
    v += __builtin_amdgcn_update_dpp(0, v, 0x143, 0xc, 0xf, false);
    return __builtin_amdgcn_readlane(v, 63);
}
__device__ __forceinline__ void transpose32(unsigned (&a)[32]) {
#pragma unroll
    for (int st = 0; st < 5; ++st) { const int j = 16 >> st; const unsigned m = (j == 16) ? 0x0000FFFFu : (j == 8) ? 0x00FF00FFu : (j == 4) ? 0x0F0F0F0Fu : (j == 2) ? 0x33333333u : 0x55555555u;
#pragma unroll
        for (int k = 0; k < 32; ++k) if ((k & j) == 0) { const unsigned t = ((a[k] >> j) ^ a[k + j]) & m; a[k + j] ^= t; a[k] ^= (t << j); } }
}
template <int NQ>
__device__ __forceinline__ void topk_select(const LAS float* sc, unsigned long long* MASK, size_t rowbase, int t0, int wave, int lane) {
#pragma unroll 1
    for (int u = 0; u < 2; ++u) {
        const int tk = 2 * wave + u, t = t0 + tk;
        unsigned a[32];
#pragma unroll
        for (int q = 0; q < 32; ++q) { if (q < NQ) { const unsigned k = ordkey(sc[tk * 2048 + lane + 64 * q]); a[q] = (lane + 64 * q <= t) ? k : 0u; } else a[q] = 0u; }
        transpose32(a);
        unsigned eq = 0xFFFFFFFFu, gt = 0u, sel = 0u; int cgt = 0; bool done = false;
#pragma unroll
        for (int b = 31; b >= 0; --b) {
            if (!done) {
                const unsigned m = eq & a[b]; const int pm = __builtin_popcount(m);
                const int c = wave_sum_i(cgt + pm);
                if (c >= 256) { eq = m; if (c == 256) { done = true; sel = gt | m; } }
                else { gt |= m; cgt += pm; eq &= ~a[b]; }
            }
        }
        if (!done) {
            const int tg = wave_sum_i(cgt), te = wave_sum_i(__builtin_popcount(eq)); int need = 256 - tg;
            if (te == need) sel = gt | eq;
            else { sel = gt;
#pragma unroll 1
                for (int q = 0; q < 32; ++q) {
                    unsigned long long bal = __ballot((eq >> q) & 1u);
                    int pc = __builtin_popcountll(bal); const int take = pc < need ? pc : need;
                    while (pc > take) { bal &= ~(1ull << (63 - __builtin_clzll(bal))); --pc; }
                    need -= take;
                    if ((bal >> lane) & 1ull) sel |= 1u << q; } }
        }
        unsigned long long mymask = 0ull;
#pragma unroll
        for (int q = 0; q < NQ; ++q) { const unsigned long long bal = __ballot((sel >> q) & 1u); if (lane == q) mymask = bal; }
        if (lane < 32) MASK[(rowbase + t) * 32 + lane] = mymask;
    }
}
__device__ __forceinline__ void p_indexer(Frame& F) {
    const bf16_t* QI = (const bf16_t*)(F.ws + WS_QI); const bf16_t* KI = (const bf16_t*)(F.ws + WS_KI); const float* WI = (const float*)(F.ws + WS_WI);
    unsigned long long* MASK = (unsigned long long*)(F.ws + WS_MASK);
    LAS float* sc = (LAS float*)F.lds;
    LAS float* wis = (LAS float*)(F.lds + 131072);
    const int lane = F.lane, r32 = lane & 31, hi = lane >> 5, wave = F.wave;
    for (int i = 0;; ++i) {
        const int U = i * F.G + (int)blockIdx.x; if (U >= NB * 128) break;
        const int b = U >> 7, tl = U & 127, tile = (i & 1) ? 127 - tl : tl;
        const int t0 = tile * 16; const size_t rowbase = (size_t)b * SEQ;
        if (t0 < 256) {
#pragma unroll
            for (int u = 0; u < 2; ++u) { const int t = t0 + 2 * wave + u;
                if (lane < 32) { const int nb = t + 1 - 64 * lane; const unsigned long long m = nb >= 64 ? ~0ull : (nb <= 0 ? 0ull : ((1ull << nb) - 1ull)); MASK[(rowbase + t) * 32 + lane] = m; } }
            continue;
        }
        if (F.tid < 128) wis[F.tid] = WI[(rowbase + t0) * 8 + F.tid];
        bf16x8 af[4][4];
        { const int m = r32, j = m & 3, hp = (m >> 2) & 1, ii = m >> 3, tokl = 2 * hp + (ii >> 1), head = 4 * (ii & 1) + j;
#pragma unroll
          for (int mt = 0; mt < 4; ++mt)
#pragma unroll
            for (int ks = 0; ks < 4; ++ks) af[mt][ks] = *(const bf16x8*)(QI + (rowbase + t0 + 4 * mt + tokl) * 512 + head * 64 + ks * 16 + hi * 8); }
        __syncthreads();
        const int n32 = (t0 + 16 + 31) >> 5;
        bf16x8 bnx[4];
        if (wave < n32) {
#pragma unroll
            for (int ks = 0; ks < 4; ++ks) bnx[ks] = *(const bf16x8*)(KI + (rowbase + wave * 32 + r32) * 64 + ks * 16 + hi * 8); }
        for (int kt = wave; kt < n32; kt += NWAVES) {
            const int key = kt * 32 + r32;
            bf16x8 bfr[4];
#pragma unroll
            for (int ks = 0; ks < 4; ++ks) bfr[ks] = bnx[ks];
            if (kt + NWAVES < n32) {
#pragma unroll
                for (int ks = 0; ks < 4; ++ks) bnx[ks] = *(const bf16x8*)(KI + (rowbase + key + NWAVES * 32) * 64 + ks * 16 + hi * 8); }
#pragma unroll
            for (int mt = 0; mt < 4; ++mt) {
                f32x16 acc = {};
#pragma unroll
                for (int ks = 0; ks < 4; ++ks) acc = __builtin_amdgcn_mfma_f32_32x32x16_bf16(af[mt][ks], bfr[ks], acc, 0, 0, 0);
#pragma unroll
                for (int u = 0; u < 2; ++u) { const int tk = 4 * mt + 2 * hi + u;
                    const f32x4 w0 = *(const LAS f32x4*)(wis + tk * 8), w1 = *(const LAS f32x4*)(wis + tk * 8 + 4);
                    float s = 0.f;
#pragma unroll
                    for (int h = 0; h < 4; ++h) { s += w0[h] * fmaxf(acc[8 * u + h], 0.f); }
#pragma unroll
                    for (int h = 0; h < 4; ++h) { s += w1[h] * fmaxf(acc[8 * u + 4 + h], 0.f); }
                    sc[tk * 2048 + key] = s + 0.f; }
            }
        }
        __syncthreads();
        { const int nq = ((t0 + 15) >> 6) + 1;
          if (nq <= 8) topk_select<8>(sc, MASK, rowbase, t0, wave, lane);
          else if (nq <= 16) topk_select<16>(sc, MASK, rowbase, t0, wave, lane);
          else if (nq <= 24) topk_select<24>(sc, MASK, rowbase, t0, wave, lane);
          else topk_select<32>(sc, MASK, rowbase, t0, wave, lane); }
        __syncthreads();
    }
}

typedef short v4i16_t __attribute__((ext_vector_type(4)));
__device__ __forceinline__ s16x4 vtr(const LAS unsigned char* p) { return __builtin_bit_cast(s16x4, __builtin_amdgcn_ds_read_tr16_b64_v4i16((LAS v4i16_t*)p)); }
template <bool MASKED>
__device__ __forceinline__ void attn_unit(Frame& F, const bf16_t* Qp, int qpitch, const bf16_t* Kp, const bf16_t* Vp, int kvpitch, int ntiles,
                                          const unsigned long long* maskp, bf16_t* Op, int opitch) {
    const int tid = F.tid, lane = F.lane, r32 = lane & 31, hi = lane >> 5, wave = F.wave;
    LAS unsigned char* lds = F.lds;
    bf16x8 qf[4];
#pragma unroll
    for (int ks = 0; ks < 4; ++ks) qf[ks] = *(const bf16x8*)(Qp + (size_t)(wave * 32 + r32) * qpitch + ks * 16 + hi * 8);
    const unsigned long long* mrow = maskp + (size_t)(wave * 32 + r32) * 32;
    const int kkey = tid & 63, kch = tid >> 6, vkey = tid >> 3, vpc = tid & 7;
    const bf16_t* ksrc = Kp + (size_t)kkey * kvpitch + kch * 8; const bf16_t* vsrc = Vp + (size_t)vkey * kvpitch + vpc * 8;
    const int kdst = kch * 1024 + kkey * 16, vdst = 8192 + (vpc >> 2) * 4096 + vkey * 64 + (vpc & 3) * 16;
    u32x4 kreg = *(const u32x4*)ksrc, vreg = *(const u32x4*)vsrc;
    *(LAS u32x4*)(lds + kdst) = kreg; *(LAS u32x4*)(lds + vdst) = vreg;
    __syncthreads();
    float m_run = 0.f, l_run = 0.f; bool started = false; f32x16 o0 = {}, o1 = {};
    constexpr float THR = 8.f, NEGBIG = -1e30f;
    const int vlane = ((lane >> 4) & 1) * 32 + (lane & 3) * 8 + (4 * hi + ((lane & 15) >> 2)) * 64;
    unsigned long long mw_next = ~0ull; if (MASKED) mw_next = mrow[0];
    for (int t = 0; t < ntiles; ++t) {
        const int cb = (t & 1) * 16384, nb = 16384 - cb;
        if (t + 1 < ntiles) { kreg = *(const u32x4*)(ksrc + (size_t)(t + 1) * 64 * kvpitch); vreg = *(const u32x4*)(vsrc + (size_t)(t + 1) * 64 * kvpitch); }
        const unsigned long long mw = mw_next; if (MASKED && t + 1 < ntiles) mw_next = mrow[t + 1];
        f32x16 p0, p1; const float negm = -m_run;
        if (MASKED) { const int lo = (int)((unsigned)mw >> (4 * hi)), hw = (int)((unsigned)(mw >> 32) >> (4 * hi));
            const int nb_ = __builtin_bit_cast(int, negm), ng_ = __builtin_bit_cast(int, NEGBIG);
#pragma unroll
            for (int r = 0; r < 16; ++r) { const unsigned pos = (r & 3) + 8 * (r >> 2);
                const int m0 = __builtin_amdgcn_sbfe(lo, pos, 1), m1 = __builtin_amdgcn_sbfe(hw, pos, 1);
                p0[r] = __builtin_bit_cast(float, __builtin_amdgcn_bitop3_b32(m0, nb_, ng_, 0xCA)); p1[r] = __builtin_bit_cast(float, __builtin_amdgcn_bitop3_b32(m1, nb_, ng_, 0xCA)); } }
        else {
#pragma unroll
            for (int r = 0; r < 16; ++r) { p0[r] = negm; p1[r] = negm; } }
#pragma unroll
        for (int ks = 0; ks < 4; ++ks) {
            const bf16x8 a0 = *(const LAS bf16x8*)(lds + cb + (2 * ks + hi) * 1024 + r32 * 16);
            const bf16x8 a1 = *(const LAS bf16x8*)(lds + cb + (2 * ks + hi) * 1024 + (32 + r32) * 16);
            p0 = __builtin_amdgcn_mfma_f32_32x32x16_bf16(a0, qf[ks], p0, 0, 0, 0);
            p1 = __builtin_amdgcn_mfma_f32_32x32x16_bf16(a1, qf[ks], p1, 0, 0, 0);
        }
        float rm;
        { float a = __builtin_fmaxf(__builtin_fmaxf(p0[0], p0[1]), p1[0]), b = __builtin_fmaxf(__builtin_fmaxf(p0[2], p0[3]), p1[1]); a = __builtin_fmaxf(__builtin_fmaxf(a, p1[2]), p1[3]);
#pragma unroll
          for (int r = 4; r < 16; r += 4) { a = __builtin_fmaxf(__builtin_fmaxf(a, p0[r]), p0[r + 1]); b = __builtin_fmaxf(__builtin_fmaxf(b, p0[r + 2]), p0[r + 3]); a = __builtin_fmaxf(__builtin_fmaxf(a, p1[r]), p1[r + 1]); b = __builtin_fmaxf(__builtin_fmaxf(b, p1[r + 2]), p1[r + 3]); }
          rm = __builtin_fmaxf(a, b);
          auto rr = __builtin_amdgcn_permlane32_swap(__float_as_uint(rm), __float_as_uint(rm), false, false); rm = __builtin_fmaxf(__uint_as_float(rr[0]), __uint_as_float(rr[1])); }
        const bool valid = rm > -1e29f, adj = (rm > THR) || (valid && !started);
        if (__any(adj)) {
            const float dl = adj ? rm : 0.f; m_run += dl;
#pragma unroll
            for (int r = 0; r < 16; ++r) { p0[r] -= dl; p1[r] -= dl; }
            const float alpha = started ? fast_exp2(-dl) : 1.f;
            l_run *= alpha;
#pragma unroll
            for (int r = 0; r < 16; ++r) { o0[r] *= alpha; o1[r] *= alpha; }
        }
        started = started || valid;
#pragma unroll
        for (int r = 0; r < 16; ++r) { p0[r] = fast_exp2(p0[r]); p1[r] = fast_exp2(p1[r]); }
        { f32x2 sa[8];
#pragma unroll
          for (int r = 0; r < 8; ++r) sa[r] = (f32x2){p0[2 * r], p0[2 * r + 1]} + (f32x2){p1[2 * r], p1[2 * r + 1]};
          const f32x2 sb = ((sa[0] + sa[1]) + (sa[2] + sa[3])) + ((sa[4] + sa[5]) + (sa[6] + sa[7]));
          l_run += sb.x + sb.y; }
        bf16x8 pw[2][2];
#pragma unroll
        for (int s = 0; s < 2; ++s) {
            u32x4 w; w.x = pg8::cvt_pk_bf16(p0[8 * s + 0], p0[8 * s + 1]); w.y = pg8::cvt_pk_bf16(p0[8 * s + 2], p0[8 * s + 3]); w.z = pg8::cvt_pk_bf16(p0[8 * s + 4], p0[8 * s + 5]); w.w = pg8::cvt_pk_bf16(p0[8 * s + 6], p0[8 * s + 7]);
            pw[0][s] = __builtin_bit_cast(bf16x8, w);
            u32x4 x; x.x = pg8::cvt_pk_bf16(p1[8 * s + 0], p1[8 * s + 1]); x.y = pg8::cvt_pk_bf16(p1[8 * s + 2], p1[8 * s + 3]); x.z = pg8::cvt_pk_bf16(p1[8 * s + 4], p1[8 * s + 5]); x.w = pg8::cvt_pk_bf16(p1[8 * s + 6], p1[8 * s + 7]);
            pw[1][s] = __builtin_bit_cast(bf16x8, x);
        }
        const LAS unsigned char* vb = lds + cb + 8192 + vlane;
#pragma unroll
        for (int kh = 0; kh < 2; ++kh)
#pragma unroll
            for (int s = 0; s < 2; ++s) {
                const int ko = (32 * kh + 16 * s) * 64;
                const s16x4 a_lo0 = vtr(vb + ko), a_hi0 = vtr(vb + ko + 512), a_lo1 = vtr(vb + 4096 + ko), a_hi1 = vtr(vb + 4096 + ko + 512);
                const bf16x8 A0 = (bf16x8){a_lo0[0], a_lo0[1], a_lo0[2], a_lo0[3], a_hi0[0], a_hi0[1], a_hi0[2], a_hi0[3]};
                const bf16x8 A1 = (bf16x8){a_lo1[0], a_lo1[1], a_lo1[2], a_lo1[3], a_hi1[0], a_hi1[1], a_hi1[2], a_hi1[3]};
                o0 = __builtin_amdgcn_mfma_f32_32x32x16_bf16(A0, pw[kh][s], o0, 0, 0, 0);
                o1 = __builtin_amdgcn_mfma_f32_32x32x16_bf16(A1, pw[kh][s], o1, 0, 0, 0);
            }
        if (t + 1 < ntiles) { *(LAS u32x4*)(lds + nb + kdst) = kreg; *(LAS u32x4*)(lds + nb + vdst) = vreg; }
        __syncthreads();
    }
    { auto rr = __builtin_amdgcn_permlane32_swap(__float_as_uint(l_run), __float_as_uint(l_run), false, false); l_run = __uint_as_float(rr[0]) + __uint_as_float(rr[1]); }
    const float inv = 1.f / l_run;
    bf16_t* orow = Op + (size_t)(wave * 32 + r32) * opitch;
#pragma unroll
    for (int rg = 0; rg < 4; ++rg) {
        u32x2 w0, w1;
        w0.x = pg8::cvt_pk_bf16(o0[4 * rg] * inv, o0[4 * rg + 1] * inv); w0.y = pg8::cvt_pk_bf16(o0[4 * rg + 2] * inv, o0[4 * rg + 3] * inv);
        w1.x = pg8::cvt_pk_bf16(o1[4 * rg] * inv, o1[4 * rg + 1] * inv); w1.y = pg8::cvt_pk_bf16(o1[4 * rg + 2] * inv, o1[4 * rg + 3] * inv);
        *(u32x2*)(orow + 8 * rg + 4 * hi) = w0; *(u32x2*)(orow + 32 + 8 * rg + 4 * hi) = w1;
    }
}
__device__ __forceinline__ void mem_attn_units(Frame& F, const bf16_t* QM, int layer, bf16_t* AO) {
    const bf16_t* KVM = (const bf16_t*)(F.ws + WS_KVM);
    for (int mu = blockIdx.x; mu < NB * 32; mu += F.G) {
        const int b = mu >> 5, hm = (mu >> 3) & 3, qb = mu & 7;
        const size_t row0 = (size_t)b * SEQ + qb * 256;
        attn_unit<false>(F, QM + row0 * 256 + hm * 64, 256, KVM + (size_t)b * NMEM * 1024 + layer * 512 + hm * 64, KVM + (size_t)b * NMEM * 1024 + layer * 512 + 256 + hm * 64, 1024, 4,
                         nullptr, AO + row0 * 1024 + 768 + hm * 64, 1024);
    }
}
__device__ __forceinline__ void p_attn_dsa(Frame& F) {
    const bf16_t* Q = (const bf16_t*)(F.ws + WS_Q); const bf16_t* K = (const bf16_t*)(F.ws + WS_K); const bf16_t* V = (const bf16_t*)(F.ws + WS_V);
    const unsigned long long* MASK = (const unsigned long long*)(F.ws + WS_MASK); bf16_t* AO = (bf16_t*)(F.ws + WS_AO0);
    for (int pu = blockIdx.x; pu < NB * 12 * 4; pu += F.G) {
        const int bh = pu >> 2, pr = pu & 3, b = bh / 12, h = bh % 12;
#pragma unroll 1
        for (int z = 0; z < 2; ++z) {
            const int qb = z ? 7 - pr : pr; const size_t rb = (size_t)b * SEQ, row0 = rb + qb * 256;
            attn_unit<true>(F, Q + row0 * 768 + h * 64, 768, K + rb * 768 + h * 64, V + rb * 768 + h * 64, 768, 4 * (qb + 1), MASK + row0 * 32, AO + row0 * 1024 + h * 64, 1024);
        }
    }
    mem_attn_units(F, (const bf16_t*)(F.ws + WS_QM), 0, AO);
}

template <bool RESID_F32>
__device__ __forceinline__ void p_ln1_router(Frame& F, const Args& a, int layer, const void* resid, bf16_t* X1b) {
    const bf16_t* MIX = (const bf16_t*)F.out;
    const float* g1 = (const float*)a.in[I_LN1G] + layer * 1024; const float* b1 = (const float*)a.in[I_LN1B] + layer * 1024;
    const float* wg = (const float*)a.in[I_MOE_WG] + (size_t)layer * 1024 * 4; const float* bg = (const float*)a.in[I_MOE_BG] + layer * 4;
    const float* wr = (const float*)a.in[I_MOE_WR] + (size_t)layer * 4 * 1024 * 8; const float* br = (const float*)a.in[I_MOE_BR] + layer * 32;
    unsigned* cnt = F.ctl + CW_CNT + layer * 2048;
    int* LISTTOK = (int*)(F.ws + WS_LISTTOK); float* LISTW = (float*)(F.ws + WS_LISTW); int* TOKSLOT = (int*)(F.ws + WS_TOKSLOT);
    const int lane = F.lane;
    LAS float* WR = (LAS float*)F.lds;
    for (int i = F.tid; i < 4 * 1024 * 2; i += 512) { const int g = i >> 11, k = (i & 2047) >> 1, hf = i & 1;
        const f32x4 w4 = *(const f32x4*)(wr + ((size_t)g * 1024 + k) * 8 + hf * 4);
#pragma unroll
        for (int c = 0; c < 4; ++c) WR[(g * 8 + hf * 4 + c) * 1024 + k] = w4[c]; }
    __syncthreads();
    f32x4 gv[4], bv[4], wgr[4][4];
#pragma unroll
    for (int j = 0; j < 4; ++j) { gv[j] = *((const f32x4*)g1 + lane + 64 * j); bv[j] = *((const f32x4*)b1 + lane + 64 * j);
#pragma unroll
        for (int c = 0; c < 4; ++c) wgr[j][c] = *(const f32x4*)(wg + (size_t)(256 * j + 4 * lane + c) * 4); }
    LAS int* cntL = (LAS int*)(F.lds + MISC_OFF + 512); LAS int* baseL = cntL + 32; LAS int* tokdat = (LAS int*)(F.lds + MISC_OFF + 1024);
    if (F.tid < 32) cntL[F.tid] = 0;
    __syncthreads();
    int nloc = 0;
    for (int tb = F.gw; tb < NT; tb += 2 * F.NGW) {
      f32x4 vv[2][4];
#pragma unroll
      for (int hh = 0; hh < 2; ++hh) { const int t = tb + hh * F.NGW; if (t < NT) {
        const u32x2* mr = (const u32x2*)(MIX + (size_t)t * DM) + lane;
#pragma unroll
        for (int j = 0; j < 4; ++j) {
            f32x4 xv;
            if (RESID_F32) xv = *((const f32x4*)((const float*)resid + (size_t)t * DM) + lane + 64 * j);
            else { const u32x2 p = *((const u32x2*)((const bf16_t*)resid + (size_t)t * DM) + lane + 64 * j); xv = (f32x4){bf2f(p.x & 0xffffu), bf2f(p.x >> 16), bf2f(p.y & 0xffffu), bf2f(p.y >> 16)}; }
            const u32x2 m = mr[64 * j];
            vv[hh][j] = xv * ALPHA + (f32x4){bf2f(m.x & 0xffffu), bf2f(m.x >> 16), bf2f(m.y & 0xffffu), bf2f(m.y >> 16)}; } } }
#pragma unroll
      for (int hh = 0; hh < 2; ++hh) { const int t = tb + hh * F.NGW; if (t >= NT) break;
        f32x4 v[4]; float s = 0.f;
#pragma unroll
        for (int j = 0; j < 4; ++j) { v[j] = vv[hh][j]; s += (v[j].x + v[j].y) + (v[j].z + v[j].w); }
        const float mean = wave_sum(s) * (1.f / DM); float s2 = 0.f;
#pragma unroll
        for (int j = 0; j < 4; ++j) { v[j] = v[j] - mean; s2 += (v[j].x * v[j].x + v[j].y * v[j].y) + (v[j].z * v[j].z + v[j].w * v[j].w); }
        const float rstd = 1.f / sqrtf(wave_sum(s2) * (1.f / DM) + LN_EPS);
        u32x2* ob = (u32x2*)(X1b + (size_t)t * DM) + lane;
#pragma unroll
        for (int j = 0; j < 4; ++j) { v[j] = v[j] * rstd * gv[j] + bv[j]; u32x2 w; w.x = pk2(v[j].x, v[j].y); w.y = pk2(v[j].z, v[j].w); ob[64 * j] = w; }
        float gl[4] = {0.f, 0.f, 0.f, 0.f};
#pragma unroll
        for (int j = 0; j < 4; ++j)
#pragma unroll
            for (int c = 0; c < 4; ++c)
#pragma unroll
                for (int k = 0; k < 4; ++k) gl[k] += v[j][c] * wgr[j][c][k];
#pragma unroll
        for (int k = 0; k < 4; ++k) gl[k] = wave_sum(gl[k]) + bg[k];
        int gsel = 0; float gmax = gl[0];
#pragma unroll
        for (int k = 1; k < 4; ++k) if (gl[k] > gmax) { gmax = gl[k]; gsel = k; }
        float gs = 0.f;
#pragma unroll
        for (int k = 0; k < 4; ++k) gs += __expf(gl[k] - gmax);
        const float pg = 1.f / gs;
        gsel = __builtin_amdgcn_readfirstlane(gsel);
        const LAS float* wrg = WR + gsel * 8 * 1024 + 4 * lane;
        float el[8];
#pragma unroll
        for (int e = 0; e < 8; ++e) { float acc = 0.f;
#pragma unroll
            for (int j = 0; j < 4; ++j) { const f32x4 w4 = *(const LAS f32x4*)(wrg + e * 1024 + 256 * j); acc += (v[j].x * w4.x + v[j].y * w4.y) + (v[j].z * w4.z + v[j].w * w4.w); }
            el[e] = wave_sum(acc) + br[gsel * 8 + e]; }
        int i1 = 0; float v1 = el[0];
#pragma unroll
        for (int k = 1; k < 8; ++k) if (el[k] > v1) { v1 = el[k]; i1 = k; }
        int i2 = -1; float v2 = -INFINITY;
#pragma unroll
        for (int k = 0; k < 8; ++k) if (k != i1 && (i2 < 0 || el[k] > v2)) { v2 = el[k]; i2 = k; }
        const float e2 = __expf(v2 - v1); const float wt1 = pg / (1.f + e2), wt2 = pg * e2 / (1.f + e2);
        if (lane == 0) {
            const int ge1 = gsel * 8 + i1, ge2 = gsel * 8 + i2;
            const int l1 = __hip_atomic_fetch_add(&cntL[ge1], 1, __ATOMIC_RELAXED, __HIP_MEMORY_SCOPE_WORKGROUP), l2 = __hip_atomic_fetch_add(&cntL[ge2], 1, __ATOMIC_RELAXED, __HIP_MEMORY_SCOPE_WORKGROUP);
            LAS int* td = tokdat + (nloc * NWAVES + F.wave) * 8;
            td[0] = t; td[1] = ge1; td[2] = l1; td[3] = __float_as_int(wt1); td[4] = ge2; td[5] = l2; td[6] = __float_as_int(wt2);
        }
        ++nloc;
      }
    }
    __syncthreads();
    if (F.tid < 32) { const int n = cntL[F.tid]; baseL[F.tid] = n ? (int)atomicAdd(&cnt[F.tid * 64], (unsigned)n) : 0; }
    __syncthreads();
    for (int i = F.tid; i < nloc * NWAVES; i += 512) {
        const LAS int* td = tokdat + i * 8; const int t = td[0], ge1 = td[1], ge2 = td[4]; const int p1 = baseL[ge1] + td[2], p2 = baseL[ge2] + td[5];
        LISTTOK[(size_t)ge1 * NT + p1] = t; LISTW[(size_t)ge1 * NT + p1] = __int_as_float(td[3]);
        LISTTOK[(size_t)ge2 * NT + p2] = t; LISTW[(size_t)ge2 * NT + p2] = __int_as_float(td[6]);
        *(int4*)(TOKSLOT + (size_t)t * 4) = make_int4(ge1, p1, ge2, p2);
    }
}
template <bool OUT_F32>
__device__ __forceinline__ void p_ln2(Frame& F, const Args& a, int layer, const bf16_t* X1b, void* dst) {
    const bf16_t* Y = (const bf16_t*)(F.ws + WS_Y); const int* TOKSLOT = (const int*)(F.ws + WS_TOKSLOT);
    const float* g2 = (const float*)a.in[I_LN2G] + layer * 1024; const float* b2 = (const float*)a.in[I_LN2B] + layer * 1024;
    LAS int* tp = (LAS int*)(F.lds + MISC_OFF + 256);
    moe_tile_table(F, F.ctl + CW_CNT + layer * 2048, tp);
    const int lane = F.lane;
    f32x4 gv[4], bv[4];
#pragma unroll
    for (int j = 0; j < 4; ++j) { gv[j] = *((const f32x4*)g2 + lane + 64 * j); bv[j] = *((const f32x4*)b2 + lane + 64 * j); }
    for (int tb = F.gw; tb < NT; tb += 2 * F.NGW) {
      f32x4 vv[2][4];
#pragma unroll
      for (int hh = 0; hh < 2; ++hh) { const int t = tb + hh * F.NGW; if (t < NT) {
        const int4 ts = *(const int4*)(TOKSLOT + (size_t)t * 4);
        const size_t s0 = (size_t)tp[ts.x] * 256 + ts.y, s1 = (size_t)tp[ts.z] * 256 + ts.w;
        const u32x2* xr = (const u32x2*)(X1b + (size_t)t * DM) + lane;
        const u32x2* y0 = (const u32x2*)(Y + s0 * DM) + lane; const u32x2* y1 = (const u32x2*)(Y + s1 * DM) + lane;
#pragma unroll
        for (int j = 0; j < 4; ++j) { const u32x2 p = y0[64 * j], q = y1[64 * j], x = xr[64 * j];
            f32x4 yy; yy.x = bf2f(p.x & 0xffffu) + bf2f(q.x & 0xffffu); yy.y = bf2f(p.x >> 16) + bf2f(q.x >> 16); yy.z = bf2f(p.y & 0xffffu) + bf2f(q.y & 0xffffu); yy.w = bf2f(p.y >> 16) + bf2f(q.y >> 16);
            vv[hh][j] = (f32x4){bf2f(x.x & 0xffffu), bf2f(x.x >> 16), bf2f(x.y & 0xffffu), bf2f(x.y >> 16)} * ALPHA + yy; } } }
#pragma unroll
      for (int hh = 0; hh < 2; ++hh) { const int t = tb + hh * F.NGW; if (t >= NT) break;
        f32x4 v[4]; float s = 0.f;
#pragma unroll
        for (int j = 0; j < 4; ++j) { v[j] = vv[hh][j]; s += (v[j].x + v[j].y) + (v[j].z + v[j].w); }
        const float mean = wave_sum(s) * (1.f / DM); float s2 = 0.f;
#pragma unroll
        for (int j = 0; j < 4; ++j) { v[j] = v[j] - mean; s2 += (v[j].x * v[j].x + v[j].y * v[j].y) + (v[j].z * v[j].z + v[j].w * v[j].w); }
        const float rstd = 1.f / sqrtf(wave_sum(s2) * (1.f / DM) + LN_EPS);
#pragma unroll
        for (int j = 0; j < 4; ++j) v[j] = v[j] * rstd * gv[j] + bv[j];
        if (OUT_F32) { f32x4* o4 = (f32x4*)((float*)dst + (size_t)t * DM) + lane;
#pragma unroll
            for (int j = 0; j < 4; ++j) o4[64 * j] = v[j]; }
        else { u32x2* ob = (u32x2*)((bf16_t*)dst + (size_t)t * DM) + lane;
#pragma unroll
            for (int j = 0; j < 4; ++j) { u32x2 w; w.x = pk2(v[j].x, v[j].y); w.y = pk2(v[j].z, v[j].w); ob[64 * j] = w; } }
      }
    }
}

__device__ __forceinline__ bf16x8 pack8(f32x4 lo, f32x4 hi) { u32x4 w; w.x = pg8::cvt_pk_bf16(lo[0], lo[1]); w.y = pg8::cvt_pk_bf16(lo[2], lo[3]); w.z = pg8::cvt_pk_bf16(hi[0], hi[1]); w.w = pg8::cvt_pk_bf16(hi[2], hi[3]); return __builtin_bit_cast(bf16x8, w); }
constexpr int GLA_QP = 208, GLA_VP = 400;
constexpr int GL_WGS = 0, GL_BGS = 6144, GL_Q = 8192, GL_K = 8192 + 13312, GL_V = 8192 + 2 * 13312, GL_ST = GL_V + 25600;
__device__ __forceinline__ void gla_gates(const float* a1row, const LAS float* wgs, const LAS float* bgs, int w, int lane, float (&bq)[12], float (&bl)[12]) {
    f32x4 av[4];
#pragma unroll
    for (int r = 0; r < 4; ++r) av[r] = *(const f32x4*)(a1row + 4 * r);
#pragma unroll
    for (int k = 0; k < 12; ++k) {
        const int d = 12 * w + k; float z = bgs[d];
#pragma unroll
        for (int r = 0; r < 16; ++r) z += av[r >> 2][r & 3] * wgs[r * 96 + d];
        float g = (fminf(z, 0.f) - __logf(1.f + __expf(-fabsf(z)))) * (1.f / 16.f);
#pragma unroll
        for (int o = 1; o < 64; o <<= 1) { const float t = __shfl_up(g, o); if (lane >= o) g += t; }
        bq[k] = g; bl[k] = __shfl(g, 63);
    }
}
__device__ __forceinline__ void gla_stage_common(Frame& F, const Args& a, int h, size_t row0) {
    const float* wgate = (const float*)a.in[I_GLA_WGATE]; const float* bgate = (const float*)a.in[I_GLA_BGATE];
    const bf16_t* GV = (const bf16_t*)(F.ws + WS_GV);
    LAS float* wgs = (LAS float*)(F.lds + GL_WGS); LAS float* bgs = (LAS float*)(F.lds + GL_BGS);
    const int tid = F.tid;
    if (tid < 384) { const int r = tid / 24, d4 = (tid % 24) * 4; *(LAS f32x4*)(wgs + r * 96 + d4) = *(const f32x4*)(wgate + r * 384 + h * 96 + d4); }
    if (tid < 96) bgs[tid] = bgate[h * 96 + tid];
#pragma unroll
    for (int i = 0; i < 3; ++i) { const int p = tid + 512 * i, row = p / 24, pc = p % 24;
        *(LAS u32x4*)(F.lds + GL_V + row * GLA_VP + pc * 16) = *(const u32x4*)(GV + (row0 + row) * 768 + h * 192 + pc * 8); }
}
__device__ __forceinline__ bf16x8 tr2(const LAS unsigned char* p0, const LAS unsigned char* p1) { const s16x4 a = vtr(p0), b = vtr(p1); return (bf16x8){a[0], a[1], a[2], a[3], b[0], b[1], b[2], b[3]}; }
__device__ __forceinline__ u32x2 pack4(f32x4 v) { u32x2 w; w.x = pg8::cvt_pk_bf16(v[0], v[1]); w.y = pg8::cvt_pk_bf16(v[2], v[3]); return w; }
__device__ __forceinline__ void p_gla_u(Frame& F, const Args& a) {
    const bf16_t* GK = (const bf16_t*)(F.ws + WS_GK); const float* A1 = (const float*)(F.ws + WS_A1);
    u32x2* UF = (u32x2*)F.out; float* DEC = (float*)(F.ws + WS_DEC);
    const int lane = F.lane, w = F.wave, fq = lane >> 4, qq = (lane & 15) >> 2, pp = lane & 3;
    for (int U = blockIdx.x; U < NB * 4 * 32; U += F.G) {
        const int c = U & 31, h = (U >> 5) & 3, b = U >> 7; const size_t row0 = (size_t)b * SEQ + c * 64;
        gla_stage_common(F, a, h, row0);
        u32x2 kpre[3];
        { const u32x2* kp = (const u32x2*)(GK + (row0 + lane) * 384 + h * 96 + 12 * w);
#pragma unroll
          for (int i = 0; i < 3; ++i) kpre[i] = kp[i]; }
        __syncthreads();
        float bq[12], bl[12];
        gla_gates(A1 + (row0 + lane) * 16, (const LAS float*)(F.lds + GL_WGS), (const LAS float*)(F.lds + GL_BGS), w, lane, bq, bl);
        {
#pragma unroll
          for (int i = 0; i < 3; ++i) { const u32x2 kv = kpre[i]; f32x4 o;
              o[0] = bf2f(kv.x & 0xffffu) * __expf(bl[4 * i] - bq[4 * i]); o[1] = bf2f(kv.x >> 16) * __expf(bl[4 * i + 1] - bq[4 * i + 1]);
              o[2] = bf2f(kv.y & 0xffffu) * __expf(bl[4 * i + 2] - bq[4 * i + 2]); o[3] = bf2f(kv.y >> 16) * __expf(bl[4 * i + 3] - bq[4 * i + 3]);
              *(LAS u32x2*)(F.lds + GL_K + lane * GLA_QP + (12 * w + 4 * i) * 2) = pack4(o); } }
        if (lane == 0) {
#pragma unroll
            for (int i = 0; i < 3; ++i) *(f32x4*)(DEC + (size_t)U * 96 + 12 * w + 4 * i) = (f32x4){__expf(bl[4 * i]), __expf(bl[4 * i + 1]), __expf(bl[4 * i + 2]), __expf(bl[4 * i + 3])}; }
        __syncthreads();
        const int dt0 = 3 * (w >> 2), et0 = 3 * (w & 3);
        bf16x8 af[3][2], bfv[3][2];
#pragma unroll
        for (int ks = 0; ks < 2; ++ks) { const int prow = 32 * ks + 8 * fq + qq;
#pragma unroll
            for (int i = 0; i < 3; ++i) {
                const LAS unsigned char* ka = F.lds + GL_K + prow * GLA_QP + (16 * (dt0 + i) + 4 * pp) * 2; af[i][ks] = tr2(ka, ka + 4 * GLA_QP);
                const LAS unsigned char* va = F.lds + GL_V + prow * GLA_VP + (16 * (et0 + i) + 4 * pp) * 2; bfv[i][ks] = tr2(va, va + 4 * GLA_VP); } }
#pragma unroll
        for (int i = 0; i < 3; ++i)
#pragma unroll
            for (int j = 0; j < 3; ++j) { f32x4 acc = (f32x4){0.f, 0.f, 0.f, 0.f};
#pragma unroll
                for (int ks = 0; ks < 2; ++ks) acc = __builtin_amdgcn_mfma_f32_16x16x32_bf16(af[i][ks], bfv[j][ks], acc, 0, 0, 0);
                UF[((size_t)U * 72 + (dt0 + i) * 12 + (et0 + j)) * 64 + lane] = pack4(acc); }
        __syncthreads();
    }
}
__device__ __forceinline__ void p_gla_scan(Frame& F) {
    u32x2* UF = (u32x2*)F.out; const float* DEC = (const float*)(F.ws + WS_DEC);
    for (int idx = blockIdx.x * 512 + F.tid; idx < 64 * 72 * 64; idx += F.G * 512) {
        const int bh = idx / 4608, rem = idx % 4608, tile = rem >> 6, ln = rem & 63, dt = tile / 12, fq = ln >> 4;
        f32x4 S = (f32x4){0.f, 0.f, 0.f, 0.f};
        u32x2* p = UF + ((size_t)bh * 32 * 72 + tile) * 64 + ln; const float* dp = DEC + (size_t)bh * 32 * 96 + 16 * dt + 4 * fq;
#pragma unroll 8
        for (int c = 0; c < 32; ++c) {
            const u32x2 u = *p; const f32x4 dc = *(const f32x4*)dp;
            *p = pack4(S);
            S[0] = S[0] * dc[0] + bf2f(u.x & 0xffffu); S[1] = S[1] * dc[1] + bf2f(u.x >> 16); S[2] = S[2] * dc[2] + bf2f(u.y & 0xffffu); S[3] = S[3] * dc[3] + bf2f(u.y >> 16);
            p += 72 * 64; dp += 96; }
    }
}
__device__ __forceinline__ void p_gla_out(Frame& F, const Args& a) {
    const bf16_t* GQ = (const bf16_t*)(F.ws + WS_GQ); const bf16_t* GK = (const bf16_t*)(F.ws + WS_GK); const bf16_t* GR = (const bf16_t*)(F.ws + WS_GR); const float* A1 = (const float*)(F.ws + WS_A1);
    const u32x2* SF = (const u32x2*)F.out; bf16_t* AO = (bf16_t*)(F.ws + WS_AO1); const float* ng = (const float*)a.in[I_GLA_NORMG];
    const int lane = F.lane, w = F.wave, li = lane & 15, fq = lane >> 4, qq = li >> 2, pp = lane & 3;
    LAS float* stats = (LAS float*)(F.lds + GL_ST);
    for (int U = blockIdx.x; U < NB * 4 * 32; U += F.G) {
        const int c = U & 31, h = (U >> 5) & 3, b = U >> 7; const size_t row0 = (size_t)b * SEQ + c * 64;
        gla_stage_common(F, a, h, row0);
        const int ip = w >> 2, et0 = 3 * (w & 3);
        u32x2 sfr[3][3][2]; bf16_t grv[2][4][3];
#pragma unroll
        for (int eti = 0; eti < 3; ++eti)
#pragma unroll
            for (int sx = 0; sx < 3; ++sx) { sfr[eti][sx][0] = SF[((size_t)U * 72 + (2 * sx) * 12 + et0 + eti) * 64 + lane]; sfr[eti][sx][1] = SF[((size_t)U * 72 + (2 * sx + 1) * 12 + et0 + eti) * 64 + lane]; }
#pragma unroll
        for (int iti = 0; iti < 2; ++iti)
#pragma unroll
            for (int r = 0; r < 4; ++r)
#pragma unroll
                for (int eti = 0; eti < 3; ++eti) grv[iti][r][eti] = GR[(row0 + 16 * (2 * ip + iti) + 4 * fq + r) * 768 + h * 192 + 16 * (et0 + eti) + li];
        __syncthreads();
        { float bq[12], bl[12];
          gla_gates(A1 + (row0 + lane) * 16, (const LAS float*)(F.lds + GL_WGS), (const LAS float*)(F.lds + GL_BGS), w, lane, bq, bl);
          const u32x2* qp = (const u32x2*)(GQ + (row0 + lane) * 384 + h * 96 + 12 * w); const u32x2* kp = (const u32x2*)(GK + (row0 + lane) * 384 + h * 96 + 12 * w);
#pragma unroll
          for (int i = 0; i < 3; ++i) { const u32x2 qv = qp[i], kv = kp[i]; f32x4 oq, ok;
              const float e0 = __expf(bq[4 * i]), e1 = __expf(bq[4 * i + 1]), e2 = __expf(bq[4 * i + 2]), e3 = __expf(bq[4 * i + 3]);
              oq[0] = bf2f(qv.x & 0xffffu) * e0; oq[1] = bf2f(qv.x >> 16) * e1; oq[2] = bf2f(qv.y & 0xffffu) * e2; oq[3] = bf2f(qv.y >> 16) * e3;
              ok[0] = bf2f(kv.x & 0xffffu) * __builtin_amdgcn_rcpf(e0); ok[1] = bf2f(kv.x >> 16) * __builtin_amdgcn_rcpf(e1); ok[2] = bf2f(kv.y & 0xffffu) * __builtin_amdgcn_rcpf(e2); ok[3] = bf2f(kv.y >> 16) * __builtin_amdgcn_rcpf(e3);
              *(LAS u32x2*)(F.lds + GL_Q + lane * GLA_QP + (12 * w + 4 * i) * 2) = pack4(oq);
              *(LAS u32x2*)(F.lds + GL_K + lane * GLA_QP + (12 * w + 4 * i) * 2) = pack4(ok); } }
        __syncthreads();
        f32x4 o[2][3]; float ssq[2][4];
#pragma unroll
        for (int iti = 0; iti < 2; ++iti) {
            const int it = 2 * ip + iti;
            const LAS unsigned char* qrow = F.lds + GL_Q + (16 * it + li) * GLA_QP;
            bf16x8 qB[3], qA[3];
#pragma unroll
            for (int ks = 0; ks < 3; ++ks) { qB[ks] = *(const LAS bf16x8*)(qrow + (32 * ks + 8 * fq) * 2);
                const u32x2 x0 = *(const LAS u32x2*)(qrow + (32 * ks + 4 * fq) * 2), x1 = *(const LAS u32x2*)(qrow + (32 * ks + 16 + 4 * fq) * 2);
                u32x4 x; x.x = x0.x; x.y = x0.y; x.z = x1.x; x.w = x1.y; qA[ks] = __builtin_bit_cast(bf16x8, x); }
            f32x4 tl[4];
#pragma unroll
            for (int jt = 0; jt < 4; ++jt) {
                tl[jt] = (f32x4){0.f, 0.f, 0.f, 0.f};
                if (jt <= it) {
                    const LAS unsigned char* krow = F.lds + GL_K + (16 * jt + li) * GLA_QP;
#pragma unroll
                    for (int ks = 0; ks < 3; ++ks) tl[jt] = __builtin_amdgcn_mfma_f32_16x16x32_bf16(*(const LAS bf16x8*)(krow + (32 * ks + 8 * fq) * 2), qB[ks], tl[jt], 0, 0, 0);
                    if (jt == it) {
#pragma unroll
                        for (int r = 0; r < 4; ++r) if (4 * fq + r > li) tl[jt][r] = 0.f; }
                }
            }
            bf16x8 am[2]; am[0] = pack8(tl[0], tl[1]); am[1] = pack8(tl[2], tl[3]);
#pragma unroll
            for (int eti = 0; eti < 3; ++eti) {
                const int et = et0 + eti;
                f32x4 acc = (f32x4){0.f, 0.f, 0.f, 0.f};
#pragma unroll
                for (int s2 = 0; s2 < 2; ++s2) if (2 * s2 <= it) {
                    const LAS unsigned char* va = F.lds + GL_V + (32 * s2 + 4 * fq + qq) * GLA_VP + (16 * et + 4 * pp) * 2;
                    acc = __builtin_amdgcn_mfma_f32_16x16x32_bf16(am[s2], tr2(va, va + 16 * GLA_VP), acc, 0, 0, 0); }
#pragma unroll
                for (int s = 0; s < 3; ++s) {
                    const u32x2 s0 = sfr[eti][s][0], s1 = sfr[eti][s][1];
                    u32x4 x; x.x = s0.x; x.y = s0.y; x.z = s1.x; x.w = s1.y;
                    acc = __builtin_amdgcn_mfma_f32_16x16x32_bf16(qA[s], __builtin_bit_cast(bf16x8, x), acc, 0, 0, 0); }
                o[iti][eti] = acc;
            }
#pragma unroll
            for (int r = 0; r < 4; ++r) { float q2 = o[iti][0][r] * o[iti][0][r] + o[iti][1][r] * o[iti][1][r] + o[iti][2][r] * o[iti][2][r];
                q2 += __shfl_xor(q2, 1); q2 += __shfl_xor(q2, 2); q2 += __shfl_xor(q2, 4); q2 += __shfl_xor(q2, 8); ssq[iti][r] = q2; }
            if (li == 0) {
#pragma unroll
                for (int r = 0; r < 4; ++r) stats[(16 * it + 4 * fq + r) * 4 + (w & 3)] = ssq[iti][r]; }
        }
        __syncthreads();
#pragma unroll
        for (int iti = 0; iti < 2; ++iti) { const int it = 2 * ip + iti;
#pragma unroll
            for (int r = 0; r < 4; ++r) { const int rl = 16 * it + 4 * fq + r; const f32x4 st = *(const LAS f32x4*)(stats + rl * 4);
                const float rs = 1.f / sqrtf(((st[0] + st[1]) + (st[2] + st[3])) * (1.f / 192.f) + RMS_EPS);
#pragma unroll
                for (int eti = 0; eti < 3; ++eti) { const int e = 16 * (et0 + eti) + li;
                    const float rr = bf2f(grv[iti][r][eti]);
                    AO[(row0 + rl) * 1024 + h * 192 + e] = (bf16_t)f2bf(o[iti][eti][r] * rs * ng[e] * silu_f(rr)); } } }
        __syncthreads();
    }
}
constexpr int NPHASE = 19;
__device__ __forceinline__ int opaque_int(int v) { asm volatile("" : "+s"(v)); return v; }
#define GEMM_CALL(EpiT, SchedT, g, S, E) pg8::gemm_phase<EpiT, SchedT, true, true>(F.lds, g, S, E)
__device__ __forceinline__ void moe_gemms_up(Frame& F, int layer, const bf16_t* X1b, bf16_t* ACT) {
    LAS int* tp = (LAS int*)(F.lds + MISC_OFF + 256);
    const unsigned* cnt = F.ctl + CW_CNT + layer * 2048;
    moe_tile_table(F, cnt, tp);
    pg8::Gemm g{X1b, (const bf16_t*)(F.ws + WS_W13), SLOT_ROWS, 512, 1024};
    MoeOrder S{tp, cnt, (const int*)(F.ws + WS_LISTTOK), 2, F.G, (int)blockIdx.x, true};
    EpiMoe1 E{ACT, (const float*)(F.ws + WS_LISTW), cnt};
    GEMM_CALL(EpiMoe1, MoeOrder, g, S, E);
}
__device__ __forceinline__ void moe_gemms_down(Frame& F, int layer, const bf16_t* ACT) {
    LAS int* tp = (LAS int*)(F.lds + MISC_OFF + 256);
    const unsigned* cnt = F.ctl + CW_CNT + layer * 2048;
    moe_tile_table(F, cnt, tp);
    pg8::Gemm g{ACT, (const bf16_t*)(F.ws + WS_W2), SLOT_ROWS, 1024, 256};
    MoeOrder S{tp, cnt, nullptr, 4, F.G, (int)blockIdx.x, false};
    EpiBf16Plain E{(bf16_t*)(F.ws + WS_Y), 1024, 3};
    GEMM_CALL(EpiBf16Plain, MoeOrder, g, S, E);
}
__device__ __forceinline__ void out_proj(Frame& F, int layer, const bf16_t* AO) {
    pg8::Gemm g{AO, (const bf16_t*)(F.ws + WS_WO) + (size_t)layer * 1024 * 1024, NT, 1024, 1024};
    pg8::StaticOrder S; S.init(NT, 1024, F.G, (int)blockIdx.x);
    EpiBf16Plain E{(bf16_t*)F.out, 1024, 0x7fffffff};
    GEMM_CALL(EpiBf16Plain, pg8::StaticOrder, g, S, E);
}

__global__ void __launch_bounds__(NWAVES * 64, 2) mk_fwd(Args args) {
    extern __shared__ __attribute__((aligned(16))) unsigned char lds_raw[];
    Frame F;
    F.lds = (LAS unsigned char*)lds_raw; F.ws = args.ws; F.out = args.out; F.ctl = (unsigned*)(args.ws + WS_CTL);
    F.tid = threadIdx.x; F.lane = F.tid & 63; F.wave = __builtin_amdgcn_readfirstlane(F.tid >> 6); F.G = gridDim.x;
    F.gw = blockIdx.x * NWAVES + F.wave; F.NGW = F.G * NWAVES;
    volatile LAS unsigned* MISC = (volatile LAS unsigned*)(F.lds + MISC_OFF);
    if (F.tid < 64) MISC[F.tid] = 0u;
    __syncthreads();
#if N_LAUNCH_MODE == 1
    XcdBarrier bar = xcd_barrier_post(F.ctl + CW_BAR, MISC + 8);
#define SEAM() xcd_barrier(bar)
#else
#define SEAM() do {} while (0)
#endif
    const int lo = args.ph_lo, hi = args.ph_hi;
#ifndef PH_ENABLE
#define PH_ENABLE 0xFFFFFFFFu
#endif
#define IN(k) (((PH_ENABLE >> (k)) & 1u) && lo <= (k) && (k) < hi)
#define ENDPH(k) do { if (IN((k) + 1)) SEAM(); } while (0)
#ifndef REP_MASK
#define REP_MASK 0u
#endif
#define REPS(k) _Pragma("unroll 1") for (int rep_ = 0, nrep_ = ((REP_MASK >> (k)) & 1u) ? opaque_int(2) : 1; rep_ < nrep_; ++rep_)
#define REPSEAM(k) do { if ((REP_MASK >> (k)) & 1u) { if (rep_ == 0) SEAM(); } } while (0)

    if (IN(0)) REPS(0) { p_prologue(F, args); ENDPH(0); }
    if (IN(1)) REPS(1) {
        { pg8::Gemm g{(const bf16_t*)F.ws, (const bf16_t*)F.ws, NT, ND, 1024};
          DsaKvmOrder S; S.init(F.G, (int)blockIdx.x);
          EpiDsaKvm E{{(bf16_t*)(F.ws + WS_Q), (bf16_t*)(F.ws + WS_K), (bf16_t*)(F.ws + WS_V), (bf16_t*)(F.ws + WS_QI), (bf16_t*)(F.ws + WS_QM), (bf16_t*)(F.ws + WS_KI), (float*)(F.ws + WS_WI),
                       (const float*)(F.ws + WS_ROPEC), (const float*)(F.ws + WS_ROPES), (const float*)args.in[I_DSA_KG], (const float*)args.in[I_DSA_KB], F.lds + MISC_OFF + 8192}, {(bf16_t*)(F.ws + WS_KVM), 1024, 0x7fffffff}};
          GEMM_CALL(EpiDsaKvm, DsaKvmOrder, g, S, E); }
        ENDPH(1);
    }
    if (IN(3)) REPS(3) { p_indexer(F); ENDPH(3); }
    if (IN(4)) REPS(4) { p_attn_dsa(F); ENDPH(4); }
    if (IN(5)) REPS(5) { out_proj(F, 0, (const bf16_t*)(F.ws + WS_AO0)); ENDPH(5); }
    if (IN(6)) { p_ln1_router<true>(F, args, 0, args.in[I_X], (bf16_t*)(F.ws + WS_X1B0)); ENDPH(6); }
    if (IN(7)) REPS(7) { moe_gemms_up(F, 0, (const bf16_t*)(F.ws + WS_X1B0), (bf16_t*)(F.ws + WS_ACT0)); ENDPH(7); }
    if (IN(8)) REPS(8) { moe_gemms_down(F, 0, (const bf16_t*)(F.ws + WS_ACT0)); ENDPH(8); }
    if (IN(9)) { p_ln2<false>(F, args, 0, (const bf16_t*)(F.ws + WS_X1B0), F.ws + WS_C);
                 moe_weight_items(F, (const float*)args.in[I_MOE_W13], (const float*)args.in[I_MOE_W2], 1); ENDPH(9); }
    if (IN(10)) {
        pg8::Gemm g{(const bf16_t*)(F.ws + WS_C), (const bf16_t*)(F.ws + WS_WG), NT, NG, 1024};
        pg8::StaticOrder S; S.init(NT, NG, F.G, (int)blockIdx.x);
        EpiGlaProj E{(bf16_t*)(F.ws + WS_GQ), (bf16_t*)(F.ws + WS_GK), (bf16_t*)(F.ws + WS_GV), (bf16_t*)(F.ws + WS_GR), (bf16_t*)(F.ws + WS_GQM), (float*)(F.ws + WS_A1)};
        GEMM_CALL(EpiGlaProj, pg8::StaticOrder, g, S, E);
#if defined(PROBE_DUP10)
        SEAM(); GEMM_CALL(EpiGlaProj, pg8::StaticOrder, g, S, E);
#endif
        ENDPH(10);
    }
    if (IN(11)) REPS(11) { p_gla_u(F, args); ENDPH(11); }
    if (IN(12)) { p_gla_scan(F); ENDPH(12); }
    if (IN(13)) REPS(13) { p_gla_out(F, args); mem_attn_units(F, (const bf16_t*)(F.ws + WS_GQM), 1, (bf16_t*)(F.ws + WS_AO1)); ENDPH(13); }
    if (IN(14)) REPS(14) { out_proj(F, 1, (const bf16_t*)(F.ws + WS_AO1)); ENDPH(14); }
    if (IN(15)) { p_ln1_router<false>(F, args, 1, F.ws + WS_C, (bf16_t*)(F.ws + WS_X1B1)); ENDPH(15); }
    if (IN(16)) REPS(16) { moe_gemms_up(F, 1, (const bf16_t*)(F.ws + WS_X1B1), (bf16_t*)(F.ws + WS_ACT1)); ENDPH(16); }
    if (IN(17)) REPS(17) { moe_gemms_down(F, 1, (const bf16_t*)(F.ws + WS_ACT1)); ENDPH(17); }
    if (IN(18)) REPS(18) { p_ln2<true>(F, args, 1, (const bf16_t*)(F.ws + WS_X1B1), F.out); }
#undef IN
#undef ENDPH
}

extern "C" void kernel_launch(void* const* d_in, const int* in_sizes, int n_in, void* d_out, int out_size, void* d_ws, size_t ws_size, hipStream_t stream) {
    static int grid = 0;
    if (grid == 0) {
        if (n_in != 22 || out_size != NT * DM || ws_size < WS_END) { fprintf(stderr, "kernel_launch: unexpected shapes: n_in %d out %d ws %zu (need %zu)\n", n_in, out_size, ws_size, (size_t)WS_END); grid = -1; return; }
        int dev = 0, cus = 0, per_cu = 0;
        if (hipGetDevice(&dev) != hipSuccess || hipDeviceGetAttribute(&cus, hipDeviceAttributeMultiprocessorCount, dev) != hipSuccess) { grid = -1; return; }
        if (hipFuncSetAttribute((const void*)mk_fwd, hipFuncAttributeMaxDynamicSharedMemorySize, LDS_BYTES) != hipSuccess) { fprintf(stderr, "kernel_launch: hipFuncSetAttribute failed\n"); grid = -1; return; }
        if (hipOccupancyMaxActiveBlocksPerMultiprocessor(&per_cu, (const void*)mk_fwd, NWAVES * 64, LDS_BYTES) != hipSuccess || per_cu < 1) fprintf(stderr, "kernel_launch: occupancy query reports %d\n", per_cu);
        (void)hipGetLastError();
        grid = cus;
    }
    if (grid < 0) return;
    (void)hipMemsetAsync((char*)d_ws + WS_CTL, 0, CTL_ZERO_BYTES, stream);
    Args a{};
    for (int i = 0; i < 22; ++i) a.in[i] = d_in[i];
    a.out = (float*)d_out; a.ws = (unsigned char*)d_ws;
#if N_LAUNCH_MODE == 1
    a.ph_lo = 0; a.ph_hi = NPHASE;
    hipLaunchKernelGGL(mk_fwd, dim3(grid), dim3(NWAVES * 64), LDS_BYTES, stream, a);
#else
    for (int k = 0; k < NPHASE; ++k) { a.ph_lo = k; a.ph_hi = k + 1; hipLaunchKernelGGL(mk_fwd, dim3(grid), dim3(NWAVES * 64), LDS_BYTES, stream, a); }
#endif
}
```
